# Optimizing an MI355X kernel written in HIP

```python
import math
import jax, jax.numpy as jnp
from jax import lax
import numpy as np

D_MODEL = 1024
BATCH = 1
SEQ = 16384
DEPTH = 1

HEAD_DIM = 64
A_HEADS = 8
A_KV = 2
A_GROUP = A_HEADS // A_KV
A_WINDOW = 128
B_HEADS = 8
B_KV = 2
B_GROUP = B_HEADS // B_KV
CMP_LEN = 32
CMP_STRIDE = 16
CMP_HIDDEN = 256
SLC_LEN = 64
SLC_TOPK = 16
B_WINDOW = 512
Q_BLOCK = 128
REL_BUCKETS = 32
REL_MAX_EXACT = 16
REL_MAX_DIST = 128
PEER_HEADS = 8
PEER_KEYS = 128
PEER_EXPERTS = PEER_KEYS * PEER_KEYS
PEER_QDIM = 256
PEER_HALF = PEER_QDIM // 2
PEER_TOPK = 16
PEER_CHUNK = 128
PLE_DIM = 256
EPS = 1e-6

A_QW = A_HEADS * HEAD_DIM
A_KVW = A_KV * HEAD_DIM
B_QW = B_HEADS * HEAD_DIM
B_KVW = B_KV * HEAD_DIM
IN_SPLIT_SIZES = (A_QW, A_KVW, A_KVW, B_QW, B_KVW, B_KVW, B_KVW, B_KVW, B_KVW, B_KVW, 3 * B_HEADS, 2 * D_MODEL)
IN_COLS = sum(IN_SPLIT_SIZES)

kernel_name = "hybrid_swa_nsa_peer_block"


def rmsnorm(x, g):
    xf = x.astype(jnp.float32)
    y = xf * lax.rsqrt(jnp.mean(xf * xf, axis=-1, keepdims=True) + EPS)
    return (y * g.astype(jnp.float32)).astype(x.dtype)


def rel_bucket(dist):
    d = jnp.maximum(dist, 0)
    large = REL_MAX_EXACT + (jnp.log(jnp.maximum(d, 1).astype(jnp.float32) / REL_MAX_EXACT)
                             / math.log(REL_MAX_DIST / REL_MAX_EXACT)
                             * (REL_BUCKETS - REL_MAX_EXACT)).astype(jnp.int32)
    large = jnp.minimum(large, REL_BUCKETS - 1)
    return jnp.where(d < REL_MAX_EXACT, d, large)


def masked_softmax(s, mask, sink=None):
    s = jnp.where(mask, s, -jnp.inf)
    m = jnp.max(s, axis=-1, keepdims=True)
    if sink is not None:
        m = jnp.maximum(m, sink)
    m = jnp.where(jnp.isfinite(m), m, 0.0)
    e = jnp.where(mask, jnp.exp(s - m), 0.0)
    den = jnp.sum(e, axis=-1, keepdims=True)
    if sink is not None:
        den = den + jnp.exp(sink - m)
    return e / jnp.maximum(den, 1e-30)


def banded_attention(q, k, v, bias_tab, window, sink=None):
    B, S, G, R, Dh = q.shape
    nblk = S // Q_BLOCK
    nb = window // Q_BLOCK
    kw_len = (nb + 1) * Q_BLOCK
    pad = nb * Q_BLOCK

    def windows(t):
        tp = jnp.pad(t, ((0, 0), (pad, 0), (0, 0), (0, 0))).reshape(B, nblk + nb, Q_BLOCK, G, Dh)
        return jnp.concatenate([tp[:, o:o + nblk] for o in range(nb + 1)], axis=2)

    kb, vb = windows(k), windows(v)
    qb = q.reshape(B, nblk, Q_BLOCK, G, R, Dh)
    s = jnp.einsum('bnqgrd,bnkgd->bngrqk', qb, kb).astype(jnp.float32) * (Dh ** -0.5)
    qi = jnp.arange(Q_BLOCK)[:, None]
    ki = jnp.arange(kw_len)[None, :]
    rel = pad + qi - ki
    bias = bias_tab[rel_bucket(rel)].astype(jnp.float32)
    s = s + jnp.transpose(bias, (2, 3, 0, 1))
    kpos = (jnp.arange(nblk)[:, None, None] - nb) * Q_BLOCK + ki[None]
    mask = (rel >= 0) & (rel < window) & (kpos >= 0)
    p = masked_softmax(s, mask[None, :, None, None], sink)
    o = jnp.einsum('bngrqk,bnkgd->bnqgrd', p.astype(v.dtype), vb)
    return o.reshape(B, S, G, R, Dh)


def compress_blocks(t, pos, w1, w2):
    B, S, G, Dh = t.shape
    nch = S // CMP_STRIDE
    r = CMP_LEN // CMP_STRIDE
    n_cmp = nch - r + 1
    ch = t.reshape(B, nch, CMP_STRIDE, G, Dh)
    blocks = jnp.concatenate([ch[:, o:o + n_cmp] for o in range(r)], axis=2)
    blocks = blocks + pos[None, None, :, None, :]
    flat = jnp.transpose(blocks, (0, 1, 3, 2, 4)).reshape(B, n_cmp, G, CMP_LEN * Dh)
    return jax.nn.gelu(flat @ w1) @ w2


def nsa_attention(q, k_c, v_c, k_s, v_s, k_w, v_w, gates, cmp_pos, ck_w1, ck_w2, cv_w1, cv_w2, bias_tab):
    B, S, G, R, Dh = q.shape
    scale = Dh ** -0.5
    kc = compress_blocks(k_c, cmp_pos, ck_w1, ck_w2)
    vc = compress_blocks(v_c, cmp_pos, cv_w1, cv_w2)
    n_cmp = kc.shape[1]
    n_slc = S // SLC_LEN
    k_sel = min(SLC_TOPK, n_slc)
    ci = jnp.arange(n_cmp)[:, None] * CMP_STRIDE
    sj = jnp.arange(n_slc)[None, :] * SLC_LEN
    overlap = (jnp.clip(jnp.minimum(ci + CMP_LEN, sj + SLC_LEN) - jnp.maximum(ci, sj), 0)
               .astype(jnp.float32) / CMP_LEN)
    cend = jnp.arange(n_cmp) * CMP_STRIDE + CMP_LEN - 1
    ks_blocks = jnp.transpose(k_s.reshape(B, n_slc, SLC_LEN, G, Dh), (0, 3, 1, 2, 4))
    vs_blocks = jnp.transpose(v_s.reshape(B, n_slc, SLC_LEN, G, Dh), (0, 3, 1, 2, 4))
    tab_g = jnp.transpose(bias_tab, (1, 0, 2)).astype(jnp.float32)
    bi = jnp.arange(B)[:, None, None, None]
    gi = jnp.arange(G)[None, None, :, None]
    jidx = jnp.arange(n_slc)
    forced_score = float(R + 1)

    def block_fn(args):
        qc, tpos = args
        sc = jnp.einsum('bqgrd,bcgd->bqgrc', qc, kc).astype(jnp.float32) * scale
        cmask = cend[None, :] <= tpos[:, None]
        pc = masked_softmax(sc, cmask[None, :, None, None, :])
        o_cmp = jnp.einsum('bqgrc,bcgd->bqgrd', pc.astype(vc.dtype), vc)
        ps = jnp.einsum('bqgrc,cj->bqgj', pc, overlap)
        jt = (tpos // SLC_LEN)[:, None]
        forced = (jidx[None] == 0) | (jidx[None] == jt) | (jidx[None] == jt - 1)
        future = jidx[None] > jt
        ps = jnp.where(future[None, :, None, :], -1.0,
                       jnp.where(forced[None, :, None, :], forced_score, ps))
        _, idx = lax.top_k(ps, k_sel)
        kg = ks_blocks[bi, gi, idx].reshape(B, Q_BLOCK, G, k_sel * SLC_LEN, Dh)
        vg = vs_blocks[bi, gi, idx].reshape(B, Q_BLOCK, G, k_sel * SLC_LEN, Dh)
        kpos = (idx[..., None] * SLC_LEN + jnp.arange(SLC_LEN)).reshape(B, Q_BLOCK, G, k_sel * SLC_LEN)
        dist = tpos[None, :, None, None] - kpos
        ss = jnp.einsum('bqgrd,bqgkd->bqgrk', qc, kg).astype(jnp.float32) * scale
        bias = jnp.moveaxis(tab_g[gi, rel_bucket(dist)], -1, 3)
        psel = masked_softmax(ss + bias, (dist >= 0)[:, :, :, None, :])
        o_slc = jnp.einsum('bqgrk,bqgkd->bqgrd', psel.astype(vg.dtype), vg)
        return o_cmp, o_slc

    nblk = S // Q_BLOCK
    qcs = jnp.transpose(q.reshape(B, nblk, Q_BLOCK, G, R, Dh), (1, 0, 2, 3, 4, 5))
    tposs = jnp.arange(S).reshape(nblk, Q_BLOCK)
    o_cmp, o_slc = lax.map(block_fn, (qcs, tposs))
    o_cmp = jnp.transpose(o_cmp, (1, 0, 2, 3, 4, 5)).reshape(B, S, G, R, Dh)
    o_slc = jnp.transpose(o_slc, (1, 0, 2, 3, 4, 5)).reshape(B, S, G, R, Dh)
    o_win = banded_attention(q, k_w, v_w, bias_tab, B_WINDOW)
    g = jax.nn.sigmoid(gates.astype(jnp.float32)).reshape(B, S, 3, G, R, 1).astype(q.dtype)
    return g[:, :, 0] * o_cmp + g[:, :, 1] * o_slc + g[:, :, 2] * o_win


def peer(h, w_q, sub_k1, sub_k2, u, v):
    B, S, D = h.shape
    q = (h @ w_q).reshape(B, S, PEER_HEADS, 2, PEER_HALF)
    s1 = jnp.einsum('bshd,nd->bshn', q[..., 0, :], sub_k1).astype(jnp.float32)
    s2 = jnp.einsum('bshd,nd->bshn', q[..., 1, :], sub_k2).astype(jnp.float32)
    v1, i1 = lax.top_k(s1, PEER_TOPK)
    v2, i2 = lax.top_k(s2, PEER_TOPK)
    cand = (v1[..., :, None] + v2[..., None, :]).reshape(B, S, PEER_HEADS, PEER_TOPK * PEER_TOPK)
    cidx = (i1[..., :, None] * PEER_KEYS + i2[..., None, :]).reshape(B, S, PEER_HEADS, PEER_TOPK * PEER_TOPK)
    sc, pos = lax.top_k(cand, PEER_TOPK)
    eidx = jnp.take_along_axis(cidx, pos, axis=-1)
    gate = jax.nn.softmax(sc, axis=-1)
    T = B * S
    nchunk = T // PEER_CHUNK
    hc = h.reshape(nchunk, PEER_CHUNK, D)
    ec = eidx.reshape(nchunk, PEER_CHUNK, PEER_HEADS, PEER_TOPK)
    gc = gate.reshape(nchunk, PEER_CHUNK, PEER_HEADS, PEER_TOPK)

    def chunk_fn(args):
        hx, ex, gx = args
        act = jax.nn.gelu(jnp.einsum('td,thkd->thk', hx, u[ex]))
        return jnp.einsum('thk,thkd->td', (gx.astype(act.dtype) * act), v[ex])

    return lax.map(chunk_fn, (hc, ec, gc)).reshape(B, S, D)


def setup_inputs(seed: int = 0) -> dict:
    key = jax.random.key(seed)
    ks = jax.random.split(key, 32)
    f32 = jnp.float32

    def nrm(k, shape, scale):
        return jax.random.normal(k, shape, f32) * scale

    L, D = DEPTH, D_MODEL
    return {
        'x': nrm(ks[0], (BATCH, SEQ, D), 1.0),
        'p': nrm(ks[1], (DEPTH, BATCH, SEQ, PLE_DIM), 1.0),
        'g_mix': 1.0 + nrm(ks[2], (L, D), 0.05),
        'w_in': nrm(ks[3], (L, D, IN_COLS), D ** -0.5),
        'a_sink': nrm(ks[4], (L, A_KV, A_GROUP), 0.5),
        'rel_bias': nrm(ks[5], (REL_BUCKETS, A_HEADS + B_HEADS), 0.5),
        'cmp_pos': nrm(ks[6], (L, CMP_LEN, HEAD_DIM), 0.1),
        'cmp_k_w1': nrm(ks[7], (L, CMP_LEN * HEAD_DIM, CMP_HIDDEN), (CMP_LEN * HEAD_DIM) ** -0.5),
        'cmp_k_w2': nrm(ks[8], (L, CMP_HIDDEN, HEAD_DIM), CMP_HIDDEN ** -0.5),
        'cmp_v_w1': nrm(ks[9], (L, CMP_LEN * HEAD_DIM, CMP_HIDDEN), (CMP_LEN * HEAD_DIM) ** -0.5),
        'cmp_v_w2': nrm(ks[10], (L, CMP_HIDDEN, HEAD_DIM), CMP_HIDDEN ** -0.5),
        'w_up_a': nrm(ks[11], (L, A_QW, D), A_QW ** -0.5),
        'w_up_b': nrm(ks[12], (L, B_QW, D), B_QW ** -0.5),
        'w_o': nrm(ks[13], (L, D, D), D ** -0.5),
        'g_ffn': 1.0 + nrm(ks[14], (L, D), 0.05),
        'peer_wq': nrm(ks[15], (L, D, PEER_HEADS * PEER_QDIM), D ** -0.5),
        'peer_k1': nrm(ks[16], (L, PEER_KEYS, PEER_HALF), PEER_HALF ** -0.5),
        'peer_k2': nrm(ks[17], (L, PEER_KEYS, PEER_HALF), PEER_HALF ** -0.5),
        'peer_u': nrm(ks[18], (L, PEER_EXPERTS, D), D ** -0.5),
        'peer_v': nrm(ks[19], (L, PEER_EXPERTS, D), 0.5),
        'g_ple': 1.0 + nrm(ks[20], (L, D), 0.05),
        'w_ple_gate': nrm(ks[21], (L, D, D), D ** -0.5),
        'w_ple': nrm(ks[22], (L, PLE_DIM, D), PLE_DIM ** -0.5),
        'g_final': 1.0 + nrm(ks[23], (D,), 0.05),
    }


def reference(x, p, g_mix, w_in, a_sink, rel_bias, cmp_pos, cmp_k_w1, cmp_k_w2, cmp_v_w1, cmp_v_w2,
              w_up_a, w_up_b, w_o, g_ffn, peer_wq, peer_k1, peer_k2, peer_u, peer_v,
              g_ple, w_ple_gate, w_ple, g_final):
    B, S, D = x.shape
    bias_a = rel_bias[:, :A_HEADS].reshape(REL_BUCKETS, A_KV, A_GROUP)
    bias_b = rel_bias[:, A_HEADS:].reshape(REL_BUCKETS, B_KV, B_GROUP)
    split_at = np.cumsum(IN_SPLIT_SIZES)[:-1].tolist()
    for i in range(DEPTH):
        h = rmsnorm(x, g_mix[i])
        z = h @ w_in[i]
        (aq, ak, av, bq, bkc, bvc, bks, bvs, bkw, bvw, bgates, mgates) = jnp.split(z, split_at, axis=-1)
        sink = a_sink[i].astype(jnp.float32)[None, None, :, :, None, None]
        o_a = banded_attention(aq.reshape(B, S, A_KV, A_GROUP, HEAD_DIM),
                               ak.reshape(B, S, A_KV, HEAD_DIM), av.reshape(B, S, A_KV, HEAD_DIM),
                               bias_a, A_WINDOW, sink)
        y_a = o_a.reshape(B, S, A_QW) @ w_up_a[i]
        kv = lambda t: t.reshape(B, S, B_KV, HEAD_DIM)
        o_b = nsa_attention(bq.reshape(B, S, B_KV, B_GROUP, HEAD_DIM), kv(bkc), kv(bvc), kv(bks), kv(bvs),
                            kv(bkw), kv(bvw), bgates, cmp_pos[i], cmp_k_w1[i], cmp_k_w2[i],
                            cmp_v_w1[i], cmp_v_w2[i], bias_b)
        y_b = o_b.reshape(B, S, B_QW) @ w_up_b[i]
        mg = jax.nn.sigmoid(mgates.reshape(B, S, 2, D))
        x = x + (mg[:, :, 0] * y_a + mg[:, :, 1] * y_b) @ w_o[i]
        x = x + peer(rmsnorm(x, g_ffn[i]), peer_wq[i], peer_k1[i], peer_k2[i], peer_u[i], peer_v[i])
        x = x + jax.nn.sigmoid(rmsnorm(x, g_ple[i]) @ w_ple_gate[i]) * (p[i] @ w_ple[i])
    return rmsnorm(x, g_final)
```

```cpp
#include <hip/hip_runtime.h>
#include <cstdio>
#include <cstdint>

#define GAS __attribute__((address_space(1)))
#define LAS __attribute__((address_space(3)))
typedef unsigned short bf16;
typedef short bf16x8 __attribute__((ext_vector_type(8)));
typedef short s16x4 __attribute__((ext_vector_type(4)));
typedef float f32x4 __attribute__((ext_vector_type(4)));
typedef float f32x16 __attribute__((ext_vector_type(16)));
typedef unsigned u32x4 __attribute__((ext_vector_type(4)));
typedef unsigned u32x2 __attribute__((ext_vector_type(2)));
typedef _Float16 h16x8 __attribute__((ext_vector_type(8)));
typedef GAS unsigned gu32;
typedef float f32x2_t __attribute__((ext_vector_type(2))); typedef __bf16 bf16x2_t __attribute__((ext_vector_type(2)));
__device__ __forceinline__ unsigned pkbf(float lo, float hi) { f32x2_t v = {lo, hi}; bf16x2_t b = __builtin_convertvector(v, bf16x2_t); return __builtin_bit_cast(unsigned, b); }
__device__ __forceinline__ float bf_lo(unsigned u) { return __uint_as_float(u << 16); }
__device__ __forceinline__ float bf_hi(unsigned u) { return __uint_as_float(u & 0xffff0000u); }
__device__ __forceinline__ float fexp2(float x) { return __builtin_amdgcn_exp2f(x); }
__device__ __forceinline__ float frcp(float x) { return __builtin_amdgcn_rcpf(x); }
__device__ __forceinline__ float sigmoidf_(float x) { return frcp(1.0f + fexp2(-1.4426950408889634f * x)); }
__device__ __forceinline__ float gelu_tanh(float x) { const float u = x * (1.0f + 0.044715f * x * x); return x * frcp(1.0f + fexp2(-2.302208198f * u)); }
#define LOG2E 1.4426950408889634f
#define RLX_AGENT __ATOMIC_RELAXED, __HIP_MEMORY_SCOPE_AGENT
#define LDS_WAIT() asm volatile("s_waitcnt lgkmcnt(0)" ::: "memory")
#define VM_WAIT() asm volatile("s_waitcnt vmcnt(0)" ::: "memory")

namespace pg8 {
#define PG8_LAS __attribute__((address_space(3)))
typedef unsigned short bf16_t;
typedef short bf16x8 __attribute__((ext_vector_type(8)));
typedef float f32x4 __attribute__((ext_vector_type(4)));
typedef unsigned u32x4 __attribute__((ext_vector_type(4)));
constexpr int BM = 256, BK = 64, HALF = 128, HTB = HALF * BK * 2  , STAGE_BYTES = 8 * HTB, NXCD = 8, WGM = 8;

__host__ __device__ __forceinline__ int lds_byte(int r, int c) { const int st = (r >> 4) * 2 + (c >> 5), rr = r & 15, cc = c & 31, ob = rr * 64 + cc * 2; return st * 1024 + (ob ^ (((ob >> 9) & 1) << 5)); }
__host__ __device__ __forceinline__ void stage_rc(int b, int& R, int& C) { const int st = b / 1024, sb = b % 1024, swz = sb ^ (((sb >> 9) & 1) << 5); R = (st >> 1) * 16 + swz / 64; C = (st & 1) * 32 + (swz % 64) / 2; }
__host__ __device__ __forceinline__ int perm32(int rho) { const int n = rho >> 4, i = rho & 15; return 8 * (i >> 2) + 4 * n + (i & 3); }

struct Unit { int pm, pn; };
struct Gemm { const bf16_t* A; const bf16_t* Bt; int M, N, K, lda, ldb; };

struct StaticOrder {
    int nM, nN, nwg, G, c;
    __host__ __device__ void init(int M, int N, int G_, int c_) { nM = M / BM; nN = N / BM; nwg = nM * nN; G = G_; c = c_; }
    __host__ __device__ bool next(int i, Unit& u) const {
        const long L = (long)i * G + c; if (L >= nwg) return false;
        int wgid = (int)L; { const int q = nwg / NXCD, r = nwg % NXCD, xcd = wgid % NXCD, off = wgid / NXCD; wgid = (xcd < r ? xcd * (q + 1) : r * (q + 1) + (xcd - r) * q) + off; }
        const int nig = WGM * nN, gid = wgid / nig, fm = gid * WGM, gsz = (nM - fm) < WGM ? (nM - fm) : WGM;
        u.pm = fm + ((wgid % nig) % gsz); u.pn = (wgid % nig) / gsz; return true;
    }
    __device__ __forceinline__ void a_ready(const Unit&) const {}
    __device__ __forceinline__ void done(const Unit&) const {}
};
struct OneUnit {
    int pm, pn, has;
    __device__ bool next(int i, Unit& u) const { if (i == 0 && has) { u.pm = pm; u.pn = pn; return true; } return false; }
    __device__ __forceinline__ void a_ready(const Unit&) const {}
    __device__ __forceinline__ void done(const Unit&) const {}
};
template <class Epi, class Sched, bool ALIGN_EPI = false, bool SP2 = false>
__device__ __forceinline__ void gemm_phase(PG8_LAS unsigned char* lds, const Gemm g, const Sched& S, const Epi& E) {
    const int tid = threadIdx.x, wid = __builtin_amdgcn_readfirstlane(tid >> 6), lane = tid & 63, wr = wid >> 2, wc = wid & 3, fr = lane & 15, fq = lane >> 4;
    const int K = g.K, nt = K / BK;
    unsigned voffA[2], voffB[2];
#pragma unroll
    for (int i = 0; i < 2; ++i) { int R, C; stage_rc(tid * 16 + i * 8192, R, C); const int Rb = Epi::PERM ? ((R & ~31) + perm32(R & 31)) : R;
        voffA[i] = (unsigned)(R * g.lda + C) * 2u; voffB[i] = (unsigned)(Rb * g.ldb + C) * 2u; }
    const size_t kstep = (size_t)(BK * 2);
    const size_t hstepA = (size_t)HALF * g.lda * 2, hstepB = (size_t)HALF * g.ldb * 2;
    const size_t tstepA = 2 * hstepA, tstepB = 2 * hstepB;
    const unsigned ldsw = (unsigned)wid * 1024u;
    const int aoff = lds_byte(wr * 64 + fr, fq * 8), boff = lds_byte(wc * 32 + fr, fq * 8);
#define PG8_SA(b, h) (((b) * 2 + (h)) * HTB)
#define PG8_SB(b, h) ((4 + (b) * 2 + (h)) * HTB)
#define PG8_STAGE(bufoff, gbase, voff) do { _Pragma("unroll") for (int _i = 0; _i < 2; ++_i) \
        __builtin_amdgcn_global_load_lds((const unsigned*)((const char*)(gbase) + (voff)[_i]), (PG8_LAS unsigned*)(lds + (bufoff) + ldsw + _i * 8192), 16, 0, 0); } while (0)
#define PG8_LDA(dst, b, h) do { _Pragma("unroll") for (int m = 0; m < 4; ++m) _Pragma("unroll") for (int k = 0; k < 2; ++k) dst[m][k] = *(const PG8_LAS bf16x8*)(lds + PG8_SA(b, h) + aoff + m * 2048 + k * 1024); } while (0)
#define PG8_LDB(dst, b, h) do { _Pragma("unroll") for (int n = 0; n < 2; ++n) _Pragma("unroll") for (int k = 0; k < 2; ++k) dst[n][k] = *(const PG8_LAS bf16x8*)(lds + PG8_SB(b, h) + boff + n * 2048 + k * 1024); } while (0)
#define PG8_MMA(ai, bj, At, Bt) do { __builtin_amdgcn_s_setprio(1); _Pragma("unroll") for (int m = 0; m < 4; ++m) _Pragma("unroll") for (int n = 0; n < 2; ++n) _Pragma("unroll") for (int k = 0; k < 2; ++k) \
        acc[ai][bj][m][n] = __builtin_amdgcn_mfma_f32_16x16x32_bf16(Bt[n][k], At[m][k], acc[ai][bj][m][n], 0, 0, 0); __builtin_amdgcn_s_setprio(0); } while (0)
#define PG8_WAIT_V(n) asm volatile("s_waitcnt vmcnt(" #n ")" ::: "memory")
#define PG8_WAIT_L(n) asm volatile("s_waitcnt lgkmcnt(" #n ")" ::: "memory")
#define PG8_BAR __builtin_amdgcn_s_barrier()
#define PG8_SCHED __builtin_amdgcn_sched_barrier(0)
    Unit cur, nxt; int ui = 0;
    if (!S.next(0, cur)) return;
    f32x4 acc[2][2][4][2];
#pragma unroll
    for (int a = 0; a < 2; ++a)
#pragma unroll
        for (int b = 0; b < 2; ++b)
#pragma unroll
            for (int m = 0; m < 4; ++m)
#pragma unroll
                for (int n = 0; n < 2; ++n) acc[a][b][m][n] = (f32x4){0.f, 0.f, 0.f, 0.f};
    bf16x8 At[4][2], B0[2][2], B1[2][2];
    const char* cA = (const char*)g.A + (size_t)cur.pm * tstepA; const char* cB = (const char*)g.Bt + (size_t)cur.pn * tstepB;
    S.a_ready(cur);
    if constexpr (SP2) {
        PG8_STAGE(PG8_SB(0, 0), cB, voffB); PG8_STAGE(PG8_SB(0, 1), cB + hstepB, voffB); PG8_STAGE(PG8_SA(0, 0), cA, voffA); PG8_STAGE(PG8_SA(0, 1), cA + hstepA, voffA);
        if (wr == 1) PG8_BAR;
        PG8_WAIT_V(2); PG8_BAR;
        PG8_STAGE(PG8_SB(1, 0), cB + kstep, voffB); PG8_STAGE(PG8_SA(1, 0), cA + kstep, voffA); PG8_STAGE(PG8_SB(1, 1), cB + hstepB + kstep, voffB);
        PG8_WAIT_V(6); PG8_BAR;
    } else {
        PG8_STAGE(PG8_SB(0, 0), cB, voffB); PG8_STAGE(PG8_SA(0, 0), cA, voffA); PG8_STAGE(PG8_SB(0, 1), cB + hstepB, voffB); PG8_STAGE(PG8_SA(0, 1), cA + hstepA, voffA);
        if (wr == 1) PG8_BAR;
        PG8_WAIT_V(4); PG8_BAR;
        PG8_STAGE(PG8_SB(1, 0), cB + kstep, voffB); PG8_STAGE(PG8_SA(1, 0), cA + kstep, voffA); PG8_STAGE(PG8_SB(1, 1), cB + hstepB + kstep, voffB);
        PG8_WAIT_V(6); PG8_BAR;
    }
    for (;;) {
        const bool has_next = S.next(ui + 1, nxt);
        const char* nA = has_next ? (const char*)g.A + (size_t)nxt.pm * tstepA : cA; const char* nB = has_next ? (const char*)g.Bt + (size_t)nxt.pn * tstepB : cB;
        for (int t = 0; t < nt; t += 2) {
            const bool last = (t == nt - 2);
            const char* a1 = cA + (size_t)(t + 1) * kstep;
            const char* a2 = last ? nA : cA + (size_t)(t + 2) * kstep; const char* b2 = last ? nB : cB + (size_t)(t + 2) * kstep;
            const char* a3 = a2 + kstep; const char* b3 = b2 + kstep;
            if (last && has_next) S.a_ready(nxt);
            if constexpr (SP2) {
            PG8_LDB(B0, 0, 0); PG8_LDB(B1, 0, 1); PG8_SCHED; PG8_LDA(At, 0, 0); PG8_STAGE(PG8_SA(1, 1), a1 + hstepA, voffA);
            PG8_WAIT_V(8); PG8_WAIT_L(0); PG8_BAR; PG8_MMA(0, 0, At, B0); PG8_MMA(0, 1, At, B1); PG8_BAR; PG8_SCHED;
            PG8_LDA(At, 0, 1); PG8_STAGE(PG8_SB(0, 0), b2, voffB); PG8_STAGE(PG8_SB(0, 1), b2 + hstepB, voffB); PG8_STAGE(PG8_SA(0, 0), a2, voffA);
            PG8_WAIT_V(8); PG8_WAIT_L(0); PG8_BAR; PG8_MMA(1, 0, At, B0); PG8_MMA(1, 1, At, B1); PG8_BAR; PG8_SCHED;
            PG8_LDB(B0, 1, 0); PG8_LDB(B1, 1, 1); PG8_SCHED; PG8_LDA(At, 1, 0); PG8_STAGE(PG8_SA(0, 1), a2 + hstepA, voffA);
            PG8_WAIT_V(8); PG8_WAIT_L(0); PG8_BAR; PG8_MMA(0, 0, At, B0); PG8_MMA(0, 1, At, B1); PG8_BAR; PG8_SCHED;
            PG8_LDA(At, 1, 1); PG8_STAGE(PG8_SB(1, 0), b3, voffB); PG8_STAGE(PG8_SB(1, 1), b3 + hstepB, voffB); PG8_STAGE(PG8_SA(1, 0), a3, voffA);
            PG8_WAIT_V(8); PG8_WAIT_L(0); PG8_BAR; PG8_MMA(1, 0, At, B0); PG8_MMA(1, 1, At, B1); PG8_BAR; PG8_SCHED;
            } else {
            PG8_LDB(B0, 0, 0); PG8_SCHED; PG8_LDA(At, 0, 0); PG8_STAGE(PG8_SA(1, 1), a1 + hstepA, voffA);
            PG8_WAIT_L(8); PG8_BAR; PG8_WAIT_L(0); PG8_MMA(0, 0, At, B0); PG8_BAR; PG8_SCHED;
            PG8_LDB(B1, 0, 1); PG8_STAGE(PG8_SB(0, 0), b2, voffB);
            PG8_BAR; PG8_WAIT_L(0); PG8_MMA(0, 1, At, B1); PG8_BAR;
            PG8_LDA(At, 0, 1); PG8_STAGE(PG8_SA(0, 0), a2, voffA);
            PG8_BAR; PG8_WAIT_L(0); PG8_MMA(1, 0, At, B0); PG8_BAR; PG8_SCHED;
            PG8_STAGE(PG8_SB(0, 1), b2 + hstepB, voffB);
            PG8_WAIT_V(6); PG8_BAR; PG8_MMA(1, 1, At, B1); PG8_BAR;
            PG8_LDB(B0, 1, 0); PG8_SCHED; PG8_LDA(At, 1, 0); PG8_STAGE(PG8_SA(0, 1), a2 + hstepA, voffA);
            PG8_WAIT_L(8); PG8_BAR; PG8_WAIT_L(0); PG8_MMA(0, 0, At, B0); PG8_BAR; PG8_SCHED;
            PG8_LDB(B1, 1, 1); PG8_STAGE(PG8_SB(1, 0), b3, voffB);
            PG8_BAR; PG8_WAIT_L(0); PG8_MMA(0, 1, At, B1); PG8_BAR;
            PG8_LDA(At, 1, 1); PG8_STAGE(PG8_SA(1, 0), a3, voffA);
            PG8_BAR; PG8_WAIT_L(0); PG8_MMA(1, 0, At, B0); PG8_BAR; PG8_SCHED;
            PG8_STAGE(PG8_SB(1, 1), b3 + hstepB, voffB);
            PG8_WAIT_V(6); PG8_BAR; PG8_MMA(1, 1, At, B1); PG8_BAR;
            }
        }
        if constexpr (ALIGN_EPI) { if (wr == 0) PG8_BAR; }
        if constexpr (!Epi::AFTER_DRAIN) { E(acc, cur, wr, wc, fr, fq); S.done(cur); }
        if (!has_next) break;
#pragma unroll
        for (int a = 0; a < 2; ++a)
#pragma unroll
            for (int b = 0; b < 2; ++b)
#pragma unroll
                for (int m = 0; m < 4; ++m)
#pragma unroll
                    for (int n = 0; n < 2; ++n) acc[a][b][m][n] = (f32x4){0.f, 0.f, 0.f, 0.f};
        cur = nxt; cA = nA; cB = nB; ++ui;
        if constexpr (ALIGN_EPI) { if (wr == 1) PG8_BAR; }
    }
    PG8_WAIT_V(0);
    if constexpr (!ALIGN_EPI) { if (wr == 0) PG8_BAR; }
    PG8_BAR;
    if constexpr (Epi::AFTER_DRAIN) { E.fused(acc, cur, wr, wc, fr, fq, lds, wid, lane); S.done(cur); }
#undef PG8_SA
#undef PG8_SB
#undef PG8_STAGE
#undef PG8_LDA
#undef PG8_LDB
#undef PG8_MMA
#undef PG8_WAIT_V
#undef PG8_WAIT_L
#undef PG8_BAR
#undef PG8_SCHED
}
}
#undef PG8_LAS
#define XB_TMO      128
#define XB_XCNT(j)  (256  + 64 * (j))
#define XB_XSUB(j)  (1280 + 64 * (j))
#define XB_XGEN(j)  (2304 + 64 * (j))
#define XB_TOP      3328
#define XB_TOPGEN   3392
#define XCD_BAR_WORDS 3456
#define XB_SPIN_CAP (1u << 18)

__device__ __forceinline__ unsigned xb_ld(unsigned* p)              { return __hip_atomic_load(p, __ATOMIC_RELAXED, __HIP_MEMORY_SCOPE_AGENT); }
__device__ __forceinline__ unsigned xb_add(unsigned* p, unsigned v) { return __hip_atomic_fetch_add(p, v, __ATOMIC_RELAXED, __HIP_MEMORY_SCOPE_AGENT); }
__device__ __forceinline__ unsigned xb_xcc_id() { return (unsigned)__builtin_amdgcn_s_getreg((3 << 11) | 20) & 0xFu; }
#define XB_SPIN(cond, bar) do { unsigned _sp = 0; while (cond) { __builtin_amdgcn_s_sleep(1); \
    if ((++_sp & 255u) == 0u) { if (xb_ld(&(bar)[XB_TMO])) break; if (_sp > XB_SPIN_CAP) { atomicAdd(&(bar)[XB_TMO], 1u); break; } } } } while (0)

struct XcdBarrier {
    unsigned* bar; unsigned x;
    volatile LAS unsigned* st;
};

__device__ __forceinline__ XcdBarrier xcd_barrier_post(unsigned* bar, volatile LAS unsigned* st) {
    XcdBarrier b; b.bar = bar; b.x = xb_xcc_id(); b.st = st;
    if (threadIdx.x == 0) (void)xb_add(&bar[XB_XCNT(b.x)], 1u);
    return b;
}
__device__ __forceinline__ void xcd_barrier_complete(unsigned* bar, unsigned x, unsigned& nloc, unsigned& nx) {
    const unsigned G = gridDim.x * gridDim.y * gridDim.z;
    unsigned sum, cnt, mine, sp = 0u;
    for (;;) {
        sum = 0u; cnt = 0u; mine = 0u;
#pragma unroll
        for (unsigned j = 0; j < 16; ++j) { const unsigned c = xb_ld(&bar[XB_XCNT(j)]); sum += c; cnt += (c > 0u) ? 1u : 0u; mine = (j == x) ? c : mine; }
        if (sum == G) break;
        __builtin_amdgcn_s_sleep(1);
        if ((++sp & 255u) == 0u) { if (xb_ld(&bar[XB_TMO])) break; if (sp > XB_SPIN_CAP) { atomicAdd(&bar[XB_TMO], 1u); break; } }
    }
    nloc = mine > 0u ? mine : 1u; nx = cnt > 0u ? cnt : 1u;
}

__device__ __forceinline__ void xcd_barrier(const XcdBarrier& b) {
    asm volatile("s_waitcnt vmcnt(0)" ::: "memory");
    __syncthreads();
    if (threadIdx.x == 0) {
        unsigned* bar = b.bar;
        __builtin_amdgcn_s_waitcnt(0);
        unsigned nloc = b.st[0], nx = b.st[1];
        if (nloc == 0u) { xcd_barrier_complete(bar, b.x, nloc, nx); b.st[0] = nloc; b.st[1] = nx; }
        const unsigned old = xb_add(&bar[XB_XSUB(b.x)], 1u);
        const unsigned gen = old / nloc;
        if (old + 1u == (gen + 1u) * nloc) {
            __builtin_amdgcn_fence(__ATOMIC_RELEASE, "agent");
            asm volatile("s_waitcnt vmcnt(0)" ::: "memory");
            const unsigned og = xb_add(&bar[XB_TOP], 1u);
            const unsigned tg = og / nx;
            if (og + 1u == (tg + 1u) * nx) xb_add(&bar[XB_TOPGEN], 1u);
            else XB_SPIN(xb_ld(&bar[XB_TOPGEN]) == tg, bar);
            __builtin_amdgcn_fence(__ATOMIC_ACQUIRE, "agent");
            xb_add(&bar[XB_XGEN(b.x)], 1u);
            asm volatile("s_waitcnt vmcnt(0)" ::: "memory");
        } else {
            XB_SPIN(xb_ld(&bar[XB_XGEN(b.x)]) == gen, bar);
            __builtin_amdgcn_fence(__ATOMIC_ACQUIRE, "agent");
            asm volatile("s_waitcnt vmcnt(0)" ::: "memory");
        }
    }
    __syncthreads();
}

constexpr int SEQ = 16384, DM = 1024, N1 = 4352  , NWAVES = 8;
constexpr float EPS = 1e-6f, QSCALE = 0.125f * LOG2E;
constexpr size_t MiB = 1u << 20;
constexpr size_t WS_CTL = 0, CTL_ZERO_BYTES = 1 * MiB;
constexpr size_t WS_WIN = 1 * MiB, WS_WUPA = 10 * MiB, WS_WUPB = 11 * MiB, WS_WO2 = 12 * MiB, WS_WQ = 16 * MiB, WS_WPG = 20 * MiB, WS_WPLE = 22 * MiB, WS_W1KV = 23 * MiB;
constexpr size_t WS_SMALL = 25 * MiB, WS_W2KT = WS_SMALL, WS_W2VT = WS_SMALL + 32768, WS_K1B = WS_SMALL + 65536, WS_K2B = WS_SMALL + 98304, WS_POSB = WS_SMALL + 131072,
                 WS_RS0 = WS_SMALL + 262144, WS_RS2 = WS_SMALL + 393216;
constexpr size_t WS_SSQ1 = 26 * MiB, WS_BG = 27 * MiB, WS_KC = 28 * MiB + 512 * 1024, WS_VCT = WS_KC + 262144, WS_H = 29 * MiB;
constexpr size_t WS_XB = 32 * MiB, WS_MG = 64 * MiB, WS_QA = 128 * MiB, WS_QB = 144 * MiB;
constexpr size_t WS_KA = 160 * MiB, WS_VTA = 164 * MiB, WS_CK = 168 * MiB, WS_KS = 176 * MiB, WS_VTS = 180 * MiB, WS_KW = 184 * MiB, WS_VTW = 188 * MiB;
constexpr size_t WS_OW = 192 * MiB, WS_PW = 208 * MiB, WS_PB = 240 * MiB;
constexpr size_t WS_U16 = 128 * MiB, WS_V16 = 160 * MiB, WS_Q2 = 64 * MiB;
constexpr size_t WS_END = 256 * MiB;
constexpr int CW_TMO = 0, CW_BAR = 4096, CW_QUEUE = 8192;
constexpr int LDS_BYTES = 147456, LDSCTL_OFF = 143360;
constexpr int KROW = 144, VROW = 136;
constexpr int AT_K0 = 0, AT_KSZ = 64 * KROW, AT_V0 = 2 * AT_KSZ, AT_VSZ = 64 * VROW, AT_LUT = 36864, LUTS = 136, AT_IMP = 46080, AT_SEL = 111616;
constexpr int PK_ROW = 272, PK1_OFF = 0, PK2_OFF = 128 * PK_ROW, PW_OFF = 2 * 128 * PK_ROW, PW_BYTES = 8192;
static_assert(AT_V0 + 2 * AT_VSZ <= AT_LUT && AT_LUT + 16 * LUTS * 4 <= AT_IMP && AT_SEL + 2048 <= LDSCTL_OFF && PW_OFF + 8 * PW_BYTES <= LDSCTL_OFF, "LDS map");

__device__ const unsigned char BKT[129] = {0,1,2,3,4,5,6,7,8,9,10,11,12,13,14,15,16,16,16,17,17,18,18,18,19,19,19,20,20,20,20,21,21,21,21,22,22,22,22,22,23,23,23,23,23,23,24,24,24,24,24,24,
    25,25,25,25,25,25,25,26,26,26,26,26,26,26,26,27,27,27,27,27,27,27,27,27,27,28,28,28,28,28,28,28,28,28,28,29,29,29,29,29,29,29,29,29,29,29,29,30,30,30,30,30,30,30,30,30,30,30,30,30,30,
    31,31,31,31,31,31,31,31,31,31,31,31,31,31,31,31};

struct Args { const float* in[24]; float* out; unsigned char* ws; int ph_lo, ph_hi; };
struct Frame {
    LAS unsigned char* lds; volatile LAS unsigned* MISC; gu32* ctl; unsigned char* ws;
    int tid, lane, wave, vcu, G;
    float* out;
};
template <int CTRL> __device__ __forceinline__ float dpp_f(float v) { return __uint_as_float((unsigned)__builtin_amdgcn_update_dpp(0, (int)__float_as_uint(v), CTRL, 0xf, 0xf, true)); }
template <int CTRL> __device__ __forceinline__ unsigned dpp_u(unsigned v) { return (unsigned)__builtin_amdgcn_update_dpp(0, (int)v, CTRL, 0xf, 0xf, true); }
__device__ __forceinline__ float wave_sum(float v) {
#pragma unroll
    for (int o = 1; o < 64; o <<= 1) v += __shfl_xor(v, o);
    return v;
}
__device__ __forceinline__ float quad_sum(float v) { v += dpp_f<0xB1>(v); v += dpp_f<0x4E>(v); return v; }
__device__ __forceinline__ unsigned umax_(unsigned a, unsigned b) { return a > b ? a : b; }
__device__ __forceinline__ unsigned wave_max_u32(unsigned v) {
    v = umax_(v, dpp_u<0xB1>(v)); v = umax_(v, dpp_u<0x4E>(v)); v = umax_(v, dpp_u<0x141>(v)); v = umax_(v, dpp_u<0x140>(v));
    const unsigned a = __builtin_amdgcn_readlane(v, 0), b = __builtin_amdgcn_readlane(v, 16), c = __builtin_amdgcn_readlane(v, 32), d = __builtin_amdgcn_readlane(v, 48);
    return umax_(umax_(a, b), umax_(c, d));
}
__device__ __forceinline__ float pair_max(float v) { auto rr = __builtin_amdgcn_permlane32_swap(__float_as_uint(v), __float_as_uint(v), false, false); return fmaxf(__uint_as_float(rr[0]), __uint_as_float(rr[1])); }
__device__ __forceinline__ float pair_sum(float v) { auto rr = __builtin_amdgcn_permlane32_swap(__float_as_uint(v), __float_as_uint(v), false, false); return __uint_as_float(rr[0]) + __uint_as_float(rr[1]); }
__device__ __forceinline__ unsigned pair_umax(unsigned v) { auto rr = __builtin_amdgcn_permlane32_swap(v, v, false, false); return umax_(rr[0], rr[1]); }
#define WG_BAR_LDS() do { asm volatile("s_waitcnt lgkmcnt(0)" ::: "memory"); __builtin_amdgcn_s_barrier(); asm volatile("" ::: "memory"); } while (0)
__device__ __forceinline__ u32x4 pack8(const f32x4& a, const f32x4& b) { u32x4 w; w.x = pkbf(a[0], a[1]); w.y = pkbf(a[2], a[3]); w.z = pkbf(b[0], b[1]); w.w = pkbf(b[2], b[3]); return w; }

typedef const f32x4 (&AccRef)[2][2][4][2];
struct Epi1 {
    static constexpr bool PERM = true, AFTER_DRAIN = false;
    const float* rs0; unsigned char* ws;
    __device__ __forceinline__ void operator()(AccRef acc, const pg8::Unit& u, int wr, int wc, int fr, int fq) const {
        const int row0 = u.pm * 256 + wr * 64 + fr, pn = u.pn, cl = wc * 32 + 8 * fq;
        if (pn < 4) {
            bf16* Q = (bf16*)(ws + (pn < 2 ? WS_QA : WS_QB)) + (pn & 1) * 256 + cl;
#pragma unroll
            for (int ai = 0; ai < 2; ++ai)
#pragma unroll
                for (int m = 0; m < 4; ++m) { const int row = row0 + ai * 128 + m * 16; const float s = rs0[row] * QSCALE;
#pragma unroll
                    for (int bj = 0; bj < 2; ++bj) *(u32x4*)(Q + (size_t)row * 512 + bj * 128) = pack8(acc[ai][bj][m][0] * s, acc[ai][bj][m][1] * s); }
        } else if (pn < 8) {
            const int g = wc >> 1, dl = cl & 63;
            const size_t koff = pn == 4 ? WS_KA : pn == 5 ? WS_CK : pn == 6 ? WS_KS : WS_KW;
            const size_t voff = pn == 4 ? WS_VTA : pn == 5 ? WS_CK + (size_t)2 * SEQ * 64 * 2 : pn == 6 ? WS_VTS : WS_VTW;
            bf16* Kd = (bf16*)(ws + koff) + (size_t)g * SEQ * 64 + dl;
            bf16* Vd = (bf16*)(ws + voff);
#pragma unroll
            for (int ai = 0; ai < 2; ++ai)
#pragma unroll
                for (int m = 0; m < 4; ++m) { const int row = row0 + ai * 128 + m * 16; const float s = rs0[row];
                    *(u32x4*)(Kd + (size_t)row * 64) = pack8(acc[ai][0][m][0] * s, acc[ai][0][m][1] * s);
                    const u32x4 v = pack8(acc[ai][1][m][0] * s, acc[ai][1][m][1] * s);
                    if (pn == 5) *(u32x4*)(Vd + ((size_t)g * SEQ + row) * 64 + dl) = v;
                    else { bf16* vt = Vd + (size_t)(g * 64 + dl) * SEQ + row;
                        vt[0 * (size_t)SEQ] = (bf16)v.x; vt[1 * (size_t)SEQ] = (bf16)(v.x >> 16); vt[2 * (size_t)SEQ] = (bf16)v.y; vt[3 * (size_t)SEQ] = (bf16)(v.y >> 16);
                        vt[4 * (size_t)SEQ] = (bf16)v.z; vt[5 * (size_t)SEQ] = (bf16)(v.z >> 16); vt[6 * (size_t)SEQ] = (bf16)v.w; vt[7 * (size_t)SEQ] = (bf16)(v.w >> 16); } }
        } else if (pn < 16) {
            bf16* MG = (bf16*)(ws + WS_MG) + (pn - 8) * 256 + cl;
#pragma unroll
            for (int ai = 0; ai < 2; ++ai)
#pragma unroll
                for (int m = 0; m < 4; ++m) { const int row = row0 + ai * 128 + m * 16; const float s = rs0[row];
#pragma unroll
                    for (int bj = 0; bj < 2; ++bj) { f32x4 a = acc[ai][bj][m][0] * s, b = acc[ai][bj][m][1] * s;
#pragma unroll
                        for (int e = 0; e < 4; ++e) { a[e] = sigmoidf_(a[e]); b[e] = sigmoidf_(b[e]); }
                        *(u32x4*)(MG + (size_t)row * 2048 + bj * 128) = pack8(a, b); } }
        } else {
            if (wc == 0 && fq < 3) { float* BG = (float*)(ws + WS_BG) + 8 * fq;
#pragma unroll
                for (int ai = 0; ai < 2; ++ai)
#pragma unroll
                    for (int m = 0; m < 4; ++m) { const int row = row0 + ai * 128 + m * 16; const float s = rs0[row]; f32x4 a = acc[ai][0][m][0] * s, b = acc[ai][0][m][1] * s;
#pragma unroll
                        for (int e = 0; e < 4; ++e) { a[e] = sigmoidf_(a[e]); b[e] = sigmoidf_(b[e]); }
                        *(f32x4*)(BG + (size_t)row * 24) = a; *(f32x4*)(BG + (size_t)row * 24 + 4) = b; } }
        }
    }
};
struct EpiUp {
    static constexpr bool PERM = true, AFTER_DRAIN = false;
    bf16* MG; int coloff;
    __device__ __forceinline__ void operator()(AccRef acc, const pg8::Unit& u, int wr, int wc, int fr, int fq) const {
        const int row0 = u.pm * 256 + wr * 64 + fr; bf16* base = MG + coloff + u.pn * 256 + wc * 32 + 8 * fq;
#pragma unroll
        for (int ai = 0; ai < 2; ++ai)
#pragma unroll
            for (int m = 0; m < 4; ++m) { bf16* rp = base + (size_t)(row0 + ai * 128 + m * 16) * 2048;
#pragma unroll
                for (int bj = 0; bj < 2; ++bj) { const u32x4 gt = *(const u32x4*)(rp + bj * 128); const f32x4 a = acc[ai][bj][m][0], b = acc[ai][bj][m][1]; u32x4 w;
                    w.x = pkbf(bf_lo(gt.x) * a[0], bf_hi(gt.x) * a[1]); w.y = pkbf(bf_lo(gt.y) * a[2], bf_hi(gt.y) * a[3]);
                    w.z = pkbf(bf_lo(gt.z) * b[0], bf_hi(gt.z) * b[1]); w.w = pkbf(bf_lo(gt.w) * b[2], bf_hi(gt.w) * b[3]);
                    *(u32x4*)(rp + bj * 128) = w; } }
    }
};
struct EpiWo {
    static constexpr bool PERM = true, AFTER_DRAIN = false;
    const float* x; float* out; bf16* xb; float* ssq;
    __device__ __forceinline__ void operator()(AccRef acc, const pg8::Unit& u, int wr, int wc, int fr, int fq) const {
        const int row0 = u.pm * 256 + wr * 64 + fr, c0 = u.pn * 256 + wc * 32 + 8 * fq;
#pragma unroll
        for (int ai = 0; ai < 2; ++ai)
#pragma unroll
            for (int m = 0; m < 4; ++m) { const int row = row0 + ai * 128 + m * 16; float ss = 0.f;
#pragma unroll
                for (int bj = 0; bj < 2; ++bj) { const size_t o = (size_t)row * DM + c0 + bj * 128;
                    const f32x4 a = *(const f32x4*)(x + o) + acc[ai][bj][m][0], b = *(const f32x4*)(x + o + 4) + acc[ai][bj][m][1];
                    *(f32x4*)(out + o) = a; *(f32x4*)(out + o + 4) = b; *(u32x4*)(xb + o) = pack8(a, b);
                    ss += (a[0] * a[0] + a[1] * a[1]) + (a[2] * a[2] + a[3] * a[3]) + (b[0] * b[0] + b[1] * b[1]) + (b[2] * b[2] + b[3] * b[3]); }
                ss += __shfl_xor(ss, 16); ss += __shfl_xor(ss, 32);
                if (fq == 0) ssq[(size_t)row * 16 + u.pn * 4 + wc] = ss; }
    }
};
__device__ __forceinline__ float rs_from_ssq(const float* ssq, int row) {
    const f32x4* p = (const f32x4*)(ssq + (size_t)row * 16); const f32x4 a = p[0], b = p[1], c = p[2], d = p[3];
    const float s = ((a[0] + a[1]) + (a[2] + a[3])) + ((b[0] + b[1]) + (b[2] + b[3])) + ((c[0] + c[1]) + (c[2] + c[3])) + ((d[0] + d[1]) + (d[2] + d[3]));
    return __builtin_amdgcn_rsqf(s * (1.0f / DM) + EPS);
}
struct EpiPw {
    static constexpr bool PERM = true, AFTER_DRAIN = false;
    bf16* O; int ldc;
    __device__ __forceinline__ void operator()(AccRef acc, const pg8::Unit& u, int wr, int wc, int fr, int fq) const {
        const int row0 = u.pm * 256 + wr * 64 + fr; bf16* base = O + u.pn * 256 + wc * 32 + 8 * fq;
#pragma unroll
        for (int ai = 0; ai < 2; ++ai)
#pragma unroll
            for (int m = 0; m < 4; ++m)
#pragma unroll
                for (int bj = 0; bj < 2; ++bj) *(u32x4*)(base + (size_t)(row0 + ai * 128 + m * 16) * ldc + bj * 128) = pack8(acc[ai][bj][m][0], acc[ai][bj][m][1]);
    }
};
struct EpiPle {
    static constexpr bool PERM = true, AFTER_DRAIN = false;
    const float* rs2; const bf16* pw; float* out;
    __device__ __forceinline__ void operator()(AccRef acc, const pg8::Unit& u, int wr, int wc, int fr, int fq) const {
        const int row0 = u.pm * 256 + wr * 64 + fr, c0 = u.pn * 256 + wc * 32 + 8 * fq;
#pragma unroll
        for (int ai = 0; ai < 2; ++ai)
#pragma unroll
            for (int m = 0; m < 4; ++m) { const int row = row0 + ai * 128 + m * 16; const float s = rs2[row];
#pragma unroll
                for (int bj = 0; bj < 2; ++bj) { const size_t o = (size_t)row * DM + c0 + bj * 128; const u32x4 pv = *(const u32x4*)(pw + o);
                    f32x4 a = *(const f32x4*)(out + o), b = *(const f32x4*)(out + o + 4); const f32x4 ga = acc[ai][bj][m][0] * s, gb = acc[ai][bj][m][1] * s;
                    a[0] += sigmoidf_(ga[0]) * bf_lo(pv.x); a[1] += sigmoidf_(ga[1]) * bf_hi(pv.x); a[2] += sigmoidf_(ga[2]) * bf_lo(pv.y); a[3] += sigmoidf_(ga[3]) * bf_hi(pv.y);
                    b[0] += sigmoidf_(gb[0]) * bf_lo(pv.z); b[1] += sigmoidf_(gb[1]) * bf_hi(pv.z); b[2] += sigmoidf_(gb[2]) * bf_lo(pv.w); b[3] += sigmoidf_(gb[3]) * bf_hi(pv.w);
                    *(f32x4*)(out + o) = a; *(f32x4*)(out + o + 4) = b; } }
    }
};
struct EpiCmp {
    static constexpr bool PERM = true, AFTER_DRAIN = false;
    bf16* H; const float* posb;
    __device__ __forceinline__ void operator()(AccRef acc, const pg8::Unit& u, int wr, int wc, int fr, int fq) const {
        const int row0 = u.pm * 256 + wr * 64 + fr, cl = wc * 32 + 8 * fq;
#pragma unroll
        for (int bj = 0; bj < 2; ++bj) { const f32x4 pa = *(const f32x4*)(posb + u.pn * 256 + bj * 128 + cl), pb = *(const f32x4*)(posb + u.pn * 256 + bj * 128 + cl + 4);
#pragma unroll
            for (int ai = 0; ai < 2; ++ai)
#pragma unroll
                for (int m = 0; m < 4; ++m) { f32x4 a = acc[ai][bj][m][0] + pa, b = acc[ai][bj][m][1] + pb;
#pragma unroll
                    for (int e = 0; e < 4; ++e) { a[e] = gelu_tanh(a[e]); b[e] = gelu_tanh(b[e]); }
                    *(u32x4*)(H + (size_t)(row0 + ai * 128 + m * 16) * 256 + bj * 128 + cl) = pack8(a, b); } }
    }
};

__device__ __forceinline__ void tr_item(const float* W, int Nsrc, int k0, int srcc0, int nvalid, bf16* WT, int ldk, int drow0, int dk0, const float* g, LAS float* scr, int lane) {
#pragma unroll 8
    for (int i = 0; i < 32; ++i) { const int kk = 2 * i + (lane >> 5), n = lane & 31; float v = 0.f;
        if (n < nvalid) { v = W[(size_t)(k0 + kk) * Nsrc + srcc0 + n]; if (g) v *= g[k0 + kk]; }
        scr[kk * 33 + n] = v; }
    LDS_WAIT(); asm volatile("" ::: "memory");
    const int c = lane & 7;
#pragma unroll
    for (int j = 0; j < 4; ++j) { const int n = (lane >> 3) + 8 * j; const LAS float* s = scr + (8 * c) * 33 + n;
        u32x4 o; o.x = pkbf(s[0 * 33], s[1 * 33]); o.y = pkbf(s[2 * 33], s[3 * 33]); o.z = pkbf(s[4 * 33], s[5 * 33]); o.w = pkbf(s[6 * 33], s[7 * 33]);
        *(u32x4*)(WT + (size_t)(drow0 + n) * ldk + dk0 + k0 + 8 * c) = o; }
    LDS_WAIT(); asm volatile("" ::: "memory");
}
__device__ __forceinline__ void p0_prologue(Frame& F, const Args& A) {
    LAS float* scr = (LAS float*)(F.lds + F.wave * 8448);
    const int gw = F.vcu * NWAVES + F.wave, NGW = F.G * NWAVES, lane = F.lane;
    unsigned char* ws = F.ws;
    constexpr int I_IN = 16 * 136, I_UP = 8 * 32, I_O = 16 * 32, I_Q = 16 * 64, I_PG = 16 * 32, I_PLE = 4 * 32, I_W1 = 32 * 8, I_W2 = 4 * 2;
    constexpr int NITEMS = I_IN + 2 * I_UP + I_O + I_Q + I_PG + I_PLE + 2 * I_W1 + 2 * I_W2;
    for (int it = gw; it < NITEMS; it += NGW) {
        int r = it;
        if (r < I_IN) { const int kb = r / 136, nb = r % 136, n = nb * 32; int src, nv = 32;
            if (n < 512) src = n; else if (n < 1024) src = n + 256; else if (n < 1280) src = n - 512; else if (n < 2048) src = n; else if (n < 4096) src = n + 24;
            else if (n == 4096) { src = 2048; nv = 24; } else { src = 0; nv = 0; }
            tr_item(A.in[3], 4120, kb * 64, src, nv, (bf16*)(ws + WS_WIN), 1024, n, 0, A.in[2], scr, lane); continue; } r -= I_IN;
        if (r < I_UP) { tr_item(A.in[11], 1024, (r / 32) * 64, (r % 32) * 32, 32, (bf16*)(ws + WS_WUPA), 512, (r % 32) * 32, 0, nullptr, scr, lane); continue; } r -= I_UP;
        if (r < I_UP) { tr_item(A.in[12], 1024, (r / 32) * 64, (r % 32) * 32, 32, (bf16*)(ws + WS_WUPB), 512, (r % 32) * 32, 0, nullptr, scr, lane); continue; } r -= I_UP;
        if (r < I_O) { tr_item(A.in[13], 1024, (r / 32) * 64, (r % 32) * 32, 32, (bf16*)(ws + WS_WO2), 2048, (r % 32) * 32, 0, nullptr, scr, lane);
                       tr_item(A.in[13], 1024, (r / 32) * 64, (r % 32) * 32, 32, (bf16*)(ws + WS_WO2), 2048, (r % 32) * 32, 1024, nullptr, scr, lane); continue; } r -= I_O;
        if (r < I_Q) { tr_item(A.in[15], 2048, (r / 64) * 64, (r % 64) * 32, 32, (bf16*)(ws + WS_WQ), 1024, (r % 64) * 32, 0, A.in[14], scr, lane); continue; } r -= I_Q;
        if (r < I_PG) { tr_item(A.in[21], 1024, (r / 32) * 64, (r % 32) * 32, 32, (bf16*)(ws + WS_WPG), 1024, (r % 32) * 32, 0, A.in[20], scr, lane); continue; } r -= I_PG;
        if (r < I_PLE) { tr_item(A.in[22], 1024, (r / 32) * 64, (r % 32) * 32, 32, (bf16*)(ws + WS_WPLE), 256, (r % 32) * 32, 0, nullptr, scr, lane); continue; } r -= I_PLE;
        if (r < I_W1) { tr_item(A.in[7], 256, (r / 8) * 64, (r % 8) * 32, 32, (bf16*)(ws + WS_W1KV), 2048, (r % 8) * 32, 0, nullptr, scr, lane); continue; } r -= I_W1;
        if (r < I_W1) { tr_item(A.in[9], 256, (r / 8) * 64, (r % 8) * 32, 32, (bf16*)(ws + WS_W1KV), 2048, 256 + (r % 8) * 32, 0, nullptr, scr, lane); continue; } r -= I_W1;
        if (r < I_W2) { tr_item(A.in[8], 64, (r / 2) * 64, (r % 2) * 32, 32, (bf16*)(ws + WS_W2KT), 256, (r % 2) * 32, 0, nullptr, scr, lane); continue; } r -= I_W2;
        tr_item(A.in[10], 64, (r / 2) * 64, (r % 2) * 32, 32, (bf16*)(ws + WS_W2VT), 256, (r % 2) * 32, 0, nullptr, scr, lane);
    }
    { const float* x = A.in[0]; bf16* xb = (bf16*)(ws + WS_XB); float* rs0 = (float*)(ws + WS_RS0);
      for (int row = gw; row < SEQ; row += NGW) {
          const f32x4* xr = (const f32x4*)(x + (size_t)row * DM) + lane; f32x4 v[4]; float ss = 0.f;
#pragma unroll
          for (int j = 0; j < 4; ++j) { v[j] = xr[64 * j]; ss += (v[j][0] * v[j][0] + v[j][1] * v[j][1]) + (v[j][2] * v[j][2] + v[j][3] * v[j][3]); }
          ss = wave_sum(ss);
          u32x2* o8 = (u32x2*)(xb + (size_t)row * DM) + lane;
#pragma unroll
          for (int j = 0; j < 4; ++j) { u32x2 w; w.x = pkbf(v[j][0], v[j][1]); w.y = pkbf(v[j][2], v[j][3]); o8[64 * j] = w; }
          if (lane == 0) rs0[row] = __builtin_amdgcn_rsqf(ss * (1.0f / DM) + EPS);
      } }
    { const int gt = gw * 64 + lane, NGT = NGW * 64;
      const float* p = A.in[1]; bf16* pb = (bf16*)(ws + WS_PB);
      for (int i = gt; i < SEQ * 256 / 8; i += NGT) { const f32x4 a = *(const f32x4*)(p + (size_t)i * 8), b = *(const f32x4*)(p + (size_t)i * 8 + 4); *(u32x4*)(pb + (size_t)i * 8) = pack8(a, b); }
      for (int i = gt; i < 2 * 16384 / 8; i += NGT) { const int which = i >= 2048, j = i & 2047; const float* k = A.in[16 + which] + (size_t)j * 8;
          *(u32x4*)((bf16*)(ws + (which ? WS_K2B : WS_K1B)) + (size_t)j * 8) = pack8(*(const f32x4*)k, *(const f32x4*)(k + 4)); } }
    if (F.vcu < 32) {
#pragma unroll 1
        for (int oo = 0; oo < 2; ++oo) { const int o = F.vcu * 16 + F.wave * 2 + oo, kv = o >> 8, n = o & 255; const float* w1 = A.in[kv ? 9 : 7]; const float* pos = A.in[6]; float s = 0.f;
            for (int k = lane; k < 2048; k += 64) s += pos[k] * w1[(size_t)k * 256 + n];
            s = wave_sum(s); if (lane == 0) ((float*)(ws + WS_POSB))[o] = s; }
    }
}

struct TileSrc { const bf16* K; const bf16* Vt; int vpitch; };
__device__ __forceinline__ void tile_load(const TileSrc& s, int key0, bool needV, int tid, u32x4& kr, u32x4& vr) {
    const int row = tid >> 3, ch = tid & 7;
    kr = *(const u32x4*)(s.K + (size_t)(key0 + row) * 64 + ch * 8);
    if (needV) vr = *(const u32x4*)(s.Vt + (size_t)row * s.vpitch + key0 + ch * 8);
}
__device__ __forceinline__ void tile_store(LAS unsigned char* L, int buf, bool needV, int tid, const u32x4& kr, const u32x4& vr) {
    const int row = tid >> 3, ch = tid & 7;
    *(LAS u32x4*)(L + AT_K0 + buf * AT_KSZ + row * KROW + ch * 16) = kr;
    if (needV) { LAS u32x2* p = (LAS u32x2*)(L + AT_V0 + buf * AT_VSZ + row * VROW + ch * 16); u32x2 a, b; a.x = vr.x; a.y = vr.y; b.x = vr.z; b.y = vr.w; p[0] = a; p[1] = b; }
}
__device__ __forceinline__ void qk_tile(LAS const unsigned char* Kb, const bf16x8 (&q)[4], int r32, int h, f32x16& s0, f32x16& s1) {
#pragma unroll
    for (int i = 0; i < 16; ++i) { s0[i] = 0.f; s1[i] = 0.f; }
#pragma unroll
    for (int ks = 0; ks < 4; ++ks) {
        const bf16x8 a0 = *(LAS const bf16x8*)(Kb + r32 * KROW + (16 * ks + 8 * h) * 2), a1 = *(LAS const bf16x8*)(Kb + (32 + r32) * KROW + (16 * ks + 8 * h) * 2);
        s0 = __builtin_amdgcn_mfma_f32_32x32x16_bf16(a0, q[ks], s0, 0, 0, 0); s1 = __builtin_amdgcn_mfma_f32_32x32x16_bf16(a1, q[ks], s1, 0, 0, 0);
    }
}
__device__ __forceinline__ bf16x8 pack_p(const f32x16& s, int o) {
    u32x4 w; w.x = pkbf(s[o + 0], s[o + 1]); w.y = pkbf(s[o + 2], s[o + 3]); w.z = pkbf(s[o + 4], s[o + 5]); w.w = pkbf(s[o + 6], s[o + 7]); return __builtin_bit_cast(bf16x8, w);
}
__device__ __forceinline__ void softmax_pv(LAS const unsigned char* Vb, f32x16& s0, f32x16& s1, f32x16 (&o)[2], float& m, float& l, int r32, int h) {
    float mx = fmaxf(s0[0], s1[0]);
#pragma unroll
    for (int i = 1; i < 16; ++i) mx = fmaxf(mx, fmaxf(s0[i], s1[i]));
    mx = pair_max(mx);
    const float mn = fmaxf(m, mx), alpha = fexp2(m - mn); m = mn;
    float sum = 0.f;
#pragma unroll
    for (int i = 0; i < 16; ++i) { s0[i] = fexp2(s0[i] - mn); s1[i] = fexp2(s1[i] - mn); sum += s0[i] + s1[i]; }
    sum = pair_sum(sum); l = l * alpha + sum;
#pragma unroll
    for (int i = 0; i < 16; ++i) { o[0][i] *= alpha; o[1][i] *= alpha; }
    bf16x8 pf[4]; pf[0] = pack_p(s0, 0); pf[1] = pack_p(s0, 8); pf[2] = pack_p(s1, 0); pf[3] = pack_p(s1, 8);
#pragma unroll
    for (int dt = 0; dt < 2; ++dt)
#pragma unroll
        for (int s = 0; s < 4; ++s) { LAS const unsigned char* vp = Vb + (32 * dt + r32) * VROW + (16 * s + 4 * h) * 2;
            const u32x2 lo = *(LAS const u32x2*)vp, hi = *(LAS const u32x2*)(vp + 16); u32x4 a; a.x = lo.x; a.y = lo.y; a.z = hi.x; a.w = hi.y;
            o[dt] = __builtin_amdgcn_mfma_f32_32x32x16_bf16(__builtin_bit_cast(bf16x8, a), pf[s], o[dt], 0, 0, 0); }
}
#define KEYOFF(kt, i) (32 * (kt) + ((i) & 3) + 8 * ((i) >> 2))
#define NEG_INF (-__builtin_inff())

template <int W> struct FBand {
    int tq, tw, h; const LAS float* lut;
    __device__ __forceinline__ bool active(int tile) { const int key0 = tile * 64; return key0 <= tw + 7 && key0 + 63 >= tw - W + 1; }
    __device__ __forceinline__ void apply(f32x16& s0, f32x16& s1, int tile) {
        const int rel0 = tq - tile * 64 - 4 * h;
        if (tw - tile * 64 - 63 >= 128) { const float b = lut[128];
#pragma unroll
            for (int i = 0; i < 16; ++i) { const int r0 = rel0 - KEYOFF(0, i), r1 = rel0 - KEYOFF(1, i);
                s0[i] = (unsigned)r0 < (unsigned)W ? s0[i] + b : NEG_INF; s1[i] = (unsigned)r1 < (unsigned)W ? s1[i] + b : NEG_INF; }
        } else {
#pragma unroll
            for (int i = 0; i < 16; ++i) { const int r0 = rel0 - KEYOFF(0, i), r1 = rel0 - KEYOFF(1, i);
                const float b0 = lut[min(max(r0, 0), 128)], b1 = lut[min(max(r1, 0), 128)];
                s0[i] = (unsigned)r0 < (unsigned)W ? s0[i] + b0 : NEG_INF; s1[i] = (unsigned)r1 < (unsigned)W ? s1[i] + b1 : NEG_INF; }
        }
    }
};
struct FCmp {
    int lim0, cmax_w;
    __device__ __forceinline__ bool active(int tile) { return tile * 64 <= cmax_w; }
    __device__ __forceinline__ void apply(f32x16& s0, f32x16& s1, int tile) {
        const int lim = lim0 - tile * 64;
#pragma unroll
        for (int i = 0; i < 16; ++i) { s0[i] = KEYOFF(0, i) <= lim ? s0[i] : NEG_INF; s1[i] = KEYOFF(1, i) <= lim ? s1[i] : NEG_INF; }
    }
};
struct FSlc {
    int tq, tw, h; const LAS float* lut; const LAS unsigned* bits; bool sel;
    __device__ __forceinline__ bool active(int tile) { sel = (bits[tile >> 5] >> (tile & 31)) & 1u; return __ballot(sel) != 0ull; }
    __device__ __forceinline__ void apply(f32x16& s0, f32x16& s1, int tile) {
        const int rel0 = tq - tile * 64 - 4 * h;
        if (tw - tile * 64 - 63 >= 128) { const float b = sel ? lut[128] : NEG_INF;
#pragma unroll
            for (int i = 0; i < 16; ++i) { s0[i] += b; s1[i] += b; }
        } else {
#pragma unroll
            for (int i = 0; i < 16; ++i) { const int r0 = rel0 - KEYOFF(0, i), r1 = rel0 - KEYOFF(1, i);
                const float b0 = lut[min(max(r0, 0), 128)], b1 = lut[min(max(r1, 0), 128)];
                s0[i] = (sel && r0 >= 0) ? s0[i] + b0 : NEG_INF; s1[i] = (sel && r1 >= 0) ? s1[i] + b1 : NEG_INF; }
        }
    }
};
template <class Fn>
__device__ __forceinline__ void attn_loop(LAS unsigned char* L, const TileSrc& src, int tile_lo, int ntiles, const bf16x8 (&q)[4], f32x16 (&o)[2], float& m, float& l, Fn& f, int tid, int r32, int h) {
    u32x4 kr, vr;
    tile_load(src, tile_lo * 64, true, tid, kr, vr);
#pragma unroll 1
    for (int i = 0; i < ntiles; ++i) {
        const int buf = i & 1;
        tile_store(L, buf, true, tid, kr, vr);
        if (i + 1 < ntiles) tile_load(src, (tile_lo + i + 1) * 64, true, tid, kr, vr);
        WG_BAR_LDS();
        const int tile = tile_lo + i;
        if (f.active(tile)) {
            f32x16 s0, s1; qk_tile(L + AT_K0 + buf * AT_KSZ, q, r32, h, s0, s1);
            f.apply(s0, s1, tile);
            softmax_pv(L + AT_V0 + buf * AT_VSZ, s0, s1, o, m, l, r32, h);
        }
    }
    WG_BAR_LDS();
}
__device__ __forceinline__ void build_lut(Frame& F, const float* rb) {
    LAS float* lut = (LAS float*)(F.lds + AT_LUT);
    for (int i = F.tid; i < 16 * 129; i += NWAVES * 64) { const int hh = i / 129, rel = i % 129; lut[hh * LUTS + rel] = rb[(int)BKT[rel] * 16 + hh] * LOG2E; }
    __syncthreads();
}
__device__ __forceinline__ void store_o(bf16* dst, const f32x16 (&o)[2], float sc, int h) {
#pragma unroll
    for (int dt = 0; dt < 2; ++dt)
#pragma unroll
        for (int gq = 0; gq < 4; ++gq) { u32x2 w; w.x = pkbf(o[dt][4 * gq] * sc, o[dt][4 * gq + 1] * sc); w.y = pkbf(o[dt][4 * gq + 2] * sc, o[dt][4 * gq + 3] * sc);
            *(u32x2*)(dst + 32 * dt + 8 * gq + 4 * h) = w; }
}
template <int MODE>
__device__ __forceinline__ void banded_unit(Frame& F, const float* sink, int T, int g) {
    LAS unsigned char* L = F.lds; const int tid = F.tid, lane = F.lane, w = F.wave, r32 = lane & 31, h = lane >> 5;
    const int t0 = T * 64, tw = t0 + 8 * w, tq = tw + (r32 >> 2), hg = g * 4 + (r32 & 3);
    constexpr int W = MODE == 0 ? 128 : 512;
    const bf16* Qp = (const bf16*)(F.ws + (MODE == 0 ? WS_QA : WS_QB)) + (size_t)tq * 512 + hg * 64;
    bf16x8 q[4];
#pragma unroll
    for (int ks = 0; ks < 4; ++ks) q[ks] = *(const bf16x8*)(Qp + 16 * ks + 8 * h);
    f32x16 o[2];
#pragma unroll
    for (int i = 0; i < 16; ++i) { o[0][i] = 0.f; o[1][i] = 0.f; }
    float m = -1e30f, l = 0.f;
    if (MODE == 0) { m = sink[hg] * LOG2E; l = 1.f; }
    const int tlo = max(0, t0 - W + 1) >> 6, nt = T - tlo + 1;
    TileSrc src; src.K = (const bf16*)(F.ws + (MODE == 0 ? WS_KA : WS_KW)) + (size_t)g * SEQ * 64; src.Vt = (const bf16*)(F.ws + (MODE == 0 ? WS_VTA : WS_VTW)) + (size_t)g * 64 * SEQ; src.vpitch = SEQ;
    FBand<W> f; f.tq = tq; f.tw = tw; f.h = h; f.lut = (const LAS float*)(L + AT_LUT) + ((MODE == 0 ? 0 : 8) + hg) * LUTS;
    attn_loop(L, src, tlo, nt, q, o, m, l, f, tid, r32, h);
    bf16* Op = (bf16*)(F.ws + (MODE == 0 ? WS_QA : WS_OW)) + (size_t)tq * 512 + hg * 64;
    store_o(Op, o, frcp(fmaxf(l, 1e-30f)), h);
}
__device__ __forceinline__ void compress_out(Frame& F, int b) {
    const int lane = F.lane, w = F.wave, r32 = lane & 31, h = lane >> 5;
    const int kvg = b >> 2, kv = kvg >> 1, g = kvg & 1, c0 = (b & 3) * 256 + 32 * w;
    const bf16* H = (const bf16*)(F.ws + WS_H) + (size_t)(256 * b + 32 * w + r32) * 256 + 8 * h;
    const bf16* W2 = (const bf16*)(F.ws + (kv ? WS_W2VT : WS_W2KT)) + (size_t)r32 * 256 + 8 * h;
    f32x16 a0, a1;
#pragma unroll
    for (int i = 0; i < 16; ++i) { a0[i] = 0.f; a1[i] = 0.f; }
#pragma unroll 4
    for (int ks = 0; ks < 16; ++ks) {
        const bf16x8 hf = *(const bf16x8*)(H + 16 * ks), w0 = *(const bf16x8*)(W2 + 16 * ks), w1 = *(const bf16x8*)(W2 + 32 * 256 + 16 * ks);
        if (kv == 0) { a0 = __builtin_amdgcn_mfma_f32_32x32x16_bf16(w0, hf, a0, 0, 0, 0); a1 = __builtin_amdgcn_mfma_f32_32x32x16_bf16(w1, hf, a1, 0, 0, 0); }
        else         { a0 = __builtin_amdgcn_mfma_f32_32x32x16_bf16(hf, w0, a0, 0, 0, 0); a1 = __builtin_amdgcn_mfma_f32_32x32x16_bf16(hf, w1, a1, 0, 0, 0); }
    }
    if (kv == 0) {
        const int c = c0 + r32; bf16* kc = (bf16*)(F.ws + WS_KC) + ((size_t)g * 1024 + c) * 64; const bool pad = (c == 1023);
#pragma unroll
        for (int nt = 0; nt < 2; ++nt)
#pragma unroll
            for (int gq = 0; gq < 4; ++gq) { const f32x16& a = nt ? a1 : a0; u32x2 wv; wv.x = pkbf(a[4 * gq], a[4 * gq + 1]); wv.y = pkbf(a[4 * gq + 2], a[4 * gq + 3]); if (pad) { wv.x = 0u; wv.y = 0u; }
                *(u32x2*)(kc + 32 * nt + 8 * gq + 4 * h) = wv; }
    } else {
        bf16* vct = (bf16*)(F.ws + WS_VCT) + (size_t)g * 64 * 1024;
#pragma unroll
        for (int nt = 0; nt < 2; ++nt)
#pragma unroll
            for (int gq = 0; gq < 4; ++gq) { const f32x16& a = nt ? a1 : a0; const int c = c0 + 8 * gq + 4 * h;
                u32x2 wv; wv.x = pkbf(a[4 * gq], a[4 * gq + 1]); wv.y = pkbf(a[4 * gq + 2], a[4 * gq + 3]); if (c + 3 == 1023) wv.y &= 0xffffu;
                *(u32x2*)(vct + (size_t)(32 * nt + r32) * 1024 + c) = wv; }
    }
}
__device__ __forceinline__ void nsa_unit(Frame& F, int T, int g) {
    LAS unsigned char* L = F.lds; const int tid = F.tid, lane = F.lane, w = F.wave, r32 = lane & 31, h = lane >> 5;
    const int t0 = T * 64, tw = t0 + 8 * w, ql = 8 * w + (r32 >> 2), tq = t0 + ql, hd = r32 & 3, hg = g * 4 + hd, jt = T;
    bf16* Qp = (bf16*)(F.ws + WS_QB) + (size_t)tq * 512 + hg * 64;
    bf16x8 q[4];
#pragma unroll
    for (int ks = 0; ks < 4; ++ks) q[ks] = *(const bf16x8*)(Qp + 16 * ks + 8 * h);
    const float* bg = (const float*)(F.ws + WS_BG) + (size_t)tq * 24 + hg; const float g0 = bg[0], g1 = bg[8], g2 = bg[16];
    f32x16 o[2];
#pragma unroll
    for (int i = 0; i < 16; ++i) { o[0][i] = 0.f; o[1][i] = 0.f; }
    float m = -1e30f, l = 0.f;
    const int ncmp = t0 / 16 + 3, ntc = (ncmp + 63) >> 6;
    TileSrc sc; sc.K = (const bf16*)(F.ws + WS_KC) + (size_t)g * 1024 * 64; sc.Vt = (const bf16*)(F.ws + WS_VCT) + (size_t)g * 64 * 1024; sc.vpitch = 1024;
    FCmp fc; fc.lim0 = ((tq - 31) >> 4) - 4 * h; fc.cmax_w = (tw + 7 - 31) >> 4;
    attn_loop(L, sc, 0, ntc, q, o, m, l, fc, tid, r32, h);
    const float inv = frcp(fmaxf(l, 1e-30f));
    { const bf16* OWp = (const bf16*)(F.ws + WS_OW) + (size_t)tq * 512 + hg * 64; const float s0_ = g0 * inv;
#pragma unroll
      for (int dt = 0; dt < 2; ++dt)
#pragma unroll
          for (int gq = 0; gq < 4; ++gq) { const u32x2 ow = *(const u32x2*)(OWp + 32 * dt + 8 * gq + 4 * h); u32x2 wv;
              wv.x = pkbf(s0_ * o[dt][4 * gq] + g2 * bf_lo(ow.x), s0_ * o[dt][4 * gq + 1] + g2 * bf_hi(ow.x));
              wv.y = pkbf(s0_ * o[dt][4 * gq + 2] + g2 * bf_lo(ow.y), s0_ * o[dt][4 * gq + 3] + g2 * bf_hi(ow.y));
              *(u32x2*)(Qp + 32 * dt + 8 * gq + 4 * h) = wv; } }
    LAS float* imp = (LAS float*)(L + AT_IMP);
    for (int i = lane; i < 8 * 256; i += 64) imp[8 * w * 256 + i] = 0.f;
    { u32x4 kr, vr; tile_load(sc, 0, false, tid, kr, vr);
#pragma unroll 1
      for (int i = 0; i < ntc; ++i) {
          const int buf = i & 1;
          tile_store(L, buf, false, tid, kr, vr);
          if (i + 1 < ntc) tile_load(sc, (i + 1) * 64, false, tid, kr, vr);
          WG_BAR_LDS();
          if (fc.active(i)) {
              f32x16 s0, s1; qk_tile(L + AT_K0 + buf * AT_KSZ, q, r32, h, s0, s1);
              fc.apply(s0, s1, i);
#pragma unroll
              for (int kt = 0; kt < 2; ++kt) { const f32x16& s = kt ? s1 : s0; float mainv = 0.f, spv = 0.f;
#pragma unroll
                  for (int gq = 0; gq < 4; ++gq) { const float p0 = fexp2(s[4 * gq] - m) * inv, p1 = fexp2(s[4 * gq + 1] - m) * inv, p2 = fexp2(s[4 * gq + 2] - m) * inv, p3 = fexp2(s[4 * gq + 3] - m) * inv;
                      const float mq = quad_sum((p0 + p1) + (p2 + 0.5f * p3)), sq = quad_sum(0.5f * p3);
                      if (gq == hd) { mainv = mq; spv = sq; } }
                  const int j = i * 16 + 8 * kt + 2 * hd + h;
                  __hip_atomic_fetch_add(imp + ql * 256 + j, mainv, __ATOMIC_RELAXED, __HIP_MEMORY_SCOPE_WORKGROUP);
                  __hip_atomic_fetch_add(imp + ql * 256 + min(j + 1, 255), (j + 1 < 256) ? spv : 0.f, __ATOMIC_RELAXED, __HIP_MEMORY_SCOPE_WORKGROUP); }
          }
      }
      WG_BAR_LDS(); }
    LAS unsigned* selb = (LAS unsigned*)(L + AT_SEL);
#pragma unroll 1
    for (int qi = 0; qi < 8; ++qi) {
        const LAS float* row = imp + (8 * w + qi) * 256; unsigned mybits = 0u;
        if (lane == 0) mybits |= 1u;
        if (lane == (jt >> 5)) mybits |= 1u << (jt & 31);
        if (jt >= 1 && lane == ((jt - 1) >> 5)) mybits |= 1u << ((jt - 1) & 31);
        const int ncand = jt - 2;
        if (ncand > 0) {
            if (ncand <= 13) { if (lane == 0) mybits |= ((1u << (jt - 1)) - 2u); }
            else {
                unsigned k[4];
#pragma unroll
                for (int i = 0; i < 4; ++i) { const int j = lane + 64 * i; const float v = row[j]; k[i] = (j >= 1 && j <= jt - 2) ? ((__float_as_uint(v) & ~255u) | (unsigned)(255 - j)) : 0u; }
#pragma unroll 1
                for (int it = 0; it < 13; ++it) { const unsigned mx = wave_max_u32(umax_(umax_(k[0], k[1]), umax_(k[2], k[3]))); const int j = 255 - (int)(mx & 255u);
                    if (lane == (j >> 5)) mybits |= 1u << (j & 31);
#pragma unroll
                    for (int i = 0; i < 4; ++i) k[i] = (k[i] == mx) ? 0u : k[i]; }
            }
        }
        if (lane < 8) selb[(8 * w + qi) * 8 + lane] = mybits;
    }
    f32x16 o2[2];
#pragma unroll
    for (int i = 0; i < 16; ++i) { o2[0][i] = 0.f; o2[1][i] = 0.f; }
    float m2 = -1e30f, l2 = 0.f;
    TileSrc ss; ss.K = (const bf16*)(F.ws + WS_KS) + (size_t)g * SEQ * 64; ss.Vt = (const bf16*)(F.ws + WS_VTS) + (size_t)g * 64 * SEQ; ss.vpitch = SEQ;
    FSlc fs; fs.tq = tq; fs.tw = tw; fs.h = h; fs.lut = (const LAS float*)(L + AT_LUT) + (8 + hg) * LUTS; fs.bits = selb + ql * 8; fs.sel = false;
    attn_loop(L, ss, 0, jt + 1, q, o2, m2, l2, fs, tid, r32, h);
    const float s2 = g1 * frcp(fmaxf(l2, 1e-30f));
#pragma unroll
    for (int dt = 0; dt < 2; ++dt)
#pragma unroll
        for (int gq = 0; gq < 4; ++gq) { u32x2 wv; const u32x2 tt = *(const u32x2*)(Qp + 32 * dt + 8 * gq + 4 * h); const unsigned ta = tt.x, tb = tt.y;
            wv.x = pkbf(bf_lo(ta) + s2 * o2[dt][4 * gq], bf_hi(ta) + s2 * o2[dt][4 * gq + 1]); wv.y = pkbf(bf_lo(tb) + s2 * o2[dt][4 * gq + 2], bf_hi(tb) + s2 * o2[dt][4 * gq + 3]);
            *(u32x2*)(Qp + 32 * dt + 8 * gq + 4 * h) = wv; }
}

__device__ __forceinline__ unsigned ord_key(float v) { const unsigned u = __float_as_uint(v); return u ^ ((unsigned)((int)u >> 31) | 0x80000000u); }
__device__ __forceinline__ float ord_val(unsigned k) { const unsigned u = (k & 0x80000000u) ? (k ^ 0x80000000u) : ~k; return __uint_as_float(u); }
__device__ __forceinline__ void peer_top16(const bf16* qrow, LAS const unsigned char* kmat, int r32, int h2, unsigned (&sel)[16]) {
    bf16x8 qf[8];
#pragma unroll
    for (int ks = 0; ks < 8; ++ks) qf[ks] = *(const bf16x8*)(qrow + 16 * ks + 8 * h2);
    unsigned key[64];
#pragma unroll
    for (int nt = 0; nt < 4; ++nt) { f32x16 s;
#pragma unroll
        for (int i = 0; i < 16; ++i) s[i] = 0.f;
#pragma unroll
        for (int ks = 0; ks < 8; ++ks) { const bf16x8 a = *(LAS const bf16x8*)(kmat + (32 * nt + r32) * PK_ROW + (16 * ks + 8 * h2) * 2); s = __builtin_amdgcn_mfma_f32_32x32x16_bf16(a, qf[ks], s, 0, 0, 0); }
#pragma unroll
        for (int i = 0; i < 16; ++i) key[nt * 16 + i] = (ord_key(s[i]) & ~127u) | (unsigned)(((63 - (nt * 16 + i)) << 1) | (1 - h2)); }
    unsigned prev = 0xFFFFFFFFu;
#pragma unroll
    for (int k = 0; k < 16; ++k) sel[k] = 0u;
#pragma unroll 1
    for (int it = 0; it < 16; ++it) { unsigned c = 0u;
#pragma unroll
        for (int i = 0; i < 64; ++i) c = umax_(c, key[i] - prev);
        const unsigned mloc = c + prev, mm = pair_umax(mloc);
#pragma unroll
        for (int k = 0; k < 16; ++k) sel[k] = (k == it) ? mm : sel[k];
        prev = mm; }
}
__device__ __forceinline__ int key_n(unsigned k) { const int low = k & 127, Lx = 63 - (low >> 1), hh = 1 - (low & 1); return ((Lx >> 4) << 5) + (((Lx >> 2) & 3) << 3) + (hh << 2) + (Lx & 3); }

__device__ __forceinline__ void peer_phase(Frame& F) {
    LAS unsigned char* L = F.lds; const int tid = F.tid, lane = F.lane, w = F.wave, r32 = lane & 31, h2 = lane >> 5;
    unsigned char* ws = F.ws;
    for (int i = tid; i < 2 * 128 * 16; i += NWAVES * 64) { const int which = i >> 11, rr = (i >> 4) & 127, ch = i & 15;
        *(LAS u32x4*)(L + (which ? PK2_OFF : PK1_OFF) + rr * PK_ROW + ch * 16) = *(const u32x4*)((const bf16*)(ws + (which ? WS_K2B : WS_K1B)) + rr * 128 + ch * 8); }
    __syncthreads();
    LAS unsigned char* PW = L + PW_OFF + w * PW_BYTES;
    LAS unsigned char* XR = PW; LAS u32x2* LST = (LAS u32x2*)(PW + 2048); LAS unsigned char* I12 = PW + 6144; LAS float* WL = (LAS float*)(PW + 7168);
    const bf16* Q2 = (const bf16*)(ws + WS_Q2); const bf16* U16 = (const bf16*)(ws + WS_U16); const _Float16* V16 = (const _Float16*)(ws + WS_V16);
    bf16* xb = (bf16*)(ws + WS_XB); const float* ssq1 = (const float*)(ws + WS_SSQ1); float* rs2 = (float*)(ws + WS_RS2);
    const int gw = F.vcu * NWAVES + w, NGW = F.G * NWAVES;
#pragma unroll 1
    for (int item = gw; item < SEQ / 4; item += NGW) {
        const int t0 = item * 4;
        {
            const int tk = r32 >> 3, hd = r32 & 7; const bf16* qrow = Q2 + (size_t)(t0 + tk) * 2048 + hd * 256;
            const float rsq = rs_from_ssq(ssq1, t0 + tk);
            unsigned s1[16], s2[16];
            peer_top16(qrow, L + PK1_OFF, r32, h2, s1);
            peer_top16(qrow + 128, L + PK2_OFF, r32, h2, s2);
            float v1[16], v2[16];
#pragma unroll
            for (int k = 0; k < 16; ++k) { v1[k] = ord_val(s1[k] & ~127u); v2[k] = ord_val(s2[k] & ~127u); }
            if (h2 == 0) { LAS unsigned* ip = (LAS unsigned*)(I12 + r32 * 32);
#pragma unroll
                for (int k4 = 0; k4 < 4; ++k4) { ip[k4] = (unsigned)key_n(s1[4 * k4]) | ((unsigned)key_n(s1[4 * k4 + 1]) << 8) | ((unsigned)key_n(s1[4 * k4 + 2]) << 16) | ((unsigned)key_n(s1[4 * k4 + 3]) << 24);
                    ip[4 + k4] = (unsigned)key_n(s2[4 * k4]) | ((unsigned)key_n(s2[4 * k4 + 1]) << 8) | ((unsigned)key_n(s2[4 * k4 + 2]) << 16) | ((unsigned)key_n(s2[4 * k4 + 3]) << 24); } }
            unsigned ck[50]; int nc = 0;
#pragma unroll
            for (int i = 0; i < 16; ++i)
#pragma unroll
                for (int j = 0; j < 16; ++j) if ((i + 1) * (j + 1) <= 16) { ck[nc] = (ord_key(v1[i] + v2[j]) & ~255u) | (unsigned)(255 - (16 * i + j)); ++nc; }
            unsigned prev = 0xFFFFFFFFu; float sc[16]; int ei[16];
#pragma unroll
            for (int it = 0; it < 16; ++it) { unsigned c = 0u;
#pragma unroll
                for (int i = 0; i < 50; ++i) c = umax_(c, ck[i] - prev);
                const unsigned mm = c + prev; prev = mm;
                const int flat = 255 - (int)(mm & 255u); sc[it] = ord_val(mm & ~255u);
                ei[it] = (int)I12[r32 * 32 + (flat >> 4)] * 128 + (int)I12[r32 * 32 + 16 + (flat & 15)]; }
            float den = 0.f, ex[16];
#pragma unroll
            for (int k = 0; k < 16; ++k) { ex[k] = fexp2((sc[k] - sc[0]) * (rsq * LOG2E)); den += ex[k]; }
            const float rd = frcp(den);
            if (h2 == 0) {
#pragma unroll
                for (int k = 0; k < 16; ++k) { u32x2 e; e.x = (unsigned)ei[k]; e.y = __float_as_uint(ex[k] * rd); LST[tk * 128 + hd * 16 + k] = e; } }
        }
#pragma unroll 1
        for (int tk = 0; tk < 4; ++tk) {
            const int t = t0 + tk;
            { const u32x4 a = *(const u32x4*)(xb + (size_t)t * DM + lane * 8), b = *(const u32x4*)(xb + (size_t)t * DM + 512 + lane * 8);
              *(LAS u32x4*)(XR + lane * 16) = a; *(LAS u32x4*)(XR + 1024 + lane * 16) = b; }
            const float rs = rs_from_ssq(ssq1, t);
            const int er = lane & 15, kq = lane >> 4;
            int eidx[8];
#pragma unroll
            for (int eg = 0; eg < 8; ++eg) eidx[eg] = (int)LST[tk * 128 + eg * 16 + er].x;
            f32x4 acc[8];
#pragma unroll
            for (int eg = 0; eg < 8; ++eg) acc[eg] = (f32x4){0.f, 0.f, 0.f, 0.f};
#pragma unroll 1
            for (int c = 0; c < 4; ++c) {
                bf16x8 xf[8];
#pragma unroll
                for (int s = 0; s < 8; ++s) xf[s] = *(LAS const bf16x8*)(XR + (256 * c + 64 * kq + 8 * s) * 2);
#pragma unroll
                for (int eg = 0; eg < 8; ++eg) { const bf16* up = U16 + (size_t)eidx[eg] * DM + 256 * c + 64 * kq;
                    bf16x8 uf[8];
#pragma unroll
                    for (int s = 0; s < 8; ++s) uf[s] = *(const bf16x8*)(up + 8 * s);
#pragma unroll
                    for (int s = 0; s < 8; ++s) acc[eg] = __builtin_amdgcn_mfma_f32_16x16x32_bf16(uf[s], xf[s], acc[eg], 0, 0, 0); }
            }
#pragma unroll
            for (int eg = 0; eg < 8; ++eg)
#pragma unroll
                for (int r = 0; r < 4; ++r) { const int idx = eg * 16 + 4 * kq + r; const float gate = __uint_as_float(LST[tk * 128 + idx].y); const float wv = gate * gelu_tanh(acc[eg][r] * rs);
                    if (er == 0) WL[idx] = wv; }
            float oa[8], ob[8];
#pragma unroll
            for (int i = 0; i < 8; ++i) { oa[i] = 0.f; ob[i] = 0.f; }
#pragma unroll 1
            for (int e0 = 0; e0 < 128; e0 += 4) {
                h16x8 va[4], vb[4]; float wv[4];
#pragma unroll
                for (int k = 0; k < 4; ++k) { const int idx = __builtin_amdgcn_readfirstlane((int)LST[tk * 128 + e0 + k].x); wv[k] = WL[e0 + k];
                    const _Float16* vp = V16 + (size_t)idx * DM + lane * 8; va[k] = *(const h16x8*)vp; vb[k] = *(const h16x8*)(vp + 512); }
#pragma unroll
                for (int k = 0; k < 4; ++k)
#pragma unroll
                    for (int i = 0; i < 8; ++i) { oa[i] += wv[k] * (float)va[k][i]; ob[i] += wv[k] * (float)vb[k][i]; }
            }
            float* op = F.out + (size_t)t * DM + lane * 8;
            f32x4 a0 = *(const f32x4*)op, a1 = *(const f32x4*)(op + 4), b0 = *(const f32x4*)(op + 512), b1 = *(const f32x4*)(op + 516);
#pragma unroll
            for (int i = 0; i < 4; ++i) { a0[i] += oa[i]; a1[i] += oa[4 + i]; b0[i] += ob[i]; b1[i] += ob[4 + i]; }
            *(f32x4*)op = a0; *(f32x4*)(op + 4) = a1; *(f32x4*)(op + 512) = b0; *(f32x4*)(op + 516) = b1;
            *(u32x4*)(xb + (size_t)t * DM + lane * 8) = pack8(a0, a1); *(u32x4*)(xb + (size_t)t * DM + 512 + lane * 8) = pack8(b0, b1);
            float ss = 0.f;
#pragma unroll
            for (int i = 0; i < 4; ++i) ss += a0[i] * a0[i] + a1[i] * a1[i] + b0[i] * b0[i] + b1[i] * b1[i];
            ss = wave_sum(ss);
            if (lane == 0) rs2[t] = __builtin_amdgcn_rsqf(ss * (1.0f / DM) + EPS);
        }
    }
}
__device__ __forceinline__ void convert_peer_tables(Frame& F, const float* u, const float* v, const float* g) {
    const int gt = (F.vcu * NWAVES + F.wave) * 64 + F.lane, NGT = F.G * NWAVES * 64;
    bf16* U16 = (bf16*)(F.ws + WS_U16); _Float16* V16 = (_Float16*)(F.ws + WS_V16);
    for (int i = gt; i < 16384 * 1024 / 8; i += NGT) {
        const int d0 = (i & 127) * 8; const f32x4 ga = *(const f32x4*)(g + d0), gb = *(const f32x4*)(g + d0 + 4);
        const f32x4 a = *(const f32x4*)(u + (size_t)i * 8) * ga, b = *(const f32x4*)(u + (size_t)i * 8 + 4) * gb;
        *(u32x4*)(U16 + (size_t)i * 8) = pack8(a, b);
        const f32x4 c = *(const f32x4*)(v + (size_t)i * 8), d = *(const f32x4*)(v + (size_t)i * 8 + 4);
        h16x8 hv; hv[0] = (_Float16)c[0]; hv[1] = (_Float16)c[1]; hv[2] = (_Float16)c[2]; hv[3] = (_Float16)c[3]; hv[4] = (_Float16)d[0]; hv[5] = (_Float16)d[1]; hv[6] = (_Float16)d[2]; hv[7] = (_Float16)d[3];
        *(h16x8*)(V16 + (size_t)i * 8) = hv;
    }
}
__device__ __forceinline__ void final_norm(Frame& F, const float* gf) {
    const int gw = F.vcu * NWAVES + F.wave, NGW = F.G * NWAVES, lane = F.lane;
    f32x4 gv[4];
#pragma unroll
    for (int j = 0; j < 4; ++j) gv[j] = ((const f32x4*)gf)[lane + 64 * j];
    for (int row = gw; row < SEQ; row += NGW) {
        f32x4* xr = (f32x4*)(F.out + (size_t)row * DM) + lane; f32x4 v[4]; float ss = 0.f;
#pragma unroll
        for (int j = 0; j < 4; ++j) { v[j] = xr[64 * j]; ss += (v[j][0] * v[j][0] + v[j][1] * v[j][1]) + (v[j][2] * v[j][2] + v[j][3] * v[j][3]); }
        const float rs = __builtin_amdgcn_rsqf(wave_sum(ss) * (1.0f / DM) + EPS);
#pragma unroll
        for (int j = 0; j < 4; ++j) xr[64 * j] = v[j] * rs * gv[j];
    }
}

constexpr int NPHASE = 10;
__global__ void __launch_bounds__(NWAVES * 64, 2) hybrid_fwd(Args args) {
    extern __shared__ __attribute__((aligned(16))) unsigned char lds[];
    Frame F;
    F.lds = (LAS unsigned char*)lds; F.MISC = (volatile LAS unsigned*)(F.lds + LDSCTL_OFF);
    F.tid = threadIdx.x; F.lane = F.tid & 63; F.wave = __builtin_amdgcn_readfirstlane(F.tid >> 6);
    F.G = gridDim.x; { const int bx = blockIdx.x; F.vcu = (F.G % 8 == 0) ? (bx % 8) * (F.G / 8) + bx / 8 : bx; }
    F.ws = args.ws; F.ctl = (gu32*)(args.ws + WS_CTL); F.out = args.out;
    for (int u = F.tid; u < (LDS_BYTES - LDSCTL_OFF) / 4; u += NWAVES * 64) ((LAS unsigned*)(F.lds + LDSCTL_OFF))[u] = 0u;
    __syncthreads();
    const int lo = args.ph_lo, hi = args.ph_hi;
    XcdBarrier bar = xcd_barrier_post((unsigned*)(F.ctl + CW_BAR), F.MISC + 8);
#ifndef PHASE_MASK
#define PHASE_MASK 0xFFFF
#endif
#define IN(k) (((PHASE_MASK >> (k)) & 1) && lo <= (k) && (k) < hi)
#define SEAM(k) do { if (IN(k) && IN((k) + 1)) xcd_barrier(bar); } while (0)
    unsigned char* ws = args.ws;
    const int G = F.G, bx = (int)blockIdx.x;

    if (IN(0)) { p0_prologue(F, args); }
    SEAM(0);
    if (IN(1)) {
        pg8::Gemm g{(const bf16*)(ws + WS_XB), (const bf16*)(ws + WS_WIN), SEQ, N1, DM, DM, DM}; pg8::StaticOrder S; S.init(SEQ, N1, G, bx);
        Epi1 E{(const float*)(ws + WS_RS0), ws};
        pg8::gemm_phase<Epi1, pg8::StaticOrder, true, true>(F.lds, g, S, E);
    }
    SEAM(1);
    if (IN(2)) {
        { pg8::Gemm g{(const bf16*)(ws + WS_CK), (const bf16*)(ws + WS_W1KV), 4096, 512, 2048, 1024, 2048}; pg8::OneUnit S{bx, bx >> 3, bx < 16 ? 1 : 0};
          EpiCmp E{(bf16*)(ws + WS_H), (const float*)(ws + WS_POSB)};
          pg8::gemm_phase<EpiCmp, pg8::OneUnit, false, true>(F.lds, g, S, E);
          if (bx < 16) { __threadfence(); __syncthreads(); compress_out(F, bx); } }
        __syncthreads();
        build_lut(F, args.in[5]);
        for (;;) {
            __syncthreads();
            if (F.tid == 0) F.MISC[16] = __hip_atomic_fetch_add(F.ctl + CW_QUEUE, 1u, RLX_AGENT);
            __syncthreads();
            const int unit = (int)F.MISC[16];
            if (unit >= 1024) break;
            if (unit < 512) banded_unit<1>(F, args.in[4], unit >> 1, unit & 1); else banded_unit<0>(F, args.in[4], (unit - 512) >> 1, unit & 1);
        }
    }
    SEAM(2);
    if (IN(3)) {
        build_lut(F, args.in[5]);
        for (int i = bx; i < 256; i += G) { nsa_unit(F, 255 - i, 1); nsa_unit(F, i, 0); }
    }
    SEAM(3);
    if (IN(4)) {
        { pg8::Gemm g{(const bf16*)(ws + WS_QA), (const bf16*)(ws + WS_WUPA), SEQ, DM, 512, 512, 512}; pg8::StaticOrder S; S.init(SEQ, DM, G, bx); EpiUp E{(bf16*)(ws + WS_MG), 0};
          pg8::gemm_phase<EpiUp, pg8::StaticOrder, true, true>(F.lds, g, S, E); }
        { pg8::Gemm g{(const bf16*)(ws + WS_QB), (const bf16*)(ws + WS_WUPB), SEQ, DM, 512, 512, 512}; pg8::StaticOrder S; S.init(SEQ, DM, G, bx); EpiUp E{(bf16*)(ws + WS_MG), 1024};
          pg8::gemm_phase<EpiUp, pg8::StaticOrder, true, true>(F.lds, g, S, E); }
    }
    SEAM(4);
    if (IN(5)) {
        { pg8::Gemm g{(const bf16*)(ws + WS_MG), (const bf16*)(ws + WS_WO2), SEQ, DM, 2048, 2048, 2048}; pg8::StaticOrder S; S.init(SEQ, DM, G, bx);
          EpiWo E{args.in[0], F.out, (bf16*)(ws + WS_XB), (float*)(ws + WS_SSQ1)};
          pg8::gemm_phase<EpiWo, pg8::StaticOrder, true, true>(F.lds, g, S, E); }
        convert_peer_tables(F, args.in[18], args.in[19], args.in[14]);
    }
    SEAM(5);
    if (IN(6)) {
        { pg8::Gemm g{(const bf16*)(ws + WS_XB), (const bf16*)(ws + WS_WQ), SEQ, 2048, DM, DM, DM}; pg8::StaticOrder S; S.init(SEQ, 2048, G, bx); EpiPw E{(bf16*)(ws + WS_Q2), 2048};
          pg8::gemm_phase<EpiPw, pg8::StaticOrder, true, true>(F.lds, g, S, E); }
        { pg8::Gemm g{(const bf16*)(ws + WS_PB), (const bf16*)(ws + WS_WPLE), SEQ, DM, 256, 256, 256}; pg8::StaticOrder S; S.init(SEQ, DM, G, bx); EpiPw E{(bf16*)(ws + WS_PW), DM};
          pg8::gemm_phase<EpiPw, pg8::StaticOrder, true, true>(F.lds, g, S, E); }
    }
    SEAM(6);
    if (IN(7)) { __syncthreads(); peer_phase(F); }
    SEAM(7);
    if (IN(8)) {
        pg8::Gemm g{(const bf16*)(ws + WS_XB), (const bf16*)(ws + WS_WPG), SEQ, DM, DM, DM, DM}; pg8::StaticOrder S; S.init(SEQ, DM, G, bx);
        EpiPle E{(const float*)(ws + WS_RS2), (const bf16*)(ws + WS_PW), F.out};
        pg8::gemm_phase<EpiPle, pg8::StaticOrder, true, true>(F.lds, g, S, E);
    }
    SEAM(8);
    if (IN(9)) final_norm(F, args.in[23]);
#undef IN
#undef SEAM
}

#ifndef MK_ONE_LAUNCH
#define MK_ONE_LAUNCH 0
#endif
extern "C" void kernel_launch(void* const* d_in, const int* in_sizes, int n_in, void* d_out, int out_size, void* d_ws, size_t ws_size, hipStream_t stream) {
    static int grid = 0;
    if (grid == 0) {
        if (n_in != 24 || in_sizes[0] != SEQ * DM || out_size != SEQ * DM || ws_size < WS_END) { fprintf(stderr, "kernel_launch: unexpected shapes (n_in %d, in0 %d, out %d, ws %zu); nothing launched\n", n_in, n_in > 0 ? in_sizes[0] : -1, out_size, ws_size); grid = -1; return; }
        int dev = 0, cus = 0, per_cu = 0;
        if (hipGetDevice(&dev) != hipSuccess || hipDeviceGetAttribute(&cus, hipDeviceAttributeMultiprocessorCount, dev) != hipSuccess) { grid = -1; return; }
        if (hipFuncSetAttribute((const void*)hybrid_fwd, hipFuncAttributeMaxDynamicSharedMemorySize, LDS_BYTES) != hipSuccess) { fprintf(stderr, "kernel_launch: hipFuncSetAttribute failed\n"); grid = -1; return; }
        if (hipOccupancyMaxActiveBlocksPerMultiprocessor(&per_cu, (const void*)hybrid_fwd, NWAVES * 64, LDS_BYTES) != hipSuccess || per_cu < 1) { fprintf(stderr, "kernel_launch: occupancy query says %d blocks per CU\n", per_cu); }
        (void)hipGetLastError();
        grid = cus;
    }
    if (grid < 0) return;
    if (hipMemsetAsync((char*)d_ws + WS_CTL, 0, CTL_ZERO_BYTES, stream) != hipSuccess) return;
    Args a{};
    for (int i = 0; i < 24; ++i) a.in[i] = (const float*)d_in[i];
    a.out = (float*)d_out; a.ws = (unsigned char*)d_ws;
#if MK_ONE_LAUNCH
    a.ph_lo = 0; a.ph_hi = NPHASE;
    hipLaunchKernelGGL(hybrid_fwd, dim3(grid), dim3(NWAVES * 64), LDS_BYTES, stream, a);
#else
    for (int p = 0; p < NPHASE; ++p) { a.ph_lo = p; a.ph_hi = p + 1; hipLaunchKernelGGL(hybrid_fwd, dim3(grid), dim3(NWAVES * 64), LDS_BYTES, stream, a); }
#endif
}
```

```cpp
#include <hip/hip_runtime.h>
#include <cstdio>
#include <cstdint>

#define GAS __attribute__((address_space(1)))
#define LAS __attribute__((address_space(3)))
typedef unsigned short bf16;
typedef short bf16x8 __attribute__((ext_vector_type(8)));
typedef short s16x4 __attribute__((ext_vector_type(4)));
typedef float f32x4 __attribute__((ext_vector_type(4)));
typedef float f32x16 __attribute__((ext_vector_type(16)));
typedef unsigned u32x4 __attribute__((ext_vector_type(4)));
typedef unsigned u32x2 __attribute__((ext_vector_type(2)));
typedef _Float16 h16x8 __attribute__((ext_vector_type(8)));
typedef GAS unsigned gu32;
typedef float f32x2_t __attribute__((ext_vector_type(2))); typedef __bf16 bf16x2_t __attribute__((ext_vector_type(2)));
__device__ __forceinline__ unsigned pkbf(float lo, float hi) { f32x2_t v = {lo, hi}; bf16x2_t b = __builtin_convertvector(v, bf16x2_t); return __builtin_bit_cast(unsigned, b); }
__device__ __forceinline__ float bf_lo(unsigned u) { return __uint_as_float(u << 16); }
__device__ __forceinline__ float bf_hi(unsigned u) { return __uint_as_float(u & 0xffff0000u); }
__device__ __forceinline__ float fexp2(float x) { return __builtin_amdgcn_exp2f(x); }
__device__ __forceinline__ float frcp(float x) { return __builtin_amdgcn_rcpf(x); }
__device__ __forceinline__ float sigmoidf_(float x) { return frcp(1.0f + fexp2(-1.4426950408889634f * x)); }
__device__ __forceinline__ float gelu_tanh(float x) { const float u = x * (1.0f + 0.044715f * x * x); return x * frcp(1.0f + fexp2(-2.302208198f * u)); }
#define LOG2E 1.4426950408889634f
#define RLX_AGENT __ATOMIC_RELAXED, __HIP_MEMORY_SCOPE_AGENT
#define LDS_WAIT() asm volatile("s_waitcnt lgkmcnt(0)" ::: "memory")
#define VM_WAIT() asm volatile("s_waitcnt vmcnt(0)" ::: "memory")

namespace pg8 {
#define PG8_LAS __attribute__((address_space(3)))
typedef unsigned short bf16_t;
typedef short bf16x8 __attribute__((ext_vector_type(8)));
typedef float f32x4 __attribute__((ext_vector_type(4)));
typedef unsigned u32x4 __attribute__((ext_vector_type(4)));
constexpr int BM = 256, BK = 64, HALF = 128, HTB = HALF * BK * 2  , STAGE_BYTES = 8 * HTB, NXCD = 8, WGM = 8;

__host__ __device__ __forceinline__ int lds_byte(int r, int c) { const int st = (r >> 4) * 2 + (c >> 5), rr = r & 15, cc = c & 31, ob = rr * 64 + cc * 2; return st * 1024 + (ob ^ (((ob >> 9) & 1) << 5)); }
__host__ __device__ __forceinline__ void stage_rc(int b, int& R, int& C) { const int st = b / 1024, sb = b % 1024, swz = sb ^ (((sb >> 9) & 1) << 5); R = (st >> 1) * 16 + swz / 64; C = (st & 1) * 32 + (swz % 64) / 2; }
__host__ __device__ __forceinline__ int perm32(int rho) { const int n = rho >> 4, i = rho & 15; return 8 * (i >> 2) + 4 * n + (i & 3); }

struct Unit { int pm, pn; };
struct Gemm { const bf16_t* A; const bf16_t* Bt; int M, N, K, lda, ldb; };

struct StaticOrder {
    int nM, nN, nwg, G, c;
    __host__ __device__ void init(int M, int N, int G_, int c_) { nM = M / BM; nN = N / BM; nwg = nM * nN; G = G_; c = c_; }
    __host__ __device__ bool next(int i, Unit& u) const {
        const long L = (long)i * G + c; if (L >= nwg) return false;
        int wgid = (int)L; { const int q = nwg / NXCD, r = nwg % NXCD, xcd = wgid % NXCD, off = wgid / NXCD; wgid = (xcd < r ? xcd * (q + 1) : r * (q + 1) + (xcd - r) * q) + off; }
        const int nig = WGM * nN, gid = wgid / nig, fm = gid * WGM, gsz = (nM - fm) < WGM ? (nM - fm) : WGM;
        u.pm = fm + ((wgid % nig) % gsz); u.pn = (wgid % nig) / gsz; return true;
    }
    __device__ __forceinline__ void a_ready(const Unit&) const {}
    __device__ __forceinline__ void done(const Unit&) const {}
};
struct OneUnit {
    int pm, pn, has;
    __device__ bool next(int i, Unit& u) const { if (i == 0 && has) { u.pm = pm; u.pn = pn; return true; } return false; }
    __device__ __forceinline__ void a_ready(const Unit&) const {}
    __device__ __forceinline__ void done(const Unit&) const {}
};
template <class Epi, class Sched, bool ALIGN_EPI = false, bool SP2 = false>
__device__ __forceinline__ void gemm_phase(PG8_LAS unsigned char* lds, const Gemm g, const Sched& S, const Epi& E) {
    const int tid = threadIdx.x, wid = __builtin_amdgcn_readfirstlane(tid >> 6), lane = tid & 63, wr = wid >> 2, wc = wid & 3, fr = lane & 15, fq = lane >> 4;
    const int K = g.K, nt = K / BK;
    unsigned voffA[2], voffB[2];
#pragma unroll
    for (int i = 0; i < 2; ++i) { int R, C; stage_rc(tid * 16 + i * 8192, R, C); const int Rb = Epi::PERM ? ((R & ~31) + perm32(R & 31)) : R;
        voffA[i] = (unsigned)(R * g.lda + C) * 2u; voffB[i] = (unsigned)(Rb * g.ldb + C) * 2u; }
    const size_t kstep = (size_t)(BK * 2);
    const size_t hstepA = (size_t)HALF * g.lda * 2, hstepB = (size_t)HALF * g.ldb * 2;
    const size_t tstepA = 2 * hstepA, tstepB = 2 * hstepB;
    const unsigned ldsw = (unsigned)wid * 1024u;
    const int aoff = lds_byte(wr * 64 + fr, fq * 8), boff = lds_byte(wc * 32 + fr, fq * 8);
#define PG8_SA(b, h) (((b) * 2 + (h)) * HTB)
#define PG8_SB(b, h) ((4 + (b) * 2 + (h)) * HTB)
#define PG8_STAGE(bufoff, gbase, voff) do { _Pragma("unroll") for (int _i = 0; _i < 2; ++_i) \
        __builtin_amdgcn_global_load_lds((const unsigned*)((const char*)(gbase) + (voff)[_i]), (PG8_LAS unsigned*)(lds + (bufoff) + ldsw + _i * 8192), 16, 0, 0); } while (0)
#define PG8_LDA(dst, b, h) do { _Pragma("unroll") for (int m = 0; m < 4; ++m) _Pragma("unroll") for (int k = 0; k < 2; ++k) dst[m][k] = *(const PG8_LAS bf16x8*)(lds + PG8_SA(b, h) + aoff + m * 2048 + k * 1024); } while (0)
#define PG8_LDB(dst, b, h) do { _Pragma("unroll") for (int n = 0; n < 2; ++n) _Pragma("unroll") for (int k = 0; k < 2; ++k) dst[n][k] = *(const PG8_LAS bf16x8*)(lds + PG8_SB(b, h) + boff + n * 2048 + k * 1024); } while (0)
#define PG8_MMA(ai, bj, At, Bt) do { __builtin_amdgcn_s_setprio(1); _Pragma("unroll") for (int m = 0; m < 4; ++m) _Pragma("unroll") for (int n = 0; n < 2; ++n) _Pragma("unroll") for (int k = 0; k < 2; ++k) \
        acc[ai][bj][m][n] = __builtin_amdgcn_mfma_f32_16x16x32_bf16(Bt[n][k], At[m][k], acc[ai][bj][m][n], 0, 0, 0); __builtin_amdgcn_s_setprio(0); } while (0)
#define PG8_WAIT_V(n) asm volatile("s_waitcnt vmcnt(" #n ")" ::: "memory")
#define PG8_WAIT_L(n) asm volatile("s_waitcnt lgkmcnt(" #n ")" ::: "memory")
#define PG8_BAR __builtin_amdgcn_s_barrier()
#define PG8_SCHED __builtin_amdgcn_sched_barrier(0)
    Unit cur, nxt; int ui = 0;
    if (!S.next(0, cur)) return;
    f32x4 acc[2][2][4][2];
#pragma unroll
    for (int a = 0; a < 2; ++a)
#pragma unroll
        for (int b = 0; b < 2; ++b)
#pragma unroll
            for (int m = 0; m < 4; ++m)
#pragma unroll
                for (int n = 0; n < 2; ++n) acc[a][b][m][n] = (f32x4){0.f, 0.f, 0.f, 0.f};
    bf16x8 At[4][2], B0[2][2], B1[2][2];
    const char* cA = (const char*)g.A + (size_t)cur.pm * tstepA; const char* cB = (const char*)g.Bt + (size_t)cur.pn * tstepB;
    S.a_ready(cur);
    if constexpr (SP2) {
        PG8_STAGE(PG8_SB(0, 0), cB, voffB); PG8_STAGE(PG8_SB(0, 1), cB + hstepB, voffB); PG8_STAGE(PG8_SA(0, 0), cA, voffA); PG8_STAGE(PG8_SA(0, 1), cA + hstepA, voffA);
        if (wr == 1) PG8_BAR;
        PG8_WAIT_V(2); PG8_BAR;
        PG8_STAGE(PG8_SB(1, 0), cB + kstep, voffB); PG8_STAGE(PG8_SA(1, 0), cA + kstep, voffA); PG8_STAGE(PG8_SB(1, 1), cB + hstepB + kstep, voffB);
        PG8_WAIT_V(6); PG8_BAR;
    } else {
        PG8_STAGE(PG8_SB(0, 0), cB, voffB); PG8_STAGE(PG8_SA(0, 0), cA, voffA); PG8_STAGE(PG8_SB(0, 1), cB + hstepB, voffB); PG8_STAGE(PG8_SA(0, 1), cA + hstepA, voffA);
        if (wr == 1) PG8_BAR;
        PG8_WAIT_V(4); PG8_BAR;
        PG8_STAGE(PG8_SB(1, 0), cB + kstep, voffB); PG8_STAGE(PG8_SA(1, 0), cA + kstep, voffA); PG8_STAGE(PG8_SB(1, 1), cB + hstepB + kstep, voffB);
        PG8_WAIT_V(6); PG8_BAR;
    }
    for (;;) {
        const bool has_next = S.next(ui + 1, nxt);
        const char* nA = has_next ? (const char*)g.A + (size_t)nxt.pm * tstepA : cA; const char* nB = has_next ? (const char*)g.Bt + (size_t)nxt.pn * tstepB : cB;
        for (int t = 0; t < nt; t += 2) {
            const bool last = (t == nt - 2);
            const char* a1 = cA + (size_t)(t + 1) * kstep;
            const char* a2 = last ? nA : cA + (size_t)(t + 2) * kstep; const char* b2 = last ? nB : cB + (size_t)(t + 2) * kstep;
            const char* a3 = a2 + kstep; const char* b3 = b2 + kstep;
            if (last && has_next) S.a_ready(nxt);
            if constexpr (SP2) {
            PG8_LDB(B0, 0, 0); PG8_LDB(B1, 0, 1); PG8_SCHED; PG8_LDA(At, 0, 0); PG8_STAGE(PG8_SA(1, 1), a1 + hstepA, voffA);
            PG8_WAIT_V(8); PG8_WAIT_L(0); PG8_BAR; PG8_MMA(0, 0, At, B0); PG8_MMA(0, 1, At, B1); PG8_BAR; PG8_SCHED;
            PG8_LDA(At, 0, 1); PG8_STAGE(PG8_SB(0, 0), b2, voffB); PG8_STAGE(PG8_SB(0, 1), b2 + hstepB, voffB); PG8_STAGE(PG8_SA(0, 0), a2, voffA);
            PG8_WAIT_V(8); PG8_WAIT_L(0); PG8_BAR; PG8_MMA(1, 0, At, B0); PG8_MMA(1, 1, At, B1); PG8_BAR; PG8_SCHED;
            PG8_LDB(B0, 1, 0); PG8_LDB(B1, 1, 1); PG8_SCHED; PG8_LDA(At, 1, 0); PG8_STAGE(PG8_SA(0, 1), a2 + hstepA, voffA);
            PG8_WAIT_V(8); PG8_WAIT_L(0); PG8_BAR; PG8_MMA(0, 0, At, B0); PG8_MMA(0, 1, At, B1); PG8_BAR; PG8_SCHED;
            PG8_LDA(At, 1, 1); PG8_STAGE(PG8_SB(1, 0), b3, voffB); PG8_STAGE(PG8_SB(1, 1), b3 + hstepB, voffB); PG8_STAGE(PG8_SA(1, 0), a3, voffA);
            PG8_WAIT_V(8); PG8_WAIT_L(0); PG8_BAR; PG8_MMA(1, 0, At, B0); PG8_MMA(1, 1, At, B1); PG8_BAR; PG8_SCHED;
            } else {
            PG8_LDB(B0, 0, 0); PG8_SCHED; PG8_LDA(At, 0, 0); PG8_STAGE(PG8_SA(1, 1), a1 + hstepA, voffA);
            PG8_WAIT_L(8); PG8_BAR; PG8_WAIT_L(0); PG8_MMA(0, 0, At, B0); PG8_BAR; PG8_SCHED;
            PG8_LDB(B1, 0, 1); PG8_STAGE(PG8_SB(0, 0), b2, voffB);
            PG8_BAR; PG8_WAIT_L(0); PG8_MMA(0, 1, At, B1); PG8_BAR;
            PG8_LDA(At, 0, 1); PG8_STAGE(PG8_SA(0, 0), a2, voffA);
            PG8_BAR; PG8_WAIT_L(0); PG8_MMA(1, 0, At, B0); PG8_BAR; PG8_SCHED;
            PG8_STAGE(PG8_SB(0, 1), b2 + hstepB, voffB);
            PG8_WAIT_V(6); PG8_BAR; PG8_MMA(1, 1, At, B1); PG8_BAR;
            PG8_LDB(B0, 1, 0); PG8_SCHED; PG8_LDA(At, 1, 0); PG8_STAGE(PG8_SA(0, 1), a2 + hstepA, voffA);
            PG8_WAIT_L(8); PG8_BAR; PG8_WAIT_L(0); PG8_MMA(0, 0, At, B0); PG8_BAR; PG8_SCHED;
            PG8_LDB(B1, 1, 1); PG8_STAGE(PG8_SB(1, 0), b3, voffB);
            PG8_BAR; PG8_WAIT_L(0); PG8_MMA(0, 1, At, B1); PG8_BAR;
            PG8_LDA(At, 1, 1); PG8_STAGE(PG8_SA(1, 0), a3, voffA);
            PG8_BAR; PG8_WAIT_L(0); PG8_MMA(1, 0, At, B0); PG8_BAR; PG8_SCHED;
            PG8_STAGE(PG8_SB(1, 1), b3 + hstepB, voffB);
            PG8_WAIT_V(6); PG8_BAR; PG8_MMA(1, 1, At, B1); PG8_BAR;
            }
        }
        if constexpr (ALIGN_EPI) { if (wr == 0) PG8_BAR; }
        if constexpr (!Epi::AFTER_DRAIN) { E(acc, cur, wr, wc, fr, fq); S.done(cur); }
        if (!has_next) break;
#pragma unroll
        for (int a = 0; a < 2; ++a)
#pragma unroll
            for (int b = 0; b < 2; ++b)
#pragma unroll
                for (int m = 0; m < 4; ++m)
#pragma unroll
                    for (int n = 0; n < 2; ++n) acc[a][b][m][n] = (f32x4){0.f, 0.f, 0.f, 0.f};
        cur = nxt; cA = nA; cB = nB; ++ui;
        if constexpr (ALIGN_EPI) { if (wr == 1) PG8_BAR; }
    }
    PG8_WAIT_V(0);
    if constexpr (!ALIGN_EPI) { if (wr == 0) PG8_BAR; }
    PG8_BAR;
    if constexpr (Epi::AFTER_DRAIN) { E.fused(acc, cur, wr, wc, fr, fq, lds, wid, lane); S.done(cur); }
#undef PG8_SA
#undef PG8_SB
#undef PG8_STAGE
#undef PG8_LDA
#undef PG8_LDB
#undef PG8_MMA
#undef PG8_WAIT_V
#undef PG8_WAIT_L
#undef PG8_BAR
#undef PG8_SCHED
}
}
#undef PG8_LAS
#define XB_TMO      128
#define XB_XCNT(j)  (256  + 64 * (j))
#define XB_XSUB(j)  (1280 + 64 * (j))
#define XB_XGEN(j)  (2304 + 64 * (j))
#define XB_TOP      3328
#define XB_TOPGEN   3392
#define XCD_BAR_WORDS 3456
#define XB_SPIN_CAP (1u << 18)

__device__ __forceinline__ unsigned xb_ld(unsigned* p)              { return __hip_atomic_load(p, __ATOMIC_RELAXED, __HIP_MEMORY_SCOPE_AGENT); }
__device__ __forceinline__ unsigned xb_add(unsigned* p, unsigned v) { return __hip_atomic_fetch_add(p, v, __ATOMIC_RELAXED, __HIP_MEMORY_SCOPE_AGENT); }
__device__ __forceinline__ unsigned xb_xcc_id() { return (unsigned)__builtin_amdgcn_s_getreg((3 << 11) | 20) & 0xFu; }
#define XB_SPIN(cond, bar) do { unsigned _sp = 0; while (cond) { __builtin_amdgcn_s_sleep(1); \
    if ((++_sp & 255u) == 0u) { if (xb_ld(&(bar)[XB_TMO])) break; if (_sp > XB_SPIN_CAP) { atomicAdd(&(bar)[XB_TMO], 1u); break; } } } } while (0)

struct XcdBarrier {
    unsigned* bar; unsigned x;
    volatile LAS unsigned* st;
};

__device__ __forceinline__ XcdBarrier xcd_barrier_post(unsigned* bar, volatile LAS unsigned* st) {
    XcdBarrier b; b.bar = bar; b.x = xb_xcc_id(); b.st = st;
    if (threadIdx.x == 0) (void)xb_add(&bar[XB_XCNT(b.x)], 1u);
    return b;
}
__device__ __forceinline__ void xcd_barrier_complete(unsigned* bar, unsigned x, unsigned& nloc, unsigned& nx) {
    const unsigned G = gridDim.x * gridDim.y * gridDim.z;
    unsigned sum, cnt, mine, sp = 0u;
    for (;;) {
        sum = 0u; cnt = 0u; mine = 0u;
#pragma unroll
        for (unsigned j = 0; j < 16; ++j) { const unsigned c = xb_ld(&bar[XB_XCNT(j)]); sum += c; cnt += (c > 0u) ? 1u : 0u; mine = (j == x) ? c : mine; }
        if (sum == G) break;
        __builtin_amdgcn_s_sleep(1);
        if ((++sp & 255u) == 0u) { if (xb_ld(&bar[XB_TMO])) break; if (sp > XB_SPIN_CAP) { atomicAdd(&bar[XB_TMO], 1u); break; } }
    }
    nloc = mine > 0u ? mine : 1u; nx = cnt > 0u ? cnt : 1u;
}

__device__ __forceinline__ void xcd_barrier(const XcdBarrier& b) {
    asm volatile("s_waitcnt vmcnt(0)" ::: "memory");
    __syncthreads();
    if (threadIdx.x == 0) {
        unsigned* bar = b.bar;
        __builtin_amdgcn_s_waitcnt(0);
        unsigned nloc = b.st[0], nx = b.st[1];
        if (nloc == 0u) { xcd_barrier_complete(bar, b.x, nloc, nx); b.st[0] = nloc; b.st[1] = nx; }
        const unsigned old = xb_add(&bar[XB_XSUB(b.x)], 1u);
        const unsigned gen = old / nloc;
        if (old + 1u == (gen + 1u) * nloc) {
            __builtin_amdgcn_fence(__ATOMIC_RELEASE, "agent");
            asm volatile("s_waitcnt vmcnt(0)" ::: "memory");
            const unsigned og = xb_add(&bar[XB_TOP], 1u);
            const unsigned tg = og / nx;
            if (og + 1u == (tg + 1u) * nx) xb_add(&bar[XB_TOPGEN], 1u);
            else XB_SPIN(xb_ld(&bar[XB_TOPGEN]) == tg, bar);
            __builtin_amdgcn_fence(__ATOMIC_ACQUIRE, "agent");
            xb_add(&bar[XB_XGEN(b.x)], 1u);
            asm volatile("s_waitcnt vmcnt(0)" ::: "memory");
        } else {
            XB_SPIN(xb_ld(&bar[XB_XGEN(b.x)]) == gen, bar);
            __builtin_amdgcn_fence(__ATOMIC_ACQUIRE, "agent");
            asm volatile("s_waitcnt vmcnt(0)" ::: "memory");
        }
    }
    __syncthreads();
}

constexpr int SEQ = 16384, DM = 1024, N1 = 4352  , NWAVES = 8;
constexpr float EPS = 1e-6f, QSCALE = 0.125f * LOG2E;
constexpr size_t MiB = 1u << 20;
constexpr size_t WS_CTL = 0, CTL_ZERO_BYTES = 1 * MiB;
constexpr size_t WS_WIN = 1 * MiB, WS_WUPA = 10 * MiB, WS_WUPB = 11 * MiB, WS_WO2 = 12 * MiB, WS_WQ = 16 * MiB, WS_WPG = 20 * MiB, WS_WPLE = 22 * MiB, WS_W1KV = 23 * MiB;
constexpr size_t WS_SMALL = 25 * MiB, WS_W2KT = WS_SMALL, WS_W2VT = WS_SMALL + 32768, WS_K1B = WS_SMALL + 65536, WS_K2B = WS_SMALL + 98304, WS_POSB = WS_SMALL + 131072,
                 WS_RS0 = WS_SMALL + 262144, WS_RS2 = WS_SMALL + 393216;
constexpr size_t WS_SSQ1 = 26 * MiB, WS_BG = 27 * MiB, WS_KC = 28 * MiB + 512 * 1024, WS_VCT = WS_KC + 262144, WS_H = 29 * MiB;
constexpr size_t WS_XB = 32 * MiB, WS_MG = 64 * MiB, WS_QA = 128 * MiB, WS_QB = 144 * MiB;
constexpr size_t WS_KA = 160 * MiB, WS_VTA = 164 * MiB, WS_CK = 168 * MiB, WS_KS = 176 * MiB, WS_VTS = 180 * MiB, WS_KW = 184 * MiB, WS_VTW = 188 * MiB;
constexpr size_t WS_OW = 192 * MiB, WS_PW = 208 * MiB, WS_PB = 240 * MiB;
constexpr size_t WS_U16 = 128 * MiB, WS_V16 = 160 * MiB, WS_Q2 = 64 * MiB;
constexpr size_t WS_END = 256 * MiB;
constexpr int CW_TMO = 0, CW_BAR = 4096, CW_QUEUE = 8192;
constexpr int LDS_BYTES = 147456, LDSCTL_OFF = 143360;
constexpr int KROW = 144, VROW = 136;
constexpr int AT_K0 = 0, AT_KSZ = 64 * KROW, AT_V0 = 2 * AT_KSZ, AT_VSZ = 64 * VROW, AT_LUT = 36864, LUTS = 136, AT_IMP = 46080, AT_SEL = 111616;
constexpr int PK_ROW = 272, PK1_OFF = 0, PK2_OFF = 128 * PK_ROW, PW_OFF = 2 * 128 * PK_ROW, PW_BYTES = 8192;
static_assert(AT_V0 + 2 * AT_VSZ <= AT_LUT && AT_LUT + 16 * LUTS * 4 <= AT_IMP && AT_SEL + 2048 <= LDSCTL_OFF && PW_OFF + 8 * PW_BYTES <= LDSCTL_OFF, "LDS map");

__device__ const unsigned char BKT[129] = {0,1,2,3,4,5,6,7,8,9,10,11,12,13,14,15,16,16,16,17,17,18,18,18,19,19,19,20,20,20,20,21,21,21,21,22,22,22,22,22,23,23,23,23,23,23,24,24,24,24,24,24,
    25,25,25,25,25,25,25,26,26,26,26,26,26,26,26,27,27,27,27,27,27,27,27,27,27,28,28,28,28,28,28,28,28,28,28,29,29,29,29,29,29,29,29,29,29,29,29,30,30,30,30,30,30,30,30,30,30,30,30,30,30,
    31,31,31,31,31,31,31,31,31,31,31,31,31,31,31,31};

struct Args { const float* in[24]; float* out; unsigned char* ws; int ph_lo, ph_hi; };
struct Frame {
    LAS unsigned char* lds; volatile LAS unsigned* MISC; gu32* ctl; unsigned char* ws;
    int tid, lane, wave, vcu, G;
    float* out;
};
template <int CTRL> __device__ __forceinline__ float dpp_f(float v) { return __uint_as_float((unsigned)__builtin_amdgcn_update_dpp(0, (int)__float_as_uint(v), CTRL, 0xf, 0xf, true)); }
template <int CTRL> __device__ __forceinline__ unsigned dpp_u(unsigned v) { return (unsigned)__builtin_amdgcn_update_dpp(0, (int)v, CTRL, 0xf, 0xf, true); }
__device__ __forceinline__ float wave_sum(float v) {
#pragma unroll
    for (int o = 1; o < 64; o <<= 1) v += __shfl_xor(v, o);
    return v;
}
__device__ __forceinline__ float quad_sum(float v) { v += dpp_f<0xB1>(v); v += dpp_f<0x4E>(v); return v; }
__device__ __forceinline__ unsigned umax_(unsigned a, unsigned b) { return a > b ? a : b; }
__device__ __forceinline__ unsigned wave_max_u32(unsigned v) {
    v = umax_(v, dpp_u<0xB1>(v)); v = umax_(v, dpp_u<0x4E>(v)); v = umax_(v, dpp_u<0x141>(v)); v = umax_(v, dpp_u<0x140>(v));
    const unsigned a = __builtin_amdgcn_readlane(v, 0), b = __builtin_amdgcn_readlane(v, 16), c = __builtin_amdgcn_readlane(v, 32), d = __builtin_amdgcn_readlane(v, 48);
    return umax_(umax_(a, b), umax_(c, d));
}
__device__ __forceinline__ float pair_max(float v) { auto rr = __builtin_amdgcn_permlane32_swap(__float_as_uint(v), __float_as_uint(v), false, false); return fmaxf(__uint_as_float(rr[0]), __uint_as_float(rr[1])); }
__device__ __forceinline__ float pair_sum(float v) { auto rr = __builtin_amdgcn_permlane32_swap(__float_as_uint(v), __float_as_uint(v), false, false); return __uint_as_float(rr[0]) + __uint_as_float(rr[1]); }
__device__ __forceinline__ unsigned pair_umax(unsigned v) { auto rr = __builtin_amdgcn_permlane32_swap(v, v, false, false); return umax_(rr[0], rr[1]); }
#define WG_BAR_LDS() do { asm volatile("s_waitcnt lgkmcnt(0)" ::: "memory"); __builtin_amdgcn_s_barrier(); asm volatile("" ::: "memory"); } while (0)
__device__ __forceinline__ u32x4 pack8(const f32x4& a, const f32x4& b) { u32x4 w; w.x = pkbf(a[0], a[1]); w.y = pkbf(a[2], a[3]); w.z = pkbf(b[0], b[1]); w.w = pkbf(b[2], b[3]); return w; }

typedef const f32x4 (&AccRef)[2][2][4][2];
struct Epi1 {
    static constexpr bool PERM = true, AFTER_DRAIN = false;
    const float* rs0; unsigned char* ws;
    __device__ __forceinline__ void operator()(AccRef acc, const pg8::Unit& u, int wr, int wc, int fr, int fq) const {
        const int row0 = u.pm * 256 + wr * 64 + fr, pn = u.pn, cl = wc * 32 + 8 * fq;
        if (pn < 4) {
            bf16* Q = (bf16*)(ws + (pn < 2 ? WS_QA : WS_QB)) + (pn & 1) * 256 + cl;
#pragma unroll
            for (int ai = 0; ai < 2; ++ai)
#pragma unroll
                for (int m = 0; m < 4; ++m) { const int row = row0 + ai * 128 + m * 16; const float s = rs0[row] * QSCALE;
#pragma unroll
                    for (int bj = 0; bj < 2; ++bj) *(u32x4*)(Q + (size_t)row * 512 + bj * 128) = pack8(acc[ai][bj][m][0] * s, acc[ai][bj][m][1] * s); }
        } else if (pn < 8) {
            const int g = wc >> 1, dl = cl & 63;
            const size_t koff = pn == 4 ? WS_KA : pn == 5 ? WS_CK : pn == 6 ? WS_KS : WS_KW;
            const size_t voff = pn == 4 ? WS_VTA : pn == 5 ? WS_CK + (size_t)2 * SEQ * 64 * 2 : pn == 6 ? WS_VTS : WS_VTW;
            bf16* Kd = (bf16*)(ws + koff) + (size_t)g * SEQ * 64 + dl;
            bf16* Vd = (bf16*)(ws + voff);
#pragma unroll
            for (int ai = 0; ai < 2; ++ai)
#pragma unroll
                for (int m = 0; m < 4; ++m) { const int row = row0 + ai * 128 + m * 16; const float s = rs0[row];
                    *(u32x4*)(Kd + (size_t)row * 64) = pack8(acc[ai][0][m][0] * s, acc[ai][0][m][1] * s);
                    const u32x4 v = pack8(acc[ai][1][m][0] * s, acc[ai][1][m][1] * s);
                    if (pn == 5) *(u32x4*)(Vd + ((size_t)g * SEQ + row) * 64 + dl) = v;
                    else { bf16* vt = Vd + (size_t)(g * 64 + dl) * SEQ + row;
                        vt[0 * (size_t)SEQ] = (bf16)v.x; vt[1 * (size_t)SEQ] = (bf16)(v.x >> 16); vt[2 * (size_t)SEQ] = (bf16)v.y; vt[3 * (size_t)SEQ] = (bf16)(v.y >> 16);
                        vt[4 * (size_t)SEQ] = (bf16)v.z; vt[5 * (size_t)SEQ] = (bf16)(v.z >> 16); vt[6 * (size_t)SEQ] = (bf16)v.w; vt[7 * (size_t)SEQ] = (bf16)(v.w >> 16); } }
        } else if (pn < 16) {
            bf16* MG = (bf16*)(ws + WS_MG) + (pn - 8) * 256 + cl;
#pragma unroll
            for (int ai = 0; ai < 2; ++ai)
#pragma unroll
                for (int m = 0; m < 4; ++m) { const int row = row0 + ai * 128 + m * 16; const float s = rs0[row];
#pragma unroll
                    for (int bj = 0; bj < 2; ++bj) { f32x4 a = acc[ai][bj][m][0] * s, b = acc[ai][bj][m][1] * s;
#pragma unroll
                        for (int e = 0; e < 4; ++e) { a[e] = sigmoidf_(a[e]); b[e] = sigmoidf_(b[e]); }
                        *(u32x4*)(MG + (size_t)row * 2048 + bj * 128) = pack8(a, b); } }
        } else {
            if (wc == 0 && fq < 3) { float* BG = (float*)(ws + WS_BG) + 8 * fq;
#pragma unroll
                for (int ai = 0; ai < 2; ++ai)
#pragma unroll
                    for (int m = 0; m < 4; ++m) { const int row = row0 + ai * 128 + m * 16; const float s = rs0[row]; f32x4 a = acc[ai][0][m][0] * s, b = acc[ai][0][m][1] * s;
#pragma unroll
                        for (int e = 0; e < 4; ++e) { a[e] = sigmoidf_(a[e]); b[e] = sigmoidf_(b[e]); }
                        *(f32x4*)(BG + (size_t)row * 24) = a; *(f32x4*)(BG + (size_t)row * 24 + 4) = b; } }
        }
    }
};
struct EpiUp {
    static constexpr bool PERM = true, AFTER_DRAIN = false;
    bf16* MG; int coloff;
    __device__ __forceinline__ void operator()(AccRef acc, const pg8::Unit& u, int wr, int wc, int fr, int fq) const {
        const int row0 = u.pm * 256 + wr * 64 + fr; bf16* base = MG + coloff + u.pn * 256 + wc * 32 + 8 * fq;
#pragma unroll
        for (int ai = 0; ai < 2; ++ai)
#pragma unroll
            for (int m = 0; m < 4; ++m) { bf16* rp = base + (size_t)(row0 + ai * 128 + m * 16) * 2048;
#pragma unroll
                for (int bj = 0; bj < 2; ++bj) { const u32x4 gt = *(const u32x4*)(rp + bj * 128); const f32x4 a = acc[ai][bj][m][0], b = acc[ai][bj][m][1]; u32x4 w;
                    w.x = pkbf(bf_lo(gt.x) * a[0], bf_hi(gt.x) * a[1]); w.y = pkbf(bf_lo(gt.y) * a[2], bf_hi(gt.y) * a[3]);
                    w.z = pkbf(bf_lo(gt.z) * b[0], bf_hi(gt.z) * b[1]); w.w = pkbf(bf_lo(gt.w) * b[2], bf_hi(gt.w) * b[3]);
                    *(u32x4*)(rp + bj * 128) = w; } }
    }
};
struct EpiWo {
    static constexpr bool PERM = true, AFTER_DRAIN = false;
    const float* x; float* out; bf16* xb; float* ssq;
    __device__ __forceinline__ void operator()(AccRef acc, const pg8::Unit& u, int wr, int wc, int fr, int fq) const {
        const int row0 = u.pm * 256 + wr * 64 + fr, c0 = u.pn * 256 + wc * 32 + 8 * fq;
#pragma unroll
        for (int ai = 0; ai < 2; ++ai)
#pragma unroll
            for (int m = 0; m < 4; ++m) { const int row = row0 + ai * 128 + m * 16; float ss = 0.f;
#pragma unroll
                for (int bj = 0; bj < 2; ++bj) { const size_t o = (size_t)row * DM + c0 + bj * 128;
                    const f32x4 a = *(const f32x4*)(x + o) + acc[ai][bj][m][0], b = *(const f32x4*)(x + o + 4) + acc[ai][bj][m][1];
                    *(f32x4*)(out + o) = a; *(f32x4*)(out + o + 4) = b; *(u32x4*)(xb + o) = pack8(a, b);
                    ss += (a[0] * a[0] + a[1] * a[1]) + (a[2] * a[2] + a[3] * a[3]) + (b[0] * b[0] + b[1] * b[1]) + (b[2] * b[2] + b[3] * b[3]); }
                ss += __shfl_xor(ss, 16); ss += __shfl_xor(ss, 32);
                if (fq == 0) ssq[(size_t)row * 16 + u.pn * 4 + wc] = ss; }
    }
};
__device__ __forceinline__ float rs_from_ssq(const float* ssq, int row) {
    const f32x4* p = (const f32x4*)(ssq + (size_t)row * 16); const f32x4 a = p[0], b = p[1], c = p[2], d = p[3];
    const float s = ((a[0] + a[1]) + (a[2] + a[3])) + ((b[0] + b[1]) + (b[2] + b[3])) + ((c[0] + c[1]) + (c[2] + c[3])) + ((d[0] + d[1]) + (d[2] + d[3]));
    return __builtin_amdgcn_rsqf(s * (1.0f / DM) + EPS);
}
struct EpiPw {
    static constexpr bool PERM = true, AFTER_DRAIN = false;
    bf16* O; int ldc;
    __device__ __forceinline__ void operator()(AccRef acc, const pg8::Unit& u, int wr, int wc, int fr, int fq) const {
        const int row0 = u.pm * 256 + wr * 64 + fr; bf16* base = O + u.pn * 256 + wc * 32 + 8 * fq;
#pragma unroll
        for (int ai = 0; ai < 2; ++ai)
#pragma unroll
            for (int m = 0; m < 4; ++m)
#pragma unroll
                for (int bj = 0; bj < 2; ++bj) *(u32x4*)(base + (size_t)(row0 + ai * 128 + m * 16) * ldc + bj * 128) = pack8(acc[ai][bj][m][0], acc[ai][bj][m][1]);
    }
};
struct EpiPle {
    static constexpr bool PERM = true, AFTER_DRAIN = false;
    const float* rs2; const bf16* pw; float* out;
    __device__ __forceinline__ void operator()(AccRef acc, const pg8::Unit& u, int wr, int wc, int fr, int fq) const {
        const int row0 = u.pm * 256 + wr * 64 + fr, c0 = u.pn * 256 + wc * 32 + 8 * fq;
#pragma unroll
        for (int ai = 0; ai < 2; ++ai)
#pragma unroll
            for (int m = 0; m < 4; ++m) { const int row = row0 + ai * 128 + m * 16; const float s = rs2[row];
#pragma unroll
                for (int bj = 0; bj < 2; ++bj) { const size_t o = (size_t)row * DM + c0 + bj * 128; const u32x4 pv = *(const u32x4*)(pw + o);
                    f32x4 a = *(const f32x4*)(out + o), b = *(const f32x4*)(out + o + 4); const f32x4 ga = acc[ai][bj][m][0] * s, gb = acc[ai][bj][m][1] * s;
                    a[0] += sigmoidf_(ga[0]) * bf_lo(pv.x); a[1] += sigmoidf_(ga[1]) * bf_hi(pv.x); a[2] += sigmoidf_(ga[2]) * bf_lo(pv.y); a[3] += sigmoidf_(ga[3]) * bf_hi(pv.y);
                    b[0] += sigmoidf_(gb[0]) * bf_lo(pv.z); b[1] += sigmoidf_(gb[1]) * bf_hi(pv.z); b[2] += sigmoidf_(gb[2]) * bf_lo(pv.w); b[3] += sigmoidf_(gb[3]) * bf_hi(pv.w);
                    *(f32x4*)(out + o) = a; *(f32x4*)(out + o + 4) = b; } }
    }
};
struct EpiCmp {
    static constexpr bool PERM = true, AFTER_DRAIN = false;
    bf16* H; const float* posb;
    __device__ __forceinline__ void operator()(AccRef acc, const pg8::Unit& u, int wr, int wc, int fr, int fq) const {
        const int row0 = u.pm * 256 + wr * 64 + fr, cl = wc * 32 + 8 * fq;
#pragma unroll
        for (int bj = 0; bj < 2; ++bj) { const f32x4 pa = *(const f32x4*)(posb + u.pn * 256 + bj * 128 + cl), pb = *(const f32x4*)(posb + u.pn * 256 + bj * 128 + cl + 4);
#pragma unroll
            for (int ai = 0; ai < 2; ++ai)
#pragma unroll
                for (int m = 0; m < 4; ++m) { f32x4 a = acc[ai][bj][m][0] + pa, b = acc[ai][bj][m][1] + pb;
#pragma unroll
                    for (int e = 0; e < 4; ++e) { a[e] = gelu_tanh(a[e]); b[e] = gelu_tanh(b[e]); }
                    *(u32x4*)(H + (size_t)(row0 + ai * 128 + m * 16) * 256 + bj * 128 + cl) = pack8(a, b); } }
    }
};

__device__ __forceinline__ void tr_item(const float* W, int Nsrc, int k0, int srcc0, int nvalid, bf16* WT, int ldk, int drow0, int dk0, const float* g, LAS float* scr, int lane) {
#pragma unroll 8
    for (int i = 0; i < 32; ++i) { const int kk = 2 * i + (lane >> 5), n = lane & 31; float v = 0.f;
        if (n < nvalid) { v = W[(size_t)(k0 + kk) * Nsrc + srcc0 + n]; if (g) v *= g[k0 + kk]; }
        scr[kk * 33 + n] = v; }
    LDS_WAIT(); asm volatile("" ::: "memory");
    const int c = lane & 7;
#pragma unroll
    for (int j = 0; j < 4; ++j) { const int n = (lane >> 3) + 8 * j; const LAS float* s = scr + (8 * c) * 33 + n;
        u32x4 o; o.x = pkbf(s[0 * 33], s[1 * 33]); o.y = pkbf(s[2 * 33], s[3 * 33]); o.z = pkbf(s[4 * 33], s[5 * 33]); o.w = pkbf(s[6 * 33], s[7 * 33]);
        *(u32x4*)(WT + (size_t)(drow0 + n) * ldk + dk0 + k0 + 8 * c) = o; }
    LDS_WAIT(); asm volatile("" ::: "memory");
}
__device__ __forceinline__ void p0_prologue(Frame& F, const Args& A) {
    LAS float* scr = (LAS float*)(F.lds + F.wave * 8448);
    const int gw = F.vcu * NWAVES + F.wave, NGW = F.G * NWAVES, lane = F.lane;
    unsigned char* ws = F.ws;
    constexpr int I_IN = 16 * 136, I_UP = 8 * 32, I_O = 16 * 32, I_Q = 16 * 64, I_PG = 16 * 32, I_PLE = 4 * 32, I_W1 = 32 * 8, I_W2 = 4 * 2;
    constexpr int NITEMS = I_IN + 2 * I_UP + I_O + I_Q + I_PG + I_PLE + 2 * I_W1 + 2 * I_W2;
    for (int it = gw; it < NITEMS; it += NGW) {
        int r = it;
        if (r < I_IN) { const int kb = r / 136, nb = r % 136, n = nb * 32; int src, nv = 32;
            if (n < 512) src = n; else if (n < 1024) src = n + 256; else if (n < 1280) src = n - 512; else if (n < 2048) src = n; else if (n < 4096) src = n + 24;
            else if (n == 4096) { src = 2048; nv = 24; } else { src = 0; nv = 0; }
            tr_item(A.in[3], 4120, kb * 64, src, nv, (bf16*)(ws + WS_WIN), 1024, n, 0, A.in[2], scr, lane); continue; } r -= I_IN;
        if (r < I_UP) { tr_item(A.in[11], 1024, (r / 32) * 64, (r % 32) * 32, 32, (bf16*)(ws + WS_WUPA), 512, (r % 32) * 32, 0, nullptr, scr, lane); continue; } r -= I_UP;
        if (r < I_UP) { tr_item(A.in[12], 1024, (r / 32) * 64, (r % 32) * 32, 32, (bf16*)(ws + WS_WUPB), 512, (r % 32) * 32, 0, nullptr, scr, lane); continue; } r -= I_UP;
        if (r < I_O) { tr_item(A.in[13], 1024, (r / 32) * 64, (r % 32) * 32, 32, (bf16*)(ws + WS_WO2), 2048, (r % 32) * 32, 0, nullptr, scr, lane);
                       tr_item(A.in[13], 1024, (r / 32) * 64, (r % 32) * 32, 32, (bf16*)(ws + WS_WO2), 2048, (r % 32) * 32, 1024, nullptr, scr, lane); continue; } r -= I_O;
        if (r < I_Q) { tr_item(A.in[15], 2048, (r / 64) * 64, (r % 64) * 32, 32, (bf16*)(ws + WS_WQ), 1024, (r % 64) * 32, 0, A.in[14], scr, lane); continue; } r -= I_Q;
        if (r < I_PG) { tr_item(A.in[21], 1024, (r / 32) * 64, (r % 32) * 32, 32, (bf16*)(ws + WS_WPG), 1024, (r % 32) * 32, 0, A.in[20], scr, lane); continue; } r -= I_PG;
        if (r < I_PLE) { tr_item(A.in[22], 1024, (r / 32) * 64, (r % 32) * 32, 32, (bf16*)(ws + WS_WPLE), 256, (r % 32) * 32, 0, nullptr, scr, lane); continue; } r -= I_PLE;
        if (r < I_W1) { tr_item(A.in[7], 256, (r / 8) * 64, (r % 8) * 32, 32, (bf16*)(ws + WS_W1KV), 2048, (r % 8) * 32, 0, nullptr, scr, lane); continue; } r -= I_W1;
        if (r < I_W1) { tr_item(A.in[9], 256, (r / 8) * 64, (r % 8) * 32, 32, (bf16*)(ws + WS_W1KV), 2048, 256 + (r % 8) * 32, 0, nullptr, scr, lane); continue; } r -= I_W1;
        if (r < I_W2) { tr_item(A.in[8], 64, (r / 2) * 64, (r % 2) * 32, 32, (bf16*)(ws + WS_W2KT), 256, (r % 2) * 32, 0, nullptr, scr, lane); continue; } r -= I_W2;
        tr_item(A.in[10], 64, (r / 2) * 64, (r % 2) * 32, 32, (bf16*)(ws + WS_W2VT), 256, (r % 2) * 32, 0, nullptr, scr, lane);
    }
    { const float* x = A.in[0]; bf16* xb = (bf16*)(ws + WS_XB); float* rs0 = (float*)(ws + WS_RS0);
      for (int row = gw; row < SEQ; row += NGW) {
          const f32x4* xr = (const f32x4*)(x + (size_t)row * DM) + lane; f32x4 v[4]; float ss = 0.f;
#pragma unroll
          for (int j = 0; j < 4; ++j) { v[j] = xr[64 * j]; ss += (v[j][0] * v[j][0] + v[j][1] * v[j][1]) + (v[j][2] * v[j][2] + v[j][3] * v[j][3]); }
          ss = wave_sum(ss);
          u32x2* o8 = (u32x2*)(xb + (size_t)row * DM) + lane;
#pragma unroll
          for (int j = 0; j < 4; ++j) { u32x2 w; w.x = pkbf(v[j][0], v[j][1]); w.y = pkbf(v[j][2], v[j][3]); o8[64 * j] = w; }
          if (lane == 0) rs0[row] = __builtin_amdgcn_rsqf(ss * (1.0f / DM) + EPS);
      } }
    { const int gt = gw * 64 + lane, NGT = NGW * 64;
      const float* p = A.in[1]; bf16* pb = (bf16*)(ws + WS_PB);
      for (int i = gt; i < SEQ * 256 / 8; i += NGT) { const f32x4 a = *(const f32x4*)(p + (size_t)i * 8), b = *(const f32x4*)(p + (size_t)i * 8 + 4); *(u32x4*)(pb + (size_t)i * 8) = pack8(a, b); }
      for (int i = gt; i < 2 * 16384 / 8; i += NGT) { const int which = i >= 2048, j = i & 2047; const float* k = A.in[16 + which] + (size_t)j * 8;
          *(u32x4*)((bf16*)(ws + (which ? WS_K2B : WS_K1B)) + (size_t)j * 8) = pack8(*(const f32x4*)k, *(const f32x4*)(k + 4)); } }
    if (F.vcu < 32) {
#pragma unroll 1
        for (int oo = 0; oo < 2; ++oo) { const int o = F.vcu * 16 + F.wave * 2 + oo, kv = o >> 8, n = o & 255; const float* w1 = A.in[kv ? 9 : 7]; const float* pos = A.in[6]; float s = 0.f;
            for (int k = lane; k < 2048; k += 64) s += pos[k] * w1[(size_t)k * 256 + n];
            s = wave_sum(s); if (lane == 0) ((float*)(ws + WS_POSB))[o] = s; }
    }
}

struct TileSrc { const bf16* K; const bf16* Vt; int vpitch; };
__device__ __forceinline__ void tile_load(const TileSrc& s, int key0, bool needV, int tid, u32x4& kr, u32x4& vr) {
    const int row = tid >> 3, ch = tid & 7;
    kr = *(const u32x4*)(s.K + (size_t)(key0 + row) * 64 + ch * 8);
    if (needV) vr = *(const u32x4*)(s.Vt + (size_t)row * s.vpitch + key0 + ch * 8);
}
__device__ __forceinline__ void tile_store(LAS unsigned char* L, int buf, bool needV, int tid, const u32x4& kr, const u32x4& vr) {
    const int row = tid >> 3, ch = tid & 7;
    *(LAS u32x4*)(L + AT_K0 + buf * AT_KSZ + row * KROW + ch * 16) = kr;
    if (needV) { LAS u32x2* p = (LAS u32x2*)(L + AT_V0 + buf * AT_VSZ + row * VROW + ch * 16); u32x2 a, b; a.x = vr.x; a.y = vr.y; b.x = vr.z; b.y = vr.w; p[0] = a; p[1] = b; }
}
__device__ __forceinline__ void qk_tile(LAS const unsigned char* Kb, const bf16x8 (&q)[4], int r32, int h, f32x16& s0, f32x16& s1) {
#pragma unroll
    for (int i = 0; i < 16; ++i) { s0[i] = 0.f; s1[i] = 0.f; }
#pragma unroll
    for (int ks = 0; ks < 4; ++ks) {
        const bf16x8 a0 = *(LAS const bf16x8*)(Kb + r32 * KROW + (16 * ks + 8 * h) * 2), a1 = *(LAS const bf16x8*)(Kb + (32 + r32) * KROW + (16 * ks + 8 * h) * 2);
        s0 = __builtin_amdgcn_mfma_f32_32x32x16_bf16(a0, q[ks], s0, 0, 0, 0); s1 = __builtin_amdgcn_mfma_f32_32x32x16_bf16(a1, q[ks], s1, 0, 0, 0);
    }
}
__device__ __forceinline__ bf16x8 pack_p(const f32x16& s, int o) {
    u32x4 w; w.x = pkbf(s[o + 0], s[o + 1]); w.y = pkbf(s[o + 2], s[o + 3]); w.z = pkbf(s[o + 4], s[o + 5]); w.w = pkbf(s[o + 6], s[o + 7]); return __builtin_bit_cast(bf16x8, w);
}
__device__ __forceinline__ void softmax_pv(LAS const unsigned char* Vb, f32x16& s0, f32x16& s1, f32x16 (&o)[2], float& m, float& l, int r32, int h) {
    float mx = fmaxf(s0[0], s1[0]);
#pragma unroll
    for (int i = 1; i < 16; ++i) mx = fmaxf(mx, fmaxf(s0[i], s1[i]));
    mx = pair_max(mx);
    const float mn = fmaxf(m, mx), alpha = fexp2(m - mn); m = mn;
    float sum = 0.f;
#pragma unroll
    for (int i = 0; i < 16; ++i) { s0[i] = fexp2(s0[i] - mn); s1[i] = fexp2(s1[i] - mn); sum += s0[i] + s1[i]; }
    sum = pair_sum(sum); l = l * alpha + sum;
#pragma unroll
    for (int i = 0; i < 16; ++i) { o[0][i] *= alpha; o[1][i] *= alpha; }
    bf16x8 pf[4]; pf[0] = pack_p(s0, 0); pf[1] = pack_p(s0, 8); pf[2] = pack_p(s1, 0); pf[3] = pack_p(s1, 8);
#pragma unroll
    for (int dt = 0; dt < 2; ++dt)
#pragma unroll
        for (int s = 0; s < 4; ++s) { LAS const unsigned char* vp = Vb + (32 * dt + r32) * VROW + (16 * s + 4 * h) * 2;
            const u32x2 lo = *(LAS const u32x2*)vp, hi = *(LAS const u32x2*)(vp + 16); u32x4 a; a.x = lo.x; a.y = lo.y; a.z = hi.x; a.w = hi.y;
            o[dt] = __builtin_amdgcn_mfma_f32_32x32x16_bf16(__builtin_bit_cast(bf16x8, a), pf[s], o[dt], 0, 0, 0); }
}
#define KEYOFF(kt, i) (32 * (kt) + ((i) & 3) + 8 * ((i) >> 2))
#define NEG_INF (-__builtin_inff())

template <int W> struct FBand {
    int tq, tw, h; const LAS float* lut;
    __device__ __forceinline__ bool active(int tile) { const int key0 = tile * 64; return key0 <= tw + 7 && key0 + 63 >= tw - W + 1; }
    __device__ __forceinline__ void apply(f32x16& s0, f32x16& s1, int tile) {
        const int rel0 = tq - tile * 64 - 4 * h;
        if (tw - tile * 64 - 63 >= 128) { const float b = lut[128];
#pragma unroll
            for (int i = 0; i < 16; ++i) { const int r0 = rel0 - KEYOFF(0, i), r1 = rel0 - KEYOFF(1, i);
                s0[i] = (unsigned)r0 < (unsigned)W ? s0[i] + b : NEG_INF; s1[i] = (unsigned)r1 < (unsigned)W ? s1[i] + b : NEG_INF; }
        } else {
#pragma unroll
            for (int i = 0; i < 16; ++i) { const int r0 = rel0 - KEYOFF(0, i), r1 = rel0 - KEYOFF(1, i);
                const float b0 = lut[min(max(r0, 0), 128)], b1 = lut[min(max(r1, 0), 128)];
                s0[i] = (unsigned)r0 < (unsigned)W ? s0[i] + b0 : NEG_INF; s1[i] = (unsigned)r1 < (unsigned)W ? s1[i] + b1 : NEG_INF; }
        }
    }
};
struct FCmp {
    int lim0, cmax_w;
    __device__ __forceinline__ bool active(int tile) { return tile * 64 <= cmax_w; }
    __device__ __forceinline__ void apply(f32x16& s0, f32x16& s1, int tile) {
        const int lim = lim0 - tile * 64;
#pragma unroll
        for (int i = 0; i < 16; ++i) { s0[i] = KEYOFF(0, i) <= lim ? s0[i] : NEG_INF; s1[i] = KEYOFF(1, i) <= lim ? s1[i] : NEG_INF; }
    }
};
struct FSlc {
    int tq, tw, h; const LAS float* lut; const LAS unsigned* bits; bool sel;
    __device__ __forceinline__ bool active(int tile) { sel = (bits[tile >> 5] >> (tile & 31)) & 1u; return __ballot(sel) != 0ull; }
    __device__ __forceinline__ void apply(f32x16& s0, f32x16& s1, int tile) {
        const int rel0 = tq - tile * 64 - 4 * h;
        if (tw - tile * 64 - 63 >= 128) { const float b = sel ? lut[128] : NEG_INF;
#pragma unroll
            for (int i = 0; i < 16; ++i) { s0[i] += b; s1[i] += b; }
        } else {
#pragma unroll
            for (int i = 0; i < 16; ++i) { const int r0 = rel0 - KEYOFF(0, i), r1 = rel0 - KEYOFF(1, i);
                const float b0 = lut[min(max(r0, 0), 128)], b1 = lut[min(max(r1, 0), 128)];
                s0[i] = (sel && r0 >= 0) ? s0[i] + b0 : NEG_INF; s1[i] = (sel && r1 >= 0) ? s1[i] + b1 : NEG_INF; }
        }
    }
};
template <class Fn>
__device__ __forceinline__ void attn_loop(LAS unsigned char* L, const TileSrc& src, int tile_lo, int ntiles, const bf16x8 (&q)[4], f32x16 (&o)[2], float& m, float& l, Fn& f, int tid, int r32, int h) {
    u32x4 kr, vr;
    tile_load(src, tile_lo * 64, true, tid, kr, vr);
#pragma unroll 1
    for (int i = 0; i < ntiles; ++i) {
        const int buf = i & 1;
        tile_store(L, buf, true, tid, kr, vr);
        if (i + 1 < ntiles) tile_load(src, (tile_lo + i + 1) * 64, true, tid, kr, vr);
        WG_BAR_LDS();
        const int tile = tile_lo + i;
        if (f.active(tile)) {
            f32x16 s0, s1; qk_tile(L + AT_K0 + buf * AT_KSZ, q, r32, h, s0, s1);
            f.apply(s0, s1, tile);
            softmax_pv(L + AT_V0 + buf * AT_VSZ, s0, s1, o, m, l, r32, h);
        }
    }
    WG_BAR_LDS();
}
__device__ __forceinline__ void build_lut(Frame& F, const float* rb) {
    LAS float* lut = (LAS float*)(F.lds + AT_LUT);
    for (int i = F.tid; i < 16 * 129; i += NWAVES * 64) { const int hh = i / 129, rel = i % 129; lut[hh * LUTS + rel] = rb[(int)BKT[rel] * 16 + hh] * LOG2E; }
    __syncthreads();
}
__device__ __forceinline__ void store_o(bf16* dst, const f32x16 (&o)[2], float sc, int h) {
#pragma unroll
    for (int dt = 0; dt < 2; ++dt)
#pragma unroll
        for (int gq = 0; gq < 4; ++gq) { u32x2 w; w.x = pkbf(o[dt][4 * gq] * sc, o[dt][4 * gq + 1] * sc); w.y = pkbf(o[dt][4 * gq + 2] * sc, o[dt][4 * gq + 3] * sc);
            *(u32x2*)(dst + 32 * dt + 8 * gq + 4 * h) = w; }
}
template <int MODE>
__device__ __forceinline__ void banded_unit(Frame& F, const float* sink, int T, int g) {
    LAS unsigned char* L = F.lds; const int tid = F.tid, lane = F.lane, w = F.wave, r32 = lane & 31, h = lane >> 5;
    const int t0 = T * 64, tw = t0 + 8 * w, tq = tw + (r32 >> 2), hg = g * 4 + (r32 & 3);
    constexpr int W = MODE == 0 ? 128 : 512;
    const bf16* Qp = (const bf16*)(F.ws + (MODE == 0 ? WS_QA : WS_QB)) + (size_t)tq * 512 + hg * 64;
    bf16x8 q[4];
#pragma unroll
    for (int ks = 0; ks < 4; ++ks) q[ks] = *(const bf16x8*)(Qp + 16 * ks + 8 * h);
    f32x16 o[2];
#pragma unroll
    for (int i = 0; i < 16; ++i) { o[0][i] = 0.f; o[1][i] = 0.f; }
    float m = -1e30f, l = 0.f;
    if (MODE == 0) { m = sink[hg] * LOG2E; l = 1.f; }
    const int tlo = max(0, t0 - W + 1) >> 6, nt = T - tlo + 1;
    TileSrc src; src.K = (const bf16*)(F.ws + (MODE == 0 ? WS_KA : WS_KW)) + (size_t)g * SEQ * 64; src.Vt = (const bf16*)(F.ws + (MODE == 0 ? WS_VTA : WS_VTW)) + (size_t)g * 64 * SEQ; src.vpitch = SEQ;
    FBand<W> f; f.tq = tq; f.tw = tw; f.h = h; f.lut = (const LAS float*)(L + AT_LUT) + ((MODE == 0 ? 0 : 8) + hg) * LUTS;
    attn_loop(L, src, tlo, nt, q, o, m, l, f, tid, r32, h);
    bf16* Op = (bf16*)(F.ws + (MODE == 0 ? WS_QA : WS_OW)) + (size_t)tq * 512 + hg * 64;
    store_o(Op, o, frcp(fmaxf(l, 1e-30f)), h);
}
__device__ __forceinline__ void compress_out(Frame& F, int b) {
    const int lane = F.lane, w = F.wave, r32 = lane & 31, h = lane >> 5;
    const int kvg = b >> 2, kv = kvg >> 1, g = kvg & 1, c0 = (b & 3) * 256 + 32 * w;
    const bf16* H = (const bf16*)(F.ws + WS_H) + (size_t)(256 * b + 32 * w + r32) * 256 + 8 * h;
    const bf16* W2 = (const bf16*)(F.ws + (kv ? WS_W2VT : WS_W2KT)) + (size_t)r32 * 256 + 8 * h;
    f32x16 a0, a1;
#pragma unroll
    for (int i = 0; i < 16; ++i) { a0[i] = 0.f; a1[i] = 0.f; }
#pragma unroll 4
    for (int ks = 0; ks < 16; ++ks) {
        const bf16x8 hf = *(const bf16x8*)(H + 16 * ks), w0 = *(const bf16x8*)(W2 + 16 * ks), w1 = *(const bf16x8*)(W2 + 32 * 256 + 16 * ks);
        if (kv == 0) { a0 = __builtin_amdgcn_mfma_f32_32x32x16_bf16(w0, hf, a0, 0, 0, 0); a1 = __builtin_amdgcn_mfma_f32_32x32x16_bf16(w1, hf, a1, 0, 0, 0); }
        else         { a0 = __builtin_amdgcn_mfma_f32_32x32x16_bf16(hf, w0, a0, 0, 0, 0); a1 = __builtin_amdgcn_mfma_f32_32x32x16_bf16(hf, w1, a1, 0, 0, 0); }
    }
    if (kv == 0) {
        const int c = c0 + r32; bf16* kc = (bf16*)(F.ws + WS_KC) + ((size_t)g * 1024 + c) * 64; const bool pad = (c == 1023);
#pragma unroll
        for (int nt = 0; nt < 2; ++nt)
#pragma unroll
            for (int gq = 0; gq < 4; ++gq) { const f32x16& a = nt ? a1 : a0; u32x2 wv; wv.x = pkbf(a[4 * gq], a[4 * gq + 1]); wv.y = pkbf(a[4 * gq + 2], a[4 * gq + 3]); if (pad) { wv.x = 0u; wv.y = 0u; }
                *(u32x2*)(kc + 32 * nt + 8 * gq + 4 * h) = wv; }
    } else {
        bf16* vct = (bf16*)(F.ws + WS_VCT) + (size_t)g * 64 * 1024;
#pragma unroll
        for (int nt = 0; nt < 2; ++nt)
#pragma unroll
            for (int gq = 0; gq < 4; ++gq) { const f32x16& a = nt ? a1 : a0; const int c = c0 + 8 * gq + 4 * h;
                u32x2 wv; wv.x = pkbf(a[4 * gq], a[4 * gq + 1]); wv.y = pkbf(a[4 * gq + 2], a[4 * gq + 3]); if (c + 3 == 1023) wv.y &= 0xffffu;
                *(u32x2*)(vct + (size_t)(32 * nt + r32) * 1024 + c) = wv; }
    }
}
__device__ __forceinline__ void nsa_unit(Frame& F, int T, int g) {
    LAS unsigned char* L = F.lds; const int tid = F.tid, lane = F.lane, w = F.wave, r32 = lane & 31, h = lane >> 5;
    const int t0 = T * 64, tw = t0 + 8 * w, ql = 8 * w + (r32 >> 2), tq = t0 + ql, hd = r32 & 3, hg = g * 4 + hd, jt = T;
    bf16* Qp = (bf16*)(F.ws + WS_QB) + (size_t)tq * 512 + hg * 64;
    bf16x8 q[4];
#pragma unroll
    for (int ks = 0; ks < 4; ++ks) q[ks] = *(const bf16x8*)(Qp + 16 * ks + 8 * h);
    const float* bg = (const float*)(F.ws + WS_BG) + (size_t)tq * 24 + hg; const float g0 = bg[0], g1 = bg[8], g2 = bg[16];
    f32x16 o[2];
#pragma unroll
    for (int i = 0; i < 16; ++i) { o[0][i] = 0.f; o[1][i] = 0.f; }
    float m = -1e30f, l = 0.f;
    const int ncmp = t0 / 16 + 3, ntc = (ncmp + 63) >> 6;
    TileSrc sc; sc.K = (const bf16*)(F.ws + WS_KC) + (size_t)g * 1024 * 64; sc.Vt = (const bf16*)(F.ws + WS_VCT) + (size_t)g * 64 * 1024; sc.vpitch = 1024;
    FCmp fc; fc.lim0 = ((tq - 31) >> 4) - 4 * h; fc.cmax_w = (tw + 7 - 31) >> 4;
    attn_loop(L, sc, 0, ntc, q, o, m, l, fc, tid, r32, h);
    const float inv = frcp(fmaxf(l, 1e-30f));
    { const bf16* OWp = (const bf16*)(F.ws + WS_OW) + (size_t)tq * 512 + hg * 64; const float s0_ = g0 * inv;
#pragma unroll
      for (int dt = 0; dt < 2; ++dt)
#pragma unroll
          for (int gq = 0; gq < 4; ++gq) { const u32x2 ow = *(const u32x2*)(OWp + 32 * dt + 8 * gq + 4 * h); u32x2 wv;
              wv.x = pkbf(s0_ * o[dt][4 * gq] + g2 * bf_lo(ow.x), s0_ * o[dt][4 * gq + 1] + g2 * bf_hi(ow.x));
              wv.y = pkbf(s0_ * o[dt][4 * gq + 2] + g2 * bf_lo(ow.y), s0_ * o[dt][4 * gq + 3] + g2 * bf_hi(ow.y));
              *(u32x2*)(Qp + 32 * dt + 8 * gq + 4 * h) = wv; } }
    LAS float* imp = (LAS float*)(L + AT_IMP);
    for (int i = lane; i < 8 * 256; i += 64) imp[8 * w * 256 + i] = 0.f;
    { u32x4 kr, vr; tile_load(sc, 0, false, tid, kr, vr);
#pragma unroll 1
      for (int i = 0; i < ntc; ++i) {
          const int buf = i & 1;
          tile_store(L, buf, false, tid, kr, vr);
          if (i + 1 < ntc) tile_load(sc, (i + 1) * 64, false, tid, kr, vr);
          WG_BAR_LDS();
          if (fc.active(i)) {
              f32x16 s0, s1; qk_tile(L + AT_K0 + buf * AT_KSZ, q, r32, h, s0, s1);
              fc.apply(s0, s1, i);
#pragma unroll
              for (int kt = 0; kt < 2; ++kt) { const f32x16& s = kt ? s1 : s0; float mainv = 0.f, spv = 0.f;
#pragma unroll
                  for (int gq = 0; gq < 4; ++gq) { const float p0 = fexp2(s[4 * gq] - m) * inv, p1 = fexp2(s[4 * gq + 1] - m) * inv, p2 = fexp2(s[4 * gq + 2] - m) * inv, p3 = fexp2(s[4 * gq + 3] - m) * inv;
                      const float mq = quad_sum((p0 + p1) + (p2 + 0.5f * p3)), sq = quad_sum(0.5f * p3);
                      if (gq == hd) { mainv = mq; spv = sq; } }
                  const int j = i * 16 + 8 * kt + 2 * hd + h;
                  __hip_atomic_fetch_add(imp + ql * 256 + j, mainv, __ATOMIC_RELAXED, __HIP_MEMORY_SCOPE_WORKGROUP);
                  __hip_atomic_fetch_add(imp + ql * 256 + min(j + 1, 255), (j + 1 < 256) ? spv : 0.f, __ATOMIC_RELAXED, __HIP_MEMORY_SCOPE_WORKGROUP); }
          }
      }
      WG_BAR_LDS(); }
    LAS unsigned* selb = (LAS unsigned*)(L + AT_SEL);
#pragma unroll 1
    for (int qi = 0; qi < 8; ++qi) {
        const LAS float* row = imp + (8 * w + qi) * 256; unsigned mybits = 0u;
        if (lane == 0) mybits |= 1u;
        if (lane == (jt >> 5)) mybits |= 1u << (jt & 31);
        if (jt >= 1 && lane == ((jt - 1) >> 5)) mybits |= 1u << ((jt - 1) & 31);
        const int ncand = jt - 2;
        if (ncand > 0) {
            if (ncand <= 13) { if (lane == 0) mybits |= ((1u << (jt - 1)) - 2u); }
            else {
                unsigned k[4];
#pragma unroll
                for (int i = 0; i < 4; ++i) { const int j = lane + 64 * i; const float v = row[j]; k[i] = (j >= 1 && j <= jt - 2) ? ((__float_as_uint(v) & ~255u) | (unsigned)(255 - j)) : 0u; }
#pragma unroll 1
                for (int it = 0; it < 13; ++it) { const unsigned mx = wave_max_u32(umax_(umax_(k[0], k[1]), umax_(k[2], k[3]))); const int j = 255 - (int)(mx & 255u);
                    if (lane == (j >> 5)) mybits |= 1u << (j & 31);
#pragma unroll
                    for (int i = 0; i < 4; ++i) k[i] = (k[i] == mx) ? 0u : k[i]; }
            }
        }
        if (lane < 8) selb[(8 * w + qi) * 8 + lane] = mybits;
    }
    f32x16 o2[2];
#pragma unroll
    for (int i = 0; i < 16; ++i) { o2[0][i] = 0.f; o2[1][i] = 0.f; }
    float m2 = -1e30f, l2 = 0.f;
    TileSrc ss; ss.K = (const bf16*)(F.ws + WS_KS) + (size_t)g * SEQ * 64; ss.Vt = (const bf16*)(F.ws + WS_VTS) + (size_t)g * 64 * SEQ; ss.vpitch = SEQ;
    FSlc fs; fs.tq = tq; fs.tw = tw; fs.h = h; fs.lut = (const LAS float*)(L + AT_LUT) + (8 + hg) * LUTS; fs.bits = selb + ql * 8; fs.sel = false;
    attn_loop(L, ss, 0, jt + 1, q, o2, m2, l2, fs, tid, r32, h);
    const float s2 = g1 * frcp(fmaxf(l2, 1e-30f));
#pragma unroll
    for (int dt = 0; dt < 2; ++dt)
#pragma unroll
        for (int gq = 0; gq < 4; ++gq) { u32x2 wv; const u32x2 tt = *(const u32x2*)(Qp + 32 * dt + 8 * gq + 4 * h); const unsigned ta = tt.x, tb = tt.y;
            wv.x = pkbf(bf_lo(ta) + s2 * o2[dt][4 * gq], bf_hi(ta) + s2 * o2[dt][4 * gq + 1]); wv.y = pkbf(bf_lo(tb) + s2 * o2[dt][4 * gq + 2], bf_hi(tb) + s2 * o2[dt][4 * gq + 3]);
            *(u32x2*)(Qp + 32 * dt + 8 * gq + 4 * h) = wv; }
}

__device__ __forceinline__ unsigned ord_key(float v) { const unsigned u = __float_as_uint(v); return u ^ ((unsigned)((int)u >> 31) | 0x80000000u); }
__device__ __forceinline__ float ord_val(unsigned k) { const unsigned u = (k & 0x80000000u) ? (k ^ 0x80000000u) : ~k; return __uint_as_float(u); }
__device__ __forceinline__ void peer_top16(const bf16* qrow, LAS const unsigned char* kmat, int r32, int h2, unsigned (&sel)[16]) {
    bf16x8 qf[8];
#pragma unroll
    for (int ks = 0; ks < 8; ++ks) qf[ks] = *(const bf16x8*)(qrow + 16 * ks + 8 * h2);
    unsigned key[64];
#pragma unroll
    for (int nt = 0; nt < 4; ++nt) { f32x16 s;
#pragma unroll
        for (int i = 0; i < 16; ++i) s[i] = 0.f;
#pragma unroll
        for (int ks = 0; ks < 8; ++ks) { const bf16x8 a = *(LAS const bf16x8*)(kmat + (32 * nt + r32) * PK_ROW + (16 * ks + 8 * h2) * 2); s = __builtin_amdgcn_mfma_f32_32x32x16_bf16(a, qf[ks], s, 0, 0, 0); }
#pragma unroll
        for (int i = 0; i < 16; ++i) key[nt * 16 + i] = (ord_key(s[i]) & ~127u) | (unsigned)(((63 - (nt * 16 + i)) << 1) | (1 - h2)); }
    unsigned prev = 0xFFFFFFFFu;
#pragma unroll
    for (int k = 0; k < 16; ++k) sel[k] = 0u;
#pragma unroll 1
    for (int it = 0; it < 16; ++it) { unsigned c = 0u;
#pragma unroll
        for (int i = 0; i < 64; ++i) c = umax_(c, key[i] - prev);
        const unsigned mloc = c + prev, mm = pair_umax(mloc);
#pragma unroll
        for (int k = 0; k < 16; ++k) sel[k] = (k == it) ? mm : sel[k];
        prev = mm; }
}
__device__ __forceinline__ int key_n(unsigned k) { const int low = k & 127, Lx = 63 - (low >> 1), hh = 1 - (low & 1); return ((Lx >> 4) << 5) + (((Lx >> 2) & 3) << 3) + (hh << 2) + (Lx & 3); }

__device__ __forceinline__ void peer_phase(Frame& F) {
    LAS unsigned char* L = F.lds; const int tid = F.tid, lane = F.lane, w = F.wave, r32 = lane & 31, h2 = lane >> 5;
    unsigned char* ws = F.ws;
    for (int i = tid; i < 2 * 128 * 16; i += NWAVES * 64) { const int which = i >> 11, rr = (i >> 4) & 127, ch = i & 15;
        *(LAS u32x4*)(L + (which ? PK2_OFF : PK1_OFF) + rr * PK_ROW + ch * 16) = *(const u32x4*)((const bf16*)(ws + (which ? WS_K2B : WS_K1B)) + rr * 128 + ch * 8); }
    __syncthreads();
    LAS unsigned char* PW = L + PW_OFF + w * PW_BYTES;
    LAS unsigned char* XR = PW; LAS u32x2* LST = (LAS u32x2*)(PW + 2048); LAS unsigned char* I12 = PW + 6144; LAS float* WL = (LAS float*)(PW + 7168);
    const bf16* Q2 = (const bf16*)(ws + WS_Q2); const bf16* U16 = (const bf16*)(ws + WS_U16); const _Float16* V16 = (const _Float16*)(ws + WS_V16);
    bf16* xb = (bf16*)(ws + WS_XB); const float* ssq1 = (const float*)(ws + WS_SSQ1); float* rs2 = (float*)(ws + WS_RS2);
    const int gw = F.vcu * NWAVES + w, NGW = F.G * NWAVES;
#pragma unroll 1
    for (int item = gw; item < SEQ / 4; item += NGW) {
        const int t0 = item * 4;
        {
            const int tk = r32 >> 3, hd = r32 & 7; const bf16* qrow = Q2 + (size_t)(t0 + tk) * 2048 + hd * 256;
            const float rsq = rs_from_ssq(ssq1, t0 + tk);
            unsigned s1[16], s2[16];
            peer_top16(qrow, L + PK1_OFF, r32, h2, s1);
            peer_top16(qrow + 128, L + PK2_OFF, r32, h2, s2);
            float v1[16], v2[16];
#pragma unroll
            for (int k = 0; k < 16; ++k) { v1[k] = ord_val(s1[k] & ~127u); v2[k] = ord_val(s2[k] & ~127u); }
            if (h2 == 0) { LAS unsigned* ip = (LAS unsigned*)(I12 + r32 * 32);
#pragma unroll
                for (int k4 = 0; k4 < 4; ++k4) { ip[k4] = (unsigned)key_n(s1[4 * k4]) | ((unsigned)key_n(s1[4 * k4 + 1]) << 8) | ((unsigned)key_n(s1[4 * k4 + 2]) << 16) | ((unsigned)key_n(s1[4 * k4 + 3]) << 24);
                    ip[4 + k4] = (unsigned)key_n(s2[4 * k4]) | ((unsigned)key_n(s2[4 * k4 + 1]) << 8) | ((unsigned)key_n(s2[4 * k4 + 2]) << 16) | ((unsigned)key_n(s2[4 * k4 + 3]) << 24); } }
            unsigned ck[50]; int nc = 0;
#pragma unroll
            for (int i = 0; i < 16; ++i)
#pragma unroll
                for (int j = 0; j < 16; ++j) if ((i + 1) * (j + 1) <= 16) { ck[nc] = (ord_key(v1[i] + v2[j]) & ~255u) | (unsigned)(255 - (16 * i + j)); ++nc; }
            unsigned prev = 0xFFFFFFFFu; float sc[16]; int ei[16];
#pragma unroll
            for (int it = 0; it < 16; ++it) { unsigned c = 0u;
#pragma unroll
                for (int i = 0; i < 50; ++i) c = umax_(c, ck[i] - prev);
                const unsigned mm = c + prev; prev = mm;
                const int flat = 255 - (int)(mm & 255u); sc[it] = ord_val(mm & ~255u);
                ei[it] = (int)I12[r32 * 32 + (flat >> 4)] * 128 + (int)I12[r32 * 32 + 16 + (flat & 15)]; }
            float den = 0.f, ex[16];
#pragma unroll
            for (int k = 0; k < 16; ++k) { ex[k] = fexp2((sc[k] - sc[0]) * (rsq * LOG2E)); den += ex[k]; }
            const float rd = frcp(den);
            if (h2 == 0) {
#pragma unroll
                for (int k = 0; k < 16; ++k) { u32x2 e; e.x = (unsigned)ei[k]; e.y = __float_as_uint(ex[k] * rd); LST[tk * 128 + hd * 16 + k] = e; } }
        }
#pragma unroll 1
        for (int tk = 0; tk < 4; ++tk) {
            const int t = t0 + tk;
            { const u32x4 a = *(const u32x4*)(xb + (size_t)t * DM + lane * 8), b = *(const u32x4*)(xb + (size_t)t * DM + 512 + lane * 8);
              *(LAS u32x4*)(XR + lane * 16) = a; *(LAS u32x4*)(XR + 1024 + lane * 16) = b; }
            const float rs = rs_from_ssq(ssq1, t);
            const int er = lane & 15, kq = lane >> 4;
            int eidx[8];
#pragma unroll
            for (int eg = 0; eg < 8; ++eg) eidx[eg] = (int)LST[tk * 128 + eg * 16 + er].x;
            f32x4 acc[8];
#pragma unroll
            for (int eg = 0; eg < 8; ++eg) acc[eg] = (f32x4){0.f, 0.f, 0.f, 0.f};
#pragma unroll 1
            for (int c = 0; c < 4; ++c) {
                bf16x8 xf[8];
#pragma unroll
                for (int s = 0; s < 8; ++s) xf[s] = *(LAS const bf16x8*)(XR + (256 * c + 64 * kq + 8 * s) * 2);
#pragma unroll
                for (int eg = 0; eg < 8; ++eg) { const bf16* up = U16 + (size_t)eidx[eg] * DM + 256 * c + 64 * kq;
                    bf16x8 uf[8];
#pragma unroll
                    for (int s = 0; s < 8; ++s) uf[s] = *(const bf16x8*)(up + 8 * s);
#pragma unroll
                    for (int s = 0; s < 8; ++s) acc[eg] = __builtin_amdgcn_mfma_f32_16x16x32_bf16(uf[s], xf[s], acc[eg], 0, 0, 0); }
            }
#pragma unroll
            for (int eg = 0; eg < 8; ++eg)
#pragma unroll
                for (int r = 0; r < 4; ++r) { const int idx = eg * 16 + 4 * kq + r; const float gate = __uint_as_float(LST[tk * 128 + idx].y); const float wv = gate * gelu_tanh(acc[eg][r] * rs);
                    if (er == 0) WL[idx] = wv; }
            float oa[8], ob[8];
#pragma unroll
            for (int i = 0; i < 8; ++i) { oa[i] = 0.f; ob[i] = 0.f; }
#pragma unroll 1
            for (int e0 = 0; e0 < 128; e0 += 4) {
                h16x8 va[4], vb[4]; float wv[4];
#pragma unroll
                for (int k = 0; k < 4; ++k) { const int idx = __builtin_amdgcn_readfirstlane((int)LST[tk * 128 + e0 + k].x); wv[k] = WL[e0 + k];
                    const _Float16* vp = V16 + (size_t)idx * DM + lane * 8; va[k] = *(const h16x8*)vp; vb[k] = *(const h16x8*)(vp + 512); }
#pragma unroll
                for (int k = 0; k < 4; ++k)
#pragma unroll
                    for (int i = 0; i < 8; ++i) { oa[i] += wv[k] * (float)va[k][i]; ob[i] += wv[k] * (float)vb[k][i]; }
            }
            float* op = F.out + (size_t)t * DM + lane * 8;
            f32x4 a0 = *(const f32x4*)op, a1 = *(const f32x4*)(op + 4), b0 = *(const f32x4*)(op + 512), b1 = *(const f32x4*)(op + 516);
#pragma unroll
            for (int i = 0; i < 4; ++i) { a0[i] += oa[i]; a1[i] += oa[4 + i]; b0[i] += ob[i]; b1[i] += ob[4 + i]; }
            *(f32x4*)op = a0; *(f32x4*)(op + 4) = a1; *(f32x4*)(op + 512) = b0; *(f32x4*)(op + 516) = b1;
            *(u32x4*)(xb + (size_t)t * DM + lane * 8) = pack8(a0, a1); *(u32x4*)(xb + (size_t)t * DM + 512 + lane * 8) = pack8(b0, b1);
            float ss = 0.f;
#pragma unroll
            for (int i = 0; i < 4; ++i) ss += a0[i] * a0[i] + a1[i] * a1[i] + b0[i] * b0[i] + b1[i] * b1[i];
            ss = wave_sum(ss);
            if (lane == 0) rs2[t] = __builtin_amdgcn_rsqf(ss * (1.0f / DM) + EPS);
        }
    }
}
__device__ __forceinline__ void convert_peer_tables(Frame& F, const float* u, const float* v, const float* g) {
    const int gt = (F.vcu * NWAVES + F.wave) * 64 + F.lane, NGT = F.G * NWAVES * 64;
    bf16* U16 = (bf16*)(F.ws + WS_U16); _Float16* V16 = (_Float16*)(F.ws + WS_V16);
    for (int i = gt; i < 16384 * 1024 / 8; i += NGT) {
        const int d0 = (i & 127) * 8; const f32x4 ga = *(const f32x4*)(g + d0), gb = *(const f32x4*)(g + d0 + 4);
        const f32x4 a = *(const f32x4*)(u + (size_t)i * 8) * ga, b = *(const f32x4*)(u + (size_t)i * 8 + 4) * gb;
        *(u32x4*)(U16 + (size_t)i * 8) = pack8(a, b);
        const f32x4 c = *(const f32x4*)(v + (size_t)i * 8), d = *(const f32x4*)(v + (size_t)i * 8 + 4);
        h16x8 hv; hv[0] = (_Float16)c[0]; hv[1] = (_Float16)c[1]; hv[2] = (_Float16)c[2]; hv[3] = (_Float16)c[3]; hv[4] = (_Float16)d[0]; hv[5] = (_Float16)d[1]; hv[6] = (_Float16)d[2]; hv[7] = (_Float16)d[3];
        *(h16x8*)(V16 + (size_t)i * 8) = hv;
    }
}
__device__ __forceinline__ void final_norm(Frame& F, const float* gf) {
    const int gw = F.vcu * NWAVES + F.wave, NGW = F.G * NWAVES, lane = F.lane;
    f32x4 gv[4];
#pragma unroll
    for (int j = 0; j < 4; ++j) gv[j] = ((const f32x4*)gf)[lane + 64 * j];
    for (int row = gw; row < SEQ; row += NGW) {
        f32x4* xr = (f32x4*)(F.out + (size_t)row * DM) + lane; f32x4 v[4]; float ss = 0.f;
#pragma unroll
        for (int j = 0; j < 4; ++j) { v[j] = xr[64 * j]; ss += (v[j][0] * v[j][0] + v[j][1] * v[j][1]) + (v[j][2] * v[j][2] + v[j][3] * v[j][3]); }
        const float rs = __builtin_amdgcn_rsqf(wave_sum(ss) * (1.0f / DM) + EPS);
#pragma unroll
        for (int j = 0; j < 4; ++j) xr[64 * j] = v[j] * rs * gv[j];
    }
}

constexpr int NPHASE = 10;
__global__ void __launch_bounds__(NWAVES * 64, 2) hybrid_fwd(Args args) {
    extern __shared__ __attribute__((aligned(16))) unsigned char lds[];
    Frame F;
    F.lds = (LAS unsigned char*)lds; F.MISC = (volatile LAS unsigned*)(F.lds + LDSCTL_OFF);
    F.tid = threadIdx.x; F.lane = F.tid & 63; F.wave = __builtin_amdgcn_readfirstlane(F.tid >> 6);
    F.G = gridDim.x; { const int bx = blockIdx.x; F.vcu = (F.G % 8 == 0) ? (bx % 8) * (F.G / 8) + bx / 8 : bx; }
    F.ws = args.ws; F.ctl = (gu32*)(args.ws + WS_CTL); F.out = args.out;
    for (int u = F.tid; u < (LDS_BYTES - LDSCTL_OFF) / 4; u += NWAVES * 64) ((LAS unsigned*)(F.lds + LDSCTL_OFF))[u] = 0u;
    __syncthreads();
    const int lo = args.ph_lo, hi = args.ph_hi;
    XcdBarrier bar = xcd_barrier_post((unsigned*)(F.ctl + CW_BAR), F.MISC + 8);
#ifndef PHASE_MASK
#define PHASE_MASK 0xFFFF
#endif
#define IN(k) (((PHASE_MASK >> (k)) & 1) && lo <= (k) && (k) < hi)
#define SEAM(k) do { if (IN(k) && IN((k) + 1)) xcd_barrier(bar); } while (0)
    unsigned char* ws = args.ws;
    const int G = F.G, bx = (int)blockIdx.x;

    if (IN(0)) { p0_prologue(F, args); }
    SEAM(0);
    if (IN(1)) {
        pg8::Gemm g{(const bf16*)(ws + WS_XB), (const bf16*)(ws + WS_WIN), SEQ, N1, DM, DM, DM}; pg8::StaticOrder S; S.init(SEQ, N1, G, bx);
        Epi1 E{(const float*)(ws + WS_RS0), ws};
        pg8::gemm_phase<Epi1, pg8::StaticOrder, true, true>(F.lds, g, S, E);
    }
    SEAM(1);
    if (IN(2)) {
        { pg8::Gemm g{(const bf16*)(ws + WS_CK), (const bf16*)(ws + WS_W1KV), 4096, 512, 2048, 1024, 2048}; pg8::OneUnit S{bx, bx >> 3, bx < 16 ? 1 : 0};
          EpiCmp E{(bf16*)(ws + WS_H), (const float*)(ws + WS_POSB)};
          pg8::gemm_phase<EpiCmp, pg8::OneUnit, false, true>(F.lds, g, S, E);
          if (bx < 16) { __threadfence(); __syncthreads(); compress_out(F, bx); } }
        __syncthreads();
        build_lut(F, args.in[5]);
        for (;;) {
            __syncthreads();
            if (F.tid == 0) F.MISC[16] = __hip_atomic_fetch_add(F.ctl + CW_QUEUE, 1u, RLX_AGENT);
            __syncthreads();
            const int unit = (int)F.MISC[16];
            if (unit >= 1024) break;
            if (unit < 512) banded_unit<1>(F, args.in[4], unit >> 1, unit & 1); else banded_unit<0>(F, args.in[4], (unit - 512) >> 1, unit & 1);
        }
    }
    SEAM(2);
    if (IN(3)) {
        build_lut(F, args.in[5]);
        for (int i = bx; i < 256; i += G) { nsa_unit(F, 255 - i, 1); nsa_unit(F, i, 0); }
    }
    SEAM(3);
    if (IN(4)) {
        { pg8::Gemm g{(const bf16*)(ws + WS_QA), (const bf16*)(ws + WS_WUPA), SEQ, DM, 512, 512, 512}; pg8::StaticOrder S; S.init(SEQ, DM, G, bx); EpiUp E{(bf16*)(ws + WS_MG), 0};
          pg8::gemm_phase<EpiUp, pg8::StaticOrder, true, true>(F.lds, g, S, E); }
        { pg8::Gemm g{(const bf16*)(ws + WS_QB), (const bf16*)(ws + WS_WUPB), SEQ, DM, 512, 512, 512}; pg8::StaticOrder S; S.init(SEQ, DM, G, bx); EpiUp E{(bf16*)(ws + WS_MG), 1024};
          pg8::gemm_phase<EpiUp, pg8::StaticOrder, true, true>(F.lds, g, S, E); }
    }
    SEAM(4);
    if (IN(5)) {
        { pg8::Gemm g{(const bf16*)(ws + WS_MG), (const bf16*)(ws + WS_WO2), SEQ, DM, 2048, 2048, 2048}; pg8::StaticOrder S; S.init(SEQ, DM, G, bx);
          EpiWo E{args.in[0], F.out, (bf16*)(ws + WS_XB), (float*)(ws + WS_SSQ1)};
          pg8::gemm_phase<EpiWo, pg8::StaticOrder, true, true>(F.lds, g, S, E); }
        convert_peer_tables(F, args.in[18], args.in[19], args.in[14]);
    }
    SEAM(5);
    if (IN(6)) {
        { pg8::Gemm g{(const bf16*)(ws + WS_XB), (const bf16*)(ws + WS_WQ), SEQ, 2048, DM, DM, DM}; pg8::StaticOrder S; S.init(SEQ, 2048, G, bx); EpiPw E{(bf16*)(ws + WS_Q2), 2048};
          pg8::gemm_phase<EpiPw, pg8::StaticOrder, true, true>(F.lds, g, S, E); }
        { pg8::Gemm g{(const bf16*)(ws + WS_PB), (const bf16*)(ws + WS_WPLE), SEQ, DM, 256, 256, 256}; pg8::StaticOrder S; S.init(SEQ, DM, G, bx); EpiPw E{(bf16*)(ws + WS_PW), DM};
          pg8::gemm_phase<EpiPw, pg8::StaticOrder, true, true>(F.lds, g, S, E); }
    }
    SEAM(6);
    if (IN(7)) { __syncthreads(); peer_phase(F); }
    SEAM(7);
    if (IN(8)) {
        pg8::Gemm g{(const bf16*)(ws + WS_XB), (const bf16*)(ws + WS_WPG), SEQ, DM, DM, DM, DM}; pg8::StaticOrder S; S.init(SEQ, DM, G, bx);
        EpiPle E{(const float*)(ws + WS_RS2), (const bf16*)(ws + WS_PW), F.out};
        pg8::gemm_phase<EpiPle, pg8::StaticOrder, true, true>(F.lds, g, S, E);
    }
    SEAM(8);
    if (IN(9)) final_norm(F, args.in[23]);
#undef IN
#undef SEAM
}

#ifndef MK_ONE_LAUNCH
#define MK_ONE_LAUNCH 1
#endif
extern "C" void kernel_launch(void* const* d_in, const int* in_sizes, int n_in, void* d_out, int out_size, void* d_ws, size_t ws_size, hipStream_t stream) {
    static int grid = 0;
    if (grid == 0) {
        if (n_in != 24 || in_sizes[0] != SEQ * DM || out_size != SEQ * DM || ws_size < WS_END) { fprintf(stderr, "kernel_launch: unexpected shapes (n_in %d, in0 %d, out %d, ws %zu); nothing launched\n", n_in, n_in > 0 ? in_sizes[0] : -1, out_size, ws_size); grid = -1; return; }
        int dev = 0, cus = 0, per_cu = 0;
        if (hipGetDevice(&dev) != hipSuccess || hipDeviceGetAttribute(&cus, hipDeviceAttributeMultiprocessorCount, dev) != hipSuccess) { grid = -1; return; }
        if (hipFuncSetAttribute((const void*)hybrid_fwd, hipFuncAttributeMaxDynamicSharedMemorySize, LDS_BYTES) != hipSuccess) { fprintf(stderr, "kernel_launch: hipFuncSetAttribute failed\n"); grid = -1; return; }
        if (hipOccupancyMaxActiveBlocksPerMultiprocessor(&per_cu, (const void*)hybrid_fwd, NWAVES * 64, LDS_BYTES) != hipSuccess || per_cu < 1) { fprintf(stderr, "kernel_launch: occupancy query says %d blocks per CU\n", per_cu); }
        (void)hipGetLastError();
        grid = cus;
    }
    if (grid < 0) return;
    if (hipMemsetAsync((char*)d_ws + WS_CTL, 0, CTL_ZERO_BYTES, stream) != hipSuccess) return;
    Args a{};
    for (int i = 0; i < 24; ++i) a.in[i] = (const float*)d_in[i];
    a.out = (float*)d_out; a.ws = (unsigned char*)d_ws;
#if MK_ONE_LAUNCH
    a.ph_lo = 0; a.ph_hi = NPHASE;
    hipLaunchKernelGGL(hybrid_fwd, dim3(grid), dim3(NWAVES * 64), LDS_BYTES, stream, a);
#else
    for (int p = 0; p < NPHASE; ++p) { a.ph_lo = p; a.ph_hi = p + 1; hipLaunchKernelGGL(hybrid_fwd, dim3(grid), dim3(NWAVES * 64), LDS_BYTES, stream, a); }
#endif
}
```

```cpp
#include <hip/hip_runtime.h>
#include <cstdio>
#include <cstdint>

#define GAS __attribute__((address_space(1)))
#define LAS __attribute__((address_space(3)))
typedef unsigned short bf16;
typedef short bf16x8 __attribute__((ext_vector_type(8)));
typedef short s16x4 __attribute__((ext_vector_type(4)));
typedef float f32x4 __attribute__((ext_vector_type(4)));
typedef float f32x16 __attribute__((ext_vector_type(16)));
typedef unsigned u32x4 __attribute__((ext_vector_type(4)));
typedef unsigned u32x2 __attribute__((ext_vector_type(2)));
typedef _Float16 h16x8 __attribute__((ext_vector_type(8)));
typedef GAS unsigned gu32;
typedef float f32x2_t __attribute__((ext_vector_type(2))); typedef __bf16 bf16x2_t __attribute__((ext_vector_type(2)));
__device__ __forceinline__ unsigned pkbf(float lo, float hi) { f32x2_t v = {lo, hi}; bf16x2_t b = __builtin_convertvector(v, bf16x2_t); return __builtin_bit_cast(unsigned, b); }
__device__ __forceinline__ float bf_lo(unsigned u) { return __uint_as_float(u << 16); }
__device__ __forceinline__ float bf_hi(unsigned u) { return __uint_as_float(u & 0xffff0000u); }
__device__ __forceinline__ float fexp2(float x) { return __builtin_amdgcn_exp2f(x); }
__device__ __forceinline__ float frcp(float x) { return __builtin_amdgcn_rcpf(x); }
__device__ __forceinline__ float sigmoidf_(float x) { return frcp(1.0f + fexp2(-1.4426950408889634f * x)); }
__device__ __forceinline__ float gelu_tanh(float x) { const float u = x * (1.0f + 0.044715f * x * x); return x * frcp(1.0f + fexp2(-2.302208198f * u)); }
#define LOG2E 1.4426950408889634f
#define RLX_AGENT __ATOMIC_RELAXED, __HIP_MEMORY_SCOPE_AGENT
#define LDS_WAIT() asm volatile("s_waitcnt lgkmcnt(0)" ::: "memory")
#define VM_WAIT() asm volatile("s_waitcnt vmcnt(0)" ::: "memory")

namespace pg8 {
#define PG8_LAS __attribute__((address_space(3)))
typedef unsigned short bf16_t;
typedef short bf16x8 __attribute__((ext_vector_type(8)));
typedef float f32x4 __attribute__((ext_vector_type(4)));
typedef unsigned u32x4 __attribute__((ext_vector_type(4)));
constexpr int BM = 256, BK = 64, HALF = 128, HTB = HALF * BK * 2  , STAGE_BYTES = 8 * HTB, NXCD = 8, WGM = 8;

__host__ __device__ __forceinline__ int lds_byte(int r, int c) { const int st = (r >> 4) * 2 + (c >> 5), rr = r & 15, cc = c & 31, ob = rr * 64 + cc * 2; return st * 1024 + (ob ^ (((ob >> 9) & 1) << 5)); }
__host__ __device__ __forceinline__ void stage_rc(int b, int& R, int& C) { const int st = b / 1024, sb = b % 1024, swz = sb ^ (((sb >> 9) & 1) << 5); R = (st >> 1) * 16 + swz / 64; C = (st & 1) * 32 + (swz % 64) / 2; }
__host__ __device__ __forceinline__ int perm32(int rho) { const int n = rho >> 4, i = rho & 15; return 8 * (i >> 2) + 4 * n + (i & 3); }

struct Unit { int pm, pn; };
struct Gemm { const bf16_t* A; const bf16_t* Bt; int M, N, K, lda, ldb; };

struct StaticOrder {
    int nM, nN, nwg, G, c;
    __host__ __device__ void init(int M, int N, int G_, int c_) { nM = M / BM; nN = N / BM; nwg = nM * nN; G = G_; c = c_; }
    __host__ __device__ bool next(int i, Unit& u) const {
        const long L = (long)i * G + c; if (L >= nwg) return false;
        int wgid = (int)L; { const int q = nwg / NXCD, r = nwg % NXCD, xcd = wgid % NXCD, off = wgid / NXCD; wgid = (xcd < r ? xcd * (q + 1) : r * (q + 1) + (xcd - r) * q) + off; }
        const int nig = WGM * nN, gid = wgid / nig, fm = gid * WGM, gsz = (nM - fm) < WGM ? (nM - fm) : WGM;
        u.pm = fm + ((wgid % nig) % gsz); u.pn = (wgid % nig) / gsz; return true;
    }
    __device__ __forceinline__ void a_ready(const Unit&) const {}
    __device__ __forceinline__ void done(const Unit&) const {}
};
struct OneUnit {
    int pm, pn, has;
    __device__ bool next(int i, Unit& u) const { if (i == 0 && has) { u.pm = pm; u.pn = pn; return true; } return false; }
    __device__ __forceinline__ void a_ready(const Unit&) const {}
    __device__ __forceinline__ void done(const Unit&) const {}
};
template <class Epi, class Sched, bool ALIGN_EPI = false, bool SP2 = false>
__device__ __forceinline__ void gemm_phase(PG8_LAS unsigned char* lds, const Gemm g, const Sched& S, const Epi& E) {
    const int tid = threadIdx.x, wid = __builtin_amdgcn_readfirstlane(tid >> 6), lane = tid & 63, wr = wid >> 2, wc = wid & 3, fr = lane & 15, fq = lane >> 4;
    const int K = g.K, nt = K / BK;
    unsigned voffA[2], voffB[2];
#pragma unroll
    for (int i = 0; i < 2; ++i) { int R, C; stage_rc(tid * 16 + i * 8192, R, C); const int Rb = Epi::PERM ? ((R & ~31) + perm32(R & 31)) : R;
        voffA[i] = (unsigned)(R * g.lda + C) * 2u; voffB[i] = (unsigned)(Rb * g.ldb + C) * 2u; }
    const size_t kstep = (size_t)(BK * 2);
    const size_t hstepA = (size_t)HALF * g.lda * 2, hstepB = (size_t)HALF * g.ldb * 2;
    const size_t tstepA = 2 * hstepA, tstepB = 2 * hstepB;
    const unsigned ldsw = (unsigned)wid * 1024u;
    const int aoff = lds_byte(wr * 64 + fr, fq * 8), boff = lds_byte(wc * 32 + fr, fq * 8);
#define PG8_SA(b, h) (((b) * 2 + (h)) * HTB)
#define PG8_SB(b, h) ((4 + (b) * 2 + (h)) * HTB)
#define PG8_STAGE(bufoff, gbase, voff) do { _Pragma("unroll") for (int _i = 0; _i < 2; ++_i) \
        __builtin_amdgcn_global_load_lds((const unsigned*)((const char*)(gbase) + (voff)[_i]), (PG8_LAS unsigned*)(lds + (bufoff) + ldsw + _i * 8192), 16, 0, 0); } while (0)
#define PG8_LDA(dst, b, h) do { _Pragma("unroll") for (int m = 0; m < 4; ++m) _Pragma("unroll") for (int k = 0; k < 2; ++k) dst[m][k] = *(const PG8_LAS bf16x8*)(lds + PG8_SA(b, h) + aoff + m * 2048 + k * 1024); } while (0)
#define PG8_LDB(dst, b, h) do { _Pragma("unroll") for (int n = 0; n < 2; ++n) _Pragma("unroll") for (int k = 0; k < 2; ++k) dst[n][k] = *(const PG8_LAS bf16x8*)(lds + PG8_SB(b, h) + boff + n * 2048 + k * 1024); } while (0)
#define PG8_MMA(ai, bj, At, Bt) do { __builtin_amdgcn_s_setprio(1); _Pragma("unroll") for (int m = 0; m < 4; ++m) _Pragma("unroll") for (int n = 0; n < 2; ++n) _Pragma("unroll") for (int k = 0; k < 2; ++k) \
        acc[ai][bj][m][n] = __builtin_amdgcn_mfma_f32_16x16x32_bf16(Bt[n][k], At[m][k], acc[ai][bj][m][n], 0, 0, 0); __builtin_amdgcn_s_setprio(0); } while (0)
#define PG8_WAIT_V(n) asm volatile("s_waitcnt vmcnt(" #n ")" ::: "memory")
#define PG8_WAIT_L(n) asm volatile("s_waitcnt lgkmcnt(" #n ")" ::: "memory")
#define PG8_BAR __builtin_amdgcn_s_barrier()
#define PG8_SCHED __builtin_amdgcn_sched_barrier(0)
    Unit cur, nxt; int ui = 0;
    if (!S.next(0, cur)) return;
    f32x4 acc[2][2][4][2];
#pragma unroll
    for (int a = 0; a < 2; ++a)
#pragma unroll
        for (int b = 0; b < 2; ++b)
#pragma unroll
            for (int m = 0; m < 4; ++m)
#pragma unroll
                for (int n = 0; n < 2; ++n) acc[a][b][m][n] = (f32x4){0.f, 0.f, 0.f, 0.f};
    bf16x8 At[4][2], B0[2][2], B1[2][2];
    const char* cA = (const char*)g.A + (size_t)cur.pm * tstepA; const char* cB = (const char*)g.Bt + (size_t)cur.pn * tstepB;
    S.a_ready(cur);
    if constexpr (SP2) {
        PG8_STAGE(PG8_SB(0, 0), cB, voffB); PG8_STAGE(PG8_SB(0, 1), cB + hstepB, voffB); PG8_STAGE(PG8_SA(0, 0), cA, voffA); PG8_STAGE(PG8_SA(0, 1), cA + hstepA, voffA);
        if (wr == 1) PG8_BAR;
        PG8_WAIT_V(2); PG8_BAR;
        PG8_STAGE(PG8_SB(1, 0), cB + kstep, voffB); PG8_STAGE(PG8_SA(1, 0), cA + kstep, voffA); PG8_STAGE(PG8_SB(1, 1), cB + hstepB + kstep, voffB);
        PG8_WAIT_V(6); PG8_BAR;
    } else {
        PG8_STAGE(PG8_SB(0, 0), cB, voffB); PG8_STAGE(PG8_SA(0, 0), cA, voffA); PG8_STAGE(PG8_SB(0, 1), cB + hstepB, voffB); PG8_STAGE(PG8_SA(0, 1), cA + hstepA, voffA);
        if (wr == 1) PG8_BAR;
        PG8_WAIT_V(4); PG8_BAR;
        PG8_STAGE(PG8_SB(1, 0), cB + kstep, voffB); PG8_STAGE(PG8_SA(1, 0), cA + kstep, voffA); PG8_STAGE(PG8_SB(1, 1), cB + hstepB + kstep, voffB);
        PG8_WAIT_V(6); PG8_BAR;
    }
    for (;;) {
        const bool has_next = S.next(ui + 1, nxt);
        const char* nA = has_next ? (const char*)g.A + (size_t)nxt.pm * tstepA : cA; const char* nB = has_next ? (const char*)g.Bt + (size_t)nxt.pn * tstepB : cB;
        for (int t = 0; t < nt; t += 2) {
            const bool last = (t == nt - 2);
            const char* a1 = cA + (size_t)(t + 1) * kstep;
            const char* a2 = last ? nA : cA + (size_t)(t + 2) * kstep; const char* b2 = last ? nB : cB + (size_t)(t + 2) * kstep;
            const char* a3 = a2 + kstep; const char* b3 = b2 + kstep;
            if (last && has_next) S.a_ready(nxt);
            if constexpr (SP2) {
            PG8_LDB(B0, 0, 0); PG8_LDB(B1, 0, 1); PG8_SCHED; PG8_LDA(At, 0, 0); PG8_STAGE(PG8_SA(1, 1), a1 + hstepA, voffA);
            PG8_WAIT_V(8); PG8_WAIT_L(0); PG8_BAR; PG8_MMA(0, 0, At, B0); PG8_MMA(0, 1, At, B1); PG8_BAR; PG8_SCHED;
            PG8_LDA(At, 0, 1); PG8_STAGE(PG8_SB(0, 0), b2, voffB); PG8_STAGE(PG8_SB(0, 1), b2 + hstepB, voffB); PG8_STAGE(PG8_SA(0, 0), a2, voffA);
            PG8_WAIT_V(8); PG8_WAIT_L(0); PG8_BAR; PG8_MMA(1, 0, At, B0); PG8_MMA(1, 1, At, B1); PG8_BAR; PG8_SCHED;
            PG8_LDB(B0, 1, 0); PG8_LDB(B1, 1, 1); PG8_SCHED; PG8_LDA(At, 1, 0); PG8_STAGE(PG8_SA(0, 1), a2 + hstepA, voffA);
            PG8_WAIT_V(8); PG8_WAIT_L(0); PG8_BAR; PG8_MMA(0, 0, At, B0); PG8_MMA(0, 1, At, B1); PG8_BAR; PG8_SCHED;
            PG8_LDA(At, 1, 1); PG8_STAGE(PG8_SB(1, 0), b3, voffB); PG8_STAGE(PG8_SB(1, 1), b3 + hstepB, voffB); PG8_STAGE(PG8_SA(1, 0), a3, voffA);
            PG8_WAIT_V(8); PG8_WAIT_L(0); PG8_BAR; PG8_MMA(1, 0, At, B0); PG8_MMA(1, 1, At, B1); PG8_BAR; PG8_SCHED;
            } else {
            PG8_LDB(B0, 0, 0); PG8_SCHED; PG8_LDA(At, 0, 0); PG8_STAGE(PG8_SA(1, 1), a1 + hstepA, voffA);
            PG8_WAIT_L(8); PG8_BAR; PG8_WAIT_L(0); PG8_MMA(0, 0, At, B0); PG8_BAR; PG8_SCHED;
            PG8_LDB(B1, 0, 1); PG8_STAGE(PG8_SB(0, 0), b2, voffB);
            PG8_BAR; PG8_WAIT_L(0); PG8_MMA(0, 1, At, B1); PG8_BAR;
            PG8_LDA(At, 0, 1); PG8_STAGE(PG8_SA(0, 0), a2, voffA);
            PG8_BAR; PG8_WAIT_L(0); PG8_MMA(1, 0, At, B0); PG8_BAR; PG8_SCHED;
            PG8_STAGE(PG8_SB(0, 1), b2 + hstepB, voffB);
            PG8_WAIT_V(6); PG8_BAR; PG8_MMA(1, 1, At, B1); PG8_BAR;
            PG8_LDB(B0, 1, 0); PG8_SCHED; PG8_LDA(At, 1, 0); PG8_STAGE(PG8_SA(0, 1), a2 + hstepA, voffA);
            PG8_WAIT_L(8); PG8_BAR; PG8_WAIT_L(0); PG8_MMA(0, 0, At, B0); PG8_BAR; PG8_SCHED;
            PG8_LDB(B1, 1, 1); PG8_STAGE(PG8_SB(1, 0), b3, voffB);
            PG8_BAR; PG8_WAIT_L(0); PG8_MMA(0, 1, At, B1); PG8_BAR;
            PG8_LDA(At, 1, 1); PG8_STAGE(PG8_SA(1, 0), a3, voffA);
            PG8_BAR; PG8_WAIT_L(0); PG8_MMA(1, 0, At, B0); PG8_BAR; PG8_SCHED;
            PG8_STAGE(PG8_SB(1, 1), b3 + hstepB, voffB);
            PG8_WAIT_V(6); PG8_BAR; PG8_MMA(1, 1, At, B1); PG8_BAR;
            }
        }
        if constexpr (ALIGN_EPI) { if (wr == 0) PG8_BAR; }
        if constexpr (!Epi::AFTER_DRAIN) { E(acc, cur, wr, wc, fr, fq); S.done(cur); }
        if (!has_next) break;
#pragma unroll
        for (int a = 0; a < 2; ++a)
#pragma unroll
            for (int b = 0; b < 2; ++b)
#pragma unroll
                for (int m = 0; m < 4; ++m)
#pragma unroll
                    for (int n = 0; n < 2; ++n) acc[a][b][m][n] = (f32x4){0.f, 0.f, 0.f, 0.f};
        cur = nxt; cA = nA; cB = nB; ++ui;
        if constexpr (ALIGN_EPI) { if (wr == 1) PG8_BAR; }
    }
    PG8_WAIT_V(0);
    if constexpr (!ALIGN_EPI) { if (wr == 0) PG8_BAR; }
    PG8_BAR;
    if constexpr (Epi::AFTER_DRAIN) { E.fused(acc, cur, wr, wc, fr, fq, lds, wid, lane); S.done(cur); }
#undef PG8_SA
#undef PG8_SB
#undef PG8_STAGE
#undef PG8_LDA
#undef PG8_LDB
#undef PG8_MMA
#undef PG8_WAIT_V
#undef PG8_WAIT_L
#undef PG8_BAR
#undef PG8_SCHED
}
}
#undef PG8_LAS
#define XB_TMO      128
#define XB_XCNT(j)  (256  + 64 * (j))
#define XB_XSUB(j)  (1280 + 64 * (j))
#define XB_XGEN(j)  (2304 + 64 * (j))
#define XB_TOP      3328
#define XB_TOPGEN   3392
#define XCD_BAR_WORDS 3456
#define XB_SPIN_CAP (1u << 18)

__device__ __forceinline__ unsigned xb_ld(unsigned* p)              { return __hip_atomic_load(p, __ATOMIC_RELAXED, __HIP_MEMORY_SCOPE_AGENT); }
__device__ __forceinline__ unsigned xb_add(unsigned* p, unsigned v) { return __hip_atomic_fetch_add(p, v, __ATOMIC_RELAXED, __HIP_MEMORY_SCOPE_AGENT); }
__device__ __forceinline__ unsigned xb_xcc_id() { return (unsigned)__builtin_amdgcn_s_getreg((3 << 11) | 20) & 0xFu; }
#define XB_SPIN(cond, bar) do { unsigned _sp = 0; while (cond) { __builtin_amdgcn_s_sleep(1); \
    if ((++_sp & 255u) == 0u) { if (xb_ld(&(bar)[XB_TMO])) break; if (_sp > XB_SPIN_CAP) { atomicAdd(&(bar)[XB_TMO], 1u); break; } } } } while (0)

struct XcdBarrier {
    unsigned* bar; unsigned x;
    volatile LAS unsigned* st;
};

__device__ __forceinline__ XcdBarrier xcd_barrier_post(unsigned* bar, volatile LAS unsigned* st) {
    XcdBarrier b; b.bar = bar; b.x = xb_xcc_id(); b.st = st;
    if (threadIdx.x == 0) (void)xb_add(&bar[XB_XCNT(b.x)], 1u);
    return b;
}
__device__ __forceinline__ void xcd_barrier_complete(unsigned* bar, unsigned x, unsigned& nloc, unsigned& nx) {
    const unsigned G = gridDim.x * gridDim.y * gridDim.z;
    unsigned sum, cnt, mine, sp = 0u;
    for (;;) {
        sum = 0u; cnt = 0u; mine = 0u;
#pragma unroll
        for (unsigned j = 0; j < 16; ++j) { const unsigned c = xb_ld(&bar[XB_XCNT(j)]); sum += c; cnt += (c > 0u) ? 1u : 0u; mine = (j == x) ? c : mine; }
        if (sum == G) break;
        __builtin_amdgcn_s_sleep(1);
        if ((++sp & 255u) == 0u) { if (xb_ld(&bar[XB_TMO])) break; if (sp > XB_SPIN_CAP) { atomicAdd(&bar[XB_TMO], 1u); break; } }
    }
    nloc = mine > 0u ? mine : 1u; nx = cnt > 0u ? cnt : 1u;
}

__device__ __forceinline__ void xcd_barrier(const XcdBarrier& b) {
    asm volatile("s_waitcnt vmcnt(0)" ::: "memory");
    __syncthreads();
    if (threadIdx.x == 0) {
        unsigned* bar = b.bar;
        __builtin_amdgcn_s_waitcnt(0);
        unsigned nloc = b.st[0], nx = b.st[1];
        if (nloc == 0u) { xcd_barrier_complete(bar, b.x, nloc, nx); b.st[0] = nloc; b.st[1] = nx; }
        const unsigned old = xb_add(&bar[XB_XSUB(b.x)], 1u);
        const unsigned gen = old / nloc;
        if (old + 1u == (gen + 1u) * nloc) {
            __builtin_amdgcn_fence(__ATOMIC_RELEASE, "agent");
            asm volatile("s_waitcnt vmcnt(0)" ::: "memory");
            const unsigned og = xb_add(&bar[XB_TOP], 1u);
            const unsigned tg = og / nx;
            if (og + 1u == (tg + 1u) * nx) xb_add(&bar[XB_TOPGEN], 1u);
            else XB_SPIN(xb_ld(&bar[XB_TOPGEN]) == tg, bar);
            __builtin_amdgcn_fence(__ATOMIC_ACQUIRE, "agent");
            xb_add(&bar[XB_XGEN(b.x)], 1u);
            asm volatile("s_waitcnt vmcnt(0)" ::: "memory");
        } else {
            XB_SPIN(xb_ld(&bar[XB_XGEN(b.x)]) == gen, bar);
            __builtin_amdgcn_fence(__ATOMIC_ACQUIRE, "agent");
            asm volatile("s_waitcnt vmcnt(0)" ::: "memory");
        }
    }
    __syncthreads();
}

constexpr int SEQ = 16384, DM = 1024, N1 = 4352  , NWAVES = 8;
constexpr float EPS = 1e-6f, QSCALE = 0.125f * LOG2E;
constexpr size_t MiB = 1u << 20;
constexpr size_t WS_CTL = 0, CTL_ZERO_BYTES = 1 * MiB;
constexpr size_t WS_WIN = 1 * MiB, WS_WUPA = 10 * MiB, WS_WUPB = 11 * MiB, WS_WO2 = 12 * MiB, WS_WQ = 16 * MiB, WS_WPG = 20 * MiB, WS_WPLE = 22 * MiB, WS_W1KV = 23 * MiB;
constexpr size_t WS_SMALL = 25 * MiB, WS_W2KT = WS_SMALL, WS_W2VT = WS_SMALL + 32768, WS_K1B = WS_SMALL + 65536, WS_K2B = WS_SMALL + 98304, WS_POSB = WS_SMALL + 131072,
                 WS_RS0 = WS_SMALL + 262144, WS_RS2 = WS_SMALL + 393216;
constexpr size_t WS_SSQ1 = 26 * MiB, WS_BG = 27 * MiB, WS_KC = 28 * MiB + 512 * 1024, WS_VCT = WS_KC + 262144, WS_H = 29 * MiB;
constexpr size_t WS_XB = 32 * MiB, WS_MG = 64 * MiB, WS_QA = 128 * MiB, WS_QB = 144 * MiB;
constexpr size_t WS_KA = 160 * MiB, WS_VTA = 164 * MiB, WS_CK = 168 * MiB, WS_KS = 176 * MiB, WS_VTS = 180 * MiB, WS_KW = 184 * MiB, WS_VTW = 188 * MiB;
constexpr size_t WS_OW = 192 * MiB, WS_PW = 208 * MiB, WS_PB = 240 * MiB;
constexpr size_t WS_OA = 208 * MiB, WS_OB = 224 * MiB;
constexpr size_t WS_U16 = 128 * MiB, WS_V16 = 160 * MiB, WS_Q2 = 64 * MiB;
constexpr size_t WS_END = 256 * MiB;
constexpr int CW_TMO = 0, CW_BAR = 4096, CW_QUEUE = 32768;
constexpr int LDS_BYTES = 147456, LDSCTL_OFF = 143360;
constexpr int KROW = 144, VROW = 136;
constexpr int AT_K0 = 0, AT_KSZ = 64 * KROW, AT_V0 = 2 * AT_KSZ, AT_VSZ = 64 * VROW, AT_LUT = 36864, LUTS = 136, AT_IMP = 46080, AT_SEL = 111616;
constexpr int PK_ROW = 272, PK1_OFF = 0, PK2_OFF = 128 * PK_ROW, PW_OFF = 2 * 128 * PK_ROW, PW_BYTES = 8192;
static_assert(AT_V0 + 2 * AT_VSZ <= AT_LUT && AT_LUT + 16 * LUTS * 4 <= AT_IMP && AT_SEL + 2048 <= LDSCTL_OFF && PW_OFF + 8 * PW_BYTES <= LDSCTL_OFF, "LDS map");

__device__ const unsigned char BKT[129] = {0,1,2,3,4,5,6,7,8,9,10,11,12,13,14,15,16,16,16,17,17,18,18,18,19,19,19,20,20,20,20,21,21,21,21,22,22,22,22,22,23,23,23,23,23,23,24,24,24,24,24,24,
    25,25,25,25,25,25,25,26,26,26,26,26,26,26,26,27,27,27,27,27,27,27,27,27,27,28,28,28,28,28,28,28,28,28,28,29,29,29,29,29,29,29,29,29,29,29,29,30,30,30,30,30,30,30,30,30,30,30,30,30,30,
    31,31,31,31,31,31,31,31,31,31,31,31,31,31,31,31};

struct Args { const float* in[24]; float* out; unsigned char* ws; int ph_lo, ph_hi, li, pad; };
struct Frame {
    LAS unsigned char* lds; volatile LAS unsigned* MISC; gu32* ctl; unsigned char* ws;
    int tid, lane, wave, vcu, G;
    float* out;
};
template <int CTRL> __device__ __forceinline__ float dpp_f(float v) { return __uint_as_float((unsigned)__builtin_amdgcn_update_dpp(0, (int)__float_as_uint(v), CTRL, 0xf, 0xf, true)); }
template <int CTRL> __device__ __forceinline__ unsigned dpp_u(unsigned v) { return (unsigned)__builtin_amdgcn_update_dpp(0, (int)v, CTRL, 0xf, 0xf, true); }
__device__ __forceinline__ float wave_sum(float v) {
#pragma unroll
    for (int o = 1; o < 64; o <<= 1) v += __shfl_xor(v, o);
    return v;
}
__device__ __forceinline__ float quad_sum(float v) { v += dpp_f<0xB1>(v); v += dpp_f<0x4E>(v); return v; }
__device__ __forceinline__ unsigned umax_(unsigned a, unsigned b) { return a > b ? a : b; }
__device__ __forceinline__ unsigned wave_max_u32(unsigned v) {
    v = umax_(v, dpp_u<0xB1>(v)); v = umax_(v, dpp_u<0x4E>(v)); v = umax_(v, dpp_u<0x141>(v)); v = umax_(v, dpp_u<0x140>(v));
    const unsigned a = __builtin_amdgcn_readlane(v, 0), b = __builtin_amdgcn_readlane(v, 16), c = __builtin_amdgcn_readlane(v, 32), d = __builtin_amdgcn_readlane(v, 48);
    return umax_(umax_(a, b), umax_(c, d));
}
__device__ __forceinline__ float pair_max(float v) { auto rr = __builtin_amdgcn_permlane32_swap(__float_as_uint(v), __float_as_uint(v), false, false); return fmaxf(__uint_as_float(rr[0]), __uint_as_float(rr[1])); }
__device__ __forceinline__ float pair_sum(float v) { auto rr = __builtin_amdgcn_permlane32_swap(__float_as_uint(v), __float_as_uint(v), false, false); return __uint_as_float(rr[0]) + __uint_as_float(rr[1]); }
__device__ __forceinline__ unsigned pair_umax(unsigned v) { auto rr = __builtin_amdgcn_permlane32_swap(v, v, false, false); return umax_(rr[0], rr[1]); }
#define WG_BAR_LDS() do { asm volatile("s_waitcnt lgkmcnt(0)" ::: "memory"); __builtin_amdgcn_s_barrier(); asm volatile("" ::: "memory"); } while (0)
__device__ __forceinline__ u32x4 pack8(const f32x4& a, const f32x4& b) { u32x4 w; w.x = pkbf(a[0], a[1]); w.y = pkbf(a[2], a[3]); w.z = pkbf(b[0], b[1]); w.w = pkbf(b[2], b[3]); return w; }

typedef const f32x4 (&AccRef)[2][2][4][2];
struct Epi1 {
    static constexpr bool PERM = true, AFTER_DRAIN = false;
    const float* rs0; unsigned char* ws;
    __device__ __forceinline__ void operator()(AccRef acc, const pg8::Unit& u, int wr, int wc, int fr, int fq) const {
        const int row0 = u.pm * 256 + wr * 64 + fr, pn = u.pn, cl = wc * 32 + 8 * fq;
        if (pn < 4) {
            bf16* Q = (bf16*)(ws + (pn < 2 ? WS_QA : WS_QB)) + (pn & 1) * 256 + cl;
#pragma unroll
            for (int ai = 0; ai < 2; ++ai)
#pragma unroll
                for (int m = 0; m < 4; ++m) { const int row = row0 + ai * 128 + m * 16; const float s = rs0[row] * QSCALE;
#pragma unroll
                    for (int bj = 0; bj < 2; ++bj) *(u32x4*)(Q + (size_t)row * 512 + bj * 128) = pack8(acc[ai][bj][m][0] * s, acc[ai][bj][m][1] * s); }
        } else if (pn < 8) {
            const int g = wc >> 1, dl = cl & 63;
            const size_t koff = pn == 4 ? WS_KA : pn == 5 ? WS_CK : pn == 6 ? WS_KS : WS_KW;
            const size_t voff = pn == 4 ? WS_VTA : pn == 5 ? WS_CK + (size_t)2 * SEQ * 64 * 2 : pn == 6 ? WS_VTS : WS_VTW;
            bf16* Kd = (bf16*)(ws + koff) + (size_t)g * SEQ * 64 + dl;
            bf16* Vd = (bf16*)(ws + voff);
#pragma unroll
            for (int ai = 0; ai < 2; ++ai)
#pragma unroll
                for (int m = 0; m < 4; ++m) { const int row = row0 + ai * 128 + m * 16; const float s = rs0[row];
                    *(u32x4*)(Kd + (size_t)row * 64) = pack8(acc[ai][0][m][0] * s, acc[ai][0][m][1] * s);
                    const u32x4 v = pack8(acc[ai][1][m][0] * s, acc[ai][1][m][1] * s);
                    if (pn == 5) *(u32x4*)(Vd + ((size_t)g * SEQ + row) * 64 + dl) = v;
                    else { bf16* vt = Vd + (size_t)(g * 64 + dl) * SEQ + row;
                        vt[0 * (size_t)SEQ] = (bf16)v.x; vt[1 * (size_t)SEQ] = (bf16)(v.x >> 16); vt[2 * (size_t)SEQ] = (bf16)v.y; vt[3 * (size_t)SEQ] = (bf16)(v.y >> 16);
                        vt[4 * (size_t)SEQ] = (bf16)v.z; vt[5 * (size_t)SEQ] = (bf16)(v.z >> 16); vt[6 * (size_t)SEQ] = (bf16)v.w; vt[7 * (size_t)SEQ] = (bf16)(v.w >> 16); } }
        } else if (pn < 16) {
            bf16* MG = (bf16*)(ws + WS_MG) + (pn - 8) * 256 + cl;
#pragma unroll
            for (int ai = 0; ai < 2; ++ai)
#pragma unroll
                for (int m = 0; m < 4; ++m) { const int row = row0 + ai * 128 + m * 16; const float s = rs0[row];
#pragma unroll
                    for (int bj = 0; bj < 2; ++bj) { f32x4 a = acc[ai][bj][m][0] * s, b = acc[ai][bj][m][1] * s;
#pragma unroll
                        for (int e = 0; e < 4; ++e) { a[e] = sigmoidf_(a[e]); b[e] = sigmoidf_(b[e]); }
                        *(u32x4*)(MG + (size_t)row * 2048 + bj * 128) = pack8(a, b); } }
        } else {
            if (wc == 0 && fq < 3) { float* BG = (float*)(ws + WS_BG) + 8 * fq;
#pragma unroll
                for (int ai = 0; ai < 2; ++ai)
#pragma unroll
                    for (int m = 0; m < 4; ++m) { const int row = row0 + ai * 128 + m * 16; const float s = rs0[row]; f32x4 a = acc[ai][0][m][0] * s, b = acc[ai][0][m][1] * s;
#pragma unroll
                        for (int e = 0; e < 4; ++e) { a[e] = sigmoidf_(a[e]); b[e] = sigmoidf_(b[e]); }
                        *(f32x4*)(BG + (size_t)row * 24) = a; *(f32x4*)(BG + (size_t)row * 24 + 4) = b; } }
        }
    }
};
struct EpiUp {
    static constexpr bool PERM = true, AFTER_DRAIN = false;
    bf16* MG; int coloff;
    __device__ __forceinline__ void operator()(AccRef acc, const pg8::Unit& u, int wr, int wc, int fr, int fq) const {
        const int row0 = u.pm * 256 + wr * 64 + fr; bf16* base = MG + coloff + u.pn * 256 + wc * 32 + 8 * fq;
#pragma unroll
        for (int ai = 0; ai < 2; ++ai)
#pragma unroll
            for (int m = 0; m < 4; ++m) { bf16* rp = base + (size_t)(row0 + ai * 128 + m * 16) * 2048;
#pragma unroll
                for (int bj = 0; bj < 2; ++bj) { const u32x4 gt = *(const u32x4*)(rp + bj * 128); const f32x4 a = acc[ai][bj][m][0], b = acc[ai][bj][m][1]; u32x4 w;
                    w.x = pkbf(bf_lo(gt.x) * a[0], bf_hi(gt.x) * a[1]); w.y = pkbf(bf_lo(gt.y) * a[2], bf_hi(gt.y) * a[3]);
                    w.z = pkbf(bf_lo(gt.z) * b[0], bf_hi(gt.z) * b[1]); w.w = pkbf(bf_lo(gt.w) * b[2], bf_hi(gt.w) * b[3]);
                    *(u32x4*)(rp + bj * 128) = w; } }
    }
};
struct EpiWo {
    static constexpr bool PERM = true, AFTER_DRAIN = false;
    const float* x; float* out; bf16* xb; float* ssq;
    __device__ __forceinline__ void operator()(AccRef acc, const pg8::Unit& u, int wr, int wc, int fr, int fq) const {
        const int row0 = u.pm * 256 + wr * 64 + fr, c0 = u.pn * 256 + wc * 32 + 8 * fq;
#pragma unroll
        for (int ai = 0; ai < 2; ++ai)
#pragma unroll
            for (int m = 0; m < 4; ++m) { const int row = row0 + ai * 128 + m * 16; float ss = 0.f;
#pragma unroll
                for (int bj = 0; bj < 2; ++bj) { const size_t o = (size_t)row * DM + c0 + bj * 128;
                    const f32x4 a = *(const f32x4*)(x + o) + acc[ai][bj][m][0], b = *(const f32x4*)(x + o + 4) + acc[ai][bj][m][1];
                    *(f32x4*)(out + o) = a; *(f32x4*)(out + o + 4) = b; *(u32x4*)(xb + o) = pack8(a, b);
                    ss += (a[0] * a[0] + a[1] * a[1]) + (a[2] * a[2] + a[3] * a[3]) + (b[0] * b[0] + b[1] * b[1]) + (b[2] * b[2] + b[3] * b[3]); }
                ss += __shfl_xor(ss, 16); ss += __shfl_xor(ss, 32);
                if (fq == 0) ssq[(size_t)row * 16 + u.pn * 4 + wc] = ss; }
    }
};
__device__ __forceinline__ float rs_from_ssq(const float* ssq, int row) {
    const f32x4* p = (const f32x4*)(ssq + (size_t)row * 16); const f32x4 a = p[0], b = p[1], c = p[2], d = p[3];
    const float s = ((a[0] + a[1]) + (a[2] + a[3])) + ((b[0] + b[1]) + (b[2] + b[3])) + ((c[0] + c[1]) + (c[2] + c[3])) + ((d[0] + d[1]) + (d[2] + d[3]));
    return __builtin_amdgcn_rsqf(s * (1.0f / DM) + EPS);
}
struct EpiPw {
    static constexpr bool PERM = true, AFTER_DRAIN = false;
    bf16* O; int ldc;
    __device__ __forceinline__ void operator()(AccRef acc, const pg8::Unit& u, int wr, int wc, int fr, int fq) const {
        const int row0 = u.pm * 256 + wr * 64 + fr; bf16* base = O + u.pn * 256 + wc * 32 + 8 * fq;
#pragma unroll
        for (int ai = 0; ai < 2; ++ai)
#pragma unroll
            for (int m = 0; m < 4; ++m)
#pragma unroll
                for (int bj = 0; bj < 2; ++bj) *(u32x4*)(base + (size_t)(row0 + ai * 128 + m * 16) * ldc + bj * 128) = pack8(acc[ai][bj][m][0], acc[ai][bj][m][1]);
    }
};
struct EpiPle {
    static constexpr bool PERM = true, AFTER_DRAIN = false;
    const float* rs2; const bf16* pw; float* out;
    __device__ __forceinline__ void operator()(AccRef acc, const pg8::Unit& u, int wr, int wc, int fr, int fq) const {
        const int row0 = u.pm * 256 + wr * 64 + fr, c0 = u.pn * 256 + wc * 32 + 8 * fq;
#pragma unroll
        for (int ai = 0; ai < 2; ++ai)
#pragma unroll
            for (int m = 0; m < 4; ++m) { const int row = row0 + ai * 128 + m * 16; const float s = rs2[row];
#pragma unroll
                for (int bj = 0; bj < 2; ++bj) { const size_t o = (size_t)row * DM + c0 + bj * 128; const u32x4 pv = *(const u32x4*)(pw + o);
                    f32x4 a = *(const f32x4*)(out + o), b = *(const f32x4*)(out + o + 4); const f32x4 ga = acc[ai][bj][m][0] * s, gb = acc[ai][bj][m][1] * s;
                    a[0] += sigmoidf_(ga[0]) * bf_lo(pv.x); a[1] += sigmoidf_(ga[1]) * bf_hi(pv.x); a[2] += sigmoidf_(ga[2]) * bf_lo(pv.y); a[3] += sigmoidf_(ga[3]) * bf_hi(pv.y);
                    b[0] += sigmoidf_(gb[0]) * bf_lo(pv.z); b[1] += sigmoidf_(gb[1]) * bf_hi(pv.z); b[2] += sigmoidf_(gb[2]) * bf_lo(pv.w); b[3] += sigmoidf_(gb[3]) * bf_hi(pv.w);
                    *(f32x4*)(out + o) = a; *(f32x4*)(out + o + 4) = b; } }
    }
};
struct EpiCmp {
    static constexpr bool PERM = true, AFTER_DRAIN = false;
    bf16* H; const float* posb;
    __device__ __forceinline__ void operator()(AccRef acc, const pg8::Unit& u, int wr, int wc, int fr, int fq) const {
        const int row0 = u.pm * 256 + wr * 64 + fr, cl = wc * 32 + 8 * fq;
#pragma unroll
        for (int bj = 0; bj < 2; ++bj) { const f32x4 pa = *(const f32x4*)(posb + u.pn * 256 + bj * 128 + cl), pb = *(const f32x4*)(posb + u.pn * 256 + bj * 128 + cl + 4);
#pragma unroll
            for (int ai = 0; ai < 2; ++ai)
#pragma unroll
                for (int m = 0; m < 4; ++m) { f32x4 a = acc[ai][bj][m][0] + pa, b = acc[ai][bj][m][1] + pb;
#pragma unroll
                    for (int e = 0; e < 4; ++e) { a[e] = gelu_tanh(a[e]); b[e] = gelu_tanh(b[e]); }
                    *(u32x4*)(H + (size_t)(row0 + ai * 128 + m * 16) * 256 + bj * 128 + cl) = pack8(a, b); } }
    }
};

__device__ __forceinline__ void tr_item(const float* W, int Nsrc, int k0, int srcc0, int nvalid, bf16* WT, int ldk, int drow0, int dk0, const float* g, LAS float* scr, int lane) {
#pragma unroll 8
    for (int i = 0; i < 32; ++i) { const int kk = 2 * i + (lane >> 5), n = lane & 31; float v = 0.f;
        if (n < nvalid) { v = W[(size_t)(k0 + kk) * Nsrc + srcc0 + n]; if (g) v *= g[k0 + kk]; }
        scr[kk * 33 + n] = v; }
    LDS_WAIT(); asm volatile("" ::: "memory");
    const int c = lane & 7;
#pragma unroll
    for (int j = 0; j < 4; ++j) { const int n = (lane >> 3) + 8 * j; const LAS float* s = scr + (8 * c) * 33 + n;
        u32x4 o; o.x = pkbf(s[0 * 33], s[1 * 33]); o.y = pkbf(s[2 * 33], s[3 * 33]); o.z = pkbf(s[4 * 33], s[5 * 33]); o.w = pkbf(s[6 * 33], s[7 * 33]);
        *(u32x4*)(WT + (size_t)(drow0 + n) * ldk + dk0 + k0 + 8 * c) = o; }
    LDS_WAIT(); asm volatile("" ::: "memory");
}
__device__ __forceinline__ void p0_prologue(Frame& F, const Args& A) {
    LAS float* scr = (LAS float*)(F.lds + F.wave * 8448);
    const int gw = F.vcu * NWAVES + F.wave, NGW = F.G * NWAVES, lane = F.lane;
    unsigned char* ws = F.ws;
    constexpr int I_IN = 16 * 136, I_UP = 8 * 32, I_O = 16 * 32, I_Q = 16 * 64, I_PG = 16 * 32, I_PLE = 4 * 32, I_W1 = 32 * 8, I_W2 = 4 * 2;
    constexpr int NITEMS = I_IN + 2 * I_UP + I_O + I_Q + I_PG + I_PLE + 2 * I_W1 + 2 * I_W2;
    for (int it = gw; it < NITEMS; it += NGW) {
        int r = it;
        if (r < I_IN) { const int kb = r / 136, nb = r % 136, n = nb * 32; int src, nv = 32;
            if (n < 512) src = n; else if (n < 1024) src = n + 256; else if (n < 1280) src = n - 512; else if (n < 2048) src = n; else if (n < 4096) src = n + 24;
            else if (n == 4096) { src = 2048; nv = 24; } else { src = 0; nv = 0; }
            tr_item(A.in[3], 4120, kb * 64, src, nv, (bf16*)(ws + WS_WIN), 1024, n, 0, A.in[2], scr, lane); continue; } r -= I_IN;
        if (r < I_UP) { tr_item(A.in[11], 1024, (r / 32) * 64, (r % 32) * 32, 32, (bf16*)(ws + WS_WUPA), 512, (r % 32) * 32, 0, nullptr, scr, lane); continue; } r -= I_UP;
        if (r < I_UP) { tr_item(A.in[12], 1024, (r / 32) * 64, (r % 32) * 32, 32, (bf16*)(ws + WS_WUPB), 512, (r % 32) * 32, 0, nullptr, scr, lane); continue; } r -= I_UP;
        if (r < I_O) { tr_item(A.in[13], 1024, (r / 32) * 64, (r % 32) * 32, 32, (bf16*)(ws + WS_WO2), 2048, (r % 32) * 32, 0, nullptr, scr, lane);
                       tr_item(A.in[13], 1024, (r / 32) * 64, (r % 32) * 32, 32, (bf16*)(ws + WS_WO2), 2048, (r % 32) * 32, 1024, nullptr, scr, lane); continue; } r -= I_O;
        if (r < I_Q) { tr_item(A.in[15], 2048, (r / 64) * 64, (r % 64) * 32, 32, (bf16*)(ws + WS_WQ), 1024, (r % 64) * 32, 0, A.in[14], scr, lane); continue; } r -= I_Q;
        if (r < I_PG) { tr_item(A.in[21], 1024, (r / 32) * 64, (r % 32) * 32, 32, (bf16*)(ws + WS_WPG), 1024, (r % 32) * 32, 0, A.in[20], scr, lane); continue; } r -= I_PG;
        if (r < I_PLE) { tr_item(A.in[22], 1024, (r / 32) * 64, (r % 32) * 32, 32, (bf16*)(ws + WS_WPLE), 256, (r % 32) * 32, 0, nullptr, scr, lane); continue; } r -= I_PLE;
        if (r < I_W1) { tr_item(A.in[7], 256, (r / 8) * 64, (r % 8) * 32, 32, (bf16*)(ws + WS_W1KV), 2048, (r % 8) * 32, 0, nullptr, scr, lane); continue; } r -= I_W1;
        if (r < I_W1) { tr_item(A.in[9], 256, (r / 8) * 64, (r % 8) * 32, 32, (bf16*)(ws + WS_W1KV), 2048, 256 + (r % 8) * 32, 0, nullptr, scr, lane); continue; } r -= I_W1;
        if (r < I_W2) { tr_item(A.in[8], 64, (r / 2) * 64, (r % 2) * 32, 32, (bf16*)(ws + WS_W2KT), 256, (r % 2) * 32, 0, nullptr, scr, lane); continue; } r -= I_W2;
        tr_item(A.in[10], 64, (r / 2) * 64, (r % 2) * 32, 32, (bf16*)(ws + WS_W2VT), 256, (r % 2) * 32, 0, nullptr, scr, lane);
    }
    { const float* x = A.in[0]; bf16* xb = (bf16*)(ws + WS_XB); float* rs0 = (float*)(ws + WS_RS0);
      for (int row = gw; row < SEQ; row += NGW) {
          const f32x4* xr = (const f32x4*)(x + (size_t)row * DM) + lane; f32x4 v[4]; float ss = 0.f;
#pragma unroll
          for (int j = 0; j < 4; ++j) { v[j] = xr[64 * j]; ss += (v[j][0] * v[j][0] + v[j][1] * v[j][1]) + (v[j][2] * v[j][2] + v[j][3] * v[j][3]); }
          ss = wave_sum(ss);
          u32x2* o8 = (u32x2*)(xb + (size_t)row * DM) + lane;
#pragma unroll
          for (int j = 0; j < 4; ++j) { u32x2 w; w.x = pkbf(v[j][0], v[j][1]); w.y = pkbf(v[j][2], v[j][3]); o8[64 * j] = w; }
          if (lane == 0) rs0[row] = __builtin_amdgcn_rsqf(ss * (1.0f / DM) + EPS);
      } }
    { const int gt = gw * 64 + lane, NGT = NGW * 64;
      const float* p = A.in[1]; bf16* pb = (bf16*)(ws + WS_PB);
      for (int i = gt; i < SEQ * 256 / 8; i += NGT) { const f32x4 a = *(const f32x4*)(p + (size_t)i * 8), b = *(const f32x4*)(p + (size_t)i * 8 + 4); *(u32x4*)(pb + (size_t)i * 8) = pack8(a, b); }
      for (int i = gt; i < 2 * 16384 / 8; i += NGT) { const int which = i >= 2048, j = i & 2047; const float* k = A.in[16 + which] + (size_t)j * 8;
          *(u32x4*)((bf16*)(ws + (which ? WS_K2B : WS_K1B)) + (size_t)j * 8) = pack8(*(const f32x4*)k, *(const f32x4*)(k + 4)); } }
    if (F.vcu < 32) {
#pragma unroll 1
        for (int oo = 0; oo < 2; ++oo) { const int o = F.vcu * 16 + F.wave * 2 + oo, kv = o >> 8, n = o & 255; const float* w1 = A.in[kv ? 9 : 7]; const float* pos = A.in[6]; float s = 0.f;
            for (int k = lane; k < 2048; k += 64) s += pos[k] * w1[(size_t)k * 256 + n];
            s = wave_sum(s); if (lane == 0) ((float*)(ws + WS_POSB))[o] = s; }
    }
}

struct TileSrc { const bf16* K; const bf16* Vt; int vpitch; };
__device__ __forceinline__ void tile_load(const TileSrc& s, int key0, bool needV, int tid, u32x4& kr, u32x4& vr) {
    const int row = tid >> 3, ch = tid & 7;
    kr = *(const u32x4*)(s.K + (size_t)(key0 + row) * 64 + ch * 8);
    if (needV) vr = *(const u32x4*)(s.Vt + (size_t)row * s.vpitch + key0 + ch * 8);
}
__device__ __forceinline__ void tile_store(LAS unsigned char* L, int buf, bool needV, int tid, const u32x4& kr, const u32x4& vr) {
    const int row = tid >> 3, ch = tid & 7;
    *(LAS u32x4*)(L + AT_K0 + buf * AT_KSZ + row * KROW + ch * 16) = kr;
    if (needV) { LAS u32x2* p = (LAS u32x2*)(L + AT_V0 + buf * AT_VSZ + row * VROW + ch * 16); u32x2 a, b; a.x = vr.x; a.y = vr.y; b.x = vr.z; b.y = vr.w; p[0] = a; p[1] = b; }
}
__device__ __forceinline__ void qk_tile(LAS const unsigned char* Kb, const bf16x8 (&q)[4], int r32, int h, f32x16& s0, f32x16& s1) {
#pragma unroll
    for (int i = 0; i < 16; ++i) { s0[i] = 0.f; s1[i] = 0.f; }
#pragma unroll
    for (int ks = 0; ks < 4; ++ks) {
        const bf16x8 a0 = *(LAS const bf16x8*)(Kb + r32 * KROW + (16 * ks + 8 * h) * 2), a1 = *(LAS const bf16x8*)(Kb + (32 + r32) * KROW + (16 * ks + 8 * h) * 2);
        s0 = __builtin_amdgcn_mfma_f32_32x32x16_bf16(a0, q[ks], s0, 0, 0, 0); s1 = __builtin_amdgcn_mfma_f32_32x32x16_bf16(a1, q[ks], s1, 0, 0, 0);
    }
}
__device__ __forceinline__ bf16x8 pack_p(const f32x16& s, int o) {
    u32x4 w; w.x = pkbf(s[o + 0], s[o + 1]); w.y = pkbf(s[o + 2], s[o + 3]); w.z = pkbf(s[o + 4], s[o + 5]); w.w = pkbf(s[o + 6], s[o + 7]); return __builtin_bit_cast(bf16x8, w);
}
__device__ __forceinline__ void softmax_pv(LAS const unsigned char* Vb, f32x16& s0, f32x16& s1, f32x16 (&o)[2], float& m, float& l, int r32, int h) {
    float mx = fmaxf(s0[0], s1[0]);
#pragma unroll
    for (int i = 1; i < 16; ++i) mx = fmaxf(mx, fmaxf(s0[i], s1[i]));
    mx = pair_max(mx);
    const float mn = fmaxf(m, mx), alpha = fexp2(m - mn); m = mn;
    float sum = 0.f;
#pragma unroll
    for (int i = 0; i < 16; ++i) { s0[i] = fexp2(s0[i] - mn); s1[i] = fexp2(s1[i] - mn); sum += s0[i] + s1[i]; }
    sum = pair_sum(sum); l = l * alpha + sum;
#pragma unroll
    for (int i = 0; i < 16; ++i) { o[0][i] *= alpha; o[1][i] *= alpha; }
    bf16x8 pf[4]; pf[0] = pack_p(s0, 0); pf[1] = pack_p(s0, 8); pf[2] = pack_p(s1, 0); pf[3] = pack_p(s1, 8);
#pragma unroll
    for (int dt = 0; dt < 2; ++dt)
#pragma unroll
        for (int s = 0; s < 4; ++s) { LAS const unsigned char* vp = Vb + (32 * dt + r32) * VROW + (16 * s + 4 * h) * 2;
            const u32x2 lo = *(LAS const u32x2*)vp, hi = *(LAS const u32x2*)(vp + 16); u32x4 a; a.x = lo.x; a.y = lo.y; a.z = hi.x; a.w = hi.y;
            o[dt] = __builtin_amdgcn_mfma_f32_32x32x16_bf16(__builtin_bit_cast(bf16x8, a), pf[s], o[dt], 0, 0, 0); }
}
#define KEYOFF(kt, i) (32 * (kt) + ((i) & 3) + 8 * ((i) >> 2))
#define NEG_INF (-__builtin_inff())

template <int W> struct FBand {
    int tq, tw, h; const LAS float* lut;
    __device__ __forceinline__ bool active(int tile) { const int key0 = tile * 64; return key0 <= tw + 7 && key0 + 63 >= tw - W + 1; }
    __device__ __forceinline__ void apply(f32x16& s0, f32x16& s1, int tile) {
        const int rel0 = tq - tile * 64 - 4 * h;
        if (tw - tile * 64 - 63 >= 128) { const float b = lut[128];
#pragma unroll
            for (int i = 0; i < 16; ++i) { const int r0 = rel0 - KEYOFF(0, i), r1 = rel0 - KEYOFF(1, i);
                s0[i] = (unsigned)r0 < (unsigned)W ? s0[i] + b : NEG_INF; s1[i] = (unsigned)r1 < (unsigned)W ? s1[i] + b : NEG_INF; }
        } else {
#pragma unroll
            for (int i = 0; i < 16; ++i) { const int r0 = rel0 - KEYOFF(0, i), r1 = rel0 - KEYOFF(1, i);
                const float b0 = lut[min(max(r0, 0), 128)], b1 = lut[min(max(r1, 0), 128)];
                s0[i] = (unsigned)r0 < (unsigned)W ? s0[i] + b0 : NEG_INF; s1[i] = (unsigned)r1 < (unsigned)W ? s1[i] + b1 : NEG_INF; }
        }
    }
};
struct FCmp {
    int lim0, cmax_w;
    __device__ __forceinline__ bool active(int tile) { return tile * 64 <= cmax_w; }
    __device__ __forceinline__ void apply(f32x16& s0, f32x16& s1, int tile) {
        const int lim = lim0 - tile * 64;
#pragma unroll
        for (int i = 0; i < 16; ++i) { s0[i] = KEYOFF(0, i) <= lim ? s0[i] : NEG_INF; s1[i] = KEYOFF(1, i) <= lim ? s1[i] : NEG_INF; }
    }
};
struct FSlc {
    int tq, tw, h; const LAS float* lut; const LAS unsigned* bits; bool sel;
    __device__ __forceinline__ bool active(int tile) { sel = (bits[tile >> 5] >> (tile & 31)) & 1u; return __ballot(sel) != 0ull; }
    __device__ __forceinline__ void apply(f32x16& s0, f32x16& s1, int tile) {
        const int rel0 = tq - tile * 64 - 4 * h;
        if (tw - tile * 64 - 63 >= 128) { const float b = sel ? lut[128] : NEG_INF;
#pragma unroll
            for (int i = 0; i < 16; ++i) { s0[i] += b; s1[i] += b; }
        } else {
#pragma unroll
            for (int i = 0; i < 16; ++i) { const int r0 = rel0 - KEYOFF(0, i), r1 = rel0 - KEYOFF(1, i);
                const float b0 = lut[min(max(r0, 0), 128)], b1 = lut[min(max(r1, 0), 128)];
                s0[i] = (sel && r0 >= 0) ? s0[i] + b0 : NEG_INF; s1[i] = (sel && r1 >= 0) ? s1[i] + b1 : NEG_INF; }
        }
    }
};
template <class Fn>
__device__ __forceinline__ void attn_loop(LAS unsigned char* L, const TileSrc& src, int tile_lo, int ntiles, const bf16x8 (&q)[4], f32x16 (&o)[2], float& m, float& l, Fn& f, int tid, int r32, int h) {
    u32x4 kr, vr;
    tile_load(src, tile_lo * 64, true, tid, kr, vr);
#pragma unroll 1
    for (int i = 0; i < ntiles; ++i) {
        const int buf = i & 1;
        tile_store(L, buf, true, tid, kr, vr);
        if (i + 1 < ntiles) tile_load(src, (tile_lo + i + 1) * 64, true, tid, kr, vr);
        WG_BAR_LDS();
        const int tile = tile_lo + i;
        if (f.active(tile)) {
            f32x16 s0, s1; qk_tile(L + AT_K0 + buf * AT_KSZ, q, r32, h, s0, s1);
            f.apply(s0, s1, tile);
            softmax_pv(L + AT_V0 + buf * AT_VSZ, s0, s1, o, m, l, r32, h);
        }
    }
    WG_BAR_LDS();
}
__device__ __forceinline__ void build_lut(Frame& F, const float* rb) {
    LAS float* lut = (LAS float*)(F.lds + AT_LUT);
    for (int i = F.tid; i < 16 * 129; i += NWAVES * 64) { const int hh = i / 129, rel = i % 129; lut[hh * LUTS + rel] = rb[(int)BKT[rel] * 16 + hh] * LOG2E; }
    __syncthreads();
}
__device__ __forceinline__ void store_o(bf16* dst, const f32x16 (&o)[2], float sc, int h) {
#pragma unroll
    for (int dt = 0; dt < 2; ++dt)
#pragma unroll
        for (int gq = 0; gq < 4; ++gq) { u32x2 w; w.x = pkbf(o[dt][4 * gq] * sc, o[dt][4 * gq + 1] * sc); w.y = pkbf(o[dt][4 * gq + 2] * sc, o[dt][4 * gq + 3] * sc);
            *(u32x2*)(dst + 32 * dt + 8 * gq + 4 * h) = w; }
}
template <int MODE>
__device__ __forceinline__ void banded_unit(Frame& F, const float* sink, int T, int g) {
    LAS unsigned char* L = F.lds; const int tid = F.tid, lane = F.lane, w = F.wave, r32 = lane & 31, h = lane >> 5;
    const int t0 = T * 64, tw = t0 + 8 * w, tq = tw + (r32 >> 2), hg = g * 4 + (r32 & 3);
    constexpr int W = MODE == 0 ? 128 : 512;
    const bf16* Qp = (const bf16*)(F.ws + (MODE == 0 ? WS_QA : WS_QB)) + (size_t)tq * 512 + hg * 64;
    bf16x8 q[4];
#pragma unroll
    for (int ks = 0; ks < 4; ++ks) q[ks] = *(const bf16x8*)(Qp + 16 * ks + 8 * h);
    f32x16 o[2];
#pragma unroll
    for (int i = 0; i < 16; ++i) { o[0][i] = 0.f; o[1][i] = 0.f; }
    float m = -1e30f, l = 0.f;
    if (MODE == 0) { m = sink[hg] * LOG2E; l = 1.f; }
    const int tlo = max(0, t0 - W + 1) >> 6, nt = T - tlo + 1;
    TileSrc src; src.K = (const bf16*)(F.ws + (MODE == 0 ? WS_KA : WS_KW)) + (size_t)g * SEQ * 64; src.Vt = (const bf16*)(F.ws + (MODE == 0 ? WS_VTA : WS_VTW)) + (size_t)g * 64 * SEQ; src.vpitch = SEQ;
    FBand<W> f; f.tq = tq; f.tw = tw; f.h = h; f.lut = (const LAS float*)(L + AT_LUT) + ((MODE == 0 ? 0 : 8) + hg) * LUTS;
    attn_loop(L, src, tlo, nt, q, o, m, l, f, tid, r32, h);
    bf16* Op = (bf16*)(F.ws + (MODE == 0 ? WS_OA : WS_OW)) + (size_t)tq * 512 + hg * 64;
    store_o(Op, o, frcp(fmaxf(l, 1e-30f)), h);
}
__device__ __forceinline__ void compress_out(Frame& F, int b) {
    const int lane = F.lane, w = F.wave, r32 = lane & 31, h = lane >> 5;
    const int kvg = b >> 2, kv = kvg >> 1, g = kvg & 1, c0 = (b & 3) * 256 + 32 * w;
    const bf16* H = (const bf16*)(F.ws + WS_H) + (size_t)(256 * b + 32 * w + r32) * 256 + 8 * h;
    const bf16* W2 = (const bf16*)(F.ws + (kv ? WS_W2VT : WS_W2KT)) + (size_t)r32 * 256 + 8 * h;
    f32x16 a0, a1;
#pragma unroll
    for (int i = 0; i < 16; ++i) { a0[i] = 0.f; a1[i] = 0.f; }
#pragma unroll 4
    for (int ks = 0; ks < 16; ++ks) {
        const bf16x8 hf = *(const bf16x8*)(H + 16 * ks), w0 = *(const bf16x8*)(W2 + 16 * ks), w1 = *(const bf16x8*)(W2 + 32 * 256 + 16 * ks);
        if (kv == 0) { a0 = __builtin_amdgcn_mfma_f32_32x32x16_bf16(w0, hf, a0, 0, 0, 0); a1 = __builtin_amdgcn_mfma_f32_32x32x16_bf16(w1, hf, a1, 0, 0, 0); }
        else         { a0 = __builtin_amdgcn_mfma_f32_32x32x16_bf16(hf, w0, a0, 0, 0, 0); a1 = __builtin_amdgcn_mfma_f32_32x32x16_bf16(hf, w1, a1, 0, 0, 0); }
    }
    if (kv == 0) {
        const int c = c0 + r32; bf16* kc = (bf16*)(F.ws + WS_KC) + ((size_t)g * 1024 + c) * 64; const bool pad = (c == 1023);
#pragma unroll
        for (int nt = 0; nt < 2; ++nt)
#pragma unroll
            for (int gq = 0; gq < 4; ++gq) { const f32x16& a = nt ? a1 : a0; u32x2 wv; wv.x = pkbf(a[4 * gq], a[4 * gq + 1]); wv.y = pkbf(a[4 * gq + 2], a[4 * gq + 3]); if (pad) { wv.x = 0u; wv.y = 0u; }
                *(u32x2*)(kc + 32 * nt + 8 * gq + 4 * h) = wv; }
    } else {
        bf16* vct = (bf16*)(F.ws + WS_VCT) + (size_t)g * 64 * 1024;
#pragma unroll
        for (int nt = 0; nt < 2; ++nt)
#pragma unroll
            for (int gq = 0; gq < 4; ++gq) { const f32x16& a = nt ? a1 : a0; const int c = c0 + 8 * gq + 4 * h;
                u32x2 wv; wv.x = pkbf(a[4 * gq], a[4 * gq + 1]); wv.y = pkbf(a[4 * gq + 2], a[4 * gq + 3]); if (c + 3 == 1023) wv.y &= 0xffffu;
                *(u32x2*)(vct + (size_t)(32 * nt + r32) * 1024 + c) = wv; }
    }
}
__device__ __forceinline__ void nsa_unit(Frame& F, int T, int g) {
    LAS unsigned char* L = F.lds; const int tid = F.tid, lane = F.lane, w = F.wave, r32 = lane & 31, h = lane >> 5;
    const int t0 = T * 64, tw = t0 + 8 * w, ql = 8 * w + (r32 >> 2), tq = t0 + ql, hd = r32 & 3, hg = g * 4 + hd, jt = T;
    const bf16* Qp = (const bf16*)(F.ws + WS_QB) + (size_t)tq * 512 + hg * 64; bf16* Ob = (bf16*)(F.ws + WS_OB) + (size_t)tq * 512 + hg * 64;
    bf16x8 q[4];
#pragma unroll
    for (int ks = 0; ks < 4; ++ks) q[ks] = *(const bf16x8*)(Qp + 16 * ks + 8 * h);
    const float* bg = (const float*)(F.ws + WS_BG) + (size_t)tq * 24 + hg; const float g0 = bg[0], g1 = bg[8], g2 = bg[16];
    f32x16 o[2];
#pragma unroll
    for (int i = 0; i < 16; ++i) { o[0][i] = 0.f; o[1][i] = 0.f; }
    float m = -1e30f, l = 0.f;
    const int ncmp = t0 / 16 + 3, ntc = (ncmp + 63) >> 6;
    TileSrc sc; sc.K = (const bf16*)(F.ws + WS_KC) + (size_t)g * 1024 * 64; sc.Vt = (const bf16*)(F.ws + WS_VCT) + (size_t)g * 64 * 1024; sc.vpitch = 1024;
    FCmp fc; fc.lim0 = ((tq - 31) >> 4) - 4 * h; fc.cmax_w = (tw + 7 - 31) >> 4;
    attn_loop(L, sc, 0, ntc, q, o, m, l, fc, tid, r32, h);
    const float inv = frcp(fmaxf(l, 1e-30f));
    { const bf16* OWp = (const bf16*)(F.ws + WS_OW) + (size_t)tq * 512 + hg * 64; const float s0_ = g0 * inv;
#pragma unroll
      for (int dt = 0; dt < 2; ++dt)
#pragma unroll
          for (int gq = 0; gq < 4; ++gq) { const u32x2 ow = *(const u32x2*)(OWp + 32 * dt + 8 * gq + 4 * h); u32x2 wv;
              wv.x = pkbf(s0_ * o[dt][4 * gq] + g2 * bf_lo(ow.x), s0_ * o[dt][4 * gq + 1] + g2 * bf_hi(ow.x));
              wv.y = pkbf(s0_ * o[dt][4 * gq + 2] + g2 * bf_lo(ow.y), s0_ * o[dt][4 * gq + 3] + g2 * bf_hi(ow.y));
              *(u32x2*)(Ob + 32 * dt + 8 * gq + 4 * h) = wv; } }
    LAS float* imp = (LAS float*)(L + AT_IMP);
    for (int i = lane; i < 8 * 256; i += 64) imp[8 * w * 256 + i] = 0.f;
    { u32x4 kr, vr; tile_load(sc, 0, false, tid, kr, vr);
#pragma unroll 1
      for (int i = 0; i < ntc; ++i) {
          const int buf = i & 1;
          tile_store(L, buf, false, tid, kr, vr);
          if (i + 1 < ntc) tile_load(sc, (i + 1) * 64, false, tid, kr, vr);
          WG_BAR_LDS();
          if (fc.active(i)) {
              f32x16 s0, s1; qk_tile(L + AT_K0 + buf * AT_KSZ, q, r32, h, s0, s1);
              fc.apply(s0, s1, i);
#pragma unroll
              for (int kt = 0; kt < 2; ++kt) { const f32x16& s = kt ? s1 : s0; float mainv = 0.f, spv = 0.f;
#pragma unroll
                  for (int gq = 0; gq < 4; ++gq) { const float p0 = fexp2(s[4 * gq] - m) * inv, p1 = fexp2(s[4 * gq + 1] - m) * inv, p2 = fexp2(s[4 * gq + 2] - m) * inv, p3 = fexp2(s[4 * gq + 3] - m) * inv;
                      const float mq = quad_sum((p0 + p1) + (p2 + 0.5f * p3)), sq = quad_sum(0.5f * p3);
                      if (gq == hd) { mainv = mq; spv = sq; } }
                  const int j = i * 16 + 8 * kt + 2 * hd + h;
                  __hip_atomic_fetch_add(imp + ql * 256 + j, mainv, __ATOMIC_RELAXED, __HIP_MEMORY_SCOPE_WORKGROUP);
                  __hip_atomic_fetch_add(imp + ql * 256 + min(j + 1, 255), (j + 1 < 256) ? spv : 0.f, __ATOMIC_RELAXED, __HIP_MEMORY_SCOPE_WORKGROUP); }
          }
      }
      WG_BAR_LDS(); }
    LAS unsigned* selb = (LAS unsigned*)(L + AT_SEL);
#pragma unroll 1
    for (int qi = 0; qi < 8; ++qi) {
        const LAS float* row = imp + (8 * w + qi) * 256; unsigned mybits = 0u;
        if (lane == 0) mybits |= 1u;
        if (lane == (jt >> 5)) mybits |= 1u << (jt & 31);
        if (jt >= 1 && lane == ((jt - 1) >> 5)) mybits |= 1u << ((jt - 1) & 31);
        const int ncand = jt - 2;
        if (ncand > 0) {
            if (ncand <= 13) { if (lane == 0) mybits |= ((1u << (jt - 1)) - 2u); }
            else {
                unsigned k[4];
#pragma unroll
                for (int i = 0; i < 4; ++i) { const int j = lane + 64 * i; const float v = row[j]; k[i] = (j >= 1 && j <= jt - 2) ? ((__float_as_uint(v) & ~255u) | (unsigned)(255 - j)) : 0u; }
#pragma unroll 1
                for (int it = 0; it < 13; ++it) { const unsigned mx = wave_max_u32(umax_(umax_(k[0], k[1]), umax_(k[2], k[3]))); const int j = 255 - (int)(mx & 255u);
                    if (lane == (j >> 5)) mybits |= 1u << (j & 31);
#pragma unroll
                    for (int i = 0; i < 4; ++i) k[i] = (k[i] == mx) ? 0u : k[i]; }
            }
        }
        if (lane < 8) selb[(8 * w + qi) * 8 + lane] = mybits;
    }
    f32x16 o2[2];
#pragma unroll
    for (int i = 0; i < 16; ++i) { o2[0][i] = 0.f; o2[1][i] = 0.f; }
    float m2 = -1e30f, l2 = 0.f;
    TileSrc ss; ss.K = (const bf16*)(F.ws + WS_KS) + (size_t)g * SEQ * 64; ss.Vt = (const bf16*)(F.ws + WS_VTS) + (size_t)g * 64 * SEQ; ss.vpitch = SEQ;
    FSlc fs; fs.tq = tq; fs.tw = tw; fs.h = h; fs.lut = (const LAS float*)(L + AT_LUT) + (8 + hg) * LUTS; fs.bits = selb + ql * 8; fs.sel = false;
    attn_loop(L, ss, 0, jt + 1, q, o2, m2, l2, fs, tid, r32, h);
    const float s2 = g1 * frcp(fmaxf(l2, 1e-30f));
#pragma unroll
    for (int dt = 0; dt < 2; ++dt)
#pragma unroll
        for (int gq = 0; gq < 4; ++gq) { u32x2 wv; const u32x2 tt = *(const u32x2*)(Ob + 32 * dt + 8 * gq + 4 * h); const unsigned ta = tt.x, tb = tt.y;
            wv.x = pkbf(bf_lo(ta) + s2 * o2[dt][4 * gq], bf_hi(ta) + s2 * o2[dt][4 * gq + 1]); wv.y = pkbf(bf_lo(tb) + s2 * o2[dt][4 * gq + 2], bf_hi(tb) + s2 * o2[dt][4 * gq + 3]);
            *(u32x2*)(Ob + 32 * dt + 8 * gq + 4 * h) = wv; }
}

typedef __bf16 v2bf __attribute__((ext_vector_type(2)));
__device__ __forceinline__ float dot2bf(unsigned a, unsigned b, float c) { return __builtin_amdgcn_fdot2_f32_bf16(__builtin_bit_cast(v2bf, a), __builtin_bit_cast(v2bf, b), c, false); }
__device__ __forceinline__ unsigned ord_key(float v) { const unsigned u = __float_as_uint(v); return u ^ ((unsigned)((int)u >> 31) | 0x80000000u); }
__device__ __forceinline__ float ord_val(unsigned k) { const unsigned u = (k & 0x80000000u) ? (k ^ 0x80000000u) : ~k; return __uint_as_float(u); }
__device__ __forceinline__ void peer_top16(const bf16* qrow, LAS const unsigned char* kmat, int r32, int h2, unsigned (&sel)[16]) {
    bf16x8 qf[8];
#pragma unroll
    for (int ks = 0; ks < 8; ++ks) qf[ks] = *(const bf16x8*)(qrow + 16 * ks + 8 * h2);
    unsigned key[64];
#pragma unroll
    for (int nt = 0; nt < 4; ++nt) { f32x16 s;
#pragma unroll
        for (int i = 0; i < 16; ++i) s[i] = 0.f;
#pragma unroll
        for (int ks = 0; ks < 8; ++ks) { const bf16x8 a = *(LAS const bf16x8*)(kmat + (32 * nt + r32) * PK_ROW + (16 * ks + 8 * h2) * 2); s = __builtin_amdgcn_mfma_f32_32x32x16_bf16(a, qf[ks], s, 0, 0, 0); }
#pragma unroll
        for (int i = 0; i < 16; ++i) key[nt * 16 + i] = (ord_key(s[i]) & ~127u) | (unsigned)(((63 - (nt * 16 + i)) << 1) | (1 - h2)); }
    unsigned prev = 0xFFFFFFFFu;
#pragma unroll
    for (int k = 0; k < 16; ++k) sel[k] = 0u;
#pragma unroll 1
    for (int it = 0; it < 16; ++it) { unsigned c = 0u;
#pragma unroll
        for (int i = 0; i < 64; ++i) c = umax_(c, key[i] - prev);
        const unsigned mloc = c + prev, mm = pair_umax(mloc);
#pragma unroll
        for (int k = 0; k < 16; ++k) sel[k] = (k == it) ? mm : sel[k];
        prev = mm; }
}
__device__ __forceinline__ int key_n(unsigned k) { const int low = k & 127, Lx = 63 - (low >> 1), hh = 1 - (low & 1); return ((Lx >> 4) << 5) + (((Lx >> 2) & 3) << 3) + (hh << 2) + (Lx & 3); }

__device__ __forceinline__ void peer_phase(Frame& F) {
    LAS unsigned char* L = F.lds; const int tid = F.tid, lane = F.lane, w = F.wave, r32 = lane & 31, h2 = lane >> 5;
    unsigned char* ws = F.ws;
    for (int i = tid; i < 2 * 128 * 16; i += NWAVES * 64) { const int which = i >> 11, rr = (i >> 4) & 127, ch = i & 15;
        *(LAS u32x4*)(L + (which ? PK2_OFF : PK1_OFF) + rr * PK_ROW + ch * 16) = *(const u32x4*)((const bf16*)(ws + (which ? WS_K2B : WS_K1B)) + rr * 128 + ch * 8); }
    __syncthreads();
    LAS unsigned char* PW = L + PW_OFF + w * PW_BYTES;
    LAS unsigned char* XR = PW; LAS u32x2* LST = (LAS u32x2*)(PW + 2048); LAS unsigned char* I12 = PW + 6144; LAS float* WL = (LAS float*)(PW + 7168);
    const bf16* Q2 = (const bf16*)(ws + WS_Q2); const bf16* U16 = (const bf16*)(ws + WS_U16); const _Float16* V16 = (const _Float16*)(ws + WS_V16);
    bf16* xb = (bf16*)(ws + WS_XB); const float* ssq1 = (const float*)(ws + WS_SSQ1); float* rs2 = (float*)(ws + WS_RS2);
    const int gw = F.vcu * NWAVES + w, NGW = F.G * NWAVES;
#pragma unroll 1
    for (int item = gw; item < SEQ / 4; item += NGW) {
        const int t0 = item * 4;
        {
            const int tk = r32 >> 3, hd = r32 & 7; const bf16* qrow = Q2 + (size_t)(t0 + tk) * 2048 + hd * 256;
            const float rsq = rs_from_ssq(ssq1, t0 + tk);
            unsigned s1[16], s2[16];
            peer_top16(qrow, L + PK1_OFF, r32, h2, s1);
            peer_top16(qrow + 128, L + PK2_OFF, r32, h2, s2);
            float v1[16], v2[16];
#pragma unroll
            for (int k = 0; k < 16; ++k) { v1[k] = ord_val(s1[k] & ~127u); v2[k] = ord_val(s2[k] & ~127u); }
            if (h2 == 0) { LAS unsigned* ip = (LAS unsigned*)(I12 + r32 * 32);
#pragma unroll
                for (int k4 = 0; k4 < 4; ++k4) { ip[k4] = (unsigned)key_n(s1[4 * k4]) | ((unsigned)key_n(s1[4 * k4 + 1]) << 8) | ((unsigned)key_n(s1[4 * k4 + 2]) << 16) | ((unsigned)key_n(s1[4 * k4 + 3]) << 24);
                    ip[4 + k4] = (unsigned)key_n(s2[4 * k4]) | ((unsigned)key_n(s2[4 * k4 + 1]) << 8) | ((unsigned)key_n(s2[4 * k4 + 2]) << 16) | ((unsigned)key_n(s2[4 * k4 + 3]) << 24); } }
            unsigned ck[50]; int nc = 0;
#pragma unroll
            for (int i = 0; i < 16; ++i)
#pragma unroll
                for (int j = 0; j < 16; ++j) if ((i + 1) * (j + 1) <= 16) { ck[nc] = (ord_key(v1[i] + v2[j]) & ~255u) | (unsigned)(255 - (16 * i + j)); ++nc; }
            unsigned prev = 0xFFFFFFFFu; float sc[16]; int ei[16];
#pragma unroll
            for (int it = 0; it < 16; ++it) { unsigned c = 0u;
#pragma unroll
                for (int i = 0; i < 50; ++i) c = umax_(c, ck[i] - prev);
                const unsigned mm = c + prev; prev = mm;
                const int flat = 255 - (int)(mm & 255u); sc[it] = ord_val(mm & ~255u);
                ei[it] = (int)I12[r32 * 32 + (flat >> 4)] * 128 + (int)I12[r32 * 32 + 16 + (flat & 15)]; }
            float den = 0.f, ex[16];
#pragma unroll
            for (int k = 0; k < 16; ++k) { ex[k] = fexp2((sc[k] - sc[0]) * (rsq * LOG2E)); den += ex[k]; }
            const float rd = frcp(den);
            if (h2 == 0) {
#pragma unroll
                for (int k = 0; k < 16; ++k) { u32x2 e; e.x = (unsigned)ei[k]; e.y = __float_as_uint(ex[k] * rd); LST[tk * 128 + hd * 16 + k] = e; } }
        }
#pragma unroll 1
        for (int tk = 0; tk < 4; ++tk) {
            const int t = t0 + tk;
            const u32x4 xa = *(const u32x4*)(xb + (size_t)t * DM + lane * 8), xc = *(const u32x4*)(xb + (size_t)t * DM + 512 + lane * 8);
            const float rs = rs_from_ssq(ssq1, t);
            const LAS u32x2* lst = LST + tk * 128;
#define PEER_ULOAD(A_, B_, e0_) _Pragma("unroll") for (int k = 0; k < 4; ++k) { const int idx = __builtin_amdgcn_readfirstlane((int)lst[(e0_) + k].x); \
                const bf16* up = U16 + (size_t)idx * DM + lane * 8; A_[k] = *(const u32x4*)up; B_[k] = *(const u32x4*)(up + 512); }
#define PEER_DOT8(a_, b_) dot2bf(a_.x, xa.x, dot2bf(a_.y, xa.y, dot2bf(a_.z, xa.z, dot2bf(a_.w, xa.w, dot2bf(b_.x, xc.x, dot2bf(b_.y, xc.y, dot2bf(b_.z, xc.z, dot2bf(b_.w, xc.w, 0.f))))))))
#define PEER_UCOMP(A_, B_, e0_) _Pragma("unroll") for (int k4 = 0; k4 < 1; ++k4) { \
                const float p0 = PEER_DOT8(A_[4 * k4], B_[4 * k4]), p1 = PEER_DOT8(A_[4 * k4 + 1], B_[4 * k4 + 1]), p2 = PEER_DOT8(A_[4 * k4 + 2], B_[4 * k4 + 2]), p3 = PEER_DOT8(A_[4 * k4 + 3], B_[4 * k4 + 3]); \
                auto s02 = __builtin_amdgcn_permlane32_swap(__float_as_uint(p0), __float_as_uint(p2), false, false); auto s13 = __builtin_amdgcn_permlane32_swap(__float_as_uint(p1), __float_as_uint(p3), false, false); \
                const float r0 = __uint_as_float(s02[0]) + __uint_as_float(s02[1]), r1 = __uint_as_float(s13[0]) + __uint_as_float(s13[1]); \
                auto s01 = __builtin_amdgcn_permlane16_swap(__float_as_uint(r0), __float_as_uint(r1), false, false); \
                float qv = __uint_as_float(s01[0]) + __uint_as_float(s01[1]); \
                qv += dpp_f<0xB1>(qv); qv += dpp_f<0x4E>(qv); qv += dpp_f<0x141>(qv); qv += dpp_f<0x140>(qv); \
                if ((lane & 15) == 0) { const int e = (e0_) + 4 * k4 + 2 * (lane >> 5) + ((lane >> 4) & 1); WL[e] = __uint_as_float(lst[e].y) * gelu_tanh(qv * rs); } }
            { u32x4 uA0[4], uB0[4], uA1[4], uB1[4];
              PEER_ULOAD(uA0, uB0, 0);
#pragma unroll 1
              for (int e0 = 0; e0 < 128; e0 += 8) {
                  PEER_ULOAD(uA1, uB1, e0 + 4);
                  PEER_UCOMP(uA0, uB0, e0);
                  if (e0 + 8 < 128) { PEER_ULOAD(uA0, uB0, e0 + 8); }
                  PEER_UCOMP(uA1, uB1, e0 + 4);
              } }
            float oa[8], ob[8];
#pragma unroll
            for (int i = 0; i < 8; ++i) { oa[i] = 0.f; ob[i] = 0.f; }
#define PEER_VLOAD(A_, B_, e0_) _Pragma("unroll") for (int k = 0; k < 4; ++k) { const int idx = __builtin_amdgcn_readfirstlane((int)lst[(e0_) + k].x); \
                const _Float16* vp = V16 + (size_t)idx * DM + lane * 8; A_[k] = *(const h16x8*)vp; B_[k] = *(const h16x8*)(vp + 512); }
#define PEER_VCOMP(A_, B_, e0_) _Pragma("unroll") for (int k = 0; k < 4; ++k) { const float wv = WL[(e0_) + k]; \
                _Pragma("unroll") for (int i = 0; i < 8; ++i) { oa[i] += wv * (float)A_[k][i]; ob[i] += wv * (float)B_[k][i]; } }
            { h16x8 vA0[4], vB0[4], vA1[4], vB1[4];
              PEER_VLOAD(vA0, vB0, 0);
#pragma unroll 1
              for (int e0 = 0; e0 < 128; e0 += 8) {
                  PEER_VLOAD(vA1, vB1, e0 + 4);
                  PEER_VCOMP(vA0, vB0, e0);
                  if (e0 + 8 < 128) { PEER_VLOAD(vA0, vB0, e0 + 8); }
                  PEER_VCOMP(vA1, vB1, e0 + 4);
              } }
            float* op = F.out + (size_t)t * DM + lane * 8;
            f32x4 a0 = *(const f32x4*)op, a1 = *(const f32x4*)(op + 4), b0 = *(const f32x4*)(op + 512), b1 = *(const f32x4*)(op + 516);
#pragma unroll
            for (int i = 0; i < 4; ++i) { a0[i] += oa[i]; a1[i] += oa[4 + i]; b0[i] += ob[i]; b1[i] += ob[4 + i]; }
            *(f32x4*)op = a0; *(f32x4*)(op + 4) = a1; *(f32x4*)(op + 512) = b0; *(f32x4*)(op + 516) = b1;
            *(u32x4*)(xb + (size_t)t * DM + lane * 8) = pack8(a0, a1); *(u32x4*)(xb + (size_t)t * DM + 512 + lane * 8) = pack8(b0, b1);
            float ss = 0.f;
#pragma unroll
            for (int i = 0; i < 4; ++i) ss += a0[i] * a0[i] + a1[i] * a1[i] + b0[i] * b0[i] + b1[i] * b1[i];
            ss = wave_sum(ss);
            if (lane == 0) rs2[t] = __builtin_amdgcn_rsqf(ss * (1.0f / DM) + EPS);
        }
    }
}
__device__ __forceinline__ void convert_peer_tables(Frame& F, const float* u, const float* v, const float* g) {
    const int gt = (F.vcu * NWAVES + F.wave) * 64 + F.lane, NGT = F.G * NWAVES * 64;
    bf16* U16 = (bf16*)(F.ws + WS_U16); _Float16* V16 = (_Float16*)(F.ws + WS_V16);
    for (int i = gt; i < 16384 * 1024 / 8; i += NGT) {
        const int d0 = (i & 127) * 8; const f32x4 ga = *(const f32x4*)(g + d0), gb = *(const f32x4*)(g + d0 + 4);
        const f32x4 a = *(const f32x4*)(u + (size_t)i * 8) * ga, b = *(const f32x4*)(u + (size_t)i * 8 + 4) * gb;
        *(u32x4*)(U16 + (size_t)i * 8) = pack8(a, b);
        const f32x4 c = *(const f32x4*)(v + (size_t)i * 8), d = *(const f32x4*)(v + (size_t)i * 8 + 4);
        h16x8 hv; hv[0] = (_Float16)c[0]; hv[1] = (_Float16)c[1]; hv[2] = (_Float16)c[2]; hv[3] = (_Float16)c[3]; hv[4] = (_Float16)d[0]; hv[5] = (_Float16)d[1]; hv[6] = (_Float16)d[2]; hv[7] = (_Float16)d[3];
        *(h16x8*)(V16 + (size_t)i * 8) = hv;
    }
}
__device__ __forceinline__ void final_norm(Frame& F, const float* gf) {
    const int gw = F.vcu * NWAVES + F.wave, NGW = F.G * NWAVES, lane = F.lane;
    f32x4 gv[4];
#pragma unroll
    for (int j = 0; j < 4; ++j) gv[j] = ((const f32x4*)gf)[lane + 64 * j];
    for (int row = gw; row < SEQ; row += NGW) {
        f32x4* xr = (f32x4*)(F.out + (size_t)row * DM) + lane; f32x4 v[4]; float ss = 0.f;
#pragma unroll
        for (int j = 0; j < 4; ++j) { v[j] = xr[64 * j]; ss += (v[j][0] * v[j][0] + v[j][1] * v[j][1]) + (v[j][2] * v[j][2] + v[j][3] * v[j][3]); }
        const float rs = __builtin_amdgcn_rsqf(wave_sum(ss) * (1.0f / DM) + EPS);
#pragma unroll
        for (int j = 0; j < 4; ++j) xr[64 * j] = v[j] * rs * gv[j];
    }
}

constexpr int NPHASE = 10;
__global__ void __launch_bounds__(NWAVES * 64, 2) hybrid_fwd(Args args) {
    extern __shared__ __attribute__((aligned(16))) unsigned char lds[];
    Frame F;
    F.lds = (LAS unsigned char*)lds; F.MISC = (volatile LAS unsigned*)(F.lds + LDSCTL_OFF);
    F.tid = threadIdx.x; F.lane = F.tid & 63; F.wave = __builtin_amdgcn_readfirstlane(F.tid >> 6);
    F.G = gridDim.x; { const int bx = blockIdx.x; F.vcu = (F.G % 8 == 0) ? (bx % 8) * (F.G / 8) + bx / 8 : bx; }
    F.ws = args.ws; F.ctl = (gu32*)(args.ws + WS_CTL); F.out = args.out;
    for (int u = F.tid; u < (LDS_BYTES - LDSCTL_OFF) / 4; u += NWAVES * 64) ((LAS unsigned*)(F.lds + LDSCTL_OFF))[u] = 0u;
    __syncthreads();
    const int lo = args.ph_lo, hi = args.ph_hi;
    XcdBarrier bar = xcd_barrier_post((unsigned*)(F.ctl + CW_BAR) + args.li * XCD_BAR_WORDS, F.MISC + 8);
#ifndef PHASE_MASK
#define PHASE_MASK 0xFFFF
#endif
#define IN(k) (((PHASE_MASK >> (k)) & 1) && lo <= (k) && (k) < hi)
#define SEAM(k) do { if (IN(k) && IN((k) + 1)) xcd_barrier(bar); } while (0)
    unsigned char* ws = args.ws;
    const int G = F.G, bx = (int)blockIdx.x;

    if (IN(0)) { p0_prologue(F, args); }
    SEAM(0);
    if (IN(1)) {
        pg8::Gemm g{(const bf16*)(ws + WS_XB), (const bf16*)(ws + WS_WIN), SEQ, N1, DM, DM, DM}; pg8::StaticOrder S; S.init(SEQ, N1, G, bx);
        Epi1 E{(const float*)(ws + WS_RS0), ws};
        pg8::gemm_phase<Epi1, pg8::StaticOrder, true, true>(F.lds, g, S, E);
    }
    SEAM(1);
    if (IN(2)) {
        { pg8::Gemm g{(const bf16*)(ws + WS_CK), (const bf16*)(ws + WS_W1KV), 4096, 512, 2048, 1024, 2048}; pg8::OneUnit S{bx, bx >> 3, bx < 16 ? 1 : 0};
          EpiCmp E{(bf16*)(ws + WS_H), (const float*)(ws + WS_POSB)};
          pg8::gemm_phase<EpiCmp, pg8::OneUnit, false, true>(F.lds, g, S, E);
          if (bx < 16) { __threadfence(); __syncthreads(); compress_out(F, bx); } }
        __syncthreads();
        build_lut(F, args.in[5]);
        for (;;) {
            __syncthreads();
            if (F.tid == 0) F.MISC[16] = __hip_atomic_fetch_add(F.ctl + CW_QUEUE + args.li * 64, 1u, RLX_AGENT);
            __syncthreads();
            const int unit = (int)F.MISC[16];
            if (unit >= 1024) break;
            if (unit < 512) banded_unit<1>(F, args.in[4], unit >> 1, unit & 1); else banded_unit<0>(F, args.in[4], (unit - 512) >> 1, unit & 1);
        }
    }
    SEAM(2);
    if (IN(3)) {
        build_lut(F, args.in[5]);
        for (int i = bx; i < 256; i += G) { nsa_unit(F, 255 - i, 1); nsa_unit(F, i, 0); }
    }
    SEAM(3);
    if (IN(4)) {
        { pg8::Gemm g{(const bf16*)(ws + WS_OA), (const bf16*)(ws + WS_WUPA), SEQ, DM, 512, 512, 512}; pg8::StaticOrder S; S.init(SEQ, DM, G, bx); EpiUp E{(bf16*)(ws + WS_MG), 0};
          pg8::gemm_phase<EpiUp, pg8::StaticOrder, true, true>(F.lds, g, S, E); }
        { pg8::Gemm g{(const bf16*)(ws + WS_OB), (const bf16*)(ws + WS_WUPB), SEQ, DM, 512, 512, 512}; pg8::StaticOrder S; S.init(SEQ, DM, G, bx); EpiUp E{(bf16*)(ws + WS_MG), 1024};
          pg8::gemm_phase<EpiUp, pg8::StaticOrder, true, true>(F.lds, g, S, E); }
    }
    SEAM(4);
    if (IN(5)) {
        { pg8::Gemm g{(const bf16*)(ws + WS_MG), (const bf16*)(ws + WS_WO2), SEQ, DM, 2048, 2048, 2048}; pg8::StaticOrder S; S.init(SEQ, DM, G, bx);
          EpiWo E{args.in[0], F.out, (bf16*)(ws + WS_XB), (float*)(ws + WS_SSQ1)};
          pg8::gemm_phase<EpiWo, pg8::StaticOrder, true, true>(F.lds, g, S, E); }
        convert_peer_tables(F, args.in[18], args.in[19], args.in[14]);
    }
    SEAM(5);
    if (IN(6)) {
        { pg8::Gemm g{(const bf16*)(ws + WS_XB), (const bf16*)(ws + WS_WQ), SEQ, 2048, DM, DM, DM}; pg8::StaticOrder S; S.init(SEQ, 2048, G, bx); EpiPw E{(bf16*)(ws + WS_Q2), 2048};
          pg8::gemm_phase<EpiPw, pg8::StaticOrder, true, true>(F.lds, g, S, E); }
        { pg8::Gemm g{(const bf16*)(ws + WS_PB), (const bf16*)(ws + WS_WPLE), SEQ, DM, 256, 256, 256}; pg8::StaticOrder S; S.init(SEQ, DM, G, bx); EpiPw E{(bf16*)(ws + WS_PW), DM};
          pg8::gemm_phase<EpiPw, pg8::StaticOrder, true, true>(F.lds, g, S, E); }
    }
    SEAM(6);
    if (IN(7)) { __syncthreads(); peer_phase(F); }
    SEAM(7);
    if (IN(8)) {
        pg8::Gemm g{(const bf16*)(ws + WS_XB), (const bf16*)(ws + WS_WPG), SEQ, DM, DM, DM, DM}; pg8::StaticOrder S; S.init(SEQ, DM, G, bx);
        EpiPle E{(const float*)(ws + WS_RS2), (const bf16*)(ws + WS_PW), F.out};
        pg8::gemm_phase<EpiPle, pg8::StaticOrder, true, true>(F.lds, g, S, E);
    }
    SEAM(8);
    if (IN(9)) final_norm(F, args.in[23]);
#undef IN
#undef SEAM
}

#ifndef MK_ONE_LAUNCH
#define MK_ONE_LAUNCH 1
#endif
extern "C" void kernel_launch(void* const* d_in, const int* in_sizes, int n_in, void* d_out, int out_size, void* d_ws, size_t ws_size, hipStream_t stream) {
    static int grid = 0;
    if (grid == 0) {
        if (n_in != 24 || in_sizes[0] != SEQ * DM || out_size != SEQ * DM || ws_size < WS_END) { fprintf(stderr, "kernel_launch: unexpected shapes (n_in %d, in0 %d, out %d, ws %zu); nothing launched\n", n_in, n_in > 0 ? in_sizes[0] : -1, out_size, ws_size); grid = -1; return; }
        int dev = 0, cus = 0, per_cu = 0;
        if (hipGetDevice(&dev) != hipSuccess || hipDeviceGetAttribute(&cus, hipDeviceAttributeMultiprocessorCount, dev) != hipSuccess) { grid = -1; return; }
        if (hipFuncSetAttribute((const void*)hybrid_fwd, hipFuncAttributeMaxDynamicSharedMemorySize, LDS_BYTES) != hipSuccess) { fprintf(stderr, "kernel_launch: hipFuncSetAttribute failed\n"); grid = -1; return; }
        if (hipOccupancyMaxActiveBlocksPerMultiprocessor(&per_cu, (const void*)hybrid_fwd, NWAVES * 64, LDS_BYTES) != hipSuccess || per_cu < 1) { fprintf(stderr, "kernel_launch: occupancy query says %d blocks per CU\n", per_cu); }
        (void)hipGetLastError();
        grid = cus;
    }
    if (grid < 0) return;
    if (hipMemsetAsync((char*)d_ws + WS_CTL, 0, CTL_ZERO_BYTES, stream) != hipSuccess) return;
    Args a{};
    for (int i = 0; i < 24; ++i) a.in[i] = (const float*)d_in[i];
    a.out = (float*)d_out; a.ws = (unsigned char*)d_ws;
#if defined(PROBE_REPEAT)
    const int cuts[4] = {0, PROBE_REPEAT + 1, PROBE_REPEAT, NPHASE};
    for (int li = 0; li < 3; ++li) { a.ph_lo = li == 0 ? 0 : li == 1 ? PROBE_REPEAT : PROBE_REPEAT + 1; a.ph_hi = li == 0 ? PROBE_REPEAT + 1 : li == 1 ? PROBE_REPEAT + 1 : NPHASE; a.li = li; (void)cuts;
        if (a.ph_lo < a.ph_hi) hipLaunchKernelGGL(hybrid_fwd, dim3(grid), dim3(NWAVES * 64), LDS_BYTES, stream, a); }
#elif MK_ONE_LAUNCH
    a.ph_lo = 0; a.ph_hi = NPHASE; a.li = 0;
    hipLaunchKernelGGL(hybrid_fwd, dim3(grid), dim3(NWAVES * 64), LDS_BYTES, stream, a);
#else
    for (int p = 0; p < NPHASE; ++p) { a.ph_lo = p; a.ph_hi = p + 1; a.li = 0; hipLaunchKernelGGL(hybrid_fwd, dim3(grid), dim3(NWAVES * 64), LDS_BYTES, stream, a); }
#endif
}
```

```cpp
#include <hip/hip_runtime.h>
#include <cstdio>
#include <cstdint>

#define GAS __attribute__((address_space(1)))
#define LAS __attribute__((address_space(3)))
typedef unsigned short bf16;
typedef short bf16x8 __attribute__((ext_vector_type(8)));
typedef short s16x4 __attribute__((ext_vector_type(4)));
typedef float f32x4 __attribute__((ext_vector_type(4)));
typedef float f32x16 __attribute__((ext_vector_type(16)));
typedef unsigned u32x4 __attribute__((ext_vector_type(4)));
typedef unsigned u32x2 __attribute__((ext_vector_type(2)));
typedef _Float16 h16x8 __attribute__((ext_vector_type(8)));
typedef GAS unsigned gu32;
typedef float f32x2_t __attribute__((ext_vector_type(2))); typedef __bf16 bf16x2_t __attribute__((ext_vector_type(2)));
__device__ __forceinline__ unsigned pkbf(float lo, float hi) { f32x2_t v = {lo, hi}; bf16x2_t b = __builtin_convertvector(v, bf16x2_t); return __builtin_bit_cast(unsigned, b); }
__device__ __forceinline__ float bf_lo(unsigned u) { return __uint_as_float(u << 16); }
__device__ __forceinline__ float bf_hi(unsigned u) { return __uint_as_float(u & 0xffff0000u); }
__device__ __forceinline__ float fexp2(float x) { return __builtin_amdgcn_exp2f(x); }
__device__ __forceinline__ float frcp(float x) { return __builtin_amdgcn_rcpf(x); }
__device__ __forceinline__ float sigmoidf_(float x) { return frcp(1.0f + fexp2(-1.4426950408889634f * x)); }
__device__ __forceinline__ float gelu_tanh(float x) { const float u = x * (1.0f + 0.044715f * x * x); return x * frcp(1.0f + fexp2(-2.302208198f * u)); }
#define LOG2E 1.4426950408889634f
#define RLX_AGENT __ATOMIC_RELAXED, __HIP_MEMORY_SCOPE_AGENT
#define LDS_WAIT() asm volatile("s_waitcnt lgkmcnt(0)" ::: "memory")
#define VM_WAIT() asm volatile("s_waitcnt vmcnt(0)" ::: "memory")

namespace pg8 {
#define PG8_LAS __attribute__((address_space(3)))
typedef unsigned short bf16_t;
typedef short bf16x8 __attribute__((ext_vector_type(8)));
typedef float f32x4 __attribute__((ext_vector_type(4)));
typedef unsigned u32x4 __attribute__((ext_vector_type(4)));
constexpr int BM = 256, BK = 64, HALF = 128, HTB = HALF * BK * 2  , STAGE_BYTES = 8 * HTB, NXCD = 8, WGM = 8;

__host__ __device__ __forceinline__ int lds_byte(int r, int c) { const int st = (r >> 4) * 2 + (c >> 5), rr = r & 15, cc = c & 31, ob = rr * 64 + cc * 2; return st * 1024 + (ob ^ (((ob >> 9) & 1) << 5)); }
__host__ __device__ __forceinline__ void stage_rc(int b, int& R, int& C) { const int st = b / 1024, sb = b % 1024, swz = sb ^ (((sb >> 9) & 1) << 5); R = (st >> 1) * 16 + swz / 64; C = (st & 1) * 32 + (swz % 64) / 2; }
__host__ __device__ __forceinline__ int perm32(int rho) { const int n = rho >> 4, i = rho & 15; return 8 * (i >> 2) + 4 * n + (i & 3); }

struct Unit { int pm, pn; };
struct Gemm { const bf16_t* A; const bf16_t* Bt; int M, N, K, lda, ldb; };

struct StaticOrder {
    int nM, nN, nwg, G, c;
    __host__ __device__ void init(int M, int N, int G_, int c_) { nM = M / BM; nN = N / BM; nwg = nM * nN; G = G_; c = c_; }
    __host__ __device__ bool next(int i, Unit& u) const {
        const long L = (long)i * G + c; if (L >= nwg) return false;
        int wgid = (int)L; { const int q = nwg / NXCD, r = nwg % NXCD, xcd = wgid % NXCD, off = wgid / NXCD; wgid = (xcd < r ? xcd * (q + 1) : r * (q + 1) + (xcd - r) * q) + off; }
        const int nig = WGM * nN, gid = wgid / nig, fm = gid * WGM, gsz = (nM - fm) < WGM ? (nM - fm) : WGM;
        u.pm = fm + ((wgid % nig) % gsz); u.pn = (wgid % nig) / gsz; return true;
    }
    __device__ __forceinline__ void a_ready(const Unit&) const {}
    __device__ __forceinline__ void done(const Unit&) const {}
};
struct OneUnit {
    int pm, pn, has;
    __device__ bool next(int i, Unit& u) const { if (i == 0 && has) { u.pm = pm; u.pn = pn; return true; } return false; }
    __device__ __forceinline__ void a_ready(const Unit&) const {}
    __device__ __forceinline__ void done(const Unit&) const {}
};
template <class Epi, class Sched, bool ALIGN_EPI = false, bool SP2 = false>
__device__ __forceinline__ void gemm_phase(PG8_LAS unsigned char* lds, const Gemm g, const Sched& S, const Epi& E) {
    const int tid = threadIdx.x, wid = __builtin_amdgcn_readfirstlane(tid >> 6), lane = tid & 63, wr = wid >> 2, wc = wid & 3, fr = lane & 15, fq = lane >> 4;
    const int K = g.K, nt = K / BK;
    unsigned voffA[2], voffB[2];
#pragma unroll
    for (int i = 0; i < 2; ++i) { int R, C; stage_rc(tid * 16 + i * 8192, R, C); const int Rb = Epi::PERM ? ((R & ~31) + perm32(R & 31)) : R;
        voffA[i] = (unsigned)(R * g.lda + C) * 2u; voffB[i] = (unsigned)(Rb * g.ldb + C) * 2u; }
    const size_t kstep = (size_t)(BK * 2);
    const size_t hstepA = (size_t)HALF * g.lda * 2, hstepB = (size_t)HALF * g.ldb * 2;
    const size_t tstepA = 2 * hstepA, tstepB = 2 * hstepB;
    const unsigned ldsw = (unsigned)wid * 1024u;
    const int aoff = lds_byte(wr * 64 + fr, fq * 8), boff = lds_byte(wc * 32 + fr, fq * 8);
#define PG8_SA(b, h) (((b) * 2 + (h)) * HTB)
#define PG8_SB(b, h) ((4 + (b) * 2 + (h)) * HTB)
#define PG8_STAGE(bufoff, gbase, voff) do { _Pragma("unroll") for (int _i = 0; _i < 2; ++_i) \
        __builtin_amdgcn_global_load_lds((const unsigned*)((const char*)(gbase) + (voff)[_i]), (PG8_LAS unsigned*)(lds + (bufoff) + ldsw + _i * 8192), 16, 0, 0); } while (0)
#define PG8_LDA(dst, b, h) do { _Pragma("unroll") for (int m = 0; m < 4; ++m) _Pragma("unroll") for (int k = 0; k < 2; ++k) dst[m][k] = *(const PG8_LAS bf16x8*)(lds + PG8_SA(b, h) + aoff + m * 2048 + k * 1024); } while (0)
#define PG8_LDB(dst, b, h) do { _Pragma("unroll") for (int n = 0; n < 2; ++n) _Pragma("unroll") for (int k = 0; k < 2; ++k) dst[n][k] = *(const PG8_LAS bf16x8*)(lds + PG8_SB(b, h) + boff + n * 2048 + k * 1024); } while (0)
#define PG8_MMA(ai, bj, At, Bt) do { __builtin_amdgcn_s_setprio(1); _Pragma("unroll") for (int m = 0; m < 4; ++m) _Pragma("unroll") for (int n = 0; n < 2; ++n) _Pragma("unroll") for (int k = 0; k < 2; ++k) \
        acc[ai][bj][m][n] = __builtin_amdgcn_mfma_f32_16x16x32_bf16(Bt[n][k], At[m][k], acc[ai][bj][m][n], 0, 0, 0); __builtin_amdgcn_s_setprio(0); } while (0)
#define PG8_WAIT_V(n) asm volatile("s_waitcnt vmcnt(" #n ")" ::: "memory")
#define PG8_WAIT_L(n) asm volatile("s_waitcnt lgkmcnt(" #n ")" ::: "memory")
#define PG8_BAR __builtin_amdgcn_s_barrier()
#define PG8_SCHED __builtin_amdgcn_sched_barrier(0)
    Unit cur, nxt; int ui = 0;
    if (!S.next(0, cur)) return;
    f32x4 acc[2][2][4][2];
#pragma unroll
    for (int a = 0; a < 2; ++a)
#pragma unroll
        for (int b = 0; b < 2; ++b)
#pragma unroll
            for (int m = 0; m < 4; ++m)
#pragma unroll
                for (int n = 0; n < 2; ++n) acc[a][b][m][n] = (f32x4){0.f, 0.f, 0.f, 0.f};
    bf16x8 At[4][2], B0[2][2], B1[2][2];
    const char* cA = (const char*)g.A + (size_t)cur.pm * tstepA; const char* cB = (const char*)g.Bt + (size_t)cur.pn * tstepB;
    S.a_ready(cur);
    if constexpr (SP2) {
        PG8_STAGE(PG8_SB(0, 0), cB, voffB); PG8_STAGE(PG8_SB(0, 1), cB + hstepB, voffB); PG8_STAGE(PG8_SA(0, 0), cA, voffA); PG8_STAGE(PG8_SA(0, 1), cA + hstepA, voffA);
        if (wr == 1) PG8_BAR;
        PG8_WAIT_V(2); PG8_BAR;
        PG8_STAGE(PG8_SB(1, 0), cB + kstep, voffB); PG8_STAGE(PG8_SA(1, 0), cA + kstep, voffA); PG8_STAGE(PG8_SB(1, 1), cB + hstepB + kstep, voffB);
        PG8_WAIT_V(6); PG8_BAR;
    } else {
        PG8_STAGE(PG8_SB(0, 0), cB, voffB); PG8_STAGE(PG8_SA(0, 0), cA, voffA); PG8_STAGE(PG8_SB(0, 1), cB + hstepB, voffB); PG8_STAGE(PG8_SA(0, 1), cA + hstepA, voffA);
        if (wr == 1) PG8_BAR;
        PG8_WAIT_V(4); PG8_BAR;
        PG8_STAGE(PG8_SB(1, 0), cB + kstep, voffB); PG8_STAGE(PG8_SA(1, 0), cA + kstep, voffA); PG8_STAGE(PG8_SB(1, 1), cB + hstepB + kstep, voffB);
        PG8_WAIT_V(6); PG8_BAR;
    }
    for (;;) {
        const bool has_next = S.next(ui + 1, nxt);
        const char* nA = has_next ? (const char*)g.A + (size_t)nxt.pm * tstepA : cA; const char* nB = has_next ? (const char*)g.Bt + (size_t)nxt.pn * tstepB : cB;
        for (int t = 0; t < nt; t += 2) {
            const bool last = (t == nt - 2);
            const char* a1 = cA + (size_t)(t + 1) * kstep;
            const char* a2 = last ? nA : cA + (size_t)(t + 2) * kstep; const char* b2 = last ? nB : cB + (size_t)(t + 2) * kstep;
            const char* a3 = a2 + kstep; const char* b3 = b2 + kstep;
            if (last && has_next) S.a_ready(nxt);
            if constexpr (SP2) {
            PG8_LDB(B0, 0, 0); PG8_LDB(B1, 0, 1); PG8_SCHED; PG8_LDA(At, 0, 0); PG8_STAGE(PG8_SA(1, 1), a1 + hstepA, voffA);
            PG8_WAIT_V(8); PG8_WAIT_L(0); PG8_BAR; PG8_MMA(0, 0, At, B0); PG8_MMA(0, 1, At, B1); PG8_BAR; PG8_SCHED;
            PG8_LDA(At, 0, 1); PG8_STAGE(PG8_SB(0, 0), b2, voffB); PG8_STAGE(PG8_SB(0, 1), b2 + hstepB, voffB); PG8_STAGE(PG8_SA(0, 0), a2, voffA);
            PG8_WAIT_V(8); PG8_WAIT_L(0); PG8_BAR; PG8_MMA(1, 0, At, B0); PG8_MMA(1, 1, At, B1); PG8_BAR; PG8_SCHED;
            PG8_LDB(B0, 1, 0); PG8_LDB(B1, 1, 1); PG8_SCHED; PG8_LDA(At, 1, 0); PG8_STAGE(PG8_SA(0, 1), a2 + hstepA, voffA);
            PG8_WAIT_V(8); PG8_WAIT_L(0); PG8_BAR; PG8_MMA(0, 0, At, B0); PG8_MMA(0, 1, At, B1); PG8_BAR; PG8_SCHED;
            PG8_LDA(At, 1, 1); PG8_STAGE(PG8_SB(1, 0), b3, voffB); PG8_STAGE(PG8_SB(1, 1), b3 + hstepB, voffB); PG8_STAGE(PG8_SA(1, 0), a3, voffA);
            PG8_WAIT_V(8); PG8_WAIT_L(0); PG8_BAR; PG8_MMA(1, 0, At, B0); PG8_MMA(1, 1, At, B1); PG8_BAR; PG8_SCHED;
            } else {
            PG8_LDB(B0, 0, 0); PG8_SCHED; PG8_LDA(At, 0, 0); PG8_STAGE(PG8_SA(1, 1), a1 + hstepA, voffA);
            PG8_WAIT_L(8); PG8_BAR; PG8_WAIT_L(0); PG8_MMA(0, 0, At, B0); PG8_BAR; PG8_SCHED;
            PG8_LDB(B1, 0, 1); PG8_STAGE(PG8_SB(0, 0), b2, voffB);
            PG8_BAR; PG8_WAIT_L(0); PG8_MMA(0, 1, At, B1); PG8_BAR;
            PG8_LDA(At, 0, 1); PG8_STAGE(PG8_SA(0, 0), a2, voffA);
            PG8_BAR; PG8_WAIT_L(0); PG8_MMA(1, 0, At, B0); PG8_BAR; PG8_SCHED;
            PG8_STAGE(PG8_SB(0, 1), b2 + hstepB, voffB);
            PG8_WAIT_V(6); PG8_BAR; PG8_MMA(1, 1, At, B1); PG8_BAR;
            PG8_LDB(B0, 1, 0); PG8_SCHED; PG8_LDA(At, 1, 0); PG8_STAGE(PG8_SA(0, 1), a2 + hstepA, voffA);
            PG8_WAIT_L(8); PG8_BAR; PG8_WAIT_L(0); PG8_MMA(0, 0, At, B0); PG8_BAR; PG8_SCHED;
            PG8_LDB(B1, 1, 1); PG8_STAGE(PG8_SB(1, 0), b3, voffB);
            PG8_BAR; PG8_WAIT_L(0); PG8_MMA(0, 1, At, B1); PG8_BAR;
            PG8_LDA(At, 1, 1); PG8_STAGE(PG8_SA(1, 0), a3, voffA);
            PG8_BAR; PG8_WAIT_L(0); PG8_MMA(1, 0, At, B0); PG8_BAR; PG8_SCHED;
            PG8_STAGE(PG8_SB(1, 1), b3 + hstepB, voffB);
            PG8_WAIT_V(6); PG8_BAR; PG8_MMA(1, 1, At, B1); PG8_BAR;
            }
        }
        if constexpr (ALIGN_EPI) { if (wr == 0) PG8_BAR; }
        if constexpr (!Epi::AFTER_DRAIN) { E(acc, cur, wr, wc, fr, fq); S.done(cur); }
        if (!has_next) break;
#pragma unroll
        for (int a = 0; a < 2; ++a)
#pragma unroll
            for (int b = 0; b < 2; ++b)
#pragma unroll
                for (int m = 0; m < 4; ++m)
#pragma unroll
                    for (int n = 0; n < 2; ++n) acc[a][b][m][n] = (f32x4){0.f, 0.f, 0.f, 0.f};
        cur = nxt; cA = nA; cB = nB; ++ui;
        if constexpr (ALIGN_EPI) { if (wr == 1) PG8_BAR; }
    }
    PG8_WAIT_V(0);
    if constexpr (!ALIGN_EPI) { if (wr == 0) PG8_BAR; }
    PG8_BAR;
    if constexpr (Epi::AFTER_DRAIN) { E.fused(acc, cur, wr, wc, fr, fq, lds, wid, lane); S.done(cur); }
#undef PG8_SA
#undef PG8_SB
#undef PG8_STAGE
#undef PG8_LDA
#undef PG8_LDB
#undef PG8_MMA
#undef PG8_WAIT_V
#undef PG8_WAIT_L
#undef PG8_BAR
#undef PG8_SCHED
}
}
#undef PG8_LAS
#define XB_TMO      128
#define XB_XCNT(j)  (256  + 64 * (j))
#define XB_XSUB(j)  (1280 + 64 * (j))
#define XB_XGEN(j)  (2304 + 64 * (j))
#define XB_TOP      3328
#define XB_TOPGEN   3392
#define XCD_BAR_WORDS 3456
#define XB_SPIN_CAP (1u << 18)

__device__ __forceinline__ unsigned xb_ld(unsigned* p)              { return __hip_atomic_load(p, __ATOMIC_RELAXED, __HIP_MEMORY_SCOPE_AGENT); }
__device__ __forceinline__ unsigned xb_add(unsigned* p, unsigned v) { return __hip_atomic_fetch_add(p, v, __ATOMIC_RELAXED, __HIP_MEMORY_SCOPE_AGENT); }
__device__ __forceinline__ unsigned xb_xcc_id() { return (unsigned)__builtin_amdgcn_s_getreg((3 << 11) | 20) & 0xFu; }
#define XB_SPIN(cond, bar) do { unsigned _sp = 0; while (cond) { __builtin_amdgcn_s_sleep(1); \
    if ((++_sp & 255u) == 0u) { if (xb_ld(&(bar)[XB_TMO])) break; if (_sp > XB_SPIN_CAP) { atomicAdd(&(bar)[XB_TMO], 1u); break; } } } } while (0)

struct XcdBarrier {
    unsigned* bar; unsigned x;
    volatile LAS unsigned* st;
};

__device__ __forceinline__ XcdBarrier xcd_barrier_post(unsigned* bar, volatile LAS unsigned* st) {
    XcdBarrier b; b.bar = bar; b.x = xb_xcc_id(); b.st = st;
    if (threadIdx.x == 0) (void)xb_add(&bar[XB_XCNT(b.x)], 1u);
    return b;
}
__device__ __forceinline__ void xcd_barrier_complete(unsigned* bar, unsigned x, unsigned& nloc, unsigned& nx) {
    const unsigned G = gridDim.x * gridDim.y * gridDim.z;
    unsigned sum, cnt, mine, sp = 0u;
    for (;;) {
        sum = 0u; cnt = 0u; mine = 0u;
#pragma unroll
        for (unsigned j = 0; j < 16; ++j) { const unsigned c = xb_ld(&bar[XB_XCNT(j)]); sum += c; cnt += (c > 0u) ? 1u : 0u; mine = (j == x) ? c : mine; }
        if (sum == G) break;
        __builtin_amdgcn_s_sleep(1);
        if ((++sp & 255u) == 0u) { if (xb_ld(&bar[XB_TMO])) break; if (sp > XB_SPIN_CAP) { atomicAdd(&bar[XB_TMO], 1u); break; } }
    }
    nloc = mine > 0u ? mine : 1u; nx = cnt > 0u ? cnt : 1u;
}

__device__ __forceinline__ void xcd_barrier(const XcdBarrier& b) {
    asm volatile("s_waitcnt vmcnt(0)" ::: "memory");
    __syncthreads();
    if (threadIdx.x == 0) {
        unsigned* bar = b.bar;
        __builtin_amdgcn_s_waitcnt(0);
        unsigned nloc = b.st[0], nx = b.st[1];
        if (nloc == 0u) { xcd_barrier_complete(bar, b.x, nloc, nx); b.st[0] = nloc; b.st[1] = nx; }
        const unsigned old = xb_add(&bar[XB_XSUB(b.x)], 1u);
        const unsigned gen = old / nloc;
        if (old + 1u == (gen + 1u) * nloc) {
            __builtin_amdgcn_fence(__ATOMIC_RELEASE, "agent");
            asm volatile("s_waitcnt vmcnt(0)" ::: "memory");
            const unsigned og = xb_add(&bar[XB_TOP], 1u);
            const unsigned tg = og / nx;
            if (og + 1u == (tg + 1u) * nx) xb_add(&bar[XB_TOPGEN], 1u);
            else XB_SPIN(xb_ld(&bar[XB_TOPGEN]) == tg, bar);
            __builtin_amdgcn_fence(__ATOMIC_ACQUIRE, "agent");
            xb_add(&bar[XB_XGEN(b.x)], 1u);
            asm volatile("s_waitcnt vmcnt(0)" ::: "memory");
        } else {
            XB_SPIN(xb_ld(&bar[XB_XGEN(b.x)]) == gen, bar);
            __builtin_amdgcn_fence(__ATOMIC_ACQUIRE, "agent");
            asm volatile("s_waitcnt vmcnt(0)" ::: "memory");
        }
    }
    __syncthreads();
}

constexpr int SEQ = 16384, DM = 1024, N1 = 4352  , NWAVES = 8;
constexpr float EPS = 1e-6f, QSCALE = 0.125f * LOG2E;
constexpr size_t MiB = 1u << 20;
constexpr size_t WS_CTL = 0, CTL_ZERO_BYTES = 1 * MiB;
constexpr size_t WS_WIN = 1 * MiB, WS_WUPA = 10 * MiB, WS_WUPB = 11 * MiB, WS_WO2 = 12 * MiB, WS_WQ = 16 * MiB, WS_WPG = 20 * MiB, WS_WPLE = 22 * MiB, WS_W1KV = 23 * MiB;
constexpr size_t WS_SMALL = 25 * MiB, WS_W2KT = WS_SMALL, WS_W2VT = WS_SMALL + 32768, WS_K1B = WS_SMALL + 65536, WS_K2B = WS_SMALL + 98304, WS_POSB = WS_SMALL + 131072,
                 WS_RS0 = WS_SMALL + 262144, WS_RS2 = WS_SMALL + 393216;
constexpr size_t WS_SSQ1 = 26 * MiB, WS_BG = 27 * MiB, WS_KC = 28 * MiB + 512 * 1024, WS_VCT = WS_KC + 262144, WS_H = 29 * MiB;
constexpr size_t WS_XB = 32 * MiB, WS_MG = 64 * MiB, WS_QA = 128 * MiB, WS_QB = 144 * MiB;
constexpr size_t WS_KA = 160 * MiB, WS_VTA = 164 * MiB, WS_CK = 168 * MiB, WS_KS = 176 * MiB, WS_VTS = 180 * MiB, WS_KW = 184 * MiB, WS_VTW = 188 * MiB;
constexpr size_t WS_OW = 192 * MiB, WS_PW = 208 * MiB, WS_PB = 240 * MiB;
constexpr size_t WS_OA = 208 * MiB, WS_OB = 224 * MiB;
constexpr size_t WS_U8 = 128 * MiB, WS_V8 = 144 * MiB, WS_Q2 = 64 * MiB;
constexpr size_t WS_END = 256 * MiB;
constexpr int CW_TMO = 0, CW_BAR = 4096, CW_QUEUE = 32768;
constexpr int LDS_BYTES = 147456, LDSCTL_OFF = 143360;
constexpr int KROW = 144, VROW = 136;
constexpr int AT_K0 = 0, AT_KSZ = 64 * KROW, AT_V0 = 2 * AT_KSZ, AT_VSZ = 64 * VROW, AT_LUT = 36864, LUTS = 136, AT_IMP = 46080, AT_SEL = 111616;
constexpr int PK_ROW = 272, PK1_OFF = 0, PK2_OFF = 128 * PK_ROW, PW_OFF = 2 * 128 * PK_ROW, PW_BYTES = 8192;
static_assert(AT_V0 + 2 * AT_VSZ <= AT_LUT && AT_LUT + 16 * LUTS * 4 <= AT_IMP && AT_SEL + 2048 <= LDSCTL_OFF && PW_OFF + 8 * PW_BYTES <= LDSCTL_OFF, "LDS map");

__device__ const unsigned char BKT[129] = {0,1,2,3,4,5,6,7,8,9,10,11,12,13,14,15,16,16,16,17,17,18,18,18,19,19,19,20,20,20,20,21,21,21,21,22,22,22,22,22,23,23,23,23,23,23,24,24,24,24,24,24,
    25,25,25,25,25,25,25,26,26,26,26,26,26,26,26,27,27,27,27,27,27,27,27,27,27,28,28,28,28,28,28,28,28,28,28,29,29,29,29,29,29,29,29,29,29,29,29,30,30,30,30,30,30,30,30,30,30,30,30,30,30,
    31,31,31,31,31,31,31,31,31,31,31,31,31,31,31,31};

struct Args { const float* in[24]; float* out; unsigned char* ws; int ph_lo, ph_hi, li, pad; };
struct Frame {
    LAS unsigned char* lds; volatile LAS unsigned* MISC; gu32* ctl; unsigned char* ws;
    int tid, lane, wave, vcu, G;
    float* out;
};
template <int CTRL> __device__ __forceinline__ float dpp_f(float v) { return __uint_as_float((unsigned)__builtin_amdgcn_update_dpp(0, (int)__float_as_uint(v), CTRL, 0xf, 0xf, true)); }
template <int CTRL> __device__ __forceinline__ unsigned dpp_u(unsigned v) { return (unsigned)__builtin_amdgcn_update_dpp(0, (int)v, CTRL, 0xf, 0xf, true); }
__device__ __forceinline__ float wave_sum(float v) {
#pragma unroll
    for (int o = 1; o < 64; o <<= 1) v += __shfl_xor(v, o);
    return v;
}
__device__ __forceinline__ float quad_sum(float v) { v += dpp_f<0xB1>(v); v += dpp_f<0x4E>(v); return v; }
__device__ __forceinline__ unsigned umax_(unsigned a, unsigned b) { return a > b ? a : b; }
__device__ __forceinline__ unsigned wave_max_u32(unsigned v) {
    v = umax_(v, dpp_u<0xB1>(v)); v = umax_(v, dpp_u<0x4E>(v)); v = umax_(v, dpp_u<0x141>(v)); v = umax_(v, dpp_u<0x140>(v));
    const unsigned a = __builtin_amdgcn_readlane(v, 0), b = __builtin_amdgcn_readlane(v, 16), c = __builtin_amdgcn_readlane(v, 32), d = __builtin_amdgcn_readlane(v, 48);
    return umax_(umax_(a, b), umax_(c, d));
}
__device__ __forceinline__ float pair_max(float v) { auto rr = __builtin_amdgcn_permlane32_swap(__float_as_uint(v), __float_as_uint(v), false, false); return fmaxf(__uint_as_float(rr[0]), __uint_as_float(rr[1])); }
__device__ __forceinline__ float pair_sum(float v) { auto rr = __builtin_amdgcn_permlane32_swap(__float_as_uint(v), __float_as_uint(v), false, false); return __uint_as_float(rr[0]) + __uint_as_float(rr[1]); }
__device__ __forceinline__ unsigned pair_umax(unsigned v) { auto rr = __builtin_amdgcn_permlane32_swap(v, v, false, false); return umax_(rr[0], rr[1]); }
#define WG_BAR_LDS() do { asm volatile("s_waitcnt lgkmcnt(0)" ::: "memory"); __builtin_amdgcn_s_barrier(); asm volatile("" ::: "memory"); } while (0)
__device__ __forceinline__ u32x4 pack8(const f32x4& a, const f32x4& b) { u32x4 w; w.x = pkbf(a[0], a[1]); w.y = pkbf(a[2], a[3]); w.z = pkbf(b[0], b[1]); w.w = pkbf(b[2], b[3]); return w; }

typedef const f32x4 (&AccRef)[2][2][4][2];
struct Epi1 {
    static constexpr bool PERM = true, AFTER_DRAIN = false;
    const float* rs0; unsigned char* ws;
    __device__ __forceinline__ void operator()(AccRef acc, const pg8::Unit& u, int wr, int wc, int fr, int fq) const {
        asm volatile("" ::: "memory");
        const int row0 = u.pm * 256 + wr * 64 + fr, pn = u.pn, cl = wc * 32 + 8 * fq;
        float rsv[2][4];
#pragma unroll
        for (int ai = 0; ai < 2; ++ai)
#pragma unroll
            for (int m = 0; m < 4; ++m) rsv[ai][m] = rs0[row0 + ai * 128 + m * 16];
#pragma unroll
        for (int ai = 0; ai < 2; ++ai)
#pragma unroll
            for (int m = 0; m < 4; ++m) asm volatile("" : "+v"(rsv[ai][m]));
        if (pn < 4) {
            bf16* Q = (bf16*)(ws + (pn < 2 ? WS_QA : WS_QB)) + (pn & 1) * 256 + cl;
#pragma unroll
            for (int ai = 0; ai < 2; ++ai)
#pragma unroll
                for (int m = 0; m < 4; ++m) { const int row = row0 + ai * 128 + m * 16; const float s = rsv[ai][m] * QSCALE;
#pragma unroll
                    for (int bj = 0; bj < 2; ++bj) *(u32x4*)(Q + (size_t)row * 512 + bj * 128) = pack8(acc[ai][bj][m][0] * s, acc[ai][bj][m][1] * s); }
        } else if (pn < 8) {
            const int g = wc >> 1, dl = cl & 63;
            const size_t koff = pn == 4 ? WS_KA : pn == 5 ? WS_CK : pn == 6 ? WS_KS : WS_KW;
            const size_t voff = pn == 4 ? WS_VTA : pn == 5 ? WS_CK + (size_t)2 * SEQ * 64 * 2 : pn == 6 ? WS_VTS : WS_VTW;
            bf16* Kd = (bf16*)(ws + koff) + (size_t)g * SEQ * 64 + dl;
            bf16* Vd = (bf16*)(ws + voff);
#pragma unroll
            for (int ai = 0; ai < 2; ++ai)
#pragma unroll
                for (int m = 0; m < 4; ++m) { const int row = row0 + ai * 128 + m * 16; const float s = rsv[ai][m];
                    *(u32x4*)(Kd + (size_t)row * 64) = pack8(acc[ai][0][m][0] * s, acc[ai][0][m][1] * s);
                    const u32x4 v = pack8(acc[ai][1][m][0] * s, acc[ai][1][m][1] * s);
                    if (pn == 5) *(u32x4*)(Vd + ((size_t)g * SEQ + row) * 64 + dl) = v;
                    else { bf16* vt = Vd + (size_t)(g * 64 + dl) * SEQ + row;
                        vt[0 * (size_t)SEQ] = (bf16)v.x; vt[1 * (size_t)SEQ] = (bf16)(v.x >> 16); vt[2 * (size_t)SEQ] = (bf16)v.y; vt[3 * (size_t)SEQ] = (bf16)(v.y >> 16);
                        vt[4 * (size_t)SEQ] = (bf16)v.z; vt[5 * (size_t)SEQ] = (bf16)(v.z >> 16); vt[6 * (size_t)SEQ] = (bf16)v.w; vt[7 * (size_t)SEQ] = (bf16)(v.w >> 16); } }
        } else if (pn < 16) {
            bf16* MG = (bf16*)(ws + WS_MG) + (pn - 8) * 256 + cl;
#pragma unroll
            for (int ai = 0; ai < 2; ++ai)
#pragma unroll
                for (int m = 0; m < 4; ++m) { const int row = row0 + ai * 128 + m * 16; const float s = rsv[ai][m];
#pragma unroll
                    for (int bj = 0; bj < 2; ++bj) { f32x4 a = acc[ai][bj][m][0] * s, b = acc[ai][bj][m][1] * s;
#pragma unroll
                        for (int e = 0; e < 4; ++e) { a[e] = sigmoidf_(a[e]); b[e] = sigmoidf_(b[e]); }
                        *(u32x4*)(MG + (size_t)row * 2048 + bj * 128) = pack8(a, b); } }
        } else {
            if (wc == 0 && fq < 3) { float* BG = (float*)(ws + WS_BG) + 8 * fq;
#pragma unroll
                for (int ai = 0; ai < 2; ++ai)
#pragma unroll
                    for (int m = 0; m < 4; ++m) { const int row = row0 + ai * 128 + m * 16; const float s = rsv[ai][m]; f32x4 a = acc[ai][0][m][0] * s, b = acc[ai][0][m][1] * s;
#pragma unroll
                        for (int e = 0; e < 4; ++e) { a[e] = sigmoidf_(a[e]); b[e] = sigmoidf_(b[e]); }
                        *(f32x4*)(BG + (size_t)row * 24) = a; *(f32x4*)(BG + (size_t)row * 24 + 4) = b; } }
        }
    }
};
struct EpiNull {
    static constexpr bool PERM = true, AFTER_DRAIN = false;
    __device__ __forceinline__ void operator()(AccRef acc, const pg8::Unit& u, int wr, int wc, int fr, int fq) const {
        asm volatile("" ::: "memory");
#pragma unroll
        for (int ai = 0; ai < 2; ++ai)
#pragma unroll
            for (int bj = 0; bj < 2; ++bj)
#pragma unroll
                for (int m = 0; m < 4; ++m)
#pragma unroll
                    for (int n = 0; n < 2; ++n) asm volatile("" :: "v"(acc[ai][bj][m][n]));
    }
};
struct EpiUp {
    static constexpr bool PERM = true, AFTER_DRAIN = false;
    bf16* MG; int coloff; bf16* DST;
    __device__ __forceinline__ void operator()(AccRef acc, const pg8::Unit& u, int wr, int wc, int fr, int fq) const {
        asm volatile("" ::: "memory");
        const int row0 = u.pm * 256 + wr * 64 + fr; bf16* base = MG + coloff + u.pn * 256 + wc * 32 + 8 * fq; bf16* dbase = DST + coloff + u.pn * 256 + wc * 32 + 8 * fq;
        u32x4 gt[2][4][2];
#pragma unroll
        for (int m = 0; m < 4; ++m)
#pragma unroll
            for (int bj = 0; bj < 2; ++bj) gt[0][m][bj] = *(const u32x4*)(base + (size_t)(row0 + m * 16) * 2048 + bj * 128);
#pragma unroll
        for (int ai = 0; ai < 2; ++ai) {
            if (ai == 0) {
#pragma unroll
                for (int m = 0; m < 4; ++m)
#pragma unroll
                    for (int bj = 0; bj < 2; ++bj) gt[1][m][bj] = *(const u32x4*)(base + (size_t)(row0 + 128 + m * 16) * 2048 + bj * 128);
            }
#pragma unroll
            for (int m = 0; m < 4; ++m) { bf16* rp = dbase + (size_t)(row0 + ai * 128 + m * 16) * 2048;
#pragma unroll
                for (int bj = 0; bj < 2; ++bj) { const u32x4 g = gt[ai][m][bj]; const f32x4 a = acc[ai][bj][m][0], b = acc[ai][bj][m][1]; u32x4 w;
                    w.x = pkbf(bf_lo(g.x) * a[0], bf_hi(g.x) * a[1]); w.y = pkbf(bf_lo(g.y) * a[2], bf_hi(g.y) * a[3]);
                    w.z = pkbf(bf_lo(g.z) * b[0], bf_hi(g.z) * b[1]); w.w = pkbf(bf_lo(g.w) * b[2], bf_hi(g.w) * b[3]);
                    *(u32x4*)(rp + bj * 128) = w; } }
        }
    }
};
struct EpiWo {
    static constexpr bool PERM = true, AFTER_DRAIN = false;
    const float* x; float* out; bf16* xb; float* ssq;
    __device__ __forceinline__ void operator()(AccRef acc, const pg8::Unit& u, int wr, int wc, int fr, int fq) const {
        asm volatile("" ::: "memory");
        const int row0 = u.pm * 256 + wr * 64 + fr, c0 = u.pn * 256 + wc * 32 + 8 * fq;
        f32x4 xv[2][2][2][2];
#define WO_LOAD(par, bt) _Pragma("unroll") for (int mm = 0; mm < 2; ++mm) _Pragma("unroll") for (int bj = 0; bj < 2; ++bj) { \
            const size_t o = (size_t)(row0 + ((bt) >> 1) * 128 + (((bt) & 1) * 2 + mm) * 16) * DM + c0 + bj * 128; xv[par][mm][bj][0] = *(const f32x4*)(x + o); xv[par][mm][bj][1] = *(const f32x4*)(x + o + 4); }
        WO_LOAD(0, 0);
#pragma unroll
        for (int bt = 0; bt < 4; ++bt) {
            if (bt == 0) { WO_LOAD(1, 1); } else if (bt == 1) { WO_LOAD(0, 2); } else if (bt == 2) { WO_LOAD(1, 3); }
            const int ai = bt >> 1;
#pragma unroll
            for (int mm = 0; mm < 2; ++mm) { const int m = (bt & 1) * 2 + mm, row = row0 + ai * 128 + m * 16; float ss = 0.f;
#pragma unroll
                for (int bj = 0; bj < 2; ++bj) { const size_t o = (size_t)row * DM + c0 + bj * 128;
                    const f32x4 a = xv[bt & 1][mm][bj][0] + acc[ai][bj][m][0], b = xv[bt & 1][mm][bj][1] + acc[ai][bj][m][1];
                    *(f32x4*)(out + o) = a; *(f32x4*)(out + o + 4) = b; *(u32x4*)(xb + o) = pack8(a, b);
                    ss += (a[0] * a[0] + a[1] * a[1]) + (a[2] * a[2] + a[3] * a[3]) + (b[0] * b[0] + b[1] * b[1]) + (b[2] * b[2] + b[3] * b[3]); }
                ss += __shfl_xor(ss, 16); ss += __shfl_xor(ss, 32);
                if (fq == 0) ssq[(size_t)row * 16 + u.pn * 4 + wc] = ss; }
        }
#undef WO_LOAD
    }
};
__device__ __forceinline__ float rs_from_ssq(const float* ssq, int row) {
    const f32x4* p = (const f32x4*)(ssq + (size_t)row * 16); const f32x4 a = p[0], b = p[1], c = p[2], d = p[3];
    const float s = ((a[0] + a[1]) + (a[2] + a[3])) + ((b[0] + b[1]) + (b[2] + b[3])) + ((c[0] + c[1]) + (c[2] + c[3])) + ((d[0] + d[1]) + (d[2] + d[3]));
    return __builtin_amdgcn_rsqf(s * (1.0f / DM) + EPS);
}
struct EpiPw {
    static constexpr bool PERM = true, AFTER_DRAIN = false;
    bf16* O; int ldc;
    __device__ __forceinline__ void operator()(AccRef acc, const pg8::Unit& u, int wr, int wc, int fr, int fq) const {
        asm volatile("" ::: "memory");
        const int row0 = u.pm * 256 + wr * 64 + fr; bf16* base = O + u.pn * 256 + wc * 32 + 8 * fq;
#pragma unroll
        for (int ai = 0; ai < 2; ++ai)
#pragma unroll
            for (int m = 0; m < 4; ++m)
#pragma unroll
                for (int bj = 0; bj < 2; ++bj) *(u32x4*)(base + (size_t)(row0 + ai * 128 + m * 16) * ldc + bj * 128) = pack8(acc[ai][bj][m][0], acc[ai][bj][m][1]);
    }
};
struct EpiPle {
    static constexpr bool PERM = true, AFTER_DRAIN = false;
    const float* rs2; const bf16* pw; float* out; float* dst;
    __device__ __forceinline__ void operator()(AccRef acc, const pg8::Unit& u, int wr, int wc, int fr, int fq) const {
        asm volatile("" ::: "memory");
        const int row0 = u.pm * 256 + wr * 64 + fr, c0 = u.pn * 256 + wc * 32 + 8 * fq;
        float rsv[2][4];
#pragma unroll
        for (int ai = 0; ai < 2; ++ai)
#pragma unroll
            for (int m = 0; m < 4; ++m) rsv[ai][m] = rs2[row0 + ai * 128 + m * 16];
#pragma unroll
        for (int ai = 0; ai < 2; ++ai)
#pragma unroll
            for (int m = 0; m < 4; ++m) asm volatile("" : "+v"(rsv[ai][m]));
        f32x4 xv[2][2][2]; u32x4 pv[2][2];
#define PLE_LOAD(par, bt) _Pragma("unroll") for (int bj = 0; bj < 2; ++bj) { \
            const size_t o = (size_t)(row0 + ((bt) >> 2) * 128 + ((bt) & 3) * 16) * DM + c0 + bj * 128; xv[par][bj][0] = *(const f32x4*)(out + o); xv[par][bj][1] = *(const f32x4*)(out + o + 4); pv[par][bj] = *(const u32x4*)(pw + o); }
        PLE_LOAD(0, 0);
#pragma unroll
        for (int bt = 0; bt < 8; ++bt) {
            if (bt < 7) { if ((bt & 1) == 0) { PLE_LOAD(1, bt + 1); } else { PLE_LOAD(0, bt + 1); } }
            const int ai = bt >> 2, m = bt & 3, row = row0 + ai * 128 + m * 16; const float s = rsv[ai][m];
#pragma unroll
            for (int bj = 0; bj < 2; ++bj) { const size_t o = (size_t)row * DM + c0 + bj * 128; const u32x4 p = pv[bt & 1][bj];
                f32x4 a = xv[bt & 1][bj][0], b = xv[bt & 1][bj][1]; const f32x4 ga = acc[ai][bj][m][0] * s, gb = acc[ai][bj][m][1] * s;
                a[0] += sigmoidf_(ga[0]) * bf_lo(p.x); a[1] += sigmoidf_(ga[1]) * bf_hi(p.x); a[2] += sigmoidf_(ga[2]) * bf_lo(p.y); a[3] += sigmoidf_(ga[3]) * bf_hi(p.y);
                b[0] += sigmoidf_(gb[0]) * bf_lo(p.z); b[1] += sigmoidf_(gb[1]) * bf_hi(p.z); b[2] += sigmoidf_(gb[2]) * bf_lo(p.w); b[3] += sigmoidf_(gb[3]) * bf_hi(p.w);
                *(f32x4*)(dst + o) = a; *(f32x4*)(dst + o + 4) = b; }
        }
#undef PLE_LOAD
    }
};
struct EpiCmp {
    static constexpr bool PERM = true, AFTER_DRAIN = false;
    bf16* H; const float* posb;
    __device__ __forceinline__ void operator()(AccRef acc, const pg8::Unit& u, int wr, int wc, int fr, int fq) const {
        asm volatile("" ::: "memory");
        const int row0 = u.pm * 256 + wr * 64 + fr, cl = wc * 32 + 8 * fq;
#pragma unroll
        for (int bj = 0; bj < 2; ++bj) { const f32x4 pa = *(const f32x4*)(posb + u.pn * 256 + bj * 128 + cl), pb = *(const f32x4*)(posb + u.pn * 256 + bj * 128 + cl + 4);
#pragma unroll
            for (int ai = 0; ai < 2; ++ai)
#pragma unroll
                for (int m = 0; m < 4; ++m) { f32x4 a = acc[ai][bj][m][0] + pa, b = acc[ai][bj][m][1] + pb;
#pragma unroll
                    for (int e = 0; e < 4; ++e) { a[e] = gelu_tanh(a[e]); b[e] = gelu_tanh(b[e]); }
                    *(u32x4*)(H + (size_t)(row0 + ai * 128 + m * 16) * 256 + bj * 128 + cl) = pack8(a, b); } }
    }
};

__device__ __forceinline__ void tr_item(const float* W, int Nsrc, int k0, int srcc0, int nvalid, bf16* WT, int ldk, int drow0, int dk0, const float* g, LAS float* scr, int lane) {
#pragma unroll 8
    for (int i = 0; i < 32; ++i) { const int kk = 2 * i + (lane >> 5), n = lane & 31; float v = 0.f;
        if (n < nvalid) { v = W[(size_t)(k0 + kk) * Nsrc + srcc0 + n]; if (g) v *= g[k0 + kk]; }
        scr[kk * 33 + n] = v; }
    LDS_WAIT(); asm volatile("" ::: "memory");
    const int c = lane & 7;
#pragma unroll
    for (int j = 0; j < 4; ++j) { const int n = (lane >> 3) + 8 * j; const LAS float* s = scr + (8 * c) * 33 + n;
        u32x4 o; o.x = pkbf(s[0 * 33], s[1 * 33]); o.y = pkbf(s[2 * 33], s[3 * 33]); o.z = pkbf(s[4 * 33], s[5 * 33]); o.w = pkbf(s[6 * 33], s[7 * 33]);
        *(u32x4*)(WT + (size_t)(drow0 + n) * ldk + dk0 + k0 + 8 * c) = o; }
    LDS_WAIT(); asm volatile("" ::: "memory");
}
__device__ __forceinline__ void p0_prologue(Frame& F, const Args& A) {
    LAS float* scr = (LAS float*)(F.lds + F.wave * 8448);
    const int gw = F.vcu * NWAVES + F.wave, NGW = F.G * NWAVES, lane = F.lane;
    unsigned char* ws = F.ws;
    constexpr int I_IN = 16 * 136, I_UP = 8 * 32, I_O = 16 * 32, I_Q = 16 * 64, I_PG = 16 * 32, I_PLE = 4 * 32, I_W1 = 32 * 8, I_W2 = 4 * 2;
    constexpr int NITEMS = I_IN + 2 * I_UP + I_O + I_Q + I_PG + I_PLE + 2 * I_W1 + 2 * I_W2;
    for (int it = gw; it < NITEMS; it += NGW) {
        int r = it;
        if (r < I_IN) { const int kb = r / 136, nb = r % 136, n = nb * 32; int src, nv = 32;
            if (n < 512) src = n; else if (n < 1024) src = n + 256; else if (n < 1280) src = n - 512; else if (n < 2048) src = n; else if (n < 4096) src = n + 24;
            else if (n == 4096) { src = 2048; nv = 24; } else { src = 0; nv = 0; }
            tr_item(A.in[3], 4120, kb * 64, src, nv, (bf16*)(ws + WS_WIN), 1024, n, 0, A.in[2], scr, lane); continue; } r -= I_IN;
        if (r < I_UP) { tr_item(A.in[11], 1024, (r / 32) * 64, (r % 32) * 32, 32, (bf16*)(ws + WS_WUPA), 512, (r % 32) * 32, 0, nullptr, scr, lane); continue; } r -= I_UP;
        if (r < I_UP) { tr_item(A.in[12], 1024, (r / 32) * 64, (r % 32) * 32, 32, (bf16*)(ws + WS_WUPB), 512, (r % 32) * 32, 0, nullptr, scr, lane); continue; } r -= I_UP;
        if (r < I_O) { tr_item(A.in[13], 1024, (r / 32) * 64, (r % 32) * 32, 32, (bf16*)(ws + WS_WO2), 2048, (r % 32) * 32, 0, nullptr, scr, lane);
                       tr_item(A.in[13], 1024, (r / 32) * 64, (r % 32) * 32, 32, (bf16*)(ws + WS_WO2), 2048, (r % 32) * 32, 1024, nullptr, scr, lane); continue; } r -= I_O;
        if (r < I_Q) { tr_item(A.in[15], 2048, (r / 64) * 64, (r % 64) * 32, 32, (bf16*)(ws + WS_WQ), 1024, (r % 64) * 32, 0, A.in[14], scr, lane); continue; } r -= I_Q;
        if (r < I_PG) { tr_item(A.in[21], 1024, (r / 32) * 64, (r % 32) * 32, 32, (bf16*)(ws + WS_WPG), 1024, (r % 32) * 32, 0, A.in[20], scr, lane); continue; } r -= I_PG;
        if (r < I_PLE) { tr_item(A.in[22], 1024, (r / 32) * 64, (r % 32) * 32, 32, (bf16*)(ws + WS_WPLE), 256, (r % 32) * 32, 0, nullptr, scr, lane); continue; } r -= I_PLE;
        if (r < I_W1) { tr_item(A.in[7], 256, (r / 8) * 64, (r % 8) * 32, 32, (bf16*)(ws + WS_W1KV), 2048, (r % 8) * 32, 0, nullptr, scr, lane); continue; } r -= I_W1;
        if (r < I_W1) { tr_item(A.in[9], 256, (r / 8) * 64, (r % 8) * 32, 32, (bf16*)(ws + WS_W1KV), 2048, 256 + (r % 8) * 32, 0, nullptr, scr, lane); continue; } r -= I_W1;
        if (r < I_W2) { tr_item(A.in[8], 64, (r / 2) * 64, (r % 2) * 32, 32, (bf16*)(ws + WS_W2KT), 256, (r % 2) * 32, 0, nullptr, scr, lane); continue; } r -= I_W2;
        tr_item(A.in[10], 64, (r / 2) * 64, (r % 2) * 32, 32, (bf16*)(ws + WS_W2VT), 256, (r % 2) * 32, 0, nullptr, scr, lane);
    }
    { const float* x = A.in[0]; bf16* xb = (bf16*)(ws + WS_XB); float* rs0 = (float*)(ws + WS_RS0);
      for (int row = gw; row < SEQ; row += NGW) {
          const f32x4* xr = (const f32x4*)(x + (size_t)row * DM) + lane; f32x4 v[4]; float ss = 0.f;
#pragma unroll
          for (int j = 0; j < 4; ++j) { v[j] = xr[64 * j]; ss += (v[j][0] * v[j][0] + v[j][1] * v[j][1]) + (v[j][2] * v[j][2] + v[j][3] * v[j][3]); }
          ss = wave_sum(ss);
          u32x2* o8 = (u32x2*)(xb + (size_t)row * DM) + lane;
#pragma unroll
          for (int j = 0; j < 4; ++j) { u32x2 w; w.x = pkbf(v[j][0], v[j][1]); w.y = pkbf(v[j][2], v[j][3]); o8[64 * j] = w; }
          if (lane == 0) rs0[row] = __builtin_amdgcn_rsqf(ss * (1.0f / DM) + EPS);
      } }
    { const int gt = gw * 64 + lane, NGT = NGW * 64;
      const float* p = A.in[1]; bf16* pb = (bf16*)(ws + WS_PB);
      for (int i = gt; i < SEQ * 256 / 8; i += NGT) { const f32x4 a = *(const f32x4*)(p + (size_t)i * 8), b = *(const f32x4*)(p + (size_t)i * 8 + 4); *(u32x4*)(pb + (size_t)i * 8) = pack8(a, b); }
      for (int i = gt; i < 2 * 16384 / 8; i += NGT) { const int which = i >= 2048, j = i & 2047; const float* k = A.in[16 + which] + (size_t)j * 8;
          *(u32x4*)((bf16*)(ws + (which ? WS_K2B : WS_K1B)) + (size_t)j * 8) = pack8(*(const f32x4*)k, *(const f32x4*)(k + 4)); } }
    if (F.vcu < 32) {
#pragma unroll 1
        for (int oo = 0; oo < 2; ++oo) { const int o = F.vcu * 16 + F.wave * 2 + oo, kv = o >> 8, n = o & 255; const float* w1 = A.in[kv ? 9 : 7]; const float* pos = A.in[6]; float s = 0.f;
            for (int k = lane; k < 2048; k += 64) s += pos[k] * w1[(size_t)k * 256 + n];
            s = wave_sum(s); if (lane == 0) ((float*)(ws + WS_POSB))[o] = s; }
    }
}

struct TileSrc { const bf16* K; const bf16* Vt; int vpitch; };
__device__ __forceinline__ void tile_load(const TileSrc& s, int key0, bool needV, int tid, u32x4& kr, u32x4& vr) {
    const int row = tid >> 3, ch = tid & 7;
    kr = *(const u32x4*)(s.K + (size_t)(key0 + row) * 64 + ch * 8);
    if (needV) vr = *(const u32x4*)(s.Vt + (size_t)row * s.vpitch + key0 + ch * 8);
}
__device__ __forceinline__ void tile_store(LAS unsigned char* L, int buf, bool needV, int tid, const u32x4& kr, const u32x4& vr) {
    const int row = tid >> 3, ch = tid & 7;
    *(LAS u32x4*)(L + AT_K0 + buf * AT_KSZ + row * KROW + ch * 16) = kr;
    if (needV) { LAS u32x2* p = (LAS u32x2*)(L + AT_V0 + buf * AT_VSZ + row * VROW + ch * 16); u32x2 a, b; a.x = vr.x; a.y = vr.y; b.x = vr.z; b.y = vr.w; p[0] = a; p[1] = b; }
}
__device__ __forceinline__ void qk_tile(LAS const unsigned char* Kb, const bf16x8 (&q)[4], int r32, int h, f32x16& s0, f32x16& s1) {
#pragma unroll
    for (int i = 0; i < 16; ++i) { s0[i] = 0.f; s1[i] = 0.f; }
#pragma unroll
    for (int ks = 0; ks < 4; ++ks) {
        const bf16x8 a0 = *(LAS const bf16x8*)(Kb + r32 * KROW + (16 * ks + 8 * h) * 2), a1 = *(LAS const bf16x8*)(Kb + (32 + r32) * KROW + (16 * ks + 8 * h) * 2);
        s0 = __builtin_amdgcn_mfma_f32_32x32x16_bf16(a0, q[ks], s0, 0, 0, 0); s1 = __builtin_amdgcn_mfma_f32_32x32x16_bf16(a1, q[ks], s1, 0, 0, 0);
    }
}
__device__ __forceinline__ bf16x8 pack_p(const f32x16& s, int o) {
    u32x4 w; w.x = pkbf(s[o + 0], s[o + 1]); w.y = pkbf(s[o + 2], s[o + 3]); w.z = pkbf(s[o + 4], s[o + 5]); w.w = pkbf(s[o + 6], s[o + 7]); return __builtin_bit_cast(bf16x8, w);
}
__device__ __forceinline__ void softmax_pv(LAS const unsigned char* Vb, f32x16& s0, f32x16& s1, f32x16 (&o)[2], float& m, float& l, int r32, int h) {
    float mx = fmaxf(s0[0], s1[0]);
#pragma unroll
    for (int i = 1; i < 16; ++i) mx = fmaxf(mx, fmaxf(s0[i], s1[i]));
    mx = pair_max(mx);
    const float mn = fmaxf(m, mx), alpha = fexp2(m - mn); m = mn;
    float sum = 0.f;
#pragma unroll
    for (int i = 0; i < 16; ++i) { s0[i] = fexp2(s0[i] - mn); s1[i] = fexp2(s1[i] - mn); sum += s0[i] + s1[i]; }
    sum = pair_sum(sum); l = l * alpha + sum;
#pragma unroll
    for (int i = 0; i < 16; ++i) { o[0][i] *= alpha; o[1][i] *= alpha; }
    bf16x8 pf[4]; pf[0] = pack_p(s0, 0); pf[1] = pack_p(s0, 8); pf[2] = pack_p(s1, 0); pf[3] = pack_p(s1, 8);
#pragma unroll
    for (int dt = 0; dt < 2; ++dt)
#pragma unroll
        for (int s = 0; s < 4; ++s) { LAS const unsigned char* vp = Vb + (32 * dt + r32) * VROW + (16 * s + 4 * h) * 2;
            const u32x2 lo = *(LAS const u32x2*)vp, hi = *(LAS const u32x2*)(vp + 16); u32x4 a; a.x = lo.x; a.y = lo.y; a.z = hi.x; a.w = hi.y;
            o[dt] = __builtin_amdgcn_mfma_f32_32x32x16_bf16(__builtin_bit_cast(bf16x8, a), pf[s], o[dt], 0, 0, 0); }
}
#define KEYOFF(kt, i) (32 * (kt) + ((i) & 3) + 8 * ((i) >> 2))
#define NEG_INF (-__builtin_inff())

template <int W> struct FBand {
    int tq, tw, h; const LAS float* lut;
    __device__ __forceinline__ bool active(int tile) { const int key0 = tile * 64; return key0 <= tw + 7 && key0 + 63 >= tw - W + 1; }
    __device__ __forceinline__ void apply(f32x16& s0, f32x16& s1, int tile) {
        const int rel0 = tq - tile * 64 - 4 * h;
        if (tw - tile * 64 - 63 >= 128) { const float b = lut[128];
#pragma unroll
            for (int i = 0; i < 16; ++i) { const int r0 = rel0 - KEYOFF(0, i), r1 = rel0 - KEYOFF(1, i);
                s0[i] = (unsigned)r0 < (unsigned)W ? s0[i] + b : NEG_INF; s1[i] = (unsigned)r1 < (unsigned)W ? s1[i] + b : NEG_INF; }
        } else {
#pragma unroll
            for (int i = 0; i < 16; ++i) { const int r0 = rel0 - KEYOFF(0, i), r1 = rel0 - KEYOFF(1, i);
                const float b0 = lut[min(max(r0, 0), 128)], b1 = lut[min(max(r1, 0), 128)];
                s0[i] = (unsigned)r0 < (unsigned)W ? s0[i] + b0 : NEG_INF; s1[i] = (unsigned)r1 < (unsigned)W ? s1[i] + b1 : NEG_INF; }
        }
    }
};
struct FCmp {
    int lim0, cmax_w;
    __device__ __forceinline__ bool active(int tile) { return tile * 64 <= cmax_w; }
    __device__ __forceinline__ void apply(f32x16& s0, f32x16& s1, int tile) {
        const int lim = lim0 - tile * 64;
#pragma unroll
        for (int i = 0; i < 16; ++i) { s0[i] = KEYOFF(0, i) <= lim ? s0[i] : NEG_INF; s1[i] = KEYOFF(1, i) <= lim ? s1[i] : NEG_INF; }
    }
};
struct FSlc {
    int tq, tw, h; const LAS float* lut; const LAS unsigned* bits; bool sel;
    __device__ __forceinline__ bool active(int tile) { sel = (bits[tile >> 5] >> (tile & 31)) & 1u; return __ballot(sel) != 0ull; }
    __device__ __forceinline__ void apply(f32x16& s0, f32x16& s1, int tile) {
        const int rel0 = tq - tile * 64 - 4 * h;
        if (tw - tile * 64 - 63 >= 128) { const float b = sel ? lut[128] : NEG_INF;
#pragma unroll
            for (int i = 0; i < 16; ++i) { s0[i] += b; s1[i] += b; }
        } else {
#pragma unroll
            for (int i = 0; i < 16; ++i) { const int r0 = rel0 - KEYOFF(0, i), r1 = rel0 - KEYOFF(1, i);
                const float b0 = lut[min(max(r0, 0), 128)], b1 = lut[min(max(r1, 0), 128)];
                s0[i] = (sel && r0 >= 0) ? s0[i] + b0 : NEG_INF; s1[i] = (sel && r1 >= 0) ? s1[i] + b1 : NEG_INF; }
        }
    }
};
template <class Fn>
__device__ __forceinline__ void attn_loop(LAS unsigned char* L, const TileSrc& src, int tile_lo, int ntiles, const bf16x8 (&q)[4], f32x16 (&o)[2], float& m, float& l, Fn& f, int tid, int r32, int h) {
    u32x4 kr, vr;
    tile_load(src, tile_lo * 64, true, tid, kr, vr);
#pragma unroll 1
    for (int i = 0; i < ntiles; ++i) {
        const int buf = i & 1;
        tile_store(L, buf, true, tid, kr, vr);
        if (i + 1 < ntiles) tile_load(src, (tile_lo + i + 1) * 64, true, tid, kr, vr);
        WG_BAR_LDS();
        const int tile = tile_lo + i;
        if (f.active(tile)) {
            f32x16 s0, s1; qk_tile(L + AT_K0 + buf * AT_KSZ, q, r32, h, s0, s1);
            f.apply(s0, s1, tile);
            softmax_pv(L + AT_V0 + buf * AT_VSZ, s0, s1, o, m, l, r32, h);
        }
    }
    WG_BAR_LDS();
}
__device__ __forceinline__ void build_lut(Frame& F, const float* rb) {
    LAS float* lut = (LAS float*)(F.lds + AT_LUT);
    for (int i = F.tid; i < 16 * 129; i += NWAVES * 64) { const int hh = i / 129, rel = i % 129; lut[hh * LUTS + rel] = rb[(int)BKT[rel] * 16 + hh] * LOG2E; }
    __syncthreads();
}
__device__ __forceinline__ void store_o(bf16* dst, const f32x16 (&o)[2], float sc, int h) {
#pragma unroll
    for (int dt = 0; dt < 2; ++dt)
#pragma unroll
        for (int gq = 0; gq < 4; ++gq) { u32x2 w; w.x = pkbf(o[dt][4 * gq] * sc, o[dt][4 * gq + 1] * sc); w.y = pkbf(o[dt][4 * gq + 2] * sc, o[dt][4 * gq + 3] * sc);
            *(u32x2*)(dst + 32 * dt + 8 * gq + 4 * h) = w; }
}
template <int MODE>
__device__ __forceinline__ void banded_unit(Frame& F, const float* sink, int T, int g) {
    LAS unsigned char* L = F.lds; const int tid = F.tid, lane = F.lane, w = F.wave, r32 = lane & 31, h = lane >> 5;
    const int t0 = T * 64, tw = t0 + 8 * w, tq = tw + (r32 >> 2), hg = g * 4 + (r32 & 3);
    constexpr int W = MODE == 0 ? 128 : 512;
    const bf16* Qp = (const bf16*)(F.ws + (MODE == 0 ? WS_QA : WS_QB)) + (size_t)tq * 512 + hg * 64;
    bf16x8 q[4];
#pragma unroll
    for (int ks = 0; ks < 4; ++ks) q[ks] = *(const bf16x8*)(Qp + 16 * ks + 8 * h);
    f32x16 o[2];
#pragma unroll
    for (int i = 0; i < 16; ++i) { o[0][i] = 0.f; o[1][i] = 0.f; }
    float m = -1e30f, l = 0.f;
    if (MODE == 0) { m = sink[hg] * LOG2E; l = 1.f; }
    const int tlo = max(0, t0 - W + 1) >> 6, nt = T - tlo + 1;
    TileSrc src; src.K = (const bf16*)(F.ws + (MODE == 0 ? WS_KA : WS_KW)) + (size_t)g * SEQ * 64; src.Vt = (const bf16*)(F.ws + (MODE == 0 ? WS_VTA : WS_VTW)) + (size_t)g * 64 * SEQ; src.vpitch = SEQ;
    FBand<W> f; f.tq = tq; f.tw = tw; f.h = h; f.lut = (const LAS float*)(L + AT_LUT) + ((MODE == 0 ? 0 : 8) + hg) * LUTS;
    attn_loop(L, src, tlo, nt, q, o, m, l, f, tid, r32, h);
    bf16* Op = (bf16*)(F.ws + (MODE == 0 ? WS_OA : WS_OW)) + (size_t)tq * 512 + hg * 64;
    store_o(Op, o, frcp(fmaxf(l, 1e-30f)), h);
}
__device__ __forceinline__ void compress_out(Frame& F, int b) {
    const int lane = F.lane, w = F.wave, r32 = lane & 31, h = lane >> 5;
    const int kvg = b >> 2, kv = kvg >> 1, g = kvg & 1, c0 = (b & 3) * 256 + 32 * w;
    const bf16* H = (const bf16*)(F.ws + WS_H) + (size_t)(256 * b + 32 * w + r32) * 256 + 8 * h;
    const bf16* W2 = (const bf16*)(F.ws + (kv ? WS_W2VT : WS_W2KT)) + (size_t)r32 * 256 + 8 * h;
    f32x16 a0, a1;
#pragma unroll
    for (int i = 0; i < 16; ++i) { a0[i] = 0.f; a1[i] = 0.f; }
#pragma unroll 4
    for (int ks = 0; ks < 16; ++ks) {
        const bf16x8 hf = *(const bf16x8*)(H + 16 * ks), w0 = *(const bf16x8*)(W2 + 16 * ks), w1 = *(const bf16x8*)(W2 + 32 * 256 + 16 * ks);
        if (kv == 0) { a0 = __builtin_amdgcn_mfma_f32_32x32x16_bf16(w0, hf, a0, 0, 0, 0); a1 = __builtin_amdgcn_mfma_f32_32x32x16_bf16(w1, hf, a1, 0, 0, 0); }
        else         { a0 = __builtin_amdgcn_mfma_f32_32x32x16_bf16(hf, w0, a0, 0, 0, 0); a1 = __builtin_amdgcn_mfma_f32_32x32x16_bf16(hf, w1, a1, 0, 0, 0); }
    }
    if (kv == 0) {
        const int c = c0 + r32; bf16* kc = (bf16*)(F.ws + WS_KC) + ((size_t)g * 1024 + c) * 64; const bool pad = (c == 1023);
#pragma unroll
        for (int nt = 0; nt < 2; ++nt)
#pragma unroll
            for (int gq = 0; gq < 4; ++gq) { const f32x16& a = nt ? a1 : a0; u32x2 wv; wv.x = pkbf(a[4 * gq], a[4 * gq + 1]); wv.y = pkbf(a[4 * gq + 2], a[4 * gq + 3]); if (pad) { wv.x = 0u; wv.y = 0u; }
                *(u32x2*)(kc + 32 * nt + 8 * gq + 4 * h) = wv; }
    } else {
        bf16* vct = (bf16*)(F.ws + WS_VCT) + (size_t)g * 64 * 1024;
#pragma unroll
        for (int nt = 0; nt < 2; ++nt)
#pragma unroll
            for (int gq = 0; gq < 4; ++gq) { const f32x16& a = nt ? a1 : a0; const int c = c0 + 8 * gq + 4 * h;
                u32x2 wv; wv.x = pkbf(a[4 * gq], a[4 * gq + 1]); wv.y = pkbf(a[4 * gq + 2], a[4 * gq + 3]); if (c + 3 == 1023) wv.y &= 0xffffu;
                *(u32x2*)(vct + (size_t)(32 * nt + r32) * 1024 + c) = wv; }
    }
}
__device__ __forceinline__ void nsa_unit(Frame& F, int T, int g) {
    LAS unsigned char* L = F.lds; const int tid = F.tid, lane = F.lane, w = F.wave, r32 = lane & 31, h = lane >> 5;
    const int t0 = T * 64, tw = t0 + 8 * w, ql = 8 * w + (r32 >> 2), tq = t0 + ql, hd = r32 & 3, hg = g * 4 + hd, jt = T;
    const bf16* Qp = (const bf16*)(F.ws + WS_QB) + (size_t)tq * 512 + hg * 64; bf16* Ob = (bf16*)(F.ws + WS_OB) + (size_t)tq * 512 + hg * 64;
    bf16x8 q[4];
#pragma unroll
    for (int ks = 0; ks < 4; ++ks) q[ks] = *(const bf16x8*)(Qp + 16 * ks + 8 * h);
    const float* bg = (const float*)(F.ws + WS_BG) + (size_t)tq * 24 + hg; const float g0 = bg[0], g1 = bg[8], g2 = bg[16];
    f32x16 o[2];
#pragma unroll
    for (int i = 0; i < 16; ++i) { o[0][i] = 0.f; o[1][i] = 0.f; }
    float m = -1e30f, l = 0.f;
    const int ncmp = t0 / 16 + 3, ntc = (ncmp + 63) >> 6;
    TileSrc sc; sc.K = (const bf16*)(F.ws + WS_KC) + (size_t)g * 1024 * 64; sc.Vt = (const bf16*)(F.ws + WS_VCT) + (size_t)g * 64 * 1024; sc.vpitch = 1024;
    FCmp fc; fc.lim0 = ((tq - 31) >> 4) - 4 * h; fc.cmax_w = (tw + 7 - 31) >> 4;
    attn_loop(L, sc, 0, ntc, q, o, m, l, fc, tid, r32, h);
    const float inv = frcp(fmaxf(l, 1e-30f));
    { const bf16* OWp = (const bf16*)(F.ws + WS_OW) + (size_t)tq * 512 + hg * 64; const float s0_ = g0 * inv;
#pragma unroll
      for (int dt = 0; dt < 2; ++dt)
#pragma unroll
          for (int gq = 0; gq < 4; ++gq) { const u32x2 ow = *(const u32x2*)(OWp + 32 * dt + 8 * gq + 4 * h); u32x2 wv;
              wv.x = pkbf(s0_ * o[dt][4 * gq] + g2 * bf_lo(ow.x), s0_ * o[dt][4 * gq + 1] + g2 * bf_hi(ow.x));
              wv.y = pkbf(s0_ * o[dt][4 * gq + 2] + g2 * bf_lo(ow.y), s0_ * o[dt][4 * gq + 3] + g2 * bf_hi(ow.y));
              *(u32x2*)(Ob + 32 * dt + 8 * gq + 4 * h) = wv; } }
    LAS float* imp = (LAS float*)(L + AT_IMP);
    for (int i = lane; i < 8 * 256; i += 64) imp[8 * w * 256 + i] = 0.f;
    { u32x4 kr, vr; tile_load(sc, 0, false, tid, kr, vr);
#pragma unroll 1
      for (int i = 0; i < ntc; ++i) {
          const int buf = i & 1;
          tile_store(L, buf, false, tid, kr, vr);
          if (i + 1 < ntc) tile_load(sc, (i + 1) * 64, false, tid, kr, vr);
          WG_BAR_LDS();
          if (fc.active(i)) {
              f32x16 s0, s1; qk_tile(L + AT_K0 + buf * AT_KSZ, q, r32, h, s0, s1);
              fc.apply(s0, s1, i);
#pragma unroll
              for (int kt = 0; kt < 2; ++kt) { const f32x16& s = kt ? s1 : s0; float mainv = 0.f, spv = 0.f;
#pragma unroll
                  for (int gq = 0; gq < 4; ++gq) { const float p0 = fexp2(s[4 * gq] - m) * inv, p1 = fexp2(s[4 * gq + 1] - m) * inv, p2 = fexp2(s[4 * gq + 2] - m) * inv, p3 = fexp2(s[4 * gq + 3] - m) * inv;
                      const float mq = quad_sum((p0 + p1) + (p2 + 0.5f * p3)), sq = quad_sum(0.5f * p3);
                      if (gq == hd) { mainv = mq; spv = sq; } }
                  const int j = i * 16 + 8 * kt + 2 * hd + h;
                  __hip_atomic_fetch_add(imp + ql * 256 + j, mainv, __ATOMIC_RELAXED, __HIP_MEMORY_SCOPE_WORKGROUP);
                  __hip_atomic_fetch_add(imp + ql * 256 + min(j + 1, 255), (j + 1 < 256) ? spv : 0.f, __ATOMIC_RELAXED, __HIP_MEMORY_SCOPE_WORKGROUP); }
          }
      }
      WG_BAR_LDS(); }
    LAS unsigned* selb = (LAS unsigned*)(L + AT_SEL);
#pragma unroll 1
    for (int qi = 0; qi < 8; ++qi) {
        const LAS float* row = imp + (8 * w + qi) * 256; unsigned mybits = 0u;
        if (lane == 0) mybits |= 1u;
        if (lane == (jt >> 5)) mybits |= 1u << (jt & 31);
        if (jt >= 1 && lane == ((jt - 1) >> 5)) mybits |= 1u << ((jt - 1) & 31);
        const int ncand = jt - 2;
        if (ncand > 0) {
            if (ncand <= 13) { if (lane == 0) mybits |= ((1u << (jt - 1)) - 2u); }
            else {
                unsigned k[4];
#pragma unroll
                for (int i = 0; i < 4; ++i) { const int j = lane + 64 * i; const float v = row[j]; k[i] = (j >= 1 && j <= jt - 2) ? ((__float_as_uint(v) & ~255u) | (unsigned)(255 - j)) : 0u; }
#pragma unroll 1
                for (int it = 0; it < 13; ++it) { const unsigned mx = wave_max_u32(umax_(umax_(k[0], k[1]), umax_(k[2], k[3]))); const int j = 255 - (int)(mx & 255u);
                    if (lane == (j >> 5)) mybits |= 1u << (j & 31);
#pragma unroll
                    for (int i = 0; i < 4; ++i) k[i] = (k[i] == mx) ? 0u : k[i]; }
            }
        }
        if (lane < 8) selb[(8 * w + qi) * 8 + lane] = mybits;
    }
    f32x16 o2[2];
#pragma unroll
    for (int i = 0; i < 16; ++i) { o2[0][i] = 0.f; o2[1][i] = 0.f; }
    float m2 = -1e30f, l2 = 0.f;
    TileSrc ss; ss.K = (const bf16*)(F.ws + WS_KS) + (size_t)g * SEQ * 64; ss.Vt = (const bf16*)(F.ws + WS_VTS) + (size_t)g * 64 * SEQ; ss.vpitch = SEQ;
    FSlc fs; fs.tq = tq; fs.tw = tw; fs.h = h; fs.lut = (const LAS float*)(L + AT_LUT) + (8 + hg) * LUTS; fs.bits = selb + ql * 8; fs.sel = false;
    attn_loop(L, ss, 0, jt + 1, q, o2, m2, l2, fs, tid, r32, h);
    const float s2 = g1 * frcp(fmaxf(l2, 1e-30f));
#pragma unroll
    for (int dt = 0; dt < 2; ++dt)
#pragma unroll
        for (int gq = 0; gq < 4; ++gq) { u32x2 wv; const u32x2 tt = *(const u32x2*)(Ob + 32 * dt + 8 * gq + 4 * h); const unsigned ta = tt.x, tb = tt.y;
            wv.x = pkbf(bf_lo(ta) + s2 * o2[dt][4 * gq], bf_hi(ta) + s2 * o2[dt][4 * gq + 1]); wv.y = pkbf(bf_lo(tb) + s2 * o2[dt][4 * gq + 2], bf_hi(tb) + s2 * o2[dt][4 * gq + 3]);
            *(u32x2*)(Ob + 32 * dt + 8 * gq + 4 * h) = wv; }
}

typedef float f32x2 __attribute__((ext_vector_type(2)));
__device__ __forceinline__ float dot16_fp8(const u32x4& r, const f32x2 (&xp)[8]) {
    f32x2 a = __builtin_amdgcn_cvt_pk_f32_fp8((int)r.x, false) * xp[0];
    a = __builtin_elementwise_fma(__builtin_amdgcn_cvt_pk_f32_fp8((int)r.x, true), xp[1], a);
    a = __builtin_elementwise_fma(__builtin_amdgcn_cvt_pk_f32_fp8((int)r.y, false), xp[2], a); a = __builtin_elementwise_fma(__builtin_amdgcn_cvt_pk_f32_fp8((int)r.y, true), xp[3], a);
    a = __builtin_elementwise_fma(__builtin_amdgcn_cvt_pk_f32_fp8((int)r.z, false), xp[4], a); a = __builtin_elementwise_fma(__builtin_amdgcn_cvt_pk_f32_fp8((int)r.z, true), xp[5], a);
    a = __builtin_elementwise_fma(__builtin_amdgcn_cvt_pk_f32_fp8((int)r.w, false), xp[6], a); a = __builtin_elementwise_fma(__builtin_amdgcn_cvt_pk_f32_fp8((int)r.w, true), xp[7], a);
    return a.x + a.y;
}
typedef __bf16 v2bf __attribute__((ext_vector_type(2)));
__device__ __forceinline__ float dot2bf(unsigned a, unsigned b, float c) { return __builtin_amdgcn_fdot2_f32_bf16(__builtin_bit_cast(v2bf, a), __builtin_bit_cast(v2bf, b), c, false); }
__device__ __forceinline__ unsigned ord_key(float v) { const unsigned u = __float_as_uint(v); return u ^ ((unsigned)((int)u >> 31) | 0x80000000u); }
__device__ __forceinline__ float ord_val(unsigned k) { const unsigned u = (k & 0x80000000u) ? (k ^ 0x80000000u) : ~k; return __uint_as_float(u); }
__device__ __forceinline__ void peer_top16(const bf16* qrow, LAS const unsigned char* kmat, int r32, int h2, unsigned (&sel)[16]) {
    bf16x8 qf[8];
#pragma unroll
    for (int ks = 0; ks < 8; ++ks) qf[ks] = *(const bf16x8*)(qrow + 16 * ks + 8 * h2);
    unsigned key[64];
#pragma unroll
    for (int nt = 0; nt < 4; ++nt) { f32x16 s;
#pragma unroll
        for (int i = 0; i < 16; ++i) s[i] = 0.f;
#pragma unroll
        for (int ks = 0; ks < 8; ++ks) { const bf16x8 a = *(LAS const bf16x8*)(kmat + (32 * nt + r32) * PK_ROW + (16 * ks + 8 * h2) * 2); s = __builtin_amdgcn_mfma_f32_32x32x16_bf16(a, qf[ks], s, 0, 0, 0); }
#pragma unroll
        for (int i = 0; i < 16; ++i) key[nt * 16 + i] = (ord_key(s[i]) & ~127u) | (unsigned)(((63 - (nt * 16 + i)) << 1) | (1 - h2)); }
    unsigned prev = 0xFFFFFFFFu;
#pragma unroll
    for (int k = 0; k < 16; ++k) sel[k] = 0u;
#pragma unroll 1
    for (int it = 0; it < 16; ++it) { unsigned c = 0u;
#pragma unroll
        for (int i = 0; i < 64; ++i) c = umax_(c, key[i] - prev);
        const unsigned mloc = c + prev, mm = pair_umax(mloc);
#pragma unroll
        for (int k = 0; k < 16; ++k) sel[k] = (k == it) ? mm : sel[k];
        prev = mm; }
}
__device__ __forceinline__ int key_n(unsigned k) { const int low = k & 127, Lx = 63 - (low >> 1), hh = 1 - (low & 1); return ((Lx >> 4) << 5) + (((Lx >> 2) & 3) << 3) + (hh << 2) + (Lx & 3); }

__device__ __forceinline__ void peer_phase(Frame& F, bool dry) {
    LAS unsigned char* L = F.lds; const int tid = F.tid, lane = F.lane, w = F.wave, r32 = lane & 31, h2 = lane >> 5;
    unsigned char* ws = F.ws;
    for (int i = tid; i < 2 * 128 * 16; i += NWAVES * 64) { const int which = i >> 11, rr = (i >> 4) & 127, ch = i & 15;
        *(LAS u32x4*)(L + (which ? PK2_OFF : PK1_OFF) + rr * PK_ROW + ch * 16) = *(const u32x4*)((const bf16*)(ws + (which ? WS_K2B : WS_K1B)) + rr * 128 + ch * 8); }
    __syncthreads();
    LAS unsigned char* PW = L + PW_OFF + w * PW_BYTES;
    LAS unsigned char* XR = PW; LAS u32x2* LST = (LAS u32x2*)(PW + 2048); LAS unsigned char* I12 = PW + 6144; LAS float* WL = (LAS float*)(PW + 7168);
    const bf16* Q2 = (const bf16*)(ws + WS_Q2); const unsigned char* U8 = ws + WS_U8; const unsigned char* V8 = ws + WS_V8;
    bf16* xb = (bf16*)(ws + WS_XB); const float* ssq1 = (const float*)(ws + WS_SSQ1); float* rs2 = (float*)(ws + WS_RS2);
    const int gw = F.vcu * NWAVES + w, NGW = F.G * NWAVES;
#pragma unroll 1
    for (int item = gw; item < SEQ / 4; item += NGW) {
        const int t0 = item * 4;
        {
            const int tk = r32 >> 3, hd = r32 & 7; const bf16* qrow = Q2 + (size_t)(t0 + tk) * 2048 + hd * 256;
            const float rsq = rs_from_ssq(ssq1, t0 + tk);
            unsigned s1[16], s2[16];
            peer_top16(qrow, L + PK1_OFF, r32, h2, s1);
            peer_top16(qrow + 128, L + PK2_OFF, r32, h2, s2);
            float v1[16], v2[16];
#pragma unroll
            for (int k = 0; k < 16; ++k) { v1[k] = ord_val(s1[k] & ~127u); v2[k] = ord_val(s2[k] & ~127u); }
            if (h2 == 0) { LAS unsigned* ip = (LAS unsigned*)(I12 + r32 * 32);
#pragma unroll
                for (int k4 = 0; k4 < 4; ++k4) { ip[k4] = (unsigned)key_n(s1[4 * k4]) | ((unsigned)key_n(s1[4 * k4 + 1]) << 8) | ((unsigned)key_n(s1[4 * k4 + 2]) << 16) | ((unsigned)key_n(s1[4 * k4 + 3]) << 24);
                    ip[4 + k4] = (unsigned)key_n(s2[4 * k4]) | ((unsigned)key_n(s2[4 * k4 + 1]) << 8) | ((unsigned)key_n(s2[4 * k4 + 2]) << 16) | ((unsigned)key_n(s2[4 * k4 + 3]) << 24); } }
            unsigned ck[50]; int nc = 0;
#pragma unroll
            for (int i = 0; i < 16; ++i)
#pragma unroll
                for (int j = 0; j < 16; ++j) if ((i + 1) * (j + 1) <= 16) { ck[nc] = (ord_key(v1[i] + v2[j]) & ~255u) | (unsigned)(255 - (16 * i + j)); ++nc; }
            unsigned prev = 0xFFFFFFFFu; float sc[16]; int ei[16];
#pragma unroll
            for (int it = 0; it < 16; ++it) { unsigned c = 0u;
#pragma unroll
                for (int i = 0; i < 50; ++i) c = umax_(c, ck[i] - prev);
                const unsigned mm = c + prev; prev = mm;
                const int flat = 255 - (int)(mm & 255u); sc[it] = ord_val(mm & ~255u);
                ei[it] = (int)I12[r32 * 32 + (flat >> 4)] * 128 + (int)I12[r32 * 32 + 16 + (flat & 15)]; }
            float den = 0.f, ex[16];
#pragma unroll
            for (int k = 0; k < 16; ++k) { ex[k] = fexp2((sc[k] - sc[0]) * (rsq * LOG2E)); den += ex[k]; }
            const float rd = frcp(den);
            if (h2 == 0) {
#pragma unroll
                for (int k = 0; k < 16; ++k) { u32x2 e; e.x = (unsigned)ei[k]; e.y = __float_as_uint(ex[k] * rd); LST[tk * 128 + hd * 16 + k] = e; } }
        }
#pragma unroll 1
        for (int tk = 0; tk < 4; ++tk) {
            const int t = t0 + tk;
            f32x2 xp[8];
            { const u32x4 xa = *(const u32x4*)(xb + (size_t)t * DM + lane * 16), xc = *(const u32x4*)(xb + (size_t)t * DM + lane * 16 + 8);
              xp[0] = (f32x2){bf_lo(xa.x), bf_hi(xa.x)}; xp[1] = (f32x2){bf_lo(xa.y), bf_hi(xa.y)}; xp[2] = (f32x2){bf_lo(xa.z), bf_hi(xa.z)}; xp[3] = (f32x2){bf_lo(xa.w), bf_hi(xa.w)};
              xp[4] = (f32x2){bf_lo(xc.x), bf_hi(xc.x)}; xp[5] = (f32x2){bf_lo(xc.y), bf_hi(xc.y)}; xp[6] = (f32x2){bf_lo(xc.z), bf_hi(xc.z)}; xp[7] = (f32x2){bf_lo(xc.w), bf_hi(xc.w)}; }
            const float rs = rs_from_ssq(ssq1, t) * (1.0f / 32.0f);
            const LAS u32x2* lst = LST + tk * 128;
#define PEER_LOAD8(R_, TAB_, e0_) _Pragma("unroll") for (int k = 0; k < 8; ++k) { const int idx = __builtin_amdgcn_readfirstlane((int)lst[(e0_) + k].x); R_[k] = *(const u32x4*)(TAB_ + (size_t)idx * DM + lane * 16); }
#define PEER_DOT16(r_) dot16_fp8(r_, xp)
#define PEER_UCOMP(R_, e0_) _Pragma("unroll") for (int k4 = 0; k4 < 2; ++k4) { \
                const float p0 = PEER_DOT16(R_[4 * k4]), p1 = PEER_DOT16(R_[4 * k4 + 1]), p2 = PEER_DOT16(R_[4 * k4 + 2]), p3 = PEER_DOT16(R_[4 * k4 + 3]); \
                auto s02 = __builtin_amdgcn_permlane32_swap(__float_as_uint(p0), __float_as_uint(p2), false, false); auto s13 = __builtin_amdgcn_permlane32_swap(__float_as_uint(p1), __float_as_uint(p3), false, false); \
                const float r0 = __uint_as_float(s02[0]) + __uint_as_float(s02[1]), r1 = __uint_as_float(s13[0]) + __uint_as_float(s13[1]); \
                auto s01 = __builtin_amdgcn_permlane16_swap(__float_as_uint(r0), __float_as_uint(r1), false, false); \
                float qv = __uint_as_float(s01[0]) + __uint_as_float(s01[1]); \
                qv += dpp_f<0xB1>(qv); qv += dpp_f<0x4E>(qv); qv += dpp_f<0x141>(qv); qv += dpp_f<0x140>(qv); \
                if ((lane & 15) == 0) { const int e = (e0_) + 4 * k4 + 2 * (lane >> 5) + ((lane >> 4) & 1); WL[e] = 0.25f * __uint_as_float(lst[e].y) * gelu_tanh(qv * rs); } }
            { u32x4 uR0[8], uR1[8];
              PEER_LOAD8(uR0, U8, 0);
#pragma unroll 1
              for (int e0 = 0; e0 < 128; e0 += 16) {
                  PEER_LOAD8(uR1, U8, e0 + 8);
                  PEER_UCOMP(uR0, e0);
                  if (e0 + 16 < 128) { PEER_LOAD8(uR0, U8, e0 + 16); }
                  PEER_UCOMP(uR1, e0 + 8);
              } }
            f32x2 o2[8];
#pragma unroll
            for (int i = 0; i < 8; ++i) o2[i] = (f32x2){0.f, 0.f};
#define PEER_VCOMP(R_, e0_) _Pragma("unroll") for (int k = 0; k < 8; ++k) { const float wv = WL[(e0_) + k]; const f32x2 w2 = (f32x2){wv, wv}; \
                o2[0] = __builtin_elementwise_fma(__builtin_amdgcn_cvt_pk_f32_fp8((int)R_[k].x, false), w2, o2[0]); o2[1] = __builtin_elementwise_fma(__builtin_amdgcn_cvt_pk_f32_fp8((int)R_[k].x, true), w2, o2[1]); \
                o2[2] = __builtin_elementwise_fma(__builtin_amdgcn_cvt_pk_f32_fp8((int)R_[k].y, false), w2, o2[2]); o2[3] = __builtin_elementwise_fma(__builtin_amdgcn_cvt_pk_f32_fp8((int)R_[k].y, true), w2, o2[3]); \
                o2[4] = __builtin_elementwise_fma(__builtin_amdgcn_cvt_pk_f32_fp8((int)R_[k].z, false), w2, o2[4]); o2[5] = __builtin_elementwise_fma(__builtin_amdgcn_cvt_pk_f32_fp8((int)R_[k].z, true), w2, o2[5]); \
                o2[6] = __builtin_elementwise_fma(__builtin_amdgcn_cvt_pk_f32_fp8((int)R_[k].w, false), w2, o2[6]); o2[7] = __builtin_elementwise_fma(__builtin_amdgcn_cvt_pk_f32_fp8((int)R_[k].w, true), w2, o2[7]); }
            { u32x4 vR0[8], vR1[8];
              PEER_LOAD8(vR0, V8, 0);
#pragma unroll 1
              for (int e0 = 0; e0 < 128; e0 += 16) {
                  PEER_LOAD8(vR1, V8, e0 + 8);
                  PEER_VCOMP(vR0, e0);
                  if (e0 + 16 < 128) { PEER_LOAD8(vR0, V8, e0 + 16); }
                  PEER_VCOMP(vR1, e0 + 8);
              } }
            float* op = F.out + (size_t)t * DM + lane * 16;
            float* od = dry ? (float*)(ws + WS_PB) + (size_t)gw * DM + lane * 16 : op; bf16* xd = dry ? (bf16*)(ws + WS_PB + 8 * MiB) + (size_t)gw * DM : xb + (size_t)t * DM; float* rd2 = dry ? (float*)(ws + WS_PB + 12 * MiB) + gw : rs2 + t;
            f32x4 a0 = *(const f32x4*)op, a1 = *(const f32x4*)(op + 4), b0 = *(const f32x4*)(op + 8), b1 = *(const f32x4*)(op + 12);
            a0[0] += o2[0].x; a0[1] += o2[0].y; a0[2] += o2[1].x; a0[3] += o2[1].y; a1[0] += o2[2].x; a1[1] += o2[2].y; a1[2] += o2[3].x; a1[3] += o2[3].y;
            b0[0] += o2[4].x; b0[1] += o2[4].y; b0[2] += o2[5].x; b0[3] += o2[5].y; b1[0] += o2[6].x; b1[1] += o2[6].y; b1[2] += o2[7].x; b1[3] += o2[7].y;
            *(f32x4*)od = a0; *(f32x4*)(od + 4) = a1; *(f32x4*)(od + 8) = b0; *(f32x4*)(od + 12) = b1;
            *(u32x4*)(xd + lane * 16) = pack8(a0, a1); *(u32x4*)(xd + lane * 16 + 8) = pack8(b0, b1);
            float ss = 0.f;
#pragma unroll
            for (int i = 0; i < 4; ++i) ss += a0[i] * a0[i] + a1[i] * a1[i] + b0[i] * b0[i] + b1[i] * b1[i];
            ss = wave_sum(ss);
            if (lane == 0) *rd2 = __builtin_amdgcn_rsqf(ss * (1.0f / DM) + EPS);
        }
    }
}
__device__ __forceinline__ void convert_peer_tables(Frame& F, const float* u, const float* v, const float* g) {
    const int gt = (F.vcu * NWAVES + F.wave) * 64 + F.lane, NGT = F.G * NWAVES * 64;
    unsigned char* U8 = F.ws + WS_U8; unsigned char* V8 = F.ws + WS_V8;
    for (int i = gt; i < 16384 * 1024 / 16; i += NGT) {
        const int d0 = (i & 63) * 16; u32x4 wu, wv;
#pragma unroll
        for (int q = 0; q < 4; ++q) { const f32x4 gq = *(const f32x4*)(g + d0 + 4 * q) * 32.0f; const f32x4 a = *(const f32x4*)(u + (size_t)i * 16 + 4 * q) * gq, c = *(const f32x4*)(v + (size_t)i * 16 + 4 * q) * 4.0f;
            int pu = __builtin_amdgcn_cvt_pk_fp8_f32(a[0], a[1], 0, false); pu = __builtin_amdgcn_cvt_pk_fp8_f32(a[2], a[3], pu, true);
            int pv = __builtin_amdgcn_cvt_pk_fp8_f32(c[0], c[1], 0, false); pv = __builtin_amdgcn_cvt_pk_fp8_f32(c[2], c[3], pv, true);
            wu[q] = (unsigned)pu; wv[q] = (unsigned)pv; }
        *(u32x4*)(U8 + (size_t)i * 16) = wu; *(u32x4*)(V8 + (size_t)i * 16) = wv;
    }
}
__device__ __forceinline__ void final_norm(Frame& F, const float* gf, float* dst) {
    const int gw = F.vcu * NWAVES + F.wave, NGW = F.G * NWAVES, lane = F.lane;
    f32x4 gv[4];
#pragma unroll
    for (int j = 0; j < 4; ++j) gv[j] = ((const f32x4*)gf)[lane + 64 * j];
    for (int row = gw; row < SEQ; row += NGW) {
        f32x4* xr = (f32x4*)(F.out + (size_t)row * DM) + lane; f32x4 v[4]; float ss = 0.f;
#pragma unroll
        for (int j = 0; j < 4; ++j) { v[j] = xr[64 * j]; ss += (v[j][0] * v[j][0] + v[j][1] * v[j][1]) + (v[j][2] * v[j][2] + v[j][3] * v[j][3]); }
        const float rs = __builtin_amdgcn_rsqf(wave_sum(ss) * (1.0f / DM) + EPS);
        f32x4* dr = (f32x4*)(dst + (size_t)row * DM) + lane;
#pragma unroll
        for (int j = 0; j < 4; ++j) dr[64 * j] = v[j] * rs * gv[j];
    }
}

constexpr int NPHASE = 10;
__global__ void __launch_bounds__(NWAVES * 64, 2) hybrid_fwd(Args args) {
    extern __shared__ __attribute__((aligned(16))) unsigned char lds[];
    Frame F;
    F.lds = (LAS unsigned char*)lds; F.MISC = (volatile LAS unsigned*)(F.lds + LDSCTL_OFF);
    F.tid = threadIdx.x; F.lane = F.tid & 63; F.wave = __builtin_amdgcn_readfirstlane(F.tid >> 6);
    F.G = gridDim.x; { const int bx = blockIdx.x; F.vcu = (F.G % 8 == 0) ? (bx % 8) * (F.G / 8) + bx / 8 : bx; }
    F.ws = args.ws; F.ctl = (gu32*)(args.ws + WS_CTL); F.out = args.out;
    for (int u = F.tid; u < (LDS_BYTES - LDSCTL_OFF) / 4; u += NWAVES * 64) ((LAS unsigned*)(F.lds + LDSCTL_OFF))[u] = 0u;
    __syncthreads();
    const int lo = args.ph_lo, hi = args.ph_hi;
    XcdBarrier bar = xcd_barrier_post((unsigned*)(F.ctl + CW_BAR) + args.li * XCD_BAR_WORDS, F.MISC + 8);
#ifndef PHASE_MASK
#define PHASE_MASK 0xFFFF
#endif
#define IN(k) (((PHASE_MASK >> (k)) & 1) && lo <= (k) && (k) < hi)
#define SEAM(k) do { if (IN(k) && IN((k) + 1)) xcd_barrier(bar); } while (0)
    unsigned char* ws = args.ws;
    const int G = F.G, bx = (int)blockIdx.x;
#if defined(PROBE_REPEAT)
    const bool dry = (args.li == 1);
#else
    constexpr bool dry = false;
#endif

    if (IN(0)) { p0_prologue(F, args); }
    SEAM(0);
    if (IN(1)) {
        pg8::Gemm g{(const bf16*)(ws + WS_XB), (const bf16*)(ws + WS_WIN), SEQ, N1, DM, DM, DM}; pg8::StaticOrder S; S.init(SEQ, N1, G, bx);
#if defined(PROBE_NULLEPI)
        if (args.li == PROBE_NULLEPI_LI) { EpiNull E0; pg8::gemm_phase<EpiNull, pg8::StaticOrder, true, true>(F.lds, g, S, E0); } else
#endif
        { Epi1 E{(const float*)(ws + WS_RS0), ws};
        pg8::gemm_phase<Epi1, pg8::StaticOrder, true, true>(F.lds, g, S, E); }
    }
    SEAM(1);
    if (IN(2)) {
        { pg8::Gemm g{(const bf16*)(ws + WS_CK), (const bf16*)(ws + WS_W1KV), 4096, 512, 2048, 1024, 2048}; pg8::OneUnit S{bx, bx >> 3, bx < 16 ? 1 : 0};
          EpiCmp E{(bf16*)(ws + WS_H), (const float*)(ws + WS_POSB)};
          pg8::gemm_phase<EpiCmp, pg8::OneUnit, false, true>(F.lds, g, S, E);
          if (bx < 16) { __threadfence(); __syncthreads(); compress_out(F, bx); } }
        __syncthreads();
        build_lut(F, args.in[5]);
        for (;;) {
            __syncthreads();
            if (F.tid == 0) F.MISC[16] = __hip_atomic_fetch_add(F.ctl + CW_QUEUE + args.li * 64, 1u, RLX_AGENT);
            __syncthreads();
            const int unit = (int)F.MISC[16];
            if (unit >= 1024) break;
            if (unit < 512) banded_unit<1>(F, args.in[4], unit >> 1, unit & 1); else banded_unit<0>(F, args.in[4], (unit - 512) >> 1, unit & 1);
        }
    }
    SEAM(2);
    if (IN(3)) {
        build_lut(F, args.in[5]);
        for (int i = bx; i < 256; i += G) { nsa_unit(F, 255 - i, 1); nsa_unit(F, i, 0); }
    }
    SEAM(3);
    if (IN(4)) {
        { pg8::Gemm g{(const bf16*)(ws + WS_OA), (const bf16*)(ws + WS_WUPA), SEQ, DM, 512, 512, 512}; pg8::StaticOrder S; S.init(SEQ, DM, G, bx); EpiUp E{(bf16*)(ws + WS_MG), 0, (bf16*)(ws + (dry ? WS_QA : WS_MG))};
          pg8::gemm_phase<EpiUp, pg8::StaticOrder, true, true>(F.lds, g, S, E); }
        { pg8::Gemm g{(const bf16*)(ws + WS_OB), (const bf16*)(ws + WS_WUPB), SEQ, DM, 512, 512, 512}; pg8::StaticOrder S; S.init(SEQ, DM, G, bx); EpiUp E{(bf16*)(ws + WS_MG), 1024, (bf16*)(ws + (dry ? WS_QA : WS_MG))};
          pg8::gemm_phase<EpiUp, pg8::StaticOrder, true, true>(F.lds, g, S, E); }
    }
    SEAM(4);
    if (IN(5)) {
        { pg8::Gemm g{(const bf16*)(ws + WS_MG), (const bf16*)(ws + WS_WO2), SEQ, DM, 2048, 2048, 2048}; pg8::StaticOrder S; S.init(SEQ, DM, G, bx);
          EpiWo E{args.in[0], F.out, (bf16*)(ws + WS_XB), (float*)(ws + WS_SSQ1)};
          pg8::gemm_phase<EpiWo, pg8::StaticOrder, true, true>(F.lds, g, S, E); }
        convert_peer_tables(F, args.in[18], args.in[19], args.in[14]);
    }
    SEAM(5);
    if (IN(6)) {
        { pg8::Gemm g{(const bf16*)(ws + WS_XB), (const bf16*)(ws + WS_WQ), SEQ, 2048, DM, DM, DM}; pg8::StaticOrder S; S.init(SEQ, 2048, G, bx); EpiPw E{(bf16*)(ws + WS_Q2), 2048};
          pg8::gemm_phase<EpiPw, pg8::StaticOrder, true, true>(F.lds, g, S, E); }
        { pg8::Gemm g{(const bf16*)(ws + WS_PB), (const bf16*)(ws + WS_WPLE), SEQ, DM, 256, 256, 256}; pg8::StaticOrder S; S.init(SEQ, DM, G, bx); EpiPw E{(bf16*)(ws + WS_PW), DM};
          pg8::gemm_phase<EpiPw, pg8::StaticOrder, true, true>(F.lds, g, S, E); }
    }
    SEAM(6);
    if (IN(7)) { __syncthreads(); peer_phase(F, dry); }
    SEAM(7);
    if (IN(8)) {
        pg8::Gemm g{(const bf16*)(ws + WS_XB), (const bf16*)(ws + WS_WPG), SEQ, DM, DM, DM, DM}; pg8::StaticOrder S; S.init(SEQ, DM, G, bx);
        EpiPle E{(const float*)(ws + WS_RS2), (const bf16*)(ws + WS_PW), F.out, dry ? (float*)(ws + WS_Q2) : F.out};
        pg8::gemm_phase<EpiPle, pg8::StaticOrder, true, true>(F.lds, g, S, E);
    }
    SEAM(8);
    if (IN(9)) final_norm(F, args.in[23], dry ? (float*)(ws + WS_Q2) : F.out);
#undef IN
#undef SEAM
}

#ifndef MK_ONE_LAUNCH
#define MK_ONE_LAUNCH 1
#endif
extern "C" void kernel_launch(void* const* d_in, const int* in_sizes, int n_in, void* d_out, int out_size, void* d_ws, size_t ws_size, hipStream_t stream) {
    static int grid = 0;
    if (grid == 0) {
        if (n_in != 24 || in_sizes[0] != SEQ * DM || out_size != SEQ * DM || ws_size < WS_END) { fprintf(stderr, "kernel_launch: unexpected shapes (n_in %d, in0 %d, out %d, ws %zu); nothing launched\n", n_in, n_in > 0 ? in_sizes[0] : -1, out_size, ws_size); grid = -1; return; }
        int dev = 0, cus = 0, per_cu = 0;
        if (hipGetDevice(&dev) != hipSuccess || hipDeviceGetAttribute(&cus, hipDeviceAttributeMultiprocessorCount, dev) != hipSuccess) { grid = -1; return; }
        if (hipFuncSetAttribute((const void*)hybrid_fwd, hipFuncAttributeMaxDynamicSharedMemorySize, LDS_BYTES) != hipSuccess) { fprintf(stderr, "kernel_launch: hipFuncSetAttribute failed\n"); grid = -1; return; }
        if (hipOccupancyMaxActiveBlocksPerMultiprocessor(&per_cu, (const void*)hybrid_fwd, NWAVES * 64, LDS_BYTES) != hipSuccess || per_cu < 1) { fprintf(stderr, "kernel_launch: occupancy query says %d blocks per CU\n", per_cu); }
        (void)hipGetLastError();
        grid = cus;
    }
    if (grid < 0) return;
    if (hipMemsetAsync((char*)d_ws + WS_CTL, 0, CTL_ZERO_BYTES, stream) != hipSuccess) return;
    Args a{};
    for (int i = 0; i < 24; ++i) a.in[i] = (const float*)d_in[i];
    a.out = (float*)d_out; a.ws = (unsigned char*)d_ws;
#if defined(PROBE_REPEAT)
    const int cuts[4] = {0, PROBE_REPEAT + 1, PROBE_REPEAT, NPHASE};
    for (int li = 0; li < 3; ++li) { a.ph_lo = li == 0 ? 0 : li == 1 ? PROBE_REPEAT : PROBE_REPEAT + 1; a.ph_hi = li == 0 ? PROBE_REPEAT + 1 : li == 1 ? PROBE_REPEAT + 1 : NPHASE; a.li = li; (void)cuts;
        if (a.ph_lo < a.ph_hi) hipLaunchKernelGGL(hybrid_fwd, dim3(grid), dim3(NWAVES * 64), LDS_BYTES, stream, a); }
#elif MK_ONE_LAUNCH
    a.ph_lo = 0; a.ph_hi = NPHASE; a.li = 0;
    hipLaunchKernelGGL(hybrid_fwd, dim3(grid), dim3(NWAVES * 64), LDS_BYTES, stream, a);
#else
    for (int p = 0; p < NPHASE; ++p) { a.ph_lo = p; a.ph_hi = p + 1; a.li = 0; hipLaunchKernelGGL(hybrid_fwd, dim3(grid), dim3(NWAVES * 64), LDS_BYTES, stream, a); }
#endif
}
```

```cpp
#include <hip/hip_runtime.h>
#include <cstdio>
#include <cstdint>

#define GAS __attribute__((address_space(1)))
#define LAS __attribute__((address_space(3)))
typedef unsigned short bf16;
typedef short bf16x8 __attribute__((ext_vector_type(8)));
typedef short s16x4 __attribute__((ext_vector_type(4)));
typedef float f32x4 __attribute__((ext_vector_type(4)));
typedef float f32x16 __attribute__((ext_vector_type(16)));
typedef unsigned u32x4 __attribute__((ext_vector_type(4)));
typedef unsigned u32x2 __attribute__((ext_vector_type(2)));
typedef _Float16 h16x8 __attribute__((ext_vector_type(8)));
typedef GAS unsigned gu32;
typedef float f32x2_t __attribute__((ext_vector_type(2))); typedef __bf16 bf16x2_t __attribute__((ext_vector_type(2)));
__device__ __forceinline__ unsigned pkbf(float lo, float hi) { f32x2_t v = {lo, hi}; bf16x2_t b = __builtin_convertvector(v, bf16x2_t); return __builtin_bit_cast(unsigned, b); }
__device__ __forceinline__ float bf_lo(unsigned u) { return __uint_as_float(u << 16); }
__device__ __forceinline__ float bf_hi(unsigned u) { return __uint_as_float(u & 0xffff0000u); }
__device__ __forceinline__ float fexp2(float x) { return __builtin_amdgcn_exp2f(x); }
__device__ __forceinline__ float frcp(float x) { return __builtin_amdgcn_rcpf(x); }
__device__ __forceinline__ float sigmoidf_(float x) { return frcp(1.0f + fexp2(-1.4426950408889634f * x)); }
__device__ __forceinline__ float gelu_tanh(float x) { const float u = x * (1.0f + 0.044715f * x * x); return x * frcp(1.0f + fexp2(-2.302208198f * u)); }
#define LOG2E 1.4426950408889634f
#define RLX_AGENT __ATOMIC_RELAXED, __HIP_MEMORY_SCOPE_AGENT
#define LDS_WAIT() asm volatile("s_waitcnt lgkmcnt(0)" ::: "memory")
#define VM_WAIT() asm volatile("s_waitcnt vmcnt(0)" ::: "memory")

namespace pg8 {
#define PG8_LAS __attribute__((address_space(3)))
typedef unsigned short bf16_t;
typedef short bf16x8 __attribute__((ext_vector_type(8)));
typedef float f32x4 __attribute__((ext_vector_type(4)));
typedef unsigned u32x4 __attribute__((ext_vector_type(4)));
constexpr int BM = 256, BK = 64, HALF = 128, HTB = HALF * BK * 2  , STAGE_BYTES = 8 * HTB, NXCD = 8, WGM = 8;

__host__ __device__ __forceinline__ int lds_byte(int r, int c) { const int st = (r >> 4) * 2 + (c >> 5), rr = r & 15, cc = c & 31, ob = rr * 64 + cc * 2; return st * 1024 + (ob ^ (((ob >> 9) & 1) << 5)); }
__host__ __device__ __forceinline__ void stage_rc(int b, int& R, int& C) { const int st = b / 1024, sb = b % 1024, swz = sb ^ (((sb >> 9) & 1) << 5); R = (st >> 1) * 16 + swz / 64; C = (st & 1) * 32 + (swz % 64) / 2; }
__host__ __device__ __forceinline__ int perm32(int rho) { const int n = rho >> 4, i = rho & 15; return 8 * (i >> 2) + 4 * n + (i & 3); }

struct Unit { int pm, pn; };
struct Gemm { const bf16_t* A; const bf16_t* Bt; int M, N, K, lda, ldb; };

struct StaticOrder {
    int nM, nN, nwg, G, c;
    __host__ __device__ void init(int M, int N, int G_, int c_) { nM = M / BM; nN = N / BM; nwg = nM * nN; G = G_; c = c_; }
    __host__ __device__ bool next(int i, Unit& u) const {
        const long L = (long)i * G + c; if (L >= nwg) return false;
        int wgid = (int)L; { const int q = nwg / NXCD, r = nwg % NXCD, xcd = wgid % NXCD, off = wgid / NXCD; wgid = (xcd < r ? xcd * (q + 1) : r * (q + 1) + (xcd - r) * q) + off; }
        const int nig = WGM * nN, gid = wgid / nig, fm = gid * WGM, gsz = (nM - fm) < WGM ? (nM - fm) : WGM;
        u.pm = fm + ((wgid % nig) % gsz); u.pn = (wgid % nig) / gsz; return true;
    }
    __device__ __forceinline__ void a_ready(const Unit&) const {}
    __device__ __forceinline__ void done(const Unit&) const {}
};
struct OneUnit {
    int pm, pn, has;
    __device__ bool next(int i, Unit& u) const { if (i == 0 && has) { u.pm = pm; u.pn = pn; return true; } return false; }
    __device__ __forceinline__ void a_ready(const Unit&) const {}
    __device__ __forceinline__ void done(const Unit&) const {}
};
template <class Epi, class Sched, bool ALIGN_EPI = false, bool SP2 = false>
__device__ __forceinline__ void gemm_phase(PG8_LAS unsigned char* lds, const Gemm g, const Sched& S, const Epi& E) {
    const int tid = threadIdx.x, wid = __builtin_amdgcn_readfirstlane(tid >> 6), lane = tid & 63, wr = wid >> 2, wc = wid & 3, fr = lane & 15, fq = lane >> 4;
    const int K = g.K, nt = K / BK;
    unsigned voffA[2], voffB[2];
#pragma unroll
    for (int i = 0; i < 2; ++i) { int R, C; stage_rc(tid * 16 + i * 8192, R, C); const int Rb = Epi::PERM ? ((R & ~31) + perm32(R & 31)) : R;
        voffA[i] = (unsigned)(R * g.lda + C) * 2u; voffB[i] = (unsigned)(Rb * g.ldb + C) * 2u; }
    const size_t kstep = (size_t)(BK * 2);
    const size_t hstepA = (size_t)HALF * g.lda * 2, hstepB = (size_t)HALF * g.ldb * 2;
    const size_t tstepA = 2 * hstepA, tstepB = 2 * hstepB;
    const unsigned ldsw = (unsigned)wid * 1024u;
    const int aoff = lds_byte(wr * 64 + fr, fq * 8), boff = lds_byte(wc * 32 + fr, fq * 8);
#define PG8_SA(b, h) (((b) * 2 + (h)) * HTB)
#define PG8_SB(b, h) ((4 + (b) * 2 + (h)) * HTB)
#define PG8_STAGE(bufoff, gbase, voff) do { _Pragma("unroll") for (int _i = 0; _i < 2; ++_i) \
        __builtin_amdgcn_global_load_lds((const unsigned*)((const char*)(gbase) + (voff)[_i]), (PG8_LAS unsigned*)(lds + (bufoff) + ldsw + _i * 8192), 16, 0, 0); } while (0)
#define PG8_LDA(dst, b, h) do { _Pragma("unroll") for (int m = 0; m < 4; ++m) _Pragma("unroll") for (int k = 0; k < 2; ++k) dst[m][k] = *(const PG8_LAS bf16x8*)(lds + PG8_SA(b, h) + aoff + m * 2048 + k * 1024); } while (0)
#define PG8_LDB(dst, b, h) do { _Pragma("unroll") for (int n = 0; n < 2; ++n) _Pragma("unroll") for (int k = 0; k < 2; ++k) dst[n][k] = *(const PG8_LAS bf16x8*)(lds + PG8_SB(b, h) + boff + n * 2048 + k * 1024); } while (0)
#define PG8_MMA(ai, bj, At, Bt) do { __builtin_amdgcn_s_setprio(1); _Pragma("unroll") for (int m = 0; m < 4; ++m) _Pragma("unroll") for (int n = 0; n < 2; ++n) _Pragma("unroll") for (int k = 0; k < 2; ++k) \
        acc[ai][bj][m][n] = __builtin_amdgcn_mfma_f32_16x16x32_bf16(Bt[n][k], At[m][k], acc[ai][bj][m][n], 0, 0, 0); __builtin_amdgcn_s_setprio(0); } while (0)
#define PG8_WAIT_V(n) asm volatile("s_waitcnt vmcnt(" #n ")" ::: "memory")
#define PG8_WAIT_L(n) asm volatile("s_waitcnt lgkmcnt(" #n ")" ::: "memory")
#define PG8_BAR __builtin_amdgcn_s_barrier()
#define PG8_SCHED __builtin_amdgcn_sched_barrier(0)
    Unit cur, nxt; int ui = 0;
    if (!S.next(0, cur)) return;
    f32x4 acc[2][2][4][2];
#pragma unroll
    for (int a = 0; a < 2; ++a)
#pragma unroll
        for (int b = 0; b < 2; ++b)
#pragma unroll
            for (int m = 0; m < 4; ++m)
#pragma unroll
                for (int n = 0; n < 2; ++n) acc[a][b][m][n] = (f32x4){0.f, 0.f, 0.f, 0.f};
    bf16x8 At[4][2], B0[2][2], B1[2][2];
    const char* cA = (const char*)g.A + (size_t)cur.pm * tstepA; const char* cB = (const char*)g.Bt + (size_t)cur.pn * tstepB;
    S.a_ready(cur);
    if constexpr (SP2) {
        PG8_STAGE(PG8_SB(0, 0), cB, voffB); PG8_STAGE(PG8_SB(0, 1), cB + hstepB, voffB); PG8_STAGE(PG8_SA(0, 0), cA, voffA); PG8_STAGE(PG8_SA(0, 1), cA + hstepA, voffA);
        if (wr == 1) PG8_BAR;
        PG8_WAIT_V(2); PG8_BAR;
        PG8_STAGE(PG8_SB(1, 0), cB + kstep, voffB); PG8_STAGE(PG8_SA(1, 0), cA + kstep, voffA); PG8_STAGE(PG8_SB(1, 1), cB + hstepB + kstep, voffB);
        PG8_WAIT_V(6); PG8_BAR;
    } else {
        PG8_STAGE(PG8_SB(0, 0), cB, voffB); PG8_STAGE(PG8_SA(0, 0), cA, voffA); PG8_STAGE(PG8_SB(0, 1), cB + hstepB, voffB); PG8_STAGE(PG8_SA(0, 1), cA + hstepA, voffA);
        if (wr == 1) PG8_BAR;
        PG8_WAIT_V(4); PG8_BAR;
        PG8_STAGE(PG8_SB(1, 0), cB + kstep, voffB); PG8_STAGE(PG8_SA(1, 0), cA + kstep, voffA); PG8_STAGE(PG8_SB(1, 1), cB + hstepB + kstep, voffB);
        PG8_WAIT_V(6); PG8_BAR;
    }
    for (;;) {
        const bool has_next = S.next(ui + 1, nxt);
        const char* nA = has_next ? (const char*)g.A + (size_t)nxt.pm * tstepA : cA; const char* nB = has_next ? (const char*)g.Bt + (size_t)nxt.pn * tstepB : cB;
        for (int t = 0; t < nt; t += 2) {
            const bool last = (t == nt - 2);
            const char* a1 = cA + (size_t)(t + 1) * kstep;
            const char* a2 = last ? nA : cA + (size_t)(t + 2) * kstep; const char* b2 = last ? nB : cB + (size_t)(t + 2) * kstep;
            const char* a3 = a2 + kstep; const char* b3 = b2 + kstep;
            if (last && has_next) S.a_ready(nxt);
            if constexpr (SP2) {
            PG8_LDB(B0, 0, 0); PG8_LDB(B1, 0, 1); PG8_SCHED; PG8_LDA(At, 0, 0); PG8_STAGE(PG8_SA(1, 1), a1 + hstepA, voffA);
            PG8_WAIT_V(8); PG8_WAIT_L(0); PG8_BAR; PG8_MMA(0, 0, At, B0); PG8_MMA(0, 1, At, B1); PG8_BAR; PG8_SCHED;
            PG8_LDA(At, 0, 1); PG8_STAGE(PG8_SB(0, 0), b2, voffB); PG8_STAGE(PG8_SB(0, 1), b2 + hstepB, voffB); PG8_STAGE(PG8_SA(0, 0), a2, voffA);
            PG8_WAIT_V(8); PG8_WAIT_L(0); PG8_BAR; PG8_MMA(1, 0, At, B0); PG8_MMA(1, 1, At, B1); PG8_BAR; PG8_SCHED;
            PG8_LDB(B0, 1, 0); PG8_LDB(B1, 1, 1); PG8_SCHED; PG8_LDA(At, 1, 0); PG8_STAGE(PG8_SA(0, 1), a2 + hstepA, voffA);
            PG8_WAIT_V(8); PG8_WAIT_L(0); PG8_BAR; PG8_MMA(0, 0, At, B0); PG8_MMA(0, 1, At, B1); PG8_BAR; PG8_SCHED;
            PG8_LDA(At, 1, 1); PG8_STAGE(PG8_SB(1, 0), b3, voffB); PG8_STAGE(PG8_SB(1, 1), b3 + hstepB, voffB); PG8_STAGE(PG8_SA(1, 0), a3, voffA);
            PG8_WAIT_V(8); PG8_WAIT_L(0); PG8_BAR; PG8_MMA(1, 0, At, B0); PG8_MMA(1, 1, At, B1); PG8_BAR; PG8_SCHED;
            } else {
            PG8_LDB(B0, 0, 0); PG8_SCHED; PG8_LDA(At, 0, 0); PG8_STAGE(PG8_SA(1, 1), a1 + hstepA, voffA);
            PG8_WAIT_L(8); PG8_BAR; PG8_WAIT_L(0); PG8_MMA(0, 0, At, B0); PG8_BAR; PG8_SCHED;
            PG8_LDB(B1, 0, 1); PG8_STAGE(PG8_SB(0, 0), b2, voffB);
            PG8_BAR; PG8_WAIT_L(0); PG8_MMA(0, 1, At, B1); PG8_BAR;
            PG8_LDA(At, 0, 1); PG8_STAGE(PG8_SA(0, 0), a2, voffA);
            PG8_BAR; PG8_WAIT_L(0); PG8_MMA(1, 0, At, B0); PG8_BAR; PG8_SCHED;
            PG8_STAGE(PG8_SB(0, 1), b2 + hstepB, voffB);
            PG8_WAIT_V(6); PG8_BAR; PG8_MMA(1, 1, At, B1); PG8_BAR;
            PG8_LDB(B0, 1, 0); PG8_SCHED; PG8_LDA(At, 1, 0); PG8_STAGE(PG8_SA(0, 1), a2 + hstepA, voffA);
            PG8_WAIT_L(8); PG8_BAR; PG8_WAIT_L(0); PG8_MMA(0, 0, At, B0); PG8_BAR; PG8_SCHED;
            PG8_LDB(B1, 1, 1); PG8_STAGE(PG8_SB(1, 0), b3, voffB);
            PG8_BAR; PG8_WAIT_L(0); PG8_MMA(0, 1, At, B1); PG8_BAR;
            PG8_LDA(At, 1, 1); PG8_STAGE(PG8_SA(1, 0), a3, voffA);
            PG8_BAR; PG8_WAIT_L(0); PG8_MMA(1, 0, At, B0); PG8_BAR; PG8_SCHED;
            PG8_STAGE(PG8_SB(1, 1), b3 + hstepB, voffB);
            PG8_WAIT_V(6); PG8_BAR; PG8_MMA(1, 1, At, B1); PG8_BAR;
            }
        }
        if constexpr (ALIGN_EPI) { if (wr == 0) PG8_BAR; }
        if constexpr (!Epi::AFTER_DRAIN) { E(acc, cur, wr, wc, fr, fq); S.done(cur); }
        if (!has_next) break;
#pragma unroll
        for (int a = 0; a < 2; ++a)
#pragma unroll
            for (int b = 0; b < 2; ++b)
#pragma unroll
                for (int m = 0; m < 4; ++m)
#pragma unroll
                    for (int n = 0; n < 2; ++n) acc[a][b][m][n] = (f32x4){0.f, 0.f, 0.f, 0.f};
        cur = nxt; cA = nA; cB = nB; ++ui;
        if constexpr (ALIGN_EPI) { if (wr == 1) PG8_BAR; }
    }
    PG8_WAIT_V(0);
    if constexpr (!ALIGN_EPI) { if (wr == 0) PG8_BAR; }
    PG8_BAR;
    if constexpr (Epi::AFTER_DRAIN) { E.fused(acc, cur, wr, wc, fr, fq, lds, wid, lane); S.done(cur); }
#undef PG8_SA
#undef PG8_SB
#undef PG8_STAGE
#undef PG8_LDA
#undef PG8_LDB
#undef PG8_MMA
#undef PG8_WAIT_V
#undef PG8_WAIT_L
#undef PG8_BAR
#undef PG8_SCHED
}
}
#undef PG8_LAS
#define XB_TMO      128
#define XB_XCNT(j)  (256  + 64 * (j))
#define XB_XSUB(j)  (1280 + 64 * (j))
#define XB_XGEN(j)  (2304 + 64 * (j))
#define XB_TOP      3328
#define XB_TOPGEN   3392
#define XCD_BAR_WORDS 3456
#define XB_SPIN_CAP (1u << 18)

__device__ __forceinline__ unsigned xb_ld(unsigned* p)              { return __hip_atomic_load(p, __ATOMIC_RELAXED, __HIP_MEMORY_SCOPE_AGENT); }
__device__ __forceinline__ unsigned xb_add(unsigned* p, unsigned v) { return __hip_atomic_fetch_add(p, v, __ATOMIC_RELAXED, __HIP_MEMORY_SCOPE_AGENT); }
__device__ __forceinline__ unsigned xb_xcc_id() { return (unsigned)__builtin_amdgcn_s_getreg((3 << 11) | 20) & 0xFu; }
#define XB_SPIN(cond, bar) do { unsigned _sp = 0; while (cond) { __builtin_amdgcn_s_sleep(1); \
    if ((++_sp & 255u) == 0u) { if (xb_ld(&(bar)[XB_TMO])) break; if (_sp > XB_SPIN_CAP) { atomicAdd(&(bar)[XB_TMO], 1u); break; } } } } while (0)

struct XcdBarrier {
    unsigned* bar; unsigned x;
    volatile LAS unsigned* st;
};

__device__ __forceinline__ XcdBarrier xcd_barrier_post(unsigned* bar, volatile LAS unsigned* st) {
    XcdBarrier b; b.bar = bar; b.x = xb_xcc_id(); b.st = st;
    if (threadIdx.x == 0) (void)xb_add(&bar[XB_XCNT(b.x)], 1u);
    return b;
}
__device__ __forceinline__ void xcd_barrier_complete(unsigned* bar, unsigned x, unsigned& nloc, unsigned& nx) {
    const unsigned G = gridDim.x * gridDim.y * gridDim.z;
    unsigned sum, cnt, mine, sp = 0u;
    for (;;) {
        sum = 0u; cnt = 0u; mine = 0u;
#pragma unroll
        for (unsigned j = 0; j < 16; ++j) { const unsigned c = xb_ld(&bar[XB_XCNT(j)]); sum += c; cnt += (c > 0u) ? 1u : 0u; mine = (j == x) ? c : mine; }
        if (sum == G) break;
        __builtin_amdgcn_s_sleep(1);
        if ((++sp & 255u) == 0u) { if (xb_ld(&bar[XB_TMO])) break; if (sp > XB_SPIN_CAP) { atomicAdd(&bar[XB_TMO], 1u); break; } }
    }
    nloc = mine > 0u ? mine : 1u; nx = cnt > 0u ? cnt : 1u;
}

__device__ __forceinline__ void xcd_barrier(const XcdBarrier& b) {
    asm volatile("s_waitcnt vmcnt(0)" ::: "memory");
    __syncthreads();
    if (threadIdx.x == 0) {
        unsigned* bar = b.bar;
        __builtin_amdgcn_s_waitcnt(0);
        unsigned nloc = b.st[0], nx = b.st[1];
        if (nloc == 0u) { xcd_barrier_complete(bar, b.x, nloc, nx); b.st[0] = nloc; b.st[1] = nx; }
        const unsigned old = xb_add(&bar[XB_XSUB(b.x)], 1u);
        const unsigned gen = old / nloc;
        if (old + 1u == (gen + 1u) * nloc) {
            __builtin_amdgcn_fence(__ATOMIC_RELEASE, "agent");
            asm volatile("s_waitcnt vmcnt(0)" ::: "memory");
            const unsigned og = xb_add(&bar[XB_TOP], 1u);
            const unsigned tg = og / nx;
            if (og + 1u == (tg + 1u) * nx) xb_add(&bar[XB_TOPGEN], 1u);
            else XB_SPIN(xb_ld(&bar[XB_TOPGEN]) == tg, bar);
            __builtin_amdgcn_fence(__ATOMIC_ACQUIRE, "agent");
            xb_add(&bar[XB_XGEN(b.x)], 1u);
            asm volatile("s_waitcnt vmcnt(0)" ::: "memory");
        } else {
            XB_SPIN(xb_ld(&bar[XB_XGEN(b.x)]) == gen, bar);
            __builtin_amdgcn_fence(__ATOMIC_ACQUIRE, "agent");
            asm volatile("s_waitcnt vmcnt(0)" ::: "memory");
        }
    }
    __syncthreads();
}

constexpr int SEQ = 16384, DM = 1024, N1 = 4352  , NWAVES = 8;
constexpr float EPS = 1e-6f, QSCALE = 0.125f * LOG2E;
constexpr size_t MiB = 1u << 20;
constexpr size_t WS_CTL = 0, CTL_ZERO_BYTES = 1 * MiB;
constexpr size_t WS_WIN = 1 * MiB, WS_WUPA = 10 * MiB, WS_WUPB = 11 * MiB, WS_WO2 = 12 * MiB, WS_WQ = 16 * MiB, WS_WPG = 20 * MiB, WS_WPLE = 22 * MiB, WS_W1KV = 23 * MiB;
constexpr size_t WS_SMALL = 25 * MiB, WS_W2KT = WS_SMALL, WS_W2VT = WS_SMALL + 32768, WS_K1B = WS_SMALL + 65536, WS_K2B = WS_SMALL + 98304, WS_POSB = WS_SMALL + 131072,
                 WS_RS0 = WS_SMALL + 262144, WS_RS2 = WS_SMALL + 393216;
constexpr size_t WS_SSQ1 = 26 * MiB, WS_BG = 27 * MiB, WS_KC = 28 * MiB + 512 * 1024, WS_VCT = WS_KC + 262144, WS_H = 29 * MiB;
constexpr size_t WS_XB = 32 * MiB, WS_MG = 64 * MiB, WS_QA = 128 * MiB, WS_QB = 144 * MiB;
constexpr size_t WS_KA = 160 * MiB, WS_VTA = 164 * MiB, WS_CK = 168 * MiB, WS_KS = 176 * MiB, WS_VTS = 180 * MiB, WS_KW = 184 * MiB, WS_VTW = 188 * MiB;
constexpr size_t WS_OW = 192 * MiB, WS_PW = 208 * MiB, WS_PB = 240 * MiB;
constexpr size_t WS_OA = 208 * MiB, WS_OB = 224 * MiB;
constexpr size_t WS_U8 = 128 * MiB, WS_V8 = 144 * MiB, WS_Q2 = 64 * MiB;
constexpr size_t WS_END = 256 * MiB;
constexpr int CW_TMO = 0, CW_BAR = 4096, CW_QUEUE = 32768;
constexpr int LDS_BYTES = 147456, LDSCTL_OFF = 143360;
constexpr int KROW = 144, VROW = 136;
constexpr int AT_K0 = 0, AT_KSZ = 64 * KROW, AT_V0 = 2 * AT_KSZ, AT_VSZ = 64 * VROW, AT_LUT = 36864, LUTS = 136, AT_IMP = 46080, AT_SEL = 112640;
constexpr int SQ_OFF = 0, SO_OFF = AT_IMP, SO_ROW = 65, SM_OFF = 114688, SL_OFF = 115712, SS_OFF = 116736, SC_OFF = 117248;
constexpr int PK_ROW = 272, PK1_OFF = 0, PK2_OFF = 128 * PK_ROW, PW_OFF = 2 * 128 * PK_ROW, PW_BYTES = 8192;
static_assert(AT_V0 + 2 * AT_VSZ <= AT_LUT && AT_LUT + 16 * LUTS * 4 <= AT_IMP && AT_IMP + 65536 <= AT_SEL && SO_OFF + 256 * SO_ROW * 4 <= AT_SEL && AT_SEL + 2048 <= SM_OFF && 256 * KROW <= AT_LUT && SC_OFF + 64 <= LDSCTL_OFF && PW_OFF + 8 * PW_BYTES <= LDSCTL_OFF, "LDS map");

__device__ const unsigned char BKT[129] = {0,1,2,3,4,5,6,7,8,9,10,11,12,13,14,15,16,16,16,17,17,18,18,18,19,19,19,20,20,20,20,21,21,21,21,22,22,22,22,22,23,23,23,23,23,23,24,24,24,24,24,24,
    25,25,25,25,25,25,25,26,26,26,26,26,26,26,26,27,27,27,27,27,27,27,27,27,27,28,28,28,28,28,28,28,28,28,28,29,29,29,29,29,29,29,29,29,29,29,29,30,30,30,30,30,30,30,30,30,30,30,30,30,30,
    31,31,31,31,31,31,31,31,31,31,31,31,31,31,31,31};

struct Args { const float* in[24]; float* out; unsigned char* ws; int ph_lo, ph_hi, li, pad; };
struct Frame {
    LAS unsigned char* lds; volatile LAS unsigned* MISC; gu32* ctl; unsigned char* ws;
    int tid, lane, wave, vcu, G;
    float* out;
};
constexpr int INTAB_OFF = LDSCTL_OFF + 256;
__device__ __forceinline__ const float* in_ptr(const Frame& F, int k) {
    const unsigned long long v = ((const LAS unsigned long long*)(F.lds + INTAB_OFF))[k];
    const unsigned lo = __builtin_amdgcn_readfirstlane((unsigned)v), hi = __builtin_amdgcn_readfirstlane((unsigned)(v >> 32));
    return (const float*)(((unsigned long long)hi << 32) | lo);
}
template <int CTRL> __device__ __forceinline__ float dpp_f(float v) { return __uint_as_float((unsigned)__builtin_amdgcn_update_dpp(0, (int)__float_as_uint(v), CTRL, 0xf, 0xf, true)); }
template <int CTRL> __device__ __forceinline__ unsigned dpp_u(unsigned v) { return (unsigned)__builtin_amdgcn_update_dpp(0, (int)v, CTRL, 0xf, 0xf, true); }
__device__ __forceinline__ float wave_sum(float v) {
#pragma unroll
    for (int o = 1; o < 64; o <<= 1) v += __shfl_xor(v, o);
    return v;
}
__device__ __forceinline__ float quad_sum(float v) { v += dpp_f<0xB1>(v); v += dpp_f<0x4E>(v); return v; }
__device__ __forceinline__ unsigned umax_(unsigned a, unsigned b) { return a > b ? a : b; }
__device__ __forceinline__ unsigned wave_max_u32(unsigned v) {
    v = umax_(v, dpp_u<0xB1>(v)); v = umax_(v, dpp_u<0x4E>(v)); v = umax_(v, dpp_u<0x141>(v)); v = umax_(v, dpp_u<0x140>(v));
    const unsigned a = __builtin_amdgcn_readlane(v, 0), b = __builtin_amdgcn_readlane(v, 16), c = __builtin_amdgcn_readlane(v, 32), d = __builtin_amdgcn_readlane(v, 48);
    return umax_(umax_(a, b), umax_(c, d));
}
__device__ __forceinline__ float pair_max(float v) { auto rr = __builtin_amdgcn_permlane32_swap(__float_as_uint(v), __float_as_uint(v), false, false); return fmaxf(__uint_as_float(rr[0]), __uint_as_float(rr[1])); }
__device__ __forceinline__ float pair_sum(float v) { auto rr = __builtin_amdgcn_permlane32_swap(__float_as_uint(v), __float_as_uint(v), false, false); return __uint_as_float(rr[0]) + __uint_as_float(rr[1]); }
__device__ __forceinline__ unsigned pair_umax(unsigned v) { auto rr = __builtin_amdgcn_permlane32_swap(v, v, false, false); return umax_(rr[0], rr[1]); }
__device__ __forceinline__ unsigned ord_key(float v) { const unsigned u = __float_as_uint(v); return u ^ ((unsigned)((int)u >> 31) | 0x80000000u); }
__device__ __forceinline__ float ord_val(unsigned k) { const unsigned u = (k & 0x80000000u) ? (k ^ 0x80000000u) : ~k; return __uint_as_float(u); }
#define WG_BAR_LDS() do { asm volatile("s_waitcnt lgkmcnt(0)" ::: "memory"); __builtin_amdgcn_s_barrier(); asm volatile("" ::: "memory"); } while (0)
__device__ __forceinline__ u32x4 pack8(const f32x4& a, const f32x4& b) { u32x4 w; w.x = pkbf(a[0], a[1]); w.y = pkbf(a[2], a[3]); w.z = pkbf(b[0], b[1]); w.w = pkbf(b[2], b[3]); return w; }

typedef const f32x4 (&AccRef)[2][2][4][2];
struct Epi1 {
    static constexpr bool PERM = true, AFTER_DRAIN = false;
    const float* rs0; unsigned char* ws;
    __device__ __forceinline__ void operator()(AccRef acc, const pg8::Unit& u, int wr, int wc, int fr, int fq) const {
        asm volatile("" : "+v"(fr), "+v"(fq) :: "memory");
        const int row0 = u.pm * 256 + wr * 64 + fr, pn = u.pn, cl = wc * 32 + 8 * fq;
        float rsv[2][4];
#pragma unroll
        for (int ai = 0; ai < 2; ++ai)
#pragma unroll
            for (int m = 0; m < 4; ++m) rsv[ai][m] = rs0[row0 + ai * 128 + m * 16];
#pragma unroll
        for (int ai = 0; ai < 2; ++ai)
#pragma unroll
            for (int m = 0; m < 4; ++m) asm volatile("" : "+v"(rsv[ai][m]));
        if (pn < 4) {
            bf16* Q = (bf16*)(ws + (pn < 2 ? WS_QA : WS_QB)) + (pn & 1) * 256 + cl;
#pragma unroll
            for (int ai = 0; ai < 2; ++ai)
#pragma unroll
                for (int m = 0; m < 4; ++m) { const int row = row0 + ai * 128 + m * 16; const float s = rsv[ai][m] * QSCALE;
#pragma unroll
                    for (int bj = 0; bj < 2; ++bj) *(u32x4*)(Q + (size_t)row * 512 + bj * 128) = pack8(acc[ai][bj][m][0] * s, acc[ai][bj][m][1] * s); }
        } else if (pn < 8) {
            const int g = wc >> 1, dl = cl & 63;
            const size_t koff = pn == 4 ? WS_KA : pn == 5 ? WS_CK : pn == 6 ? WS_KS : WS_KW;
            const size_t voff = pn == 4 ? WS_VTA : pn == 5 ? WS_CK + (size_t)2 * SEQ * 64 * 2 : pn == 6 ? WS_VTS : WS_VTW;
            bf16* Kd = (bf16*)(ws + koff) + (size_t)g * SEQ * 64 + dl;
            bf16* Vd = (bf16*)(ws + voff);
#pragma unroll
            for (int ai = 0; ai < 2; ++ai)
#pragma unroll
                for (int m = 0; m < 4; ++m) { const int row = row0 + ai * 128 + m * 16; const float s = rsv[ai][m];
                    const u32x4 kq = pack8(acc[ai][0][m][0] * s, acc[ai][0][m][1] * s);
                    const u32x4 v = pack8(acc[ai][1][m][0] * s, acc[ai][1][m][1] * s);
                    if (pn == 6) {
                        const int key = row & 63, jb = row >> 6;
                        bf16* kt_ = (bf16*)(ws + WS_KS) + ((size_t)g * 256 + jb) * 4096 + (size_t)((((key >> 5) * 4 + (dl >> 4)) * 64 + ((dl >> 3) & 1) * 32 + (key & 31)) * 8);
                        *(u32x4*)kt_ = kq;
                        const int sI = key >> 4, kk = key & 15, hI = (kk >> 2) & 1, eI = ((kk >> 3) << 2) + (kk & 3);
                        bf16* vt_ = (bf16*)(ws + WS_VTS) + ((size_t)g * 256 + jb) * 4096 + (size_t)(((((dl >> 5) * 4 + sI) * 64 + hI * 32 + (dl & 31)) * 8) + eI);
                        vt_[0] = (bf16)v.x; vt_[8] = (bf16)(v.x >> 16); vt_[16] = (bf16)v.y; vt_[24] = (bf16)(v.y >> 16); vt_[32] = (bf16)v.z; vt_[40] = (bf16)(v.z >> 16); vt_[48] = (bf16)v.w; vt_[56] = (bf16)(v.w >> 16);
                        continue; }
                    *(u32x4*)(Kd + (size_t)row * 64) = kq;
                    if (pn == 5) *(u32x4*)(Vd + ((size_t)g * SEQ + row) * 64 + dl) = v;
                    else { bf16* vt = Vd + (size_t)(g * 64 + dl) * SEQ + row;
                        vt[0 * (size_t)SEQ] = (bf16)v.x; vt[1 * (size_t)SEQ] = (bf16)(v.x >> 16); vt[2 * (size_t)SEQ] = (bf16)v.y; vt[3 * (size_t)SEQ] = (bf16)(v.y >> 16);
                        vt[4 * (size_t)SEQ] = (bf16)v.z; vt[5 * (size_t)SEQ] = (bf16)(v.z >> 16); vt[6 * (size_t)SEQ] = (bf16)v.w; vt[7 * (size_t)SEQ] = (bf16)(v.w >> 16); } }
        } else if (pn < 16) {
            bf16* MG = (bf16*)(ws + WS_MG) + (pn - 8) * 256 + cl;
#pragma unroll
            for (int ai = 0; ai < 2; ++ai)
#pragma unroll
                for (int m = 0; m < 4; ++m) { const int row = row0 + ai * 128 + m * 16; const float s = rsv[ai][m];
#pragma unroll
                    for (int bj = 0; bj < 2; ++bj) { f32x4 a = acc[ai][bj][m][0] * s, b = acc[ai][bj][m][1] * s;
#pragma unroll
                        for (int e = 0; e < 4; ++e) { a[e] = sigmoidf_(a[e]); b[e] = sigmoidf_(b[e]); }
                        *(u32x4*)(MG + (size_t)row * 2048 + bj * 128) = pack8(a, b); } }
        } else {
            if (wc == 0 && fq < 3) { float* BG = (float*)(ws + WS_BG) + 8 * fq;
#pragma unroll
                for (int ai = 0; ai < 2; ++ai)
#pragma unroll
                    for (int m = 0; m < 4; ++m) { const int row = row0 + ai * 128 + m * 16; const float s = rsv[ai][m]; f32x4 a = acc[ai][0][m][0] * s, b = acc[ai][0][m][1] * s;
#pragma unroll
                        for (int e = 0; e < 4; ++e) { a[e] = sigmoidf_(a[e]); b[e] = sigmoidf_(b[e]); }
                        *(f32x4*)(BG + (size_t)row * 24) = a; *(f32x4*)(BG + (size_t)row * 24 + 4) = b; } }
        }
    }
};
struct EpiNull {
    static constexpr bool PERM = true, AFTER_DRAIN = false;
    __device__ __forceinline__ void operator()(AccRef acc, const pg8::Unit& u, int wr, int wc, int fr, int fq) const {
        asm volatile("" : "+v"(fr), "+v"(fq) :: "memory");
#pragma unroll
        for (int ai = 0; ai < 2; ++ai)
#pragma unroll
            for (int bj = 0; bj < 2; ++bj)
#pragma unroll
                for (int m = 0; m < 4; ++m)
#pragma unroll
                    for (int n = 0; n < 2; ++n) asm volatile("" :: "v"(acc[ai][bj][m][n]));
    }
};
struct EpiUp {
    static constexpr bool PERM = true, AFTER_DRAIN = false;
    bf16* MG; int coloff; bf16* DST;
    __device__ __forceinline__ void operator()(AccRef acc, const pg8::Unit& u, int wr, int wc, int fr, int fq) const {
        asm volatile("" : "+v"(fr), "+v"(fq) :: "memory");
        const int row0 = u.pm * 256 + wr * 64 + fr; bf16* base = MG + coloff + u.pn * 256 + wc * 32 + 8 * fq; bf16* dbase = DST + coloff + u.pn * 256 + wc * 32 + 8 * fq;
        u32x4 gt[2][4][2];
#pragma unroll
        for (int m = 0; m < 4; ++m)
#pragma unroll
            for (int bj = 0; bj < 2; ++bj) gt[0][m][bj] = *(const u32x4*)(base + (size_t)(row0 + m * 16) * 2048 + bj * 128);
#pragma unroll
        for (int ai = 0; ai < 2; ++ai) {
            if (ai == 0) {
#pragma unroll
                for (int m = 0; m < 4; ++m)
#pragma unroll
                    for (int bj = 0; bj < 2; ++bj) gt[1][m][bj] = *(const u32x4*)(base + (size_t)(row0 + 128 + m * 16) * 2048 + bj * 128);
            }
#pragma unroll
            for (int m = 0; m < 4; ++m) { bf16* rp = dbase + (size_t)(row0 + ai * 128 + m * 16) * 2048;
#pragma unroll
                for (int bj = 0; bj < 2; ++bj) { const u32x4 g = gt[ai][m][bj]; const f32x4 a = acc[ai][bj][m][0], b = acc[ai][bj][m][1]; u32x4 w;
                    w.x = pkbf(bf_lo(g.x) * a[0], bf_hi(g.x) * a[1]); w.y = pkbf(bf_lo(g.y) * a[2], bf_hi(g.y) * a[3]);
                    w.z = pkbf(bf_lo(g.z) * b[0], bf_hi(g.z) * b[1]); w.w = pkbf(bf_lo(g.w) * b[2], bf_hi(g.w) * b[3]);
                    *(u32x4*)(rp + bj * 128) = w; } }
        }
    }
};
struct EpiWo {
    static constexpr bool PERM = true, AFTER_DRAIN = false;
    const float* x; float* out; bf16* xb; float* ssq;
    __device__ __forceinline__ void operator()(AccRef acc, const pg8::Unit& u, int wr, int wc, int fr, int fq) const {
        asm volatile("" : "+v"(fr), "+v"(fq) :: "memory");
        const int row0 = u.pm * 256 + wr * 64 + fr, c0 = u.pn * 256 + wc * 32 + 8 * fq;
        f32x4 xv[2][2][2][2];
#define WO_LOAD(par, bt) _Pragma("unroll") for (int mm = 0; mm < 2; ++mm) _Pragma("unroll") for (int bj = 0; bj < 2; ++bj) { \
            const size_t o = (size_t)(row0 + ((bt) >> 1) * 128 + (((bt) & 1) * 2 + mm) * 16) * DM + c0 + bj * 128; xv[par][mm][bj][0] = *(const f32x4*)(x + o); xv[par][mm][bj][1] = *(const f32x4*)(x + o + 4); }
        WO_LOAD(0, 0);
#pragma unroll
        for (int bt = 0; bt < 4; ++bt) {
            if (bt == 0) { WO_LOAD(1, 1); } else if (bt == 1) { WO_LOAD(0, 2); } else if (bt == 2) { WO_LOAD(1, 3); }
            const int ai = bt >> 1;
#pragma unroll
            for (int mm = 0; mm < 2; ++mm) { const int m = (bt & 1) * 2 + mm, row = row0 + ai * 128 + m * 16; float ss = 0.f;
#pragma unroll
                for (int bj = 0; bj < 2; ++bj) { const size_t o = (size_t)row * DM + c0 + bj * 128;
                    const f32x4 a = xv[bt & 1][mm][bj][0] + acc[ai][bj][m][0], b = xv[bt & 1][mm][bj][1] + acc[ai][bj][m][1];
                    *(f32x4*)(out + o) = a; *(f32x4*)(out + o + 4) = b; *(u32x4*)(xb + o) = pack8(a, b);
                    ss += (a[0] * a[0] + a[1] * a[1]) + (a[2] * a[2] + a[3] * a[3]) + (b[0] * b[0] + b[1] * b[1]) + (b[2] * b[2] + b[3] * b[3]); }
                ss += __shfl_xor(ss, 16); ss += __shfl_xor(ss, 32);
                if (fq == 0) ssq[(size_t)row * 16 + u.pn * 4 + wc] = ss; }
        }
#undef WO_LOAD
    }
};
__device__ __forceinline__ float rs_from_ssq(const float* ssq, int row) {
    const f32x4* p = (const f32x4*)(ssq + (size_t)row * 16); const f32x4 a = p[0], b = p[1], c = p[2], d = p[3];
    const float s = ((a[0] + a[1]) + (a[2] + a[3])) + ((b[0] + b[1]) + (b[2] + b[3])) + ((c[0] + c[1]) + (c[2] + c[3])) + ((d[0] + d[1]) + (d[2] + d[3]));
    return __builtin_amdgcn_rsqf(s * (1.0f / DM) + EPS);
}
struct EpiPw {
    static constexpr bool PERM = true, AFTER_DRAIN = false;
    bf16* O; int ldc;
    __device__ __forceinline__ void operator()(AccRef acc, const pg8::Unit& u, int wr, int wc, int fr, int fq) const {
        asm volatile("" : "+v"(fr), "+v"(fq) :: "memory");
        const int row0 = u.pm * 256 + wr * 64 + fr; bf16* base = O + u.pn * 256 + wc * 32 + 8 * fq;
#pragma unroll
        for (int ai = 0; ai < 2; ++ai)
#pragma unroll
            for (int m = 0; m < 4; ++m)
#pragma unroll
                for (int bj = 0; bj < 2; ++bj) *(u32x4*)(base + (size_t)(row0 + ai * 128 + m * 16) * ldc + bj * 128) = pack8(acc[ai][bj][m][0], acc[ai][bj][m][1]);
    }
};
struct EpiPle {
    static constexpr bool PERM = true, AFTER_DRAIN = false;
    const float* rs2; const bf16* pw; float* out; float* dst;
    __device__ __forceinline__ void operator()(AccRef acc, const pg8::Unit& u, int wr, int wc, int fr, int fq) const {
        asm volatile("" : "+v"(fr), "+v"(fq) :: "memory");
        const int row0 = u.pm * 256 + wr * 64 + fr, c0 = u.pn * 256 + wc * 32 + 8 * fq;
        float rsv[2][4];
#pragma unroll
        for (int ai = 0; ai < 2; ++ai)
#pragma unroll
            for (int m = 0; m < 4; ++m) rsv[ai][m] = rs2[row0 + ai * 128 + m * 16];
#pragma unroll
        for (int ai = 0; ai < 2; ++ai)
#pragma unroll
            for (int m = 0; m < 4; ++m) asm volatile("" : "+v"(rsv[ai][m]));
        f32x4 xv[2][2][2]; u32x4 pv[2][2];
#define PLE_LOAD(par, bt) _Pragma("unroll") for (int bj = 0; bj < 2; ++bj) { \
            const size_t o = (size_t)(row0 + ((bt) >> 2) * 128 + ((bt) & 3) * 16) * DM + c0 + bj * 128; xv[par][bj][0] = *(const f32x4*)(out + o); xv[par][bj][1] = *(const f32x4*)(out + o + 4); pv[par][bj] = *(const u32x4*)(pw + o); }
        PLE_LOAD(0, 0);
#pragma unroll
        for (int bt = 0; bt < 8; ++bt) {
            if (bt < 7) { if ((bt & 1) == 0) { PLE_LOAD(1, bt + 1); } else { PLE_LOAD(0, bt + 1); } }
            const int ai = bt >> 2, m = bt & 3, row = row0 + ai * 128 + m * 16; const float s = rsv[ai][m];
#pragma unroll
            for (int bj = 0; bj < 2; ++bj) { const size_t o = (size_t)row * DM + c0 + bj * 128; const u32x4 p = pv[bt & 1][bj];
                f32x4 a = xv[bt & 1][bj][0], b = xv[bt & 1][bj][1]; const f32x4 ga = acc[ai][bj][m][0] * s, gb = acc[ai][bj][m][1] * s;
                a[0] += sigmoidf_(ga[0]) * bf_lo(p.x); a[1] += sigmoidf_(ga[1]) * bf_hi(p.x); a[2] += sigmoidf_(ga[2]) * bf_lo(p.y); a[3] += sigmoidf_(ga[3]) * bf_hi(p.y);
                b[0] += sigmoidf_(gb[0]) * bf_lo(p.z); b[1] += sigmoidf_(gb[1]) * bf_hi(p.z); b[2] += sigmoidf_(gb[2]) * bf_lo(p.w); b[3] += sigmoidf_(gb[3]) * bf_hi(p.w);
                *(f32x4*)(dst + o) = a; *(f32x4*)(dst + o + 4) = b; }
        }
#undef PLE_LOAD
    }
};
struct EpiCmp {
    static constexpr bool PERM = true, AFTER_DRAIN = false;
    bf16* H; const float* posb;
    __device__ __forceinline__ void operator()(AccRef acc, const pg8::Unit& u, int wr, int wc, int fr, int fq) const {
        asm volatile("" : "+v"(fr), "+v"(fq) :: "memory");
        const int row0 = u.pm * 256 + wr * 64 + fr, cl = wc * 32 + 8 * fq;
#pragma unroll
        for (int bj = 0; bj < 2; ++bj) { const f32x4 pa = *(const f32x4*)(posb + u.pn * 256 + bj * 128 + cl), pb = *(const f32x4*)(posb + u.pn * 256 + bj * 128 + cl + 4);
#pragma unroll
            for (int ai = 0; ai < 2; ++ai)
#pragma unroll
                for (int m = 0; m < 4; ++m) { f32x4 a = acc[ai][bj][m][0] + pa, b = acc[ai][bj][m][1] + pb;
#pragma unroll
                    for (int e = 0; e < 4; ++e) { a[e] = gelu_tanh(a[e]); b[e] = gelu_tanh(b[e]); }
                    *(u32x4*)(H + (size_t)(row0 + ai * 128 + m * 16) * 256 + bj * 128 + cl) = pack8(a, b); } }
    }
};

__device__ __forceinline__ void tr_item(const float* W, int Nsrc, int k0, int srcc0, int nvalid, bf16* WT, int ldk, int drow0, int dk0, const float* g, LAS float* scr, int lane) {
#pragma unroll 8
    for (int i = 0; i < 32; ++i) { const int kk = 2 * i + (lane >> 5), n = lane & 31; float v = 0.f;
        if (n < nvalid) { v = W[(size_t)(k0 + kk) * Nsrc + srcc0 + n]; if (g) v *= g[k0 + kk]; }
        scr[kk * 33 + n] = v; }
    LDS_WAIT(); asm volatile("" ::: "memory");
    const int c = lane & 7;
#pragma unroll
    for (int j = 0; j < 4; ++j) { const int n = (lane >> 3) + 8 * j; const LAS float* s = scr + (8 * c) * 33 + n;
        u32x4 o; o.x = pkbf(s[0 * 33], s[1 * 33]); o.y = pkbf(s[2 * 33], s[3 * 33]); o.z = pkbf(s[4 * 33], s[5 * 33]); o.w = pkbf(s[6 * 33], s[7 * 33]);
        *(u32x4*)(WT + (size_t)(drow0 + n) * ldk + dk0 + k0 + 8 * c) = o; }
    LDS_WAIT(); asm volatile("" ::: "memory");
}
__device__ __forceinline__ void p0_prologue(Frame& F) {
    LAS float* scr = (LAS float*)(F.lds + F.wave * 8448);
    const int gw = F.vcu * NWAVES + F.wave, NGW = F.G * NWAVES, lane = F.lane;
    unsigned char* ws = F.ws;
    constexpr int I_IN = 16 * 136, I_UP = 8 * 32, I_O = 16 * 32, I_Q = 16 * 64, I_PG = 16 * 32, I_PLE = 4 * 32, I_W1 = 32 * 8, I_W2 = 4 * 2;
    constexpr int NITEMS = I_IN + 2 * I_UP + I_O + I_Q + I_PG + I_PLE + 2 * I_W1 + 2 * I_W2;
    for (int it = gw; it < NITEMS; it += NGW) {
        int r = it;
        if (r < I_IN) { const int kb = r / 136, nb = r % 136, n = nb * 32; int src, nv = 32;
            if (n < 512) src = n; else if (n < 1024) src = n + 256; else if (n < 1280) src = n - 512; else if (n < 2048) src = n; else if (n < 4096) src = n + 24;
            else if (n == 4096) { src = 2048; nv = 24; } else { src = 0; nv = 0; }
            tr_item(in_ptr(F, 3), 4120, kb * 64, src, nv, (bf16*)(ws + WS_WIN), 1024, n, 0, in_ptr(F, 2), scr, lane); continue; } r -= I_IN;
        if (r < I_UP) { tr_item(in_ptr(F, 11), 1024, (r / 32) * 64, (r % 32) * 32, 32, (bf16*)(ws + WS_WUPA), 512, (r % 32) * 32, 0, nullptr, scr, lane); continue; } r -= I_UP;
        if (r < I_UP) { tr_item(in_ptr(F, 12), 1024, (r / 32) * 64, (r % 32) * 32, 32, (bf16*)(ws + WS_WUPB), 512, (r % 32) * 32, 0, nullptr, scr, lane); continue; } r -= I_UP;
        if (r < I_O) { tr_item(in_ptr(F, 13), 1024, (r / 32) * 64, (r % 32) * 32, 32, (bf16*)(ws + WS_WO2), 2048, (r % 32) * 32, 0, nullptr, scr, lane);
                       tr_item(in_ptr(F, 13), 1024, (r / 32) * 64, (r % 32) * 32, 32, (bf16*)(ws + WS_WO2), 2048, (r % 32) * 32, 1024, nullptr, scr, lane); continue; } r -= I_O;
        if (r < I_Q) { tr_item(in_ptr(F, 15), 2048, (r / 64) * 64, (r % 64) * 32, 32, (bf16*)(ws + WS_WQ), 1024, (r % 64) * 32, 0, in_ptr(F, 14), scr, lane); continue; } r -= I_Q;
        if (r < I_PG) { tr_item(in_ptr(F, 21), 1024, (r / 32) * 64, (r % 32) * 32, 32, (bf16*)(ws + WS_WPG), 1024, (r % 32) * 32, 0, in_ptr(F, 20), scr, lane); continue; } r -= I_PG;
        if (r < I_PLE) { tr_item(in_ptr(F, 22), 1024, (r / 32) * 64, (r % 32) * 32, 32, (bf16*)(ws + WS_WPLE), 256, (r % 32) * 32, 0, nullptr, scr, lane); continue; } r -= I_PLE;
        if (r < I_W1) { tr_item(in_ptr(F, 7), 256, (r / 8) * 64, (r % 8) * 32, 32, (bf16*)(ws + WS_W1KV), 2048, (r % 8) * 32, 0, nullptr, scr, lane); continue; } r -= I_W1;
        if (r < I_W1) { tr_item(in_ptr(F, 9), 256, (r / 8) * 64, (r % 8) * 32, 32, (bf16*)(ws + WS_W1KV), 2048, 256 + (r % 8) * 32, 0, nullptr, scr, lane); continue; } r -= I_W1;
        if (r < I_W2) { tr_item(in_ptr(F, 8), 64, (r / 2) * 64, (r % 2) * 32, 32, (bf16*)(ws + WS_W2KT), 256, (r % 2) * 32, 0, nullptr, scr, lane); continue; } r -= I_W2;
        tr_item(in_ptr(F, 10), 64, (r / 2) * 64, (r % 2) * 32, 32, (bf16*)(ws + WS_W2VT), 256, (r % 2) * 32, 0, nullptr, scr, lane);
    }
    { const float* x = in_ptr(F, 0); bf16* xb = (bf16*)(ws + WS_XB); float* rs0 = (float*)(ws + WS_RS0);
      for (int row = gw; row < SEQ; row += NGW) {
          const f32x4* xr = (const f32x4*)(x + (size_t)row * DM) + lane; f32x4 v[4]; float ss = 0.f;
#pragma unroll
          for (int j = 0; j < 4; ++j) { v[j] = xr[64 * j]; ss += (v[j][0] * v[j][0] + v[j][1] * v[j][1]) + (v[j][2] * v[j][2] + v[j][3] * v[j][3]); }
          ss = wave_sum(ss);
          u32x2* o8 = (u32x2*)(xb + (size_t)row * DM) + lane;
#pragma unroll
          for (int j = 0; j < 4; ++j) { u32x2 w; w.x = pkbf(v[j][0], v[j][1]); w.y = pkbf(v[j][2], v[j][3]); o8[64 * j] = w; }
          if (lane == 0) rs0[row] = __builtin_amdgcn_rsqf(ss * (1.0f / DM) + EPS);
      } }
    { const int gt = gw * 64 + lane, NGT = NGW * 64;
      const float* p = in_ptr(F, 1); bf16* pb = (bf16*)(ws + WS_PB);
      for (int i = gt; i < SEQ * 256 / 8; i += NGT) { const f32x4 a = *(const f32x4*)(p + (size_t)i * 8), b = *(const f32x4*)(p + (size_t)i * 8 + 4); *(u32x4*)(pb + (size_t)i * 8) = pack8(a, b); }
      for (int i = gt; i < 2 * 16384 / 8; i += NGT) { const int which = i >= 2048, j = i & 2047; const float* k = in_ptr(F, 16 + which) + (size_t)j * 8;
          *(u32x4*)((bf16*)(ws + (which ? WS_K2B : WS_K1B)) + (size_t)j * 8) = pack8(*(const f32x4*)k, *(const f32x4*)(k + 4)); } }
    if (F.vcu < 32) {
#pragma unroll 1
        for (int oo = 0; oo < 2; ++oo) { const int o = F.vcu * 16 + F.wave * 2 + oo, kv = o >> 8, n = o & 255; const float* w1 = in_ptr(F, kv ? 9 : 7); const float* pos = in_ptr(F, 6); float s = 0.f;
            for (int k = lane; k < 2048; k += 64) s += pos[k] * w1[(size_t)k * 256 + n];
            s = wave_sum(s); if (lane == 0) ((float*)(ws + WS_POSB))[o] = s; }
    }
}

struct TileSrc { const bf16* K; const bf16* Vt; int vpitch; };
__device__ __forceinline__ void tile_load(const TileSrc& s, int key0, bool needV, int tid, u32x4& kr, u32x4& vr) {
    const int row = tid >> 3, ch = tid & 7;
    kr = *(const u32x4*)(s.K + (size_t)(key0 + row) * 64 + ch * 8);
    if (needV) vr = *(const u32x4*)(s.Vt + (size_t)row * s.vpitch + key0 + ch * 8);
}
__device__ __forceinline__ void tile_store(LAS unsigned char* L, int buf, bool needV, int tid, const u32x4& kr, const u32x4& vr) {
    const int row = tid >> 3, ch = tid & 7;
    *(LAS u32x4*)(L + AT_K0 + buf * AT_KSZ + row * KROW + ch * 16) = kr;
    if (needV) { LAS u32x2* p = (LAS u32x2*)(L + AT_V0 + buf * AT_VSZ + row * VROW + ch * 16); u32x2 a, b; a.x = vr.x; a.y = vr.y; b.x = vr.z; b.y = vr.w; p[0] = a; p[1] = b; }
}
__device__ __forceinline__ void qk_tile(LAS const unsigned char* Kb, const bf16x8 (&q)[4], int r32, int h, f32x16& s0, f32x16& s1) {
#pragma unroll
    for (int i = 0; i < 16; ++i) { s0[i] = 0.f; s1[i] = 0.f; }
#pragma unroll
    for (int ks = 0; ks < 4; ++ks) {
        const bf16x8 a0 = *(LAS const bf16x8*)(Kb + r32 * KROW + (16 * ks + 8 * h) * 2), a1 = *(LAS const bf16x8*)(Kb + (32 + r32) * KROW + (16 * ks + 8 * h) * 2);
        s0 = __builtin_amdgcn_mfma_f32_32x32x16_bf16(a0, q[ks], s0, 0, 0, 0); s1 = __builtin_amdgcn_mfma_f32_32x32x16_bf16(a1, q[ks], s1, 0, 0, 0);
    }
}
__device__ __forceinline__ bf16x8 pack_p(const f32x16& s, int o) {
    u32x4 w; w.x = pkbf(s[o + 0], s[o + 1]); w.y = pkbf(s[o + 2], s[o + 3]); w.z = pkbf(s[o + 4], s[o + 5]); w.w = pkbf(s[o + 6], s[o + 7]); return __builtin_bit_cast(bf16x8, w);
}
__device__ __forceinline__ void softmax_pv(LAS const unsigned char* Vb, f32x16& s0, f32x16& s1, f32x16 (&o)[2], float& m, float& l, int r32, int h) {
    float mx = fmaxf(s0[0], s1[0]);
#pragma unroll
    for (int i = 1; i < 16; ++i) mx = fmaxf(mx, fmaxf(s0[i], s1[i]));
    mx = pair_max(mx);
    const float mn = fmaxf(m, mx), alpha = fexp2(m - mn); m = mn;
    float sum = 0.f;
#pragma unroll
    for (int i = 0; i < 16; ++i) { s0[i] = fexp2(s0[i] - mn); s1[i] = fexp2(s1[i] - mn); sum += s0[i] + s1[i]; }
    sum = pair_sum(sum); l = l * alpha + sum;
#pragma unroll
    for (int i = 0; i < 16; ++i) { o[0][i] *= alpha; o[1][i] *= alpha; }
    bf16x8 pf[4]; pf[0] = pack_p(s0, 0); pf[1] = pack_p(s0, 8); pf[2] = pack_p(s1, 0); pf[3] = pack_p(s1, 8);
#pragma unroll
    for (int dt = 0; dt < 2; ++dt)
#pragma unroll
        for (int s = 0; s < 4; ++s) { LAS const unsigned char* vp = Vb + (32 * dt + r32) * VROW + (16 * s + 4 * h) * 2;
            const u32x2 lo = *(LAS const u32x2*)vp, hi = *(LAS const u32x2*)(vp + 16); u32x4 a; a.x = lo.x; a.y = lo.y; a.z = hi.x; a.w = hi.y;
            o[dt] = __builtin_amdgcn_mfma_f32_32x32x16_bf16(__builtin_bit_cast(bf16x8, a), pf[s], o[dt], 0, 0, 0); }
}
#define KEYOFF(kt, i) (32 * (kt) + ((i) & 3) + 8 * ((i) >> 2))
#define NEG_INF (-__builtin_inff())

template <int W> struct FBand {
    int tq, tw, h; const LAS float* lut;
    __device__ __forceinline__ bool active(int tile) { const int key0 = tile * 64; return key0 <= tw + 7 && key0 + 63 >= tw - W + 1; }
    __device__ __forceinline__ void apply(f32x16& s0, f32x16& s1, int tile) {
        const int rel0 = tq - tile * 64 - 4 * h;
        if (tw - tile * 64 - 63 >= 128) { const float b = lut[128];
#pragma unroll
            for (int i = 0; i < 16; ++i) { const int r0 = rel0 - KEYOFF(0, i), r1 = rel0 - KEYOFF(1, i);
                s0[i] = (unsigned)r0 < (unsigned)W ? s0[i] + b : NEG_INF; s1[i] = (unsigned)r1 < (unsigned)W ? s1[i] + b : NEG_INF; }
        } else {
#pragma unroll
            for (int i = 0; i < 16; ++i) { const int r0 = rel0 - KEYOFF(0, i), r1 = rel0 - KEYOFF(1, i);
                const float b0 = lut[min(max(r0, 0), 128)], b1 = lut[min(max(r1, 0), 128)];
                s0[i] = (unsigned)r0 < (unsigned)W ? s0[i] + b0 : NEG_INF; s1[i] = (unsigned)r1 < (unsigned)W ? s1[i] + b1 : NEG_INF; }
        }
    }
};
struct FCmp {
    int lim0, cmax_w;
    __device__ __forceinline__ bool active(int tile) { return tile * 64 <= cmax_w; }
    __device__ __forceinline__ void apply(f32x16& s0, f32x16& s1, int tile) {
        const int lim = lim0 - tile * 64;
#pragma unroll
        for (int i = 0; i < 16; ++i) { s0[i] = KEYOFF(0, i) <= lim ? s0[i] : NEG_INF; s1[i] = KEYOFF(1, i) <= lim ? s1[i] : NEG_INF; }
    }
};
#define ATTN_STEP(J) { if (i + (J) >= ntiles) break; const int buf = (i + (J)) & 1; \
        tile_store(L, buf, NEEDV, tid, kr[J], vr[J]); if (i + (J) + RD < ntiles) tile_load(src, (tile_lo + i + (J) + RD) * 64, NEEDV, tid, kr[J], vr[J]); \
        WG_BAR_LDS(); const int tile = tile_lo + i + (J); BODY }
template <int RD, class Fn>
__device__ __forceinline__ void attn_loop(LAS unsigned char* L, const TileSrc& src, int tile_lo, int ntiles, const bf16x8 (&q)[4], f32x16 (&o)[2], float& m, float& l, Fn& f, int tid, int r32, int h) {
    u32x4 kr[RD], vr[RD];
    constexpr bool NEEDV = true;
#pragma unroll
    for (int j = 0; j < RD; ++j) if (j < ntiles) tile_load(src, (tile_lo + j) * 64, true, tid, kr[j], vr[j]);
#define BODY if (f.active(tile)) { f32x16 s0, s1; qk_tile(L + AT_K0 + buf * AT_KSZ, q, r32, h, s0, s1); f.apply(s0, s1, tile); softmax_pv(L + AT_V0 + buf * AT_VSZ, s0, s1, o, m, l, r32, h); }
#pragma unroll 1
    for (int i = 0; i < ntiles; i += RD) { ATTN_STEP(0) ATTN_STEP(1) ATTN_STEP(2) if (RD > 3) ATTN_STEP(3) }
#undef BODY
    WG_BAR_LDS();
}
__device__ __forceinline__ void build_lut(Frame& F, const float* rb) {
    LAS float* lut = (LAS float*)(F.lds + AT_LUT);
    for (int i = F.tid; i < 16 * 129; i += NWAVES * 64) { const int hh = i / 129, rel = i % 129; lut[hh * LUTS + rel] = rb[(int)BKT[rel] * 16 + hh] * LOG2E; }
    __syncthreads();
}
__device__ __forceinline__ void store_o(bf16* dst, const f32x16 (&o)[2], float sc, int h) {
#pragma unroll
    for (int dt = 0; dt < 2; ++dt)
#pragma unroll
        for (int gq = 0; gq < 4; ++gq) { u32x2 w; w.x = pkbf(o[dt][4 * gq] * sc, o[dt][4 * gq + 1] * sc); w.y = pkbf(o[dt][4 * gq + 2] * sc, o[dt][4 * gq + 3] * sc);
            *(u32x2*)(dst + 32 * dt + 8 * gq + 4 * h) = w; }
}
template <int MODE>
__device__ __forceinline__ void banded_unit(Frame& F, const float* sink, int T, int g) {
    LAS unsigned char* L = F.lds; const int tid = F.tid, lane = F.lane, w = F.wave, r32 = lane & 31, h = lane >> 5;
    const int t0 = T * 64, tw = t0 + 8 * w, tq = tw + (r32 >> 2), hg = g * 4 + (r32 & 3);
    constexpr int W = MODE == 0 ? 128 : 512;
    const bf16* Qp = (const bf16*)(F.ws + (MODE == 0 ? WS_QA : WS_QB)) + (size_t)tq * 512 + hg * 64;
    bf16x8 q[4];
#pragma unroll
    for (int ks = 0; ks < 4; ++ks) q[ks] = *(const bf16x8*)(Qp + 16 * ks + 8 * h);
    f32x16 o[2];
#pragma unroll
    for (int i = 0; i < 16; ++i) { o[0][i] = 0.f; o[1][i] = 0.f; }
    float m = -1e30f, l = 0.f;
    if (MODE == 0) { m = sink[hg] * LOG2E; l = 1.f; }
    const int tlo = max(0, t0 - W + 1) >> 6, nt = T - tlo + 1;
    TileSrc src; src.K = (const bf16*)(F.ws + (MODE == 0 ? WS_KA : WS_KW)) + (size_t)g * SEQ * 64; src.Vt = (const bf16*)(F.ws + (MODE == 0 ? WS_VTA : WS_VTW)) + (size_t)g * 64 * SEQ; src.vpitch = SEQ;
    FBand<W> f; f.tq = tq; f.tw = tw; f.h = h; f.lut = (const LAS float*)(L + AT_LUT) + ((MODE == 0 ? 0 : 8) + hg) * LUTS;
    attn_loop<4>(L, src, tlo, nt, q, o, m, l, f, tid, r32, h);
    bf16* Op = (bf16*)(F.ws + (MODE == 0 ? WS_OA : WS_OW)) + (size_t)tq * 512 + hg * 64;
    store_o(Op, o, frcp(fmaxf(l, 1e-30f)), h);
}
__device__ __forceinline__ void compress_out(Frame& F, int b) {
    const int lane = F.lane, w = F.wave, r32 = lane & 31, h = lane >> 5;
    const int kvg = b >> 2, kv = kvg >> 1, g = kvg & 1, c0 = (b & 3) * 256 + 32 * w;
    const bf16* H = (const bf16*)(F.ws + WS_H) + (size_t)(256 * b + 32 * w + r32) * 256 + 8 * h;
    const bf16* W2 = (const bf16*)(F.ws + (kv ? WS_W2VT : WS_W2KT)) + (size_t)r32 * 256 + 8 * h;
    f32x16 a0, a1;
#pragma unroll
    for (int i = 0; i < 16; ++i) { a0[i] = 0.f; a1[i] = 0.f; }
#pragma unroll 4
    for (int ks = 0; ks < 16; ++ks) {
        const bf16x8 hf = *(const bf16x8*)(H + 16 * ks), w0 = *(const bf16x8*)(W2 + 16 * ks), w1 = *(const bf16x8*)(W2 + 32 * 256 + 16 * ks);
        if (kv == 0) { a0 = __builtin_amdgcn_mfma_f32_32x32x16_bf16(w0, hf, a0, 0, 0, 0); a1 = __builtin_amdgcn_mfma_f32_32x32x16_bf16(w1, hf, a1, 0, 0, 0); }
        else         { a0 = __builtin_amdgcn_mfma_f32_32x32x16_bf16(hf, w0, a0, 0, 0, 0); a1 = __builtin_amdgcn_mfma_f32_32x32x16_bf16(hf, w1, a1, 0, 0, 0); }
    }
    if (kv == 0) {
        const int c = c0 + r32; bf16* kc = (bf16*)(F.ws + WS_KC) + ((size_t)g * 1024 + c) * 64; const bool pad = (c == 1023);
#pragma unroll
        for (int nt = 0; nt < 2; ++nt)
#pragma unroll
            for (int gq = 0; gq < 4; ++gq) { const f32x16& a = nt ? a1 : a0; u32x2 wv; wv.x = pkbf(a[4 * gq], a[4 * gq + 1]); wv.y = pkbf(a[4 * gq + 2], a[4 * gq + 3]); if (pad) { wv.x = 0u; wv.y = 0u; }
                *(u32x2*)(kc + 32 * nt + 8 * gq + 4 * h) = wv; }
    } else {
        bf16* vct = (bf16*)(F.ws + WS_VCT) + (size_t)g * 64 * 1024;
#pragma unroll
        for (int nt = 0; nt < 2; ++nt)
#pragma unroll
            for (int gq = 0; gq < 4; ++gq) { const f32x16& a = nt ? a1 : a0; const int c = c0 + 8 * gq + 4 * h;
                u32x2 wv; wv.x = pkbf(a[4 * gq], a[4 * gq + 1]); wv.y = pkbf(a[4 * gq + 2], a[4 * gq + 3]); if (c + 3 == 1023) wv.y &= 0xffffu;
                *(u32x2*)(vct + (size_t)(32 * nt + r32) * 1024 + c) = wv; }
    }
}
#ifndef PROBE_SLC_MODE
#define PROBE_SLC_MODE 1
#endif
struct SlcCtx { bool probe; LAS unsigned char* L; const bf16* KSg; const bf16* VSg; const LAS float* lut; LAS unsigned char* slot; const LAS unsigned* selb; int t0, jt, lane, r32, h, hd; };
__device__ __forceinline__ int slc_perm(int k, int jt) { return k == 0 ? jt : k == 1 ? jt - 1 : k == 2 ? 0 : jt - (k - 1); }
template <int PASS>
__device__ __forceinline__ void slc_tile(const SlcCtx& C, int j, const bf16x8 (&kf)[2][4], const bf16x8 (&vf)[2][4]) {
    LAS unsigned char* L = C.L; const int lane = C.lane, r32 = C.r32, h = C.h, hd = C.hd;
    LAS unsigned* mref = (LAS unsigned*)(L + SM_OFF); LAS float* lsum = (LAS float*)(L + SL_OFF); LAS float* Oacc = (LAS float*)(L + SO_OFF);
    const bool mine = (C.selb[lane * 8 + (j >> 5)] >> (j & 31)) & 1u;
    const unsigned long long mask = __ballot(mine); const int n = __builtin_popcountll(mask);
    if (n == 0) return;
    if (mine) C.slot[__builtin_amdgcn_mbcnt_hi((unsigned)(mask >> 32), __builtin_amdgcn_mbcnt_lo((unsigned)mask, 0u))] = (unsigned char)lane;
    const bool nearb = (j + 2 >= C.jt);
    const int nch = (n + 7) >> 3;
#pragma unroll 1
    for (int pc = 0; pc < nch; ++pc) {
        const int ci = 8 * pc + (r32 >> 2); const bool cv = ci < n; const int tok = (int)C.slot[cv ? ci : 0]; const int row = tok * 4 + hd;
        const LAS unsigned char* qr = L + SQ_OFF + row * KROW + 16 * h;
        f32x16 s0, s1;
#pragma unroll
        for (int i = 0; i < 16; ++i) { s0[i] = 0.f; s1[i] = 0.f; }
#pragma unroll
        for (int ks = 0; ks < 4; ++ks) { const bf16x8 qf = *(const LAS bf16x8*)(qr + 32 * ks);
            s0 = __builtin_amdgcn_mfma_f32_32x32x16_bf16(kf[0][ks], qf, s0, 0, 0, 0); s1 = __builtin_amdgcn_mfma_f32_32x32x16_bf16(kf[1][ks], qf, s1, 0, 0, 0); }
        if (nearb) { const int rel0 = C.t0 + tok - 64 * j - 4 * h;
#pragma unroll
            for (int i = 0; i < 16; ++i) { const int r0 = rel0 - KEYOFF(0, i), r1 = rel0 - KEYOFF(1, i);
                const float b0 = C.lut[min(max(r0, 0), 128)], b1 = C.lut[min(max(r1, 0), 128)];
                s0[i] = r0 >= 0 ? s0[i] + b0 : NEG_INF; s1[i] = r1 >= 0 ? s1[i] + b1 : NEG_INF; }
        } else { const float b = C.lut[128];
#pragma unroll
            for (int i = 0; i < 16; ++i) { s0[i] += b; s1[i] += b; } }
        if (PASS == 0) {
            float mx = fmaxf(s0[0], s1[0]);
#pragma unroll
            for (int i = 1; i < 16; ++i) mx = fmaxf(mx, fmaxf(s0[i], s1[i]));
            mx = pair_max(mx);
            if (cv && h == 0) __hip_atomic_fetch_max(mref + row, ord_key(mx), __ATOMIC_RELAXED, __HIP_MEMORY_SCOPE_WORKGROUP);
        } else {
            const float mm = ord_val(mref[row]); float sum = 0.f;
#pragma unroll
            for (int i = 0; i < 16; ++i) { s0[i] = fexp2(s0[i] - mm); s1[i] = fexp2(s1[i] - mm); sum += s0[i] + s1[i]; }
            sum = pair_sum(sum);
            if (cv && h == 0) __hip_atomic_fetch_add(lsum + row, sum, __ATOMIC_RELAXED, __HIP_MEMORY_SCOPE_WORKGROUP);
            bf16x8 pf[4]; pf[0] = pack_p(s0, 0); pf[1] = pack_p(s0, 8); pf[2] = pack_p(s1, 0); pf[3] = pack_p(s1, 8);
            LAS float* orow = Oacc + row * SO_ROW + 4 * h;
#pragma unroll
            for (int dt = 0; dt < 2; ++dt) { f32x16 oo;
#pragma unroll
                for (int i = 0; i < 16; ++i) oo[i] = 0.f;
#pragma unroll
                for (int s = 0; s < 4; ++s) oo = __builtin_amdgcn_mfma_f32_32x32x16_bf16(vf[dt][s], pf[s], oo, 0, 0, 0);
                if (cv && !(C.probe && PROBE_SLC_MODE == 3)) {
#pragma unroll
                    for (int i = 0; i < 16; ++i) __hip_atomic_fetch_add((LAS int*)orow + 32 * dt + (i & 3) + 8 * (i >> 2), (int)__builtin_rintf(oo[i] * 65536.0f), __ATOMIC_RELAXED, __HIP_MEMORY_SCOPE_WORKGROUP); }
                else { asm volatile("" :: "v"(oo)); } }
        }
    }
}
template <int PASS, int NB>
__device__ __forceinline__ void slc_pass(const SlcCtx& C) {
    const int r32 = C.r32, h = C.h, jt = C.jt;
#pragma unroll 1
    for (;;) {
        int k0 = 0; if (C.lane == 0) k0 = (int)__hip_atomic_fetch_add((LAS unsigned*)(C.L + SC_OFF), (unsigned)NB, __ATOMIC_RELAXED, __HIP_MEMORY_SCOPE_WORKGROUP);
        k0 = __builtin_amdgcn_readfirstlane(k0);
        if (k0 > jt) break;
        bf16x8 kf[NB][2][4], vf[NB][2][4];
#pragma unroll
        for (int b = 0; b < NB; ++b) if (k0 + b <= jt) { const int j = slc_perm(k0 + b, jt);
#pragma unroll
            for (int kt = 0; kt < 2; ++kt)
#pragma unroll
                for (int ks = 0; ks < 4; ++ks) kf[b][kt][ks] = *(const bf16x8*)(C.KSg + (size_t)j * 4096 + ((kt * 4 + ks) * 64 + C.lane) * 8);
            if (PASS == 1) {
#pragma unroll
                for (int dt = 0; dt < 2; ++dt)
#pragma unroll
                    for (int s = 0; s < 4; ++s) vf[b][dt][s] = *(const bf16x8*)(C.VSg + (size_t)j * 4096 + ((dt * 4 + s) * 64 + C.lane) * 8); } }
#pragma unroll
        for (int b = 0; b < NB; ++b) if (k0 + b <= jt) slc_tile<PASS>(C, slc_perm(k0 + b, jt), kf[b], vf[PASS == 1 ? b : 0]);
    }
}
__device__ __forceinline__ void nsa_unit(Frame& F, int T, int g, bool probe_noslc) {
    LAS unsigned char* L = F.lds; const int tid = F.tid, lane = F.lane, w = F.wave, r32 = lane & 31, h = lane >> 5;
    const int t0 = T * 64, tw = t0 + 8 * w, ql = 8 * w + (r32 >> 2), tq = t0 + ql, hd = r32 & 3, hg = g * 4 + hd, jt = T;
    const bf16* Qp = (const bf16*)(F.ws + WS_QB) + (size_t)tq * 512 + hg * 64; bf16* Ob = (bf16*)(F.ws + WS_OB) + (size_t)tq * 512 + hg * 64;
    bf16x8 q[4];
#pragma unroll
    for (int ks = 0; ks < 4; ++ks) q[ks] = *(const bf16x8*)(Qp + 16 * ks + 8 * h);
    const float* bg = (const float*)(F.ws + WS_BG) + (size_t)tq * 24 + hg; const float g0 = bg[0], g1 = bg[8], g2 = bg[16];
    f32x16 o[2];
#pragma unroll
    for (int i = 0; i < 16; ++i) { o[0][i] = 0.f; o[1][i] = 0.f; }
    float m = -1e30f, l = 0.f;
    const int ncmp = t0 / 16 + 3, ntc = (ncmp + 63) >> 6;
    TileSrc sc; sc.K = (const bf16*)(F.ws + WS_KC) + (size_t)g * 1024 * 64; sc.Vt = (const bf16*)(F.ws + WS_VCT) + (size_t)g * 64 * 1024; sc.vpitch = 1024;
    FCmp fc; fc.lim0 = ((tq - 31) >> 4) - 4 * h; fc.cmax_w = (tw + 7 - 31) >> 4;
    attn_loop<3>(L, sc, 0, ntc, q, o, m, l, fc, tid, r32, h);
    const float inv = frcp(fmaxf(l, 1e-30f));
    { const bf16* OWp = (const bf16*)(F.ws + WS_OW) + (size_t)tq * 512 + hg * 64; const float s0_ = g0 * inv;
#pragma unroll
      for (int dt = 0; dt < 2; ++dt)
#pragma unroll
          for (int gq = 0; gq < 4; ++gq) { const u32x2 ow = *(const u32x2*)(OWp + 32 * dt + 8 * gq + 4 * h); u32x2 wv;
              wv.x = pkbf(s0_ * o[dt][4 * gq] + g2 * bf_lo(ow.x), s0_ * o[dt][4 * gq + 1] + g2 * bf_hi(ow.x));
              wv.y = pkbf(s0_ * o[dt][4 * gq + 2] + g2 * bf_lo(ow.y), s0_ * o[dt][4 * gq + 3] + g2 * bf_hi(ow.y));
              *(u32x2*)(Ob + 32 * dt + 8 * gq + 4 * h) = wv; } }
    LAS float* imp = (LAS float*)(L + AT_IMP);
    for (int i = lane; i < 8 * 256; i += 64) imp[8 * w * 256 + i] = 0.f;
    { constexpr int RD = 3; u32x4 kr[RD], vr[RD]; constexpr bool NEEDV = false; const TileSrc& src = sc; const int tile_lo = 0, ntiles = ntc;
#pragma unroll
      for (int j = 0; j < RD; ++j) if (j < ntiles) tile_load(src, j * 64, false, tid, kr[j], vr[j]);
#define BODY if (fc.active(tile)) { \
              f32x16 s0, s1; qk_tile(L + AT_K0 + buf * AT_KSZ, q, r32, h, s0, s1); \
              fc.apply(s0, s1, tile); \
              _Pragma("unroll") for (int kt = 0; kt < 2; ++kt) { const f32x16& s = kt ? s1 : s0; float mainv = 0.f, spv = 0.f; \
                  _Pragma("unroll") for (int gq = 0; gq < 4; ++gq) { const float p0 = fexp2(s[4 * gq] - m) * inv, p1 = fexp2(s[4 * gq + 1] - m) * inv, p2 = fexp2(s[4 * gq + 2] - m) * inv, p3 = fexp2(s[4 * gq + 3] - m) * inv; \
                      const float mq = quad_sum((p0 + p1) + (p2 + 0.5f * p3)), sq = quad_sum(0.5f * p3); \
                      if (gq == hd) { mainv = mq; spv = sq; } } \
                  const int j = tile * 16 + 8 * kt + 2 * hd + h; \
                  __hip_atomic_fetch_add(imp + ql * 256 + j, mainv, __ATOMIC_RELAXED, __HIP_MEMORY_SCOPE_WORKGROUP); \
                  __hip_atomic_fetch_add(imp + ql * 256 + min(j + 1, 255), (j + 1 < 256) ? spv : 0.f, __ATOMIC_RELAXED, __HIP_MEMORY_SCOPE_WORKGROUP); } }
#pragma unroll 1
      for (int i = 0; i < ntiles; i += RD) { ATTN_STEP(0) ATTN_STEP(1) ATTN_STEP(2) }
#undef BODY
      WG_BAR_LDS(); }
    LAS unsigned* selb = (LAS unsigned*)(L + AT_SEL);
#pragma unroll 1
    for (int qi = 0; qi < 8; ++qi) {
        const LAS float* row = imp + (8 * w + qi) * 256; unsigned mybits = 0u;
        if (lane == 0) mybits |= 1u;
        if (lane == (jt >> 5)) mybits |= 1u << (jt & 31);
        if (jt >= 1 && lane == ((jt - 1) >> 5)) mybits |= 1u << ((jt - 1) & 31);
        const int ncand = jt - 2;
        if (ncand > 0) {
            if (ncand <= 13) { if (lane == 0) mybits |= ((1u << (jt - 1)) - 2u); }
            else {
                unsigned k[4];
#pragma unroll
                for (int i = 0; i < 4; ++i) { const int j = lane + 64 * i; const float v = row[j]; k[i] = (j >= 1 && j <= jt - 2) ? ((__float_as_uint(v) & ~255u) | (unsigned)(255 - j)) : 0u; }
#pragma unroll 1
                for (int it = 0; it < 13; ++it) { const unsigned mx = wave_max_u32(umax_(umax_(k[0], k[1]), umax_(k[2], k[3]))); const int j = 255 - (int)(mx & 255u);
                    if (lane == (j >> 5)) mybits |= 1u << (j & 31);
#pragma unroll
                    for (int i = 0; i < 4; ++i) k[i] = (k[i] == mx) ? 0u : k[i]; }
            }
        }
        if (lane < 8) selb[(8 * w + qi) * 8 + lane] = mybits;
    }
    if (probe_noslc && PROBE_SLC_MODE == 1) return;
    WG_BAR_LDS();
    { LAS unsigned char* qs = L + SQ_OFF + (ql * 4 + hd) * KROW + 16 * h;
#pragma unroll
      for (int ks = 0; ks < 4; ++ks) *(LAS bf16x8*)(qs + 32 * ks) = q[ks];
      for (int i = tid; i < 256 * SO_ROW; i += NWAVES * 64) ((LAS float*)(L + SO_OFF))[i] = 0.f;
      if (tid < 256) { ((LAS unsigned*)(L + SM_OFF))[tid] = 0u; ((LAS float*)(L + SL_OFF))[tid] = 0.f; }
      if (tid == 0) *(LAS unsigned*)(L + SC_OFF) = 0u; }
    WG_BAR_LDS();
    { SlcCtx C; C.probe = probe_noslc; C.L = L; C.KSg = (const bf16*)(F.ws + WS_KS) + (size_t)g * 256 * 4096; C.VSg = (const bf16*)(F.ws + WS_VTS) + (size_t)g * 256 * 4096;
      C.lut = (const LAS float*)(L + AT_LUT) + (8 + hg) * LUTS; C.slot = L + SS_OFF + w * 64; C.selb = selb; C.t0 = t0; C.jt = jt; C.lane = lane; C.r32 = r32; C.h = h; C.hd = hd;
      slc_pass<0, 4>(C);
      WG_BAR_LDS();
      if (tid == 0) *(LAS unsigned*)(L + SC_OFF) = 0u;
      WG_BAR_LDS();
      if (!(probe_noslc && PROBE_SLC_MODE == 2)) slc_pass<1, 1>(C);
      WG_BAR_LDS();
      LAS float* lsum = (LAS float*)(L + SL_OFF); LAS float* Oacc = (LAS float*)(L + SO_OFF);
      const int row = ql * 4 + hd; const float s2 = g1 * frcp(fmaxf(lsum[row], 1e-30f)) * (1.0f / 65536.0f); const LAS int* orow = (const LAS int*)Oacc + row * SO_ROW + 4 * h;
#pragma unroll
      for (int dt = 0; dt < 2; ++dt)
#pragma unroll
          for (int gq = 0; gq < 4; ++gq) { u32x2 wv; const u32x2 tt = *(const u32x2*)(Ob + 32 * dt + 8 * gq + 4 * h); const LAS int* op = orow + 32 * dt + 8 * gq;
              wv.x = pkbf(bf_lo(tt.x) + s2 * (float)op[0], bf_hi(tt.x) + s2 * (float)op[1]); wv.y = pkbf(bf_lo(tt.y) + s2 * (float)op[2], bf_hi(tt.y) + s2 * (float)op[3]);
              *(u32x2*)(Ob + 32 * dt + 8 * gq + 4 * h) = wv; }
    }
    WG_BAR_LDS();
}

typedef float f32x2 __attribute__((ext_vector_type(2)));
__device__ __forceinline__ float dot16_fp8(const u32x4& r, const f32x2 (&xp)[8]) {
    f32x2 a = __builtin_amdgcn_cvt_pk_f32_fp8((int)r.x, false) * xp[0];
    a = __builtin_elementwise_fma(__builtin_amdgcn_cvt_pk_f32_fp8((int)r.x, true), xp[1], a);
    a = __builtin_elementwise_fma(__builtin_amdgcn_cvt_pk_f32_fp8((int)r.y, false), xp[2], a); a = __builtin_elementwise_fma(__builtin_amdgcn_cvt_pk_f32_fp8((int)r.y, true), xp[3], a);
    a = __builtin_elementwise_fma(__builtin_amdgcn_cvt_pk_f32_fp8((int)r.z, false), xp[4], a); a = __builtin_elementwise_fma(__builtin_amdgcn_cvt_pk_f32_fp8((int)r.z, true), xp[5], a);
    a = __builtin_elementwise_fma(__builtin_amdgcn_cvt_pk_f32_fp8((int)r.w, false), xp[6], a); a = __builtin_elementwise_fma(__builtin_amdgcn_cvt_pk_f32_fp8((int)r.w, true), xp[7], a);
    return a.x + a.y;
}
typedef __bf16 v2bf __attribute__((ext_vector_type(2)));
__device__ __forceinline__ float dot2bf(unsigned a, unsigned b, float c) { return __builtin_amdgcn_fdot2_f32_bf16(__builtin_bit_cast(v2bf, a), __builtin_bit_cast(v2bf, b), c, false); }
__device__ __forceinline__ void peer_top16(const bf16* qrow, LAS const unsigned char* kmat, int r32, int h2, unsigned (&sel)[16]) {
    bf16x8 qf[8];
#pragma unroll
    for (int ks = 0; ks < 8; ++ks) qf[ks] = *(const bf16x8*)(qrow + 16 * ks + 8 * h2);
    unsigned key[64];
#pragma unroll
    for (int nt = 0; nt < 4; ++nt) { f32x16 s;
#pragma unroll
        for (int i = 0; i < 16; ++i) s[i] = 0.f;
#pragma unroll
        for (int ks = 0; ks < 8; ++ks) { const bf16x8 a = *(LAS const bf16x8*)(kmat + (32 * nt + r32) * PK_ROW + (16 * ks + 8 * h2) * 2); s = __builtin_amdgcn_mfma_f32_32x32x16_bf16(a, qf[ks], s, 0, 0, 0); }
#pragma unroll
        for (int i = 0; i < 16; ++i) key[nt * 16 + i] = (ord_key(s[i]) & ~127u) | (unsigned)(((63 - (nt * 16 + i)) << 1) | (1 - h2)); }
    unsigned prev = 0xFFFFFFFFu;
#pragma unroll
    for (int k = 0; k < 16; ++k) sel[k] = 0u;
#pragma unroll 1
    for (int it = 0; it < 16; ++it) { unsigned c = 0u;
#pragma unroll
        for (int i = 0; i < 64; ++i) c = umax_(c, key[i] - prev);
        const unsigned mloc = c + prev, mm = pair_umax(mloc);
#pragma unroll
        for (int k = 0; k < 16; ++k) sel[k] = (k == it) ? mm : sel[k];
        prev = mm; }
}
__device__ __forceinline__ int key_n(unsigned k) { const int low = k & 127, Lx = 63 - (low >> 1), hh = 1 - (low & 1); return ((Lx >> 4) << 5) + (((Lx >> 2) & 3) << 3) + (hh << 2) + (Lx & 3); }

__device__ __forceinline__ void peer_phase(Frame& F, bool dry) {
    LAS unsigned char* L = F.lds; const int tid = F.tid, lane = F.lane, w = F.wave, r32 = lane & 31, h2 = lane >> 5;
    unsigned char* ws = F.ws;
    for (int i = tid; i < 2 * 128 * 16; i += NWAVES * 64) { const int which = i >> 11, rr = (i >> 4) & 127, ch = i & 15;
        *(LAS u32x4*)(L + (which ? PK2_OFF : PK1_OFF) + rr * PK_ROW + ch * 16) = *(const u32x4*)((const bf16*)(ws + (which ? WS_K2B : WS_K1B)) + rr * 128 + ch * 8); }
    __syncthreads();
    LAS unsigned char* PW = L + PW_OFF + w * PW_BYTES;
    LAS unsigned char* XR = PW; LAS u32x2* LST = (LAS u32x2*)(PW + 2048); LAS unsigned char* I12 = PW + 6144; LAS float* WL = (LAS float*)(PW + 7168);
    const bf16* Q2 = (const bf16*)(ws + WS_Q2); const unsigned char* U8 = ws + WS_U8; const unsigned char* V8 = ws + WS_V8;
    bf16* xb = (bf16*)(ws + WS_XB); const float* ssq1 = (const float*)(ws + WS_SSQ1); float* rs2 = (float*)(ws + WS_RS2);
    const int gw = F.vcu * NWAVES + w, NGW = F.G * NWAVES;
#pragma unroll 1
    for (int item = gw; item < SEQ / 4; item += NGW) {
        const int t0 = item * 4;
        {
            const int tk = r32 >> 3, hd = r32 & 7; const bf16* qrow = Q2 + (size_t)(t0 + tk) * 2048 + hd * 256;
            const float rsq = rs_from_ssq(ssq1, t0 + tk);
            unsigned s1[16], s2[16];
            peer_top16(qrow, L + PK1_OFF, r32, h2, s1);
            peer_top16(qrow + 128, L + PK2_OFF, r32, h2, s2);
            float v1[16], v2[16];
#pragma unroll
            for (int k = 0; k < 16; ++k) { v1[k] = ord_val(s1[k] & ~127u); v2[k] = ord_val(s2[k] & ~127u); }
            if (h2 == 0) { LAS unsigned* ip = (LAS unsigned*)(I12 + r32 * 32);
#pragma unroll
                for (int k4 = 0; k4 < 4; ++k4) { ip[k4] = (unsigned)key_n(s1[4 * k4]) | ((unsigned)key_n(s1[4 * k4 + 1]) << 8) | ((unsigned)key_n(s1[4 * k4 + 2]) << 16) | ((unsigned)key_n(s1[4 * k4 + 3]) << 24);
                    ip[4 + k4] = (unsigned)key_n(s2[4 * k4]) | ((unsigned)key_n(s2[4 * k4 + 1]) << 8) | ((unsigned)key_n(s2[4 * k4 + 2]) << 16) | ((unsigned)key_n(s2[4 * k4 + 3]) << 24); } }
            unsigned ck[50]; int nc = 0;
#pragma unroll
            for (int i = 0; i < 16; ++i)
#pragma unroll
                for (int j = 0; j < 16; ++j) if ((i + 1) * (j + 1) <= 16) { ck[nc] = (ord_key(v1[i] + v2[j]) & ~255u) | (unsigned)(255 - (16 * i + j)); ++nc; }
            unsigned prev = 0xFFFFFFFFu; float sc[16]; int ei[16];
#pragma unroll
            for (int it = 0; it < 16; ++it) { unsigned c = 0u;
#pragma unroll
                for (int i = 0; i < 50; ++i) c = umax_(c, ck[i] - prev);
                const unsigned mm = c + prev; prev = mm;
                const int flat = 255 - (int)(mm & 255u); sc[it] = ord_val(mm & ~255u);
                ei[it] = (int)I12[r32 * 32 + (flat >> 4)] * 128 + (int)I12[r32 * 32 + 16 + (flat & 15)]; }
            float den = 0.f, ex[16];
#pragma unroll
            for (int k = 0; k < 16; ++k) { ex[k] = fexp2((sc[k] - sc[0]) * (rsq * LOG2E)); den += ex[k]; }
            const float rd = frcp(den);
            if (h2 == 0) {
#pragma unroll
                for (int k = 0; k < 16; ++k) { u32x2 e; e.x = (unsigned)ei[k]; e.y = __float_as_uint(ex[k] * rd); LST[tk * 128 + hd * 16 + k] = e; } }
        }
#pragma unroll 1
        for (int tk = 0; tk < 4; ++tk) {
            const int t = t0 + tk;
            f32x2 xp[8];
            { const u32x4 xa = *(const u32x4*)(xb + (size_t)t * DM + lane * 16), xc = *(const u32x4*)(xb + (size_t)t * DM + lane * 16 + 8);
              xp[0] = (f32x2){bf_lo(xa.x), bf_hi(xa.x)}; xp[1] = (f32x2){bf_lo(xa.y), bf_hi(xa.y)}; xp[2] = (f32x2){bf_lo(xa.z), bf_hi(xa.z)}; xp[3] = (f32x2){bf_lo(xa.w), bf_hi(xa.w)};
              xp[4] = (f32x2){bf_lo(xc.x), bf_hi(xc.x)}; xp[5] = (f32x2){bf_lo(xc.y), bf_hi(xc.y)}; xp[6] = (f32x2){bf_lo(xc.z), bf_hi(xc.z)}; xp[7] = (f32x2){bf_lo(xc.w), bf_hi(xc.w)}; }
            const float rs = rs_from_ssq(ssq1, t) * (1.0f / 32.0f);
            const LAS u32x2* lst = LST + tk * 128;
#define PEER_LOAD8(R_, TAB_, e0_) _Pragma("unroll") for (int k = 0; k < 8; ++k) { const int idx = __builtin_amdgcn_readfirstlane((int)lst[(e0_) + k].x); R_[k] = *(const u32x4*)(TAB_ + (size_t)idx * DM + lane * 16); }
#define PEER_DOT16(r_) dot16_fp8(r_, xp)
#define PEER_UCOMP(R_, e0_) _Pragma("unroll") for (int k4 = 0; k4 < 2; ++k4) { \
                const float p0 = PEER_DOT16(R_[4 * k4]), p1 = PEER_DOT16(R_[4 * k4 + 1]), p2 = PEER_DOT16(R_[4 * k4 + 2]), p3 = PEER_DOT16(R_[4 * k4 + 3]); \
                auto s02 = __builtin_amdgcn_permlane32_swap(__float_as_uint(p0), __float_as_uint(p2), false, false); auto s13 = __builtin_amdgcn_permlane32_swap(__float_as_uint(p1), __float_as_uint(p3), false, false); \
                const float r0 = __uint_as_float(s02[0]) + __uint_as_float(s02[1]), r1 = __uint_as_float(s13[0]) + __uint_as_float(s13[1]); \
                auto s01 = __builtin_amdgcn_permlane16_swap(__float_as_uint(r0), __float_as_uint(r1), false, false); \
                float qv = __uint_as_float(s01[0]) + __uint_as_float(s01[1]); \
                qv += dpp_f<0xB1>(qv); qv += dpp_f<0x4E>(qv); qv += dpp_f<0x141>(qv); qv += dpp_f<0x140>(qv); \
                if ((lane & 15) == 0) { const int e = (e0_) + 4 * k4 + 2 * (lane >> 5) + ((lane >> 4) & 1); WL[e] = 0.25f * __uint_as_float(lst[e].y) * gelu_tanh(qv * rs); } }
            { u32x4 uR0[8], uR1[8];
              PEER_LOAD8(uR0, U8, 0);
#pragma unroll 1
              for (int e0 = 0; e0 < 128; e0 += 16) {
                  PEER_LOAD8(uR1, U8, e0 + 8);
                  PEER_UCOMP(uR0, e0);
                  if (e0 + 16 < 128) { PEER_LOAD8(uR0, U8, e0 + 16); }
                  PEER_UCOMP(uR1, e0 + 8);
              } }
            f32x2 o2[8];
#pragma unroll
            for (int i = 0; i < 8; ++i) o2[i] = (f32x2){0.f, 0.f};
#define PEER_VCOMP(R_, e0_) _Pragma("unroll") for (int k = 0; k < 8; ++k) { const float wv = WL[(e0_) + k]; const f32x2 w2 = (f32x2){wv, wv}; \
                o2[0] = __builtin_elementwise_fma(__builtin_amdgcn_cvt_pk_f32_fp8((int)R_[k].x, false), w2, o2[0]); o2[1] = __builtin_elementwise_fma(__builtin_amdgcn_cvt_pk_f32_fp8((int)R_[k].x, true), w2, o2[1]); \
                o2[2] = __builtin_elementwise_fma(__builtin_amdgcn_cvt_pk_f32_fp8((int)R_[k].y, false), w2, o2[2]); o2[3] = __builtin_elementwise_fma(__builtin_amdgcn_cvt_pk_f32_fp8((int)R_[k].y, true), w2, o2[3]); \
                o2[4] = __builtin_elementwise_fma(__builtin_amdgcn_cvt_pk_f32_fp8((int)R_[k].z, false), w2, o2[4]); o2[5] = __builtin_elementwise_fma(__builtin_amdgcn_cvt_pk_f32_fp8((int)R_[k].z, true), w2, o2[5]); \
                o2[6] = __builtin_elementwise_fma(__builtin_amdgcn_cvt_pk_f32_fp8((int)R_[k].w, false), w2, o2[6]); o2[7] = __builtin_elementwise_fma(__builtin_amdgcn_cvt_pk_f32_fp8((int)R_[k].w, true), w2, o2[7]); }
            { u32x4 vR0[8], vR1[8];
              PEER_LOAD8(vR0, V8, 0);
#pragma unroll 1
              for (int e0 = 0; e0 < 128; e0 += 16) {
                  PEER_LOAD8(vR1, V8, e0 + 8);
                  PEER_VCOMP(vR0, e0);
                  if (e0 + 16 < 128) { PEER_LOAD8(vR0, V8, e0 + 16); }
                  PEER_VCOMP(vR1, e0 + 8);
              } }
            float* op = F.out + (size_t)t * DM + lane * 16;
            float* od = dry ? (float*)(ws + WS_PB) + (size_t)gw * DM + lane * 16 : op; bf16* xd = dry ? (bf16*)(ws + WS_PB + 8 * MiB) + (size_t)gw * DM : xb + (size_t)t * DM; float* rd2 = dry ? (float*)(ws + WS_PB + 12 * MiB) + gw : rs2 + t;
            f32x4 a0 = *(const f32x4*)op, a1 = *(const f32x4*)(op + 4), b0 = *(const f32x4*)(op + 8), b1 = *(const f32x4*)(op + 12);
            a0[0] += o2[0].x; a0[1] += o2[0].y; a0[2] += o2[1].x; a0[3] += o2[1].y; a1[0] += o2[2].x; a1[1] += o2[2].y; a1[2] += o2[3].x; a1[3] += o2[3].y;
            b0[0] += o2[4].x; b0[1] += o2[4].y; b0[2] += o2[5].x; b0[3] += o2[5].y; b1[0] += o2[6].x; b1[1] += o2[6].y; b1[2] += o2[7].x; b1[3] += o2[7].y;
            *(f32x4*)od = a0; *(f32x4*)(od + 4) = a1; *(f32x4*)(od + 8) = b0; *(f32x4*)(od + 12) = b1;
            *(u32x4*)(xd + lane * 16) = pack8(a0, a1); *(u32x4*)(xd + lane * 16 + 8) = pack8(b0, b1);
            float ss = 0.f;
#pragma unroll
            for (int i = 0; i < 4; ++i) ss += a0[i] * a0[i] + a1[i] * a1[i] + b0[i] * b0[i] + b1[i] * b1[i];
            ss = wave_sum(ss);
            if (lane == 0) *rd2 = __builtin_amdgcn_rsqf(ss * (1.0f / DM) + EPS);
        }
    }
}
__device__ __forceinline__ void convert_peer_tables(Frame& F, const float* u, const float* v, const float* g) {
    const int gt = (F.vcu * NWAVES + F.wave) * 64 + F.lane, NGT = F.G * NWAVES * 64;
    unsigned char* U8 = F.ws + WS_U8; unsigned char* V8 = F.ws + WS_V8;
    for (int i = gt; i < 16384 * 1024 / 16; i += NGT) {
        const int d0 = (i & 63) * 16; u32x4 wu, wv;
#pragma unroll
        for (int q = 0; q < 4; ++q) { const f32x4 gq = *(const f32x4*)(g + d0 + 4 * q) * 32.0f; const f32x4 a = *(const f32x4*)(u + (size_t)i * 16 + 4 * q) * gq, c = *(const f32x4*)(v + (size_t)i * 16 + 4 * q) * 4.0f;
            int pu = __builtin_amdgcn_cvt_pk_fp8_f32(a[0], a[1], 0, false); pu = __builtin_amdgcn_cvt_pk_fp8_f32(a[2], a[3], pu, true);
            int pv = __builtin_amdgcn_cvt_pk_fp8_f32(c[0], c[1], 0, false); pv = __builtin_amdgcn_cvt_pk_fp8_f32(c[2], c[3], pv, true);
            wu[q] = (unsigned)pu; wv[q] = (unsigned)pv; }
        *(u32x4*)(U8 + (size_t)i * 16) = wu; *(u32x4*)(V8 + (size_t)i * 16) = wv;
    }
}
__device__ __forceinline__ void final_norm(Frame& F, const float* gf, float* dst) {
    const int gw = F.vcu * NWAVES + F.wave, NGW = F.G * NWAVES, lane = F.lane;
    f32x4 gv[4];
#pragma unroll
    for (int j = 0; j < 4; ++j) gv[j] = ((const f32x4*)gf)[lane + 64 * j];
    for (int row = gw; row < SEQ; row += NGW) {
        f32x4* xr = (f32x4*)(F.out + (size_t)row * DM) + lane; f32x4 v[4]; float ss = 0.f;
#pragma unroll
        for (int j = 0; j < 4; ++j) { v[j] = xr[64 * j]; ss += (v[j][0] * v[j][0] + v[j][1] * v[j][1]) + (v[j][2] * v[j][2] + v[j][3] * v[j][3]); }
        const float rs = __builtin_amdgcn_rsqf(wave_sum(ss) * (1.0f / DM) + EPS);
        f32x4* dr = (f32x4*)(dst + (size_t)row * DM) + lane;
#pragma unroll
        for (int j = 0; j < 4; ++j) dr[64 * j] = v[j] * rs * gv[j];
    }
}

constexpr int NPHASE = 10;
__global__ void __launch_bounds__(NWAVES * 64, 2) hybrid_fwd(Args args) {
    extern __shared__ __attribute__((aligned(16))) unsigned char lds[];
    Frame F;
    F.lds = (LAS unsigned char*)lds; F.MISC = (volatile LAS unsigned*)(F.lds + LDSCTL_OFF);
    F.tid = threadIdx.x; F.lane = F.tid & 63; F.wave = __builtin_amdgcn_readfirstlane(F.tid >> 6);
    F.G = gridDim.x; { const int bx = blockIdx.x; F.vcu = (F.G % 8 == 0) ? (bx % 8) * (F.G / 8) + bx / 8 : bx; }
    F.ws = args.ws; F.ctl = (gu32*)(args.ws + WS_CTL); F.out = args.out;
    for (int u = F.tid; u < (LDS_BYTES - LDSCTL_OFF) / 4; u += NWAVES * 64) ((LAS unsigned*)(F.lds + LDSCTL_OFF))[u] = 0u;
    __syncthreads();
    if (F.tid < 24) ((LAS unsigned long long*)(F.lds + INTAB_OFF))[F.tid] = (unsigned long long)args.in[F.tid];
    __syncthreads();
    const int lo = args.ph_lo, hi = args.ph_hi;
    XcdBarrier bar = xcd_barrier_post((unsigned*)(F.ctl + CW_BAR) + args.li * XCD_BAR_WORDS, F.MISC + 8);
#ifndef PHASE_MASK
#define PHASE_MASK 0xFFFF
#endif
#define IN(k) (((PHASE_MASK >> (k)) & 1) && lo <= (k) && (k) < hi)
#define SEAM(k) do { if (IN(k) && IN((k) + 1)) xcd_barrier(bar); } while (0)
    unsigned char* ws = args.ws;
    const int G = F.G, bx = (int)blockIdx.x;
#if defined(PROBE_REPEAT)
    const bool dry = (args.li == 1);
#else
    constexpr bool dry = false;
#endif

    if (IN(0)) { p0_prologue(F); }
    SEAM(0);
    if (IN(1)) {
        pg8::Gemm g{(const bf16*)(ws + WS_XB), (const bf16*)(ws + WS_WIN), SEQ, N1, DM, DM, DM}; pg8::StaticOrder S; S.init(SEQ, N1, G, bx);
#if defined(PROBE_NULLEPI)
        if (args.li == PROBE_NULLEPI_LI) { EpiNull E0; pg8::gemm_phase<EpiNull, pg8::StaticOrder, true, true>(F.lds, g, S, E0); } else
#endif
        { Epi1 E{(const float*)(ws + WS_RS0), ws};
        pg8::gemm_phase<Epi1, pg8::StaticOrder, true, true>(F.lds, g, S, E); }
    }
    SEAM(1);
    if (IN(2)) {
        { pg8::Gemm g{(const bf16*)(ws + WS_CK), (const bf16*)(ws + WS_W1KV), 4096, 512, 2048, 1024, 2048}; pg8::OneUnit S{bx, bx >> 3, bx < 16 ? 1 : 0};
          EpiCmp E{(bf16*)(ws + WS_H), (const float*)(ws + WS_POSB)};
          pg8::gemm_phase<EpiCmp, pg8::OneUnit, false, true>(F.lds, g, S, E);
          if (bx < 16) { __threadfence(); __syncthreads(); compress_out(F, bx); } }
        __syncthreads();
        build_lut(F, in_ptr(F, 5));
        for (;;) {
            __syncthreads();
            if (F.tid == 0) F.MISC[16] = __hip_atomic_fetch_add(F.ctl + CW_QUEUE + args.li * 64, 1u, RLX_AGENT);
            __syncthreads();
            const int unit = (int)F.MISC[16];
            if (unit >= 1024) break;
            if (unit < 512) banded_unit<1>(F, in_ptr(F, 4), unit >> 1, unit & 1); else banded_unit<0>(F, in_ptr(F, 4), (unit - 512) >> 1, unit & 1);
        }
    }
    SEAM(2);
    if (IN(3)) {
        build_lut(F, in_ptr(F, 5));
        for (int i = bx; i < 256; i += G) {
#pragma unroll 1
            for (int hv = 0; hv < 2; ++hv) nsa_unit(F, hv == 0 ? 255 - i : i, hv == 0 ? 1 : 0, dry); }
    }
    SEAM(3);
    if (IN(4)) {
        { pg8::Gemm g{(const bf16*)(ws + WS_OA), (const bf16*)(ws + WS_WUPA), SEQ, DM, 512, 512, 512}; pg8::StaticOrder S; S.init(SEQ, DM, G, bx); EpiUp E{(bf16*)(ws + WS_MG), 0, (bf16*)(ws + (dry ? WS_QA : WS_MG))};
          pg8::gemm_phase<EpiUp, pg8::StaticOrder, true, true>(F.lds, g, S, E); }
        { pg8::Gemm g{(const bf16*)(ws + WS_OB), (const bf16*)(ws + WS_WUPB), SEQ, DM, 512, 512, 512}; pg8::StaticOrder S; S.init(SEQ, DM, G, bx); EpiUp E{(bf16*)(ws + WS_MG), 1024, (bf16*)(ws + (dry ? WS_QA : WS_MG))};
          pg8::gemm_phase<EpiUp, pg8::StaticOrder, true, true>(F.lds, g, S, E); }
    }
    SEAM(4);
    if (IN(5)) {
        { pg8::Gemm g{(const bf16*)(ws + WS_MG), (const bf16*)(ws + WS_WO2), SEQ, DM, 2048, 2048, 2048}; pg8::StaticOrder S; S.init(SEQ, DM, G, bx);
          EpiWo E{in_ptr(F, 0), F.out, (bf16*)(ws + WS_XB), (float*)(ws + WS_SSQ1)};
          pg8::gemm_phase<EpiWo, pg8::StaticOrder, true, true>(F.lds, g, S, E); }
        convert_peer_tables(F, in_ptr(F, 18), in_ptr(F, 19), in_ptr(F, 14));
    }
    SEAM(5);
    if (IN(6)) {
        { pg8::Gemm g{(const bf16*)(ws + WS_XB), (const bf16*)(ws + WS_WQ), SEQ, 2048, DM, DM, DM}; pg8::StaticOrder S; S.init(SEQ, 2048, G, bx); EpiPw E{(bf16*)(ws + WS_Q2), 2048};
          pg8::gemm_phase<EpiPw, pg8::StaticOrder, true, true>(F.lds, g, S, E); }
        { pg8::Gemm g{(const bf16*)(ws + WS_PB), (const bf16*)(ws + WS_WPLE), SEQ, DM, 256, 256, 256}; pg8::StaticOrder S; S.init(SEQ, DM, G, bx); EpiPw E{(bf16*)(ws + WS_PW), DM};
          pg8::gemm_phase<EpiPw, pg8::StaticOrder, true, true>(F.lds, g, S, E); }
    }
    SEAM(6);
    if (IN(7)) { __syncthreads(); peer_phase(F, dry); }
    SEAM(7);
    if (IN(8)) {
        pg8::Gemm g{(const bf16*)(ws + WS_XB), (const bf16*)(ws + WS_WPG), SEQ, DM, DM, DM, DM}; pg8::StaticOrder S; S.init(SEQ, DM, G, bx);
        EpiPle E{(const float*)(ws + WS_RS2), (const bf16*)(ws + WS_PW), F.out, dry ? (float*)(ws + WS_Q2) : F.out};
        pg8::gemm_phase<EpiPle, pg8::StaticOrder, true, true>(F.lds, g, S, E);
    }
    SEAM(8);
    if (IN(9)) final_norm(F, in_ptr(F, 23), dry ? (float*)(ws + WS_Q2) : F.out);
#undef IN
#undef SEAM
}

#ifndef MK_ONE_LAUNCH
#define MK_ONE_LAUNCH 1
#endif
extern "C" void kernel_launch(void* const* d_in, const int* in_sizes, int n_in, void* d_out, int out_size, void* d_ws, size_t ws_size, hipStream_t stream) {
    static int grid = 0;
    if (grid == 0) {
        if (n_in != 24 || in_sizes[0] != SEQ * DM || out_size != SEQ * DM || ws_size < WS_END) { fprintf(stderr, "kernel_launch: unexpected shapes (n_in %d, in0 %d, out %d, ws %zu); nothing launched\n", n_in, n_in > 0 ? in_sizes[0] : -1, out_size, ws_size); grid = -1; return; }
        int dev = 0, cus = 0, per_cu = 0;
        if (hipGetDevice(&dev) != hipSuccess || hipDeviceGetAttribute(&cus, hipDeviceAttributeMultiprocessorCount, dev) != hipSuccess) { grid = -1; return; }
        if (hipFuncSetAttribute((const void*)hybrid_fwd, hipFuncAttributeMaxDynamicSharedMemorySize, LDS_BYTES) != hipSuccess) { fprintf(stderr, "kernel_launch: hipFuncSetAttribute failed\n"); grid = -1; return; }
        if (hipOccupancyMaxActiveBlocksPerMultiprocessor(&per_cu, (const void*)hybrid_fwd, NWAVES * 64, LDS_BYTES) != hipSuccess || per_cu < 1) { fprintf(stderr, "kernel_launch: occupancy query says %d blocks per CU\n", per_cu); }
        (void)hipGetLastError();
        grid = cus;
    }
    if (grid < 0) return;
    if (hipMemsetAsync((char*)d_ws + WS_CTL, 0, CTL_ZERO_BYTES, stream) != hipSuccess) return;
    Args a{};
    for (int i = 0; i < 24; ++i) a.in[i] = (const float*)d_in[i];
    a.out = (float*)d_out; a.ws = (unsigned char*)d_ws;
#if defined(PROBE_REPEAT)
    const int cuts[4] = {0, PROBE_REPEAT + 1, PROBE_REPEAT, NPHASE};
    for (int li = 0; li < 3; ++li) { a.ph_lo = li == 0 ? 0 : li == 1 ? PROBE_REPEAT : PROBE_REPEAT + 1; a.ph_hi = li == 0 ? PROBE_REPEAT + 1 : li == 1 ? PROBE_REPEAT + 1 : NPHASE; a.li = li; (void)cuts;
        if (a.ph_lo < a.ph_hi) hipLaunchKernelGGL(hybrid_fwd, dim3(grid), dim3(NWAVES * 64), LDS_BYTES, stream, a); }
#elif MK_ONE_LAUNCH
    a.ph_lo = 0; a.ph_hi = NPHASE; a.li = 0;
    hipLaunchKernelGGL(hybrid_fwd, dim3(grid), dim3(NWAVES * 64), LDS_BYTES, stream, a);
#else
    for (int p = 0; p < NPHASE; ++p) { a.ph_lo = p; a.ph_hi = p + 1; a.li = 0; hipLaunchKernelGGL(hybrid_fwd, dim3(grid), dim3(NWAVES * 64), LDS_BYTES, stream, a); }
#endif
}
```

```cpp
#include <hip/hip_runtime.h>
#include <cstdio>
#include <cstdint>

#define GAS __attribute__((address_space(1)))
#define LAS __attribute__((address_space(3)))
typedef unsigned short bf16;
typedef short bf16x8 __attribute__((ext_vector_type(8)));
typedef short s16x4 __attribute__((ext_vector_type(4)));
typedef float f32x4 __attribute__((ext_vector_type(4)));
typedef float f32x16 __attribute__((ext_vector_type(16)));
typedef unsigned u32x4 __attribute__((ext_vector_type(4)));
typedef unsigned u32x2 __attribute__((ext_vector_type(2)));
typedef _Float16 h16x8 __attribute__((ext_vector_type(8)));
typedef GAS unsigned gu32;
typedef float f32x2_t __attribute__((ext_vector_type(2))); typedef __bf16 bf16x2_t __attribute__((ext_vector_type(2)));
__device__ __forceinline__ unsigned pkbf(float lo, float hi) { f32x2_t v = {lo, hi}; bf16x2_t b = __builtin_convertvector(v, bf16x2_t); return __builtin_bit_cast(unsigned, b); }
__device__ __forceinline__ float bf_lo(unsigned u) { return __uint_as_float(u << 16); }
__device__ __forceinline__ float bf_hi(unsigned u) { return __uint_as_float(u & 0xffff0000u); }
__device__ __forceinline__ float fexp2(float x) { return __builtin_amdgcn_exp2f(x); }
__device__ __forceinline__ float frcp(float x) { return __builtin_amdgcn_rcpf(x); }
__device__ __forceinline__ float sigmoidf_(float x) { return frcp(1.0f + fexp2(-1.4426950408889634f * x)); }
__device__ __forceinline__ float gelu_tanh(float x) { const float u = x * (1.0f + 0.044715f * x * x); return x * frcp(1.0f + fexp2(-2.302208198f * u)); }
#define LOG2E 1.4426950408889634f
#define RLX_AGENT __ATOMIC_RELAXED, __HIP_MEMORY_SCOPE_AGENT
#define LDS_WAIT() asm volatile("s_waitcnt lgkmcnt(0)" ::: "memory")
#define VM_WAIT() asm volatile("s_waitcnt vmcnt(0)" ::: "memory")

namespace pg8 {
#define PG8_LAS __attribute__((address_space(3)))
typedef unsigned short bf16_t;
typedef short bf16x8 __attribute__((ext_vector_type(8)));
typedef float f32x4 __attribute__((ext_vector_type(4)));
typedef unsigned u32x4 __attribute__((ext_vector_type(4)));
constexpr int BM = 256, BK = 64, HALF = 128, HTB = HALF * BK * 2  , STAGE_BYTES = 8 * HTB, NXCD = 8, WGM = 8;

__host__ __device__ __forceinline__ int lds_byte(int r, int c) { const int st = (r >> 4) * 2 + (c >> 5), rr = r & 15, cc = c & 31, ob = rr * 64 + cc * 2; return st * 1024 + (ob ^ (((ob >> 9) & 1) << 5)); }
__host__ __device__ __forceinline__ void stage_rc(int b, int& R, int& C) { const int st = b / 1024, sb = b % 1024, swz = sb ^ (((sb >> 9) & 1) << 5); R = (st >> 1) * 16 + swz / 64; C = (st & 1) * 32 + (swz % 64) / 2; }
__host__ __device__ __forceinline__ int perm32(int rho) { const int n = rho >> 4, i = rho & 15; return 8 * (i >> 2) + 4 * n + (i & 3); }

struct Unit { int pm, pn; };
struct Gemm { const bf16_t* A; const bf16_t* Bt; int M, N, K, lda, ldb; };

struct StaticOrder {
    int nM, nN, nwg, G, c;
    __host__ __device__ void init(int M, int N, int G_, int c_) { nM = M / BM; nN = N / BM; nwg = nM * nN; G = G_; c = c_; }
    __host__ __device__ bool next(int i, Unit& u) const {
        const long L = (long)i * G + c; if (L >= nwg) return false;
        int wgid = (int)L; { const int q = nwg / NXCD, r = nwg % NXCD, xcd = wgid % NXCD, off = wgid / NXCD; wgid = (xcd < r ? xcd * (q + 1) : r * (q + 1) + (xcd - r) * q) + off; }
        const int nig = WGM * nN, gid = wgid / nig, fm = gid * WGM, gsz = (nM - fm) < WGM ? (nM - fm) : WGM;
        u.pm = fm + ((wgid % nig) % gsz); u.pn = (wgid % nig) / gsz; return true;
    }
    __device__ __forceinline__ void a_ready(const Unit&) const {}
    __device__ __forceinline__ void done(const Unit&) const {}
};
struct OneUnit {
    int pm, pn, has;
    __device__ bool next(int i, Unit& u) const { if (i == 0 && has) { u.pm = pm; u.pn = pn; return true; } return false; }
    __device__ __forceinline__ void a_ready(const Unit&) const {}
    __device__ __forceinline__ void done(const Unit&) const {}
};
struct TailOrder {
    int a, b, nN;
    __device__ bool next(int i, Unit& u) const { const int id = i == 0 ? a : i == 1 ? b : -1; if (id < 0) return false; u.pm = id / nN; u.pn = id % nN; return true; }
    __device__ __forceinline__ void a_ready(const Unit&) const {}
    __device__ __forceinline__ void done(const Unit&) const {}
};
template <class Epi, class Sched, bool ALIGN_EPI = false, bool SP2 = false>
__device__ __forceinline__ void gemm_phase(PG8_LAS unsigned char* lds, const Gemm g, const Sched& S, const Epi& E) {
    const int tid = threadIdx.x, wid = __builtin_amdgcn_readfirstlane(tid >> 6), lane = tid & 63, wr = wid >> 2, wc = wid & 3, fr = lane & 15, fq = lane >> 4;
    const int K = g.K, nt = K / BK;
    unsigned voffA[2], voffB[2];
#pragma unroll
    for (int i = 0; i < 2; ++i) { int R, C; stage_rc(tid * 16 + i * 8192, R, C); const int Rb = Epi::PERM ? ((R & ~31) + perm32(R & 31)) : R;
        voffA[i] = (unsigned)(R * g.lda + C) * 2u; voffB[i] = (unsigned)(Rb * g.ldb + C) * 2u; }
    const size_t kstep = (size_t)(BK * 2);
    const size_t hstepA = (size_t)HALF * g.lda * 2, hstepB = (size_t)HALF * g.ldb * 2;
    const size_t tstepA = 2 * hstepA, tstepB = 2 * hstepB;
    const unsigned ldsw = (unsigned)wid * 1024u;
    const int aoff = lds_byte(wr * 64 + fr, fq * 8), boff = lds_byte(wc * 32 + fr, fq * 8);
#define PG8_SA(b, h) (((b) * 2 + (h)) * HTB)
#define PG8_SB(b, h) ((4 + (b) * 2 + (h)) * HTB)
#define PG8_STAGE(bufoff, gbase, voff) do { _Pragma("unroll") for (int _i = 0; _i < 2; ++_i) \
        __builtin_amdgcn_global_load_lds((const unsigned*)((const char*)(gbase) + (voff)[_i]), (PG8_LAS unsigned*)(lds + (bufoff) + ldsw + _i * 8192), 16, 0, 0); } while (0)
#define PG8_LDA(dst, b, h) do { _Pragma("unroll") for (int m = 0; m < 4; ++m) _Pragma("unroll") for (int k = 0; k < 2; ++k) dst[m][k] = *(const PG8_LAS bf16x8*)(lds + PG8_SA(b, h) + aoff + m * 2048 + k * 1024); } while (0)
#define PG8_LDB(dst, b, h) do { _Pragma("unroll") for (int n = 0; n < 2; ++n) _Pragma("unroll") for (int k = 0; k < 2; ++k) dst[n][k] = *(const PG8_LAS bf16x8*)(lds + PG8_SB(b, h) + boff + n * 2048 + k * 1024); } while (0)
#define PG8_MMA(ai, bj, At, Bt) do { __builtin_amdgcn_s_setprio(1); _Pragma("unroll") for (int m = 0; m < 4; ++m) _Pragma("unroll") for (int n = 0; n < 2; ++n) _Pragma("unroll") for (int k = 0; k < 2; ++k) \
        acc[ai][bj][m][n] = __builtin_amdgcn_mfma_f32_16x16x32_bf16(Bt[n][k], At[m][k], acc[ai][bj][m][n], 0, 0, 0); __builtin_amdgcn_s_setprio(0); } while (0)
#define PG8_WAIT_V(n) asm volatile("s_waitcnt vmcnt(" #n ")" ::: "memory")
#define PG8_WAIT_L(n) asm volatile("s_waitcnt lgkmcnt(" #n ")" ::: "memory")
#define PG8_BAR __builtin_amdgcn_s_barrier()
#define PG8_SCHED __builtin_amdgcn_sched_barrier(0)
    Unit cur, nxt; int ui = 0;
    if (!S.next(0, cur)) return;
    f32x4 acc[2][2][4][2];
#pragma unroll
    for (int a = 0; a < 2; ++a)
#pragma unroll
        for (int b = 0; b < 2; ++b)
#pragma unroll
            for (int m = 0; m < 4; ++m)
#pragma unroll
                for (int n = 0; n < 2; ++n) acc[a][b][m][n] = (f32x4){0.f, 0.f, 0.f, 0.f};
    bf16x8 At[4][2], B0[2][2], B1[2][2];
    const char* cA = (const char*)g.A + (size_t)cur.pm * tstepA; const char* cB = (const char*)g.Bt + (size_t)cur.pn * tstepB;
    S.a_ready(cur);
    if constexpr (SP2) {
        PG8_STAGE(PG8_SB(0, 0), cB, voffB); PG8_STAGE(PG8_SB(0, 1), cB + hstepB, voffB); PG8_STAGE(PG8_SA(0, 0), cA, voffA); PG8_STAGE(PG8_SA(0, 1), cA + hstepA, voffA);
        if (wr == 1) PG8_BAR;
        PG8_WAIT_V(2); PG8_BAR;
        PG8_STAGE(PG8_SB(1, 0), cB + kstep, voffB); PG8_STAGE(PG8_SA(1, 0), cA + kstep, voffA); PG8_STAGE(PG8_SB(1, 1), cB + hstepB + kstep, voffB);
        PG8_WAIT_V(6); PG8_BAR;
    } else {
        PG8_STAGE(PG8_SB(0, 0), cB, voffB); PG8_STAGE(PG8_SA(0, 0), cA, voffA); PG8_STAGE(PG8_SB(0, 1), cB + hstepB, voffB); PG8_STAGE(PG8_SA(0, 1), cA + hstepA, voffA);
        if (wr == 1) PG8_BAR;
        PG8_WAIT_V(4); PG8_BAR;
        PG8_STAGE(PG8_SB(1, 0), cB + kstep, voffB); PG8_STAGE(PG8_SA(1, 0), cA + kstep, voffA); PG8_STAGE(PG8_SB(1, 1), cB + hstepB + kstep, voffB);
        PG8_WAIT_V(6); PG8_BAR;
    }
    for (;;) {
        const bool has_next = S.next(ui + 1, nxt);
        const char* nA = has_next ? (const char*)g.A + (size_t)nxt.pm * tstepA : cA; const char* nB = has_next ? (const char*)g.Bt + (size_t)nxt.pn * tstepB : cB;
        for (int t = 0; t < nt; t += 2) {
            const bool last = (t == nt - 2);
            const char* a1 = cA + (size_t)(t + 1) * kstep;
            const char* a2 = last ? nA : cA + (size_t)(t + 2) * kstep; const char* b2 = last ? nB : cB + (size_t)(t + 2) * kstep;
            const char* a3 = a2 + kstep; const char* b3 = b2 + kstep;
            if (last && has_next) S.a_ready(nxt);
            if constexpr (SP2) {
            PG8_LDB(B0, 0, 0); PG8_LDB(B1, 0, 1); PG8_SCHED; PG8_LDA(At, 0, 0); PG8_STAGE(PG8_SA(1, 1), a1 + hstepA, voffA);
            PG8_WAIT_V(8); PG8_WAIT_L(0); PG8_BAR; PG8_MMA(0, 0, At, B0); PG8_MMA(0, 1, At, B1); PG8_BAR; PG8_SCHED;
            PG8_LDA(At, 0, 1); PG8_STAGE(PG8_SB(0, 0), b2, voffB); PG8_STAGE(PG8_SB(0, 1), b2 + hstepB, voffB); PG8_STAGE(PG8_SA(0, 0), a2, voffA);
            PG8_WAIT_V(8); PG8_WAIT_L(0); PG8_BAR; PG8_MMA(1, 0, At, B0); PG8_MMA(1, 1, At, B1); PG8_BAR; PG8_SCHED;
            PG8_LDB(B0, 1, 0); PG8_LDB(B1, 1, 1); PG8_SCHED; PG8_LDA(At, 1, 0); PG8_STAGE(PG8_SA(0, 1), a2 + hstepA, voffA);
            PG8_WAIT_V(8); PG8_WAIT_L(0); PG8_BAR; PG8_MMA(0, 0, At, B0); PG8_MMA(0, 1, At, B1); PG8_BAR; PG8_SCHED;
            PG8_LDA(At, 1, 1); PG8_STAGE(PG8_SB(1, 0), b3, voffB); PG8_STAGE(PG8_SB(1, 1), b3 + hstepB, voffB); PG8_STAGE(PG8_SA(1, 0), a3, voffA);
            PG8_WAIT_V(8); PG8_WAIT_L(0); PG8_BAR; PG8_MMA(1, 0, At, B0); PG8_MMA(1, 1, At, B1); PG8_BAR; PG8_SCHED;
            } else {
            PG8_LDB(B0, 0, 0); PG8_SCHED; PG8_LDA(At, 0, 0); PG8_STAGE(PG8_SA(1, 1), a1 + hstepA, voffA);
            PG8_WAIT_L(8); PG8_BAR; PG8_WAIT_L(0); PG8_MMA(0, 0, At, B0); PG8_BAR; PG8_SCHED;
            PG8_LDB(B1, 0, 1); PG8_STAGE(PG8_SB(0, 0), b2, voffB);
            PG8_BAR; PG8_WAIT_L(0); PG8_MMA(0, 1, At, B1); PG8_BAR;
            PG8_LDA(At, 0, 1); PG8_STAGE(PG8_SA(0, 0), a2, voffA);
            PG8_BAR; PG8_WAIT_L(0); PG8_MMA(1, 0, At, B0); PG8_BAR; PG8_SCHED;
            PG8_STAGE(PG8_SB(0, 1), b2 + hstepB, voffB);
            PG8_WAIT_V(6); PG8_BAR; PG8_MMA(1, 1, At, B1); PG8_BAR;
            PG8_LDB(B0, 1, 0); PG8_SCHED; PG8_LDA(At, 1, 0); PG8_STAGE(PG8_SA(0, 1), a2 + hstepA, voffA);
            PG8_WAIT_L(8); PG8_BAR; PG8_WAIT_L(0); PG8_MMA(0, 0, At, B0); PG8_BAR; PG8_SCHED;
            PG8_LDB(B1, 1, 1); PG8_STAGE(PG8_SB(1, 0), b3, voffB);
            PG8_BAR; PG8_WAIT_L(0); PG8_MMA(0, 1, At, B1); PG8_BAR;
            PG8_LDA(At, 1, 1); PG8_STAGE(PG8_SA(1, 0), a3, voffA);
            PG8_BAR; PG8_WAIT_L(0); PG8_MMA(1, 0, At, B0); PG8_BAR; PG8_SCHED;
            PG8_STAGE(PG8_SB(1, 1), b3 + hstepB, voffB);
            PG8_WAIT_V(6); PG8_BAR; PG8_MMA(1, 1, At, B1); PG8_BAR;
            }
        }
        if constexpr (ALIGN_EPI) { if (wr == 0) PG8_BAR; }
        if constexpr (!Epi::AFTER_DRAIN) { E(acc, cur, wr, wc, fr, fq); S.done(cur); }
        if (!has_next) break;
#pragma unroll
        for (int a = 0; a < 2; ++a)
#pragma unroll
            for (int b = 0; b < 2; ++b)
#pragma unroll
                for (int m = 0; m < 4; ++m)
#pragma unroll
                    for (int n = 0; n < 2; ++n) acc[a][b][m][n] = (f32x4){0.f, 0.f, 0.f, 0.f};
        cur = nxt; cA = nA; cB = nB; ++ui;
        if constexpr (ALIGN_EPI) { if (wr == 1) PG8_BAR; }
    }
    PG8_WAIT_V(0);
    if constexpr (!ALIGN_EPI) { if (wr == 0) PG8_BAR; }
    PG8_BAR;
    if constexpr (Epi::AFTER_DRAIN) { E.fused(acc, cur, wr, wc, fr, fq, lds, wid, lane); S.done(cur); }
#undef PG8_SA
#undef PG8_SB
#undef PG8_STAGE
#undef PG8_LDA
#undef PG8_LDB
#undef PG8_MMA
#undef PG8_WAIT_V
#undef PG8_WAIT_L
#undef PG8_BAR
#undef PG8_SCHED
}
}
#undef PG8_LAS
#define XB_TMO      128
#define XB_XCNT(j)  (256  + 64 * (j))
#define XB_XSUB(j)  (1280 + 64 * (j))
#define XB_XGEN(j)  (2304 + 64 * (j))
#define XB_TOP      3328
#define XB_TOPGEN   3392
#define XCD_BAR_WORDS 3456
#define XB_SPIN_CAP (1u << 18)

__device__ __forceinline__ unsigned xb_ld(unsigned* p)              { return __hip_atomic_load(p, __ATOMIC_RELAXED, __HIP_MEMORY_SCOPE_AGENT); }
__device__ __forceinline__ unsigned xb_add(unsigned* p, unsigned v) { return __hip_atomic_fetch_add(p, v, __ATOMIC_RELAXED, __HIP_MEMORY_SCOPE_AGENT); }
__device__ __forceinline__ unsigned xb_xcc_id() { return (unsigned)__builtin_amdgcn_s_getreg((3 << 11) | 20) & 0xFu; }
#define XB_SPIN(cond, bar) do { unsigned _sp = 0; while (cond) { __builtin_amdgcn_s_sleep(1); \
    if ((++_sp & 255u) == 0u) { if (xb_ld(&(bar)[XB_TMO])) break; if (_sp > XB_SPIN_CAP) { atomicAdd(&(bar)[XB_TMO], 1u); break; } } } } while (0)

struct XcdBarrier {
    unsigned* bar; unsigned x;
    volatile LAS unsigned* st;
};

__device__ __forceinline__ XcdBarrier xcd_barrier_post(unsigned* bar, volatile LAS unsigned* st) {
    XcdBarrier b; b.bar = bar; b.x = xb_xcc_id(); b.st = st;
    if (threadIdx.x == 0) (void)xb_add(&bar[XB_XCNT(b.x)], 1u);
    return b;
}
__device__ __forceinline__ void xcd_barrier_complete(unsigned* bar, unsigned x, unsigned& nloc, unsigned& nx) {
    const unsigned G = gridDim.x * gridDim.y * gridDim.z;
    unsigned sum, cnt, mine, sp = 0u;
    for (;;) {
        sum = 0u; cnt = 0u; mine = 0u;
#pragma unroll
        for (unsigned j = 0; j < 16; ++j) { const unsigned c = xb_ld(&bar[XB_XCNT(j)]); sum += c; cnt += (c > 0u) ? 1u : 0u; mine = (j == x) ? c : mine; }
        if (sum == G) break;
        __builtin_amdgcn_s_sleep(1);
        if ((++sp & 255u) == 0u) { if (xb_ld(&bar[XB_TMO])) break; if (sp > XB_SPIN_CAP) { atomicAdd(&bar[XB_TMO], 1u); break; } }
    }
    nloc = mine > 0u ? mine : 1u; nx = cnt > 0u ? cnt : 1u;
}

__device__ __forceinline__ void xcd_barrier(const XcdBarrier& b) {
    asm volatile("s_waitcnt vmcnt(0)" ::: "memory");
    __syncthreads();
    if (threadIdx.x == 0) {
        unsigned* bar = b.bar;
        __builtin_amdgcn_s_waitcnt(0);
        unsigned nloc = b.st[0], nx = b.st[1];
        if (nloc == 0u) { xcd_barrier_complete(bar, b.x, nloc, nx); b.st[0] = nloc; b.st[1] = nx; }
        const unsigned old = xb_add(&bar[XB_XSUB(b.x)], 1u);
        const unsigned gen = old / nloc;
        if (old + 1u == (gen + 1u) * nloc) {
            __builtin_amdgcn_fence(__ATOMIC_RELEASE, "agent");
            asm volatile("s_waitcnt vmcnt(0)" ::: "memory");
            const unsigned og = xb_add(&bar[XB_TOP], 1u);
            const unsigned tg = og / nx;
            if (og + 1u == (tg + 1u) * nx) xb_add(&bar[XB_TOPGEN], 1u);
            else XB_SPIN(xb_ld(&bar[XB_TOPGEN]) == tg, bar);
            __builtin_amdgcn_fence(__ATOMIC_ACQUIRE, "agent");
            xb_add(&bar[XB_XGEN(b.x)], 1u);
            asm volatile("s_waitcnt vmcnt(0)" ::: "memory");
        } else {
            XB_SPIN(xb_ld(&bar[XB_XGEN(b.x)]) == gen, bar);
            __builtin_amdgcn_fence(__ATOMIC_ACQUIRE, "agent");
            asm volatile("s_waitcnt vmcnt(0)" ::: "memory");
        }
    }
    __syncthreads();
}

constexpr int SEQ = 16384, DM = 1024, N1 = 4352  , NWAVES = 8;
constexpr float EPS = 1e-6f, QSCALE = 0.125f * LOG2E;
constexpr size_t MiB = 1u << 20;
constexpr size_t WS_CTL = 0, CTL_ZERO_BYTES = 1 * MiB;
constexpr size_t WS_WIN = 1 * MiB, WS_WUPA = 10 * MiB, WS_WUPB = 11 * MiB, WS_WO2 = 12 * MiB, WS_WQ = 16 * MiB, WS_WPG = 20 * MiB, WS_WPLE = 22 * MiB, WS_W1KV = 23 * MiB;
constexpr size_t WS_SMALL = 25 * MiB, WS_W2KT = WS_SMALL, WS_W2VT = WS_SMALL + 32768, WS_K1B = WS_SMALL + 65536, WS_K2B = WS_SMALL + 98304, WS_POSB = WS_SMALL + 131072,
                 WS_RS0 = WS_SMALL + 262144, WS_RS2 = WS_SMALL + 393216;
constexpr size_t WS_SSQ1 = 26 * MiB, WS_BG = 27 * MiB, WS_KC = 28 * MiB + 512 * 1024, WS_VCT = WS_KC + 262144, WS_H = 29 * MiB;
constexpr size_t WS_XB = 32 * MiB, WS_MG = 64 * MiB, WS_QA = 128 * MiB, WS_QB = 144 * MiB;
constexpr size_t WS_KA = 160 * MiB, WS_VTA = 164 * MiB, WS_CK = 168 * MiB, WS_KS = 176 * MiB, WS_VTS = 180 * MiB, WS_KW = 184 * MiB, WS_VTW = 188 * MiB;
constexpr size_t WS_OW = 192 * MiB, WS_PW = 208 * MiB, WS_PB = 240 * MiB;
constexpr size_t WS_OA = WS_QA, WS_OB = WS_QB;
constexpr size_t WS_U8 = 32 * MiB, WS_V8 = 48 * MiB, WS_XB2 = 128 * MiB, WS_Q2 = 64 * MiB;
constexpr size_t WS_END = 256 * MiB;
constexpr int CW_TMO = 0, CW_BAR = 4096, CW_QUEUE = 32768;
constexpr int LDS_BYTES = 147456, LDSCTL_OFF = 143360;
constexpr int KROW = 144, VROW = 136;
constexpr int AT_K0 = 0, AT_KSZ = 64 * KROW, AT_V0 = 2 * AT_KSZ, AT_VSZ = 64 * VROW, AT_LUT = 36864, LUTS = 136, AT_IMP = 46080, AT_SEL = 112640;
constexpr int SQ_OFF = 0, SO_OFF = AT_IMP, SO_ROW = 65, SM_OFF = 114688, SL_OFF = 115712, SS_OFF = 116736, SC_OFF = 117248;
constexpr int PK_ROW = 272, PK1_OFF = 0, PK2_OFF = 128 * PK_ROW, PW_OFF = 2 * 128 * PK_ROW, PW_BYTES = 8192;
static_assert(AT_V0 + 2 * AT_VSZ <= AT_LUT && AT_LUT + 16 * LUTS * 4 <= AT_IMP && AT_IMP + 65536 <= AT_SEL && SO_OFF + 256 * SO_ROW * 4 <= AT_SEL && AT_SEL + 2048 <= SM_OFF && 256 * KROW <= AT_LUT && SC_OFF + 64 <= LDSCTL_OFF && PW_OFF + 8 * PW_BYTES <= LDSCTL_OFF, "LDS map");

__device__ const unsigned char BKT[129] = {0,1,2,3,4,5,6,7,8,9,10,11,12,13,14,15,16,16,16,17,17,18,18,18,19,19,19,20,20,20,20,21,21,21,21,22,22,22,22,22,23,23,23,23,23,23,24,24,24,24,24,24,
    25,25,25,25,25,25,25,26,26,26,26,26,26,26,26,27,27,27,27,27,27,27,27,27,27,28,28,28,28,28,28,28,28,28,28,29,29,29,29,29,29,29,29,29,29,29,29,30,30,30,30,30,30,30,30,30,30,30,30,30,30,
    31,31,31,31,31,31,31,31,31,31,31,31,31,31,31,31};

struct Args { const float* in[24]; float* out; unsigned char* ws; int ph_lo, ph_hi, li, pad; };
struct Frame {
    LAS unsigned char* lds; volatile LAS unsigned* MISC; gu32* ctl; unsigned char* ws;
    int tid, lane, wave, vcu, G;
    float* out;
};
constexpr int INTAB_OFF = LDSCTL_OFF + 256;
__device__ __forceinline__ const float* in_ptr(const Frame& F, int k) {
    const unsigned long long v = ((const LAS unsigned long long*)(F.lds + INTAB_OFF))[k];
    const unsigned lo = __builtin_amdgcn_readfirstlane((unsigned)v), hi = __builtin_amdgcn_readfirstlane((unsigned)(v >> 32));
    return (const float*)(((unsigned long long)hi << 32) | lo);
}
template <int CTRL> __device__ __forceinline__ float dpp_f(float v) { return __uint_as_float((unsigned)__builtin_amdgcn_update_dpp(0, (int)__float_as_uint(v), CTRL, 0xf, 0xf, true)); }
template <int CTRL> __device__ __forceinline__ unsigned dpp_u(unsigned v) { return (unsigned)__builtin_amdgcn_update_dpp(0, (int)v, CTRL, 0xf, 0xf, true); }
__device__ __forceinline__ float wave_sum(float v) {
#pragma unroll
    for (int o = 1; o < 64; o <<= 1) v += __shfl_xor(v, o);
    return v;
}
__device__ __forceinline__ float quad_sum(float v) { v += dpp_f<0xB1>(v); v += dpp_f<0x4E>(v); return v; }
__device__ __forceinline__ unsigned umax_(unsigned a, unsigned b) { return a > b ? a : b; }
__device__ __forceinline__ unsigned wave_max_u32(unsigned v) {
    v = umax_(v, dpp_u<0xB1>(v)); v = umax_(v, dpp_u<0x4E>(v)); v = umax_(v, dpp_u<0x141>(v)); v = umax_(v, dpp_u<0x140>(v));
    const unsigned a = __builtin_amdgcn_readlane(v, 0), b = __builtin_amdgcn_readlane(v, 16), c = __builtin_amdgcn_readlane(v, 32), d = __builtin_amdgcn_readlane(v, 48);
    return umax_(umax_(a, b), umax_(c, d));
}
__device__ __forceinline__ float pair_max(float v) { auto rr = __builtin_amdgcn_permlane32_swap(__float_as_uint(v), __float_as_uint(v), false, false); return fmaxf(__uint_as_float(rr[0]), __uint_as_float(rr[1])); }
__device__ __forceinline__ float pair_sum(float v) { auto rr = __builtin_amdgcn_permlane32_swap(__float_as_uint(v), __float_as_uint(v), false, false); return __uint_as_float(rr[0]) + __uint_as_float(rr[1]); }
__device__ __forceinline__ unsigned pair_umax(unsigned v) { auto rr = __builtin_amdgcn_permlane32_swap(v, v, false, false); return umax_(rr[0], rr[1]); }
__device__ __forceinline__ unsigned ord_key(float v) { const unsigned u = __float_as_uint(v); return u ^ ((unsigned)((int)u >> 31) | 0x80000000u); }
__device__ __forceinline__ float ord_val(unsigned k) { const unsigned u = (k & 0x80000000u) ? (k ^ 0x80000000u) : ~k; return __uint_as_float(u); }
#define WG_BAR_LDS() do { asm volatile("s_waitcnt lgkmcnt(0)" ::: "memory"); __builtin_amdgcn_s_barrier(); asm volatile("" ::: "memory"); } while (0)
__device__ __forceinline__ u32x4 pack8(const f32x4& a, const f32x4& b) { u32x4 w; w.x = pkbf(a[0], a[1]); w.y = pkbf(a[2], a[3]); w.z = pkbf(b[0], b[1]); w.w = pkbf(b[2], b[3]); return w; }

typedef const f32x4 (&AccRef)[2][2][4][2];
struct Epi1 {
    static constexpr bool PERM = true, AFTER_DRAIN = false;
    const float* rs0; unsigned char* ws;
    __device__ __forceinline__ void operator()(AccRef acc, const pg8::Unit& u, int wr, int wc, int fr, int fq) const {
        asm volatile("" : "+v"(fr), "+v"(fq) :: "memory");
        const int row0 = u.pm * 256 + wr * 64 + fr, pn = u.pn, cl = wc * 32 + 8 * fq;
        float rsv[2][4];
#pragma unroll
        for (int ai = 0; ai < 2; ++ai)
#pragma unroll
            for (int m = 0; m < 4; ++m) rsv[ai][m] = rs0[row0 + ai * 128 + m * 16];
#pragma unroll
        for (int ai = 0; ai < 2; ++ai)
#pragma unroll
            for (int m = 0; m < 4; ++m) asm volatile("" : "+v"(rsv[ai][m]));
        if (pn < 4) {
            bf16* Q = (bf16*)(ws + (pn < 2 ? WS_QA : WS_QB)) + (pn & 1) * 256 + cl;
#pragma unroll
            for (int ai = 0; ai < 2; ++ai)
#pragma unroll
                for (int m = 0; m < 4; ++m) { const int row = row0 + ai * 128 + m * 16; const float s = rsv[ai][m] * QSCALE;
#pragma unroll
                    for (int bj = 0; bj < 2; ++bj) *(u32x4*)(Q + (size_t)row * 512 + bj * 128) = pack8(acc[ai][bj][m][0] * s, acc[ai][bj][m][1] * s); }
        } else if (pn < 8) {
            const int g = wc >> 1, dl = cl & 63;
            const size_t koff = pn == 4 ? WS_KA : pn == 5 ? WS_CK : pn == 6 ? WS_KS : WS_KW;
            const size_t voff = pn == 4 ? WS_VTA : pn == 5 ? WS_CK + (size_t)2 * SEQ * 64 * 2 : pn == 6 ? WS_VTS : WS_VTW;
            bf16* Kd = (bf16*)(ws + koff) + (size_t)g * SEQ * 64 + dl;
            bf16* Vd = (bf16*)(ws + voff);
#pragma unroll
            for (int ai = 0; ai < 2; ++ai)
#pragma unroll
                for (int m = 0; m < 4; ++m) { const int row = row0 + ai * 128 + m * 16; const float s = rsv[ai][m];
                    const u32x4 kq = pack8(acc[ai][0][m][0] * s, acc[ai][0][m][1] * s);
                    const u32x4 v = pack8(acc[ai][1][m][0] * s, acc[ai][1][m][1] * s);
                    if (pn == 6) {
                        const int key = row & 63, jb = row >> 6;
                        bf16* kt_ = (bf16*)(ws + WS_KS) + ((size_t)g * 256 + jb) * 4096 + (size_t)((((key >> 5) * 4 + (dl >> 4)) * 64 + ((dl >> 3) & 1) * 32 + (key & 31)) * 8);
                        *(u32x4*)kt_ = kq;
                        const int sI = key >> 4, kk = key & 15, hI = (kk >> 2) & 1, eI = ((kk >> 3) << 2) + (kk & 3);
                        bf16* vt_ = (bf16*)(ws + WS_VTS) + ((size_t)g * 256 + jb) * 4096 + (size_t)(((((dl >> 5) * 4 + sI) * 64 + hI * 32 + (dl & 31)) * 8) + eI);
                        vt_[0] = (bf16)v.x; vt_[8] = (bf16)(v.x >> 16); vt_[16] = (bf16)v.y; vt_[24] = (bf16)(v.y >> 16); vt_[32] = (bf16)v.z; vt_[40] = (bf16)(v.z >> 16); vt_[48] = (bf16)v.w; vt_[56] = (bf16)(v.w >> 16);
                        continue; }
                    *(u32x4*)(Kd + (size_t)row * 64) = kq;
                    if (pn == 5) *(u32x4*)(Vd + ((size_t)g * SEQ + row) * 64 + dl) = v;
                    else { bf16* vt = Vd + (size_t)(g * 64 + dl) * SEQ + row;
                        vt[0 * (size_t)SEQ] = (bf16)v.x; vt[1 * (size_t)SEQ] = (bf16)(v.x >> 16); vt[2 * (size_t)SEQ] = (bf16)v.y; vt[3 * (size_t)SEQ] = (bf16)(v.y >> 16);
                        vt[4 * (size_t)SEQ] = (bf16)v.z; vt[5 * (size_t)SEQ] = (bf16)(v.z >> 16); vt[6 * (size_t)SEQ] = (bf16)v.w; vt[7 * (size_t)SEQ] = (bf16)(v.w >> 16); } }
        } else if (pn < 16) {
            bf16* MG = (bf16*)(ws + WS_MG) + (pn - 8) * 256 + cl;
#pragma unroll
            for (int ai = 0; ai < 2; ++ai)
#pragma unroll
                for (int m = 0; m < 4; ++m) { const int row = row0 + ai * 128 + m * 16; const float s = rsv[ai][m];
#pragma unroll
                    for (int bj = 0; bj < 2; ++bj) { f32x4 a = acc[ai][bj][m][0] * s, b = acc[ai][bj][m][1] * s;
#pragma unroll
                        for (int e = 0; e < 4; ++e) { a[e] = sigmoidf_(a[e]); b[e] = sigmoidf_(b[e]); }
                        *(u32x4*)(MG + (size_t)row * 2048 + bj * 128) = pack8(a, b); } }
        } else {
            if (wc == 0 && fq < 3) { float* BG = (float*)(ws + WS_BG) + 8 * fq;
#pragma unroll
                for (int ai = 0; ai < 2; ++ai)
#pragma unroll
                    for (int m = 0; m < 4; ++m) { const int row = row0 + ai * 128 + m * 16; const float s = rsv[ai][m]; f32x4 a = acc[ai][0][m][0] * s, b = acc[ai][0][m][1] * s;
#pragma unroll
                        for (int e = 0; e < 4; ++e) { a[e] = sigmoidf_(a[e]); b[e] = sigmoidf_(b[e]); }
                        *(f32x4*)(BG + (size_t)row * 24) = a; *(f32x4*)(BG + (size_t)row * 24 + 4) = b; } }
        }
    }
};
struct EpiNull {
    static constexpr bool PERM = true, AFTER_DRAIN = false;
    __device__ __forceinline__ void operator()(AccRef acc, const pg8::Unit& u, int wr, int wc, int fr, int fq) const {
        asm volatile("" : "+v"(fr), "+v"(fq) :: "memory");
#pragma unroll
        for (int ai = 0; ai < 2; ++ai)
#pragma unroll
            for (int bj = 0; bj < 2; ++bj)
#pragma unroll
                for (int m = 0; m < 4; ++m)
#pragma unroll
                    for (int n = 0; n < 2; ++n) asm volatile("" :: "v"(acc[ai][bj][m][n]));
    }
};
struct EpiUp {
    static constexpr bool PERM = true, AFTER_DRAIN = false;
    bf16* MG; int coloff; bf16* DST;
    __device__ __forceinline__ void operator()(AccRef acc, const pg8::Unit& u, int wr, int wc, int fr, int fq) const {
        asm volatile("" : "+v"(fr), "+v"(fq) :: "memory");
        const int row0 = u.pm * 256 + wr * 64 + fr; bf16* base = MG + coloff + u.pn * 256 + wc * 32 + 8 * fq; bf16* dbase = DST + coloff + u.pn * 256 + wc * 32 + 8 * fq;
        u32x4 gt[2][4][2];
#pragma unroll
        for (int m = 0; m < 4; ++m)
#pragma unroll
            for (int bj = 0; bj < 2; ++bj) gt[0][m][bj] = *(const u32x4*)(base + (size_t)(row0 + m * 16) * 2048 + bj * 128);
#pragma unroll
        for (int ai = 0; ai < 2; ++ai) {
            if (ai == 0) {
#pragma unroll
                for (int m = 0; m < 4; ++m)
#pragma unroll
                    for (int bj = 0; bj < 2; ++bj) gt[1][m][bj] = *(const u32x4*)(base + (size_t)(row0 + 128 + m * 16) * 2048 + bj * 128);
            }
#pragma unroll
            for (int m = 0; m < 4; ++m) { bf16* rp = dbase + (size_t)(row0 + ai * 128 + m * 16) * 2048;
#pragma unroll
                for (int bj = 0; bj < 2; ++bj) { const u32x4 g = gt[ai][m][bj]; const f32x4 a = acc[ai][bj][m][0], b = acc[ai][bj][m][1]; u32x4 w;
                    w.x = pkbf(bf_lo(g.x) * a[0], bf_hi(g.x) * a[1]); w.y = pkbf(bf_lo(g.y) * a[2], bf_hi(g.y) * a[3]);
                    w.z = pkbf(bf_lo(g.z) * b[0], bf_hi(g.z) * b[1]); w.w = pkbf(bf_lo(g.w) * b[2], bf_hi(g.w) * b[3]);
                    *(u32x4*)(rp + bj * 128) = w; } }
        }
    }
};
struct EpiUp2 {
    static constexpr bool PERM = true, AFTER_DRAIN = false;
    bf16* MG; bf16* DST;
    __device__ __forceinline__ void operator()(AccRef acc, const pg8::Unit& u, int wr, int wc, int fr, int fq) const {
        asm volatile("" : "+v"(fr), "+v"(fq) :: "memory");
        const int row0 = u.pm * 256 + wr * 64 + fr; bf16* base = MG + u.pn * 256 + wc * 32 + 8 * fq; bf16* dbase = DST + u.pn * 256 + wc * 32 + 8 * fq;
        u32x4 tv[2][2][2], gv[2][2][2];
#define UP2_LOAD(par, bt) _Pragma("unroll") for (int mm = 0; mm < 2; ++mm) _Pragma("unroll") for (int bj = 0; bj < 2; ++bj) { \
            const bf16* p = base + (size_t)(row0 + ((bt) >> 1) * 128 + (((bt) & 1) * 2 + mm) * 16) * 2048 + bj * 128; tv[par][mm][bj] = *(const u32x4*)p; gv[par][mm][bj] = *(const u32x4*)(p + 1024); }
        UP2_LOAD(0, 0);
#pragma unroll
        for (int bt = 0; bt < 4; ++bt) {
            if (bt == 0) { UP2_LOAD(1, 1); } else if (bt == 1) { UP2_LOAD(0, 2); } else if (bt == 2) { UP2_LOAD(1, 3); }
            const int ai = bt >> 1;
#pragma unroll
            for (int mm = 0; mm < 2; ++mm) { const int m = (bt & 1) * 2 + mm; bf16* rp = dbase + (size_t)(row0 + ai * 128 + m * 16) * 2048;
#pragma unroll
                for (int bj = 0; bj < 2; ++bj) { const u32x4 t = tv[bt & 1][mm][bj], g = gv[bt & 1][mm][bj]; const f32x4 a = acc[ai][bj][m][0], b = acc[ai][bj][m][1]; u32x4 w;
                    w.x = pkbf(bf_lo(t.x) + bf_lo(g.x) * a[0], bf_hi(t.x) + bf_hi(g.x) * a[1]); w.y = pkbf(bf_lo(t.y) + bf_lo(g.y) * a[2], bf_hi(t.y) + bf_hi(g.y) * a[3]);
                    w.z = pkbf(bf_lo(t.z) + bf_lo(g.z) * b[0], bf_hi(t.z) + bf_hi(g.z) * b[1]); w.w = pkbf(bf_lo(t.w) + bf_lo(g.w) * b[2], bf_hi(t.w) + bf_hi(g.w) * b[3]);
                    *(u32x4*)(rp + bj * 128) = w; } }
        }
#undef UP2_LOAD
    }
};
struct EpiWo {
    static constexpr bool PERM = true, AFTER_DRAIN = false;
    const float* x; float* out; bf16* xb; float* ssq;
    __device__ __forceinline__ void operator()(AccRef acc, const pg8::Unit& u, int wr, int wc, int fr, int fq) const {
        asm volatile("" : "+v"(fr), "+v"(fq) :: "memory");
        const int row0 = u.pm * 256 + wr * 64 + fr, c0 = u.pn * 256 + wc * 32 + 8 * fq;
        f32x4 xv[2][2][2][2];
#define WO_LOAD(par, bt) _Pragma("unroll") for (int mm = 0; mm < 2; ++mm) _Pragma("unroll") for (int bj = 0; bj < 2; ++bj) { \
            const size_t o = (size_t)(row0 + ((bt) >> 1) * 128 + (((bt) & 1) * 2 + mm) * 16) * DM + c0 + bj * 128; xv[par][mm][bj][0] = *(const f32x4*)(x + o); xv[par][mm][bj][1] = *(const f32x4*)(x + o + 4); }
        WO_LOAD(0, 0);
#pragma unroll
        for (int bt = 0; bt < 4; ++bt) {
            if (bt == 0) { WO_LOAD(1, 1); } else if (bt == 1) { WO_LOAD(0, 2); } else if (bt == 2) { WO_LOAD(1, 3); }
            const int ai = bt >> 1;
#pragma unroll
            for (int mm = 0; mm < 2; ++mm) { const int m = (bt & 1) * 2 + mm, row = row0 + ai * 128 + m * 16; float ss = 0.f;
#pragma unroll
                for (int bj = 0; bj < 2; ++bj) { const size_t o = (size_t)row * DM + c0 + bj * 128;
                    const f32x4 a = xv[bt & 1][mm][bj][0] + acc[ai][bj][m][0], b = xv[bt & 1][mm][bj][1] + acc[ai][bj][m][1];
                    *(f32x4*)(out + o) = a; *(f32x4*)(out + o + 4) = b; *(u32x4*)(xb + o) = pack8(a, b);
                    ss += (a[0] * a[0] + a[1] * a[1]) + (a[2] * a[2] + a[3] * a[3]) + (b[0] * b[0] + b[1] * b[1]) + (b[2] * b[2] + b[3] * b[3]); }
                ss += __shfl_xor(ss, 16); ss += __shfl_xor(ss, 32);
                if (fq == 0) ssq[(size_t)row * 16 + u.pn * 4 + wc] = ss; }
        }
#undef WO_LOAD
    }
};
__device__ __forceinline__ float rs_from_ssq(const float* ssq, int row) {
    const f32x4* p = (const f32x4*)(ssq + (size_t)row * 16); const f32x4 a = p[0], b = p[1], c = p[2], d = p[3];
    const float s = ((a[0] + a[1]) + (a[2] + a[3])) + ((b[0] + b[1]) + (b[2] + b[3])) + ((c[0] + c[1]) + (c[2] + c[3])) + ((d[0] + d[1]) + (d[2] + d[3]));
    return __builtin_amdgcn_rsqf(s * (1.0f / DM) + EPS);
}
struct EpiPw {
    static constexpr bool PERM = true, AFTER_DRAIN = false;
    bf16* O; int ldc;
    __device__ __forceinline__ void operator()(AccRef acc, const pg8::Unit& u, int wr, int wc, int fr, int fq) const {
        asm volatile("" : "+v"(fr), "+v"(fq) :: "memory");
        const int row0 = u.pm * 256 + wr * 64 + fr; bf16* base = O + u.pn * 256 + wc * 32 + 8 * fq;
#pragma unroll
        for (int ai = 0; ai < 2; ++ai)
#pragma unroll
            for (int m = 0; m < 4; ++m)
#pragma unroll
                for (int bj = 0; bj < 2; ++bj) *(u32x4*)(base + (size_t)(row0 + ai * 128 + m * 16) * ldc + bj * 128) = pack8(acc[ai][bj][m][0], acc[ai][bj][m][1]);
    }
};
struct EpiPle {
    static constexpr bool PERM = true, AFTER_DRAIN = false;
    const float* rs2; const bf16* pw; float* out; float* dst;
    __device__ __forceinline__ void operator()(AccRef acc, const pg8::Unit& u, int wr, int wc, int fr, int fq) const {
        asm volatile("" : "+v"(fr), "+v"(fq) :: "memory");
        const int row0 = u.pm * 256 + wr * 64 + fr, c0 = u.pn * 256 + wc * 32 + 8 * fq;
        float rsv[2][4];
#pragma unroll
        for (int ai = 0; ai < 2; ++ai)
#pragma unroll
            for (int m = 0; m < 4; ++m) rsv[ai][m] = rs2[row0 + ai * 128 + m * 16];
#pragma unroll
        for (int ai = 0; ai < 2; ++ai)
#pragma unroll
            for (int m = 0; m < 4; ++m) asm volatile("" : "+v"(rsv[ai][m]));
        f32x4 xv[2][2][2]; u32x4 pv[2][2];
#define PLE_LOAD(par, bt) _Pragma("unroll") for (int bj = 0; bj < 2; ++bj) { \
            const size_t o = (size_t)(row0 + ((bt) >> 2) * 128 + ((bt) & 3) * 16) * DM + c0 + bj * 128; xv[par][bj][0] = *(const f32x4*)(out + o); xv[par][bj][1] = *(const f32x4*)(out + o + 4); pv[par][bj] = *(const u32x4*)(pw + o); }
        PLE_LOAD(0, 0);
#pragma unroll
        for (int bt = 0; bt < 8; ++bt) {
            if (bt < 7) { if ((bt & 1) == 0) { PLE_LOAD(1, bt + 1); } else { PLE_LOAD(0, bt + 1); } }
            const int ai = bt >> 2, m = bt & 3, row = row0 + ai * 128 + m * 16; const float s = rsv[ai][m];
#pragma unroll
            for (int bj = 0; bj < 2; ++bj) { const size_t o = (size_t)row * DM + c0 + bj * 128; const u32x4 p = pv[bt & 1][bj];
                f32x4 a = xv[bt & 1][bj][0], b = xv[bt & 1][bj][1]; const f32x4 ga = acc[ai][bj][m][0] * s, gb = acc[ai][bj][m][1] * s;
                a[0] += sigmoidf_(ga[0]) * bf_lo(p.x); a[1] += sigmoidf_(ga[1]) * bf_hi(p.x); a[2] += sigmoidf_(ga[2]) * bf_lo(p.y); a[3] += sigmoidf_(ga[3]) * bf_hi(p.y);
                b[0] += sigmoidf_(gb[0]) * bf_lo(p.z); b[1] += sigmoidf_(gb[1]) * bf_hi(p.z); b[2] += sigmoidf_(gb[2]) * bf_lo(p.w); b[3] += sigmoidf_(gb[3]) * bf_hi(p.w);
                *(f32x4*)(dst + o) = a; *(f32x4*)(dst + o + 4) = b; }
        }
#undef PLE_LOAD
    }
};
struct EpiCmp {
    static constexpr bool PERM = true, AFTER_DRAIN = false;
    bf16* H; const float* posb;
    __device__ __forceinline__ void operator()(AccRef acc, const pg8::Unit& u, int wr, int wc, int fr, int fq) const {
        asm volatile("" : "+v"(fr), "+v"(fq) :: "memory");
        const int row0 = u.pm * 256 + wr * 64 + fr, cl = wc * 32 + 8 * fq;
#pragma unroll
        for (int bj = 0; bj < 2; ++bj) { const f32x4 pa = *(const f32x4*)(posb + u.pn * 256 + bj * 128 + cl), pb = *(const f32x4*)(posb + u.pn * 256 + bj * 128 + cl + 4);
#pragma unroll
            for (int ai = 0; ai < 2; ++ai)
#pragma unroll
                for (int m = 0; m < 4; ++m) { f32x4 a = acc[ai][bj][m][0] + pa, b = acc[ai][bj][m][1] + pb;
#pragma unroll
                    for (int e = 0; e < 4; ++e) { a[e] = gelu_tanh(a[e]); b[e] = gelu_tanh(b[e]); }
                    *(u32x4*)(H + (size_t)(row0 + ai * 128 + m * 16) * 256 + bj * 128 + cl) = pack8(a, b); } }
    }
};

__device__ __forceinline__ void tr_item(const float* W, int Nsrc, int k0, int srcc0, int nvalid, bf16* WT, int ldk, int drow0, int dk0, const float* g, LAS float* scr, int lane) {
#pragma unroll 8
    for (int i = 0; i < 32; ++i) { const int kk = 2 * i + (lane >> 5), n = lane & 31; float v = 0.f;
        if (n < nvalid) { v = W[(size_t)(k0 + kk) * Nsrc + srcc0 + n]; if (g) v *= g[k0 + kk]; }
        scr[kk * 33 + n] = v; }
    LDS_WAIT(); asm volatile("" ::: "memory");
    const int c = lane & 7;
#pragma unroll
    for (int j = 0; j < 4; ++j) { const int n = (lane >> 3) + 8 * j; const LAS float* s = scr + (8 * c) * 33 + n;
        u32x4 o; o.x = pkbf(s[0 * 33], s[1 * 33]); o.y = pkbf(s[2 * 33], s[3 * 33]); o.z = pkbf(s[4 * 33], s[5 * 33]); o.w = pkbf(s[6 * 33], s[7 * 33]);
        *(u32x4*)(WT + (size_t)(drow0 + n) * ldk + dk0 + k0 + 8 * c) = o; }
    LDS_WAIT(); asm volatile("" ::: "memory");
}
__device__ __forceinline__ void weight_items(Frame& F, int part, int gw, int NGW) {
    LAS float* scr = (LAS float*)(F.lds + F.wave * 8448); const int lane = F.lane; unsigned char* ws = F.ws;
    constexpr int I_IN = 16 * 136, I_UP = 8 * 32, I_O = 16 * 32, I_Q = 16 * 64, I_PG = 16 * 32, I_PLE = 4 * 32, I_W1 = 32 * 8, I_W2 = 4 * 2;
    if (part == 0) {
        constexpr int NITEMS = I_IN + I_PLE + 2 * I_W1 + 2 * I_W2;
        for (int it = gw; it < NITEMS; it += NGW) {
            int r = it;
            if (r < I_IN) { const int kb = r / 136, nb = r % 136, n = nb * 32; int src, nv = 32;
                if (n < 512) src = n; else if (n < 1024) src = n + 256; else if (n < 1280) src = n - 512; else if (n < 2048) src = n; else if (n < 4096) src = n + 24;
                else if (n == 4096) { src = 2048; nv = 24; } else { src = 0; nv = 0; }
                tr_item(in_ptr(F, 3), 4120, kb * 64, src, nv, (bf16*)(ws + WS_WIN), 1024, n, 0, in_ptr(F, 2), scr, lane); continue; } r -= I_IN;
            if (r < I_PLE) { tr_item(in_ptr(F, 22), 1024, (r / 32) * 64, (r % 32) * 32, 32, (bf16*)(ws + WS_WPLE), 256, (r % 32) * 32, 0, nullptr, scr, lane); continue; } r -= I_PLE;
            if (r < I_W1) { tr_item(in_ptr(F, 7), 256, (r / 8) * 64, (r % 8) * 32, 32, (bf16*)(ws + WS_W1KV), 2048, (r % 8) * 32, 0, nullptr, scr, lane); continue; } r -= I_W1;
            if (r < I_W1) { tr_item(in_ptr(F, 9), 256, (r / 8) * 64, (r % 8) * 32, 32, (bf16*)(ws + WS_W1KV), 2048, 256 + (r % 8) * 32, 0, nullptr, scr, lane); continue; } r -= I_W1;
            if (r < I_W2) { tr_item(in_ptr(F, 8), 64, (r / 2) * 64, (r % 2) * 32, 32, (bf16*)(ws + WS_W2KT), 256, (r % 2) * 32, 0, nullptr, scr, lane); continue; } r -= I_W2;
            tr_item(in_ptr(F, 10), 64, (r / 2) * 64, (r % 2) * 32, 32, (bf16*)(ws + WS_W2VT), 256, (r % 2) * 32, 0, nullptr, scr, lane);
        }
    } else {
        constexpr int NITEMS = 2 * I_UP + I_O + I_Q + I_PG;
        for (int it = gw; it < NITEMS; it += NGW) {
            int r = it;
            if (r < I_UP) { tr_item(in_ptr(F, 11), 1024, (r / 32) * 64, (r % 32) * 32, 32, (bf16*)(ws + WS_WUPA), 512, (r % 32) * 32, 0, nullptr, scr, lane); continue; } r -= I_UP;
            if (r < I_UP) { tr_item(in_ptr(F, 12), 1024, (r / 32) * 64, (r % 32) * 32, 32, (bf16*)(ws + WS_WUPB), 512, (r % 32) * 32, 0, nullptr, scr, lane); continue; } r -= I_UP;
            if (r < I_O) { tr_item(in_ptr(F, 13), 1024, (r / 32) * 64, (r % 32) * 32, 32, (bf16*)(ws + WS_WO2), 1024, (r % 32) * 32, 0, nullptr, scr, lane); continue; } r -= I_O;
            if (r < I_Q) { tr_item(in_ptr(F, 15), 2048, (r / 64) * 64, (r % 64) * 32, 32, (bf16*)(ws + WS_WQ), 1024, (r % 64) * 32, 0, in_ptr(F, 14), scr, lane); continue; } r -= I_Q;
            tr_item(in_ptr(F, 21), 1024, (r / 32) * 64, (r % 32) * 32, 32, (bf16*)(ws + WS_WPG), 1024, (r % 32) * 32, 0, in_ptr(F, 20), scr, lane);
        }
    }
}
__device__ __forceinline__ void p0_prologue(Frame& F) {
    const int gw = F.vcu * NWAVES + F.wave, NGW = F.G * NWAVES, lane = F.lane;
    unsigned char* ws = F.ws;
    weight_items(F, 0, gw, NGW);
    { const float* x = in_ptr(F, 0); bf16* xb = (bf16*)(ws + WS_XB); float* rs0 = (float*)(ws + WS_RS0);
      for (int row = gw; row < SEQ; row += NGW) {
          const f32x4* xr = (const f32x4*)(x + (size_t)row * DM) + lane; f32x4 v[4]; float ss = 0.f;
#pragma unroll
          for (int j = 0; j < 4; ++j) { v[j] = xr[64 * j]; ss += (v[j][0] * v[j][0] + v[j][1] * v[j][1]) + (v[j][2] * v[j][2] + v[j][3] * v[j][3]); }
          ss = wave_sum(ss);
          u32x2* o8 = (u32x2*)(xb + (size_t)row * DM) + lane;
#pragma unroll
          for (int j = 0; j < 4; ++j) { u32x2 w; w.x = pkbf(v[j][0], v[j][1]); w.y = pkbf(v[j][2], v[j][3]); o8[64 * j] = w; }
          if (lane == 0) rs0[row] = __builtin_amdgcn_rsqf(ss * (1.0f / DM) + EPS);
      } }
    { const int gt = gw * 64 + lane, NGT = NGW * 64;
      const float* p = in_ptr(F, 1); bf16* pb = (bf16*)(ws + WS_PB);
      for (int i = gt; i < SEQ * 256 / 8; i += NGT) { const f32x4 a = *(const f32x4*)(p + (size_t)i * 8), b = *(const f32x4*)(p + (size_t)i * 8 + 4); *(u32x4*)(pb + (size_t)i * 8) = pack8(a, b); }
      for (int i = gt; i < 2 * 16384 / 8; i += NGT) { const int which = i >= 2048, j = i & 2047; const float* k = in_ptr(F, 16 + which) + (size_t)j * 8;
          *(u32x4*)((bf16*)(ws + (which ? WS_K2B : WS_K1B)) + (size_t)j * 8) = pack8(*(const f32x4*)k, *(const f32x4*)(k + 4)); } }
    if (F.vcu < 32) {
#pragma unroll 1
        for (int oo = 0; oo < 2; ++oo) { const int o = F.vcu * 16 + F.wave * 2 + oo, kv = o >> 8, n = o & 255; const float* w1 = in_ptr(F, kv ? 9 : 7); const float* pos = in_ptr(F, 6); float s = 0.f;
            for (int k = lane; k < 2048; k += 64) s += pos[k] * w1[(size_t)k * 256 + n];
            s = wave_sum(s); if (lane == 0) ((float*)(ws + WS_POSB))[o] = s; }
    }
}

struct TileSrc { const bf16* K; const bf16* Vt; int vpitch; };
__device__ __forceinline__ void tile_load(const TileSrc& s, int key0, bool needV, int tid, u32x4& kr, u32x4& vr) {
    const int row = tid >> 3, ch = tid & 7;
    kr = *(const u32x4*)(s.K + (size_t)(key0 + row) * 64 + ch * 8);
    if (needV) vr = *(const u32x4*)(s.Vt + (size_t)row * s.vpitch + key0 + ch * 8);
}
__device__ __forceinline__ void tile_store(LAS unsigned char* L, int buf, bool needV, int tid, const u32x4& kr, const u32x4& vr) {
    const int row = tid >> 3, ch = tid & 7;
    *(LAS u32x4*)(L + AT_K0 + buf * AT_KSZ + row * KROW + ch * 16) = kr;
    if (needV) { LAS u32x2* p = (LAS u32x2*)(L + AT_V0 + buf * AT_VSZ + row * VROW + ch * 16); u32x2 a, b; a.x = vr.x; a.y = vr.y; b.x = vr.z; b.y = vr.w; p[0] = a; p[1] = b; }
}
__device__ __forceinline__ void qk_tile(LAS const unsigned char* Kb, const bf16x8 (&q)[4], int r32, int h, f32x16& s0, f32x16& s1) {
#pragma unroll
    for (int i = 0; i < 16; ++i) { s0[i] = 0.f; s1[i] = 0.f; }
#pragma unroll
    for (int ks = 0; ks < 4; ++ks) {
        const bf16x8 a0 = *(LAS const bf16x8*)(Kb + r32 * KROW + (16 * ks + 8 * h) * 2), a1 = *(LAS const bf16x8*)(Kb + (32 + r32) * KROW + (16 * ks + 8 * h) * 2);
        s0 = __builtin_amdgcn_mfma_f32_32x32x16_bf16(a0, q[ks], s0, 0, 0, 0); s1 = __builtin_amdgcn_mfma_f32_32x32x16_bf16(a1, q[ks], s1, 0, 0, 0);
    }
}
__device__ __forceinline__ bf16x8 pack_p(const f32x16& s, int o) {
    u32x4 w; w.x = pkbf(s[o + 0], s[o + 1]); w.y = pkbf(s[o + 2], s[o + 3]); w.z = pkbf(s[o + 4], s[o + 5]); w.w = pkbf(s[o + 6], s[o + 7]); return __builtin_bit_cast(bf16x8, w);
}
__device__ __forceinline__ void softmax_pv(LAS const unsigned char* Vb, f32x16& s0, f32x16& s1, f32x16 (&o)[2], float& m, float& l, int r32, int h) {
    float mx = fmaxf(s0[0], s1[0]);
#pragma unroll
    for (int i = 1; i < 16; ++i) mx = fmaxf(mx, fmaxf(s0[i], s1[i]));
    mx = pair_max(mx);
    const float mn = fmaxf(m, mx), alpha = fexp2(m - mn); m = mn;
    float sum = 0.f;
#pragma unroll
    for (int i = 0; i < 16; ++i) { s0[i] = fexp2(s0[i] - mn); s1[i] = fexp2(s1[i] - mn); sum += s0[i] + s1[i]; }
    sum = pair_sum(sum); l = l * alpha + sum;
#pragma unroll
    for (int i = 0; i < 16; ++i) { o[0][i] *= alpha; o[1][i] *= alpha; }
    bf16x8 pf[4]; pf[0] = pack_p(s0, 0); pf[1] = pack_p(s0, 8); pf[2] = pack_p(s1, 0); pf[3] = pack_p(s1, 8);
#pragma unroll
    for (int dt = 0; dt < 2; ++dt)
#pragma unroll
        for (int s = 0; s < 4; ++s) { LAS const unsigned char* vp = Vb + (32 * dt + r32) * VROW + (16 * s + 4 * h) * 2;
            const u32x2 lo = *(LAS const u32x2*)vp, hi = *(LAS const u32x2*)(vp + 16); u32x4 a; a.x = lo.x; a.y = lo.y; a.z = hi.x; a.w = hi.y;
            o[dt] = __builtin_amdgcn_mfma_f32_32x32x16_bf16(__builtin_bit_cast(bf16x8, a), pf[s], o[dt], 0, 0, 0); }
}
#define KEYOFF(kt, i) (32 * (kt) + ((i) & 3) + 8 * ((i) >> 2))
#define NEG_INF (-__builtin_inff())

template <int W> struct FBand {
    int tq, tw, h; const LAS float* lut;
    __device__ __forceinline__ bool active(int tile) { const int key0 = tile * 64; return key0 <= tw + 7 && key0 + 63 >= tw - W + 1; }
    __device__ __forceinline__ void apply(f32x16& s0, f32x16& s1, int tile) {
        const int rel0 = tq - tile * 64 - 4 * h;
        if (tw - tile * 64 - 63 >= 128) { const float b = lut[128];
#pragma unroll
            for (int i = 0; i < 16; ++i) { const int r0 = rel0 - KEYOFF(0, i), r1 = rel0 - KEYOFF(1, i);
                s0[i] = (unsigned)r0 < (unsigned)W ? s0[i] + b : NEG_INF; s1[i] = (unsigned)r1 < (unsigned)W ? s1[i] + b : NEG_INF; }
        } else {
#pragma unroll
            for (int i = 0; i < 16; ++i) { const int r0 = rel0 - KEYOFF(0, i), r1 = rel0 - KEYOFF(1, i);
                const float b0 = lut[min(max(r0, 0), 128)], b1 = lut[min(max(r1, 0), 128)];
                s0[i] = (unsigned)r0 < (unsigned)W ? s0[i] + b0 : NEG_INF; s1[i] = (unsigned)r1 < (unsigned)W ? s1[i] + b1 : NEG_INF; }
        }
    }
};
struct FCmp {
    int lim0, cmax_w;
    __device__ __forceinline__ bool active(int tile) { return tile * 64 <= cmax_w; }
    __device__ __forceinline__ void apply(f32x16& s0, f32x16& s1, int tile) {
        const int lim = lim0 - tile * 64;
#pragma unroll
        for (int i = 0; i < 16; ++i) { s0[i] = KEYOFF(0, i) <= lim ? s0[i] : NEG_INF; s1[i] = KEYOFF(1, i) <= lim ? s1[i] : NEG_INF; }
    }
};
#define ATTN_STEP(J) { if (i + (J) >= ntiles) break; const int buf = (i + (J)) & 1; \
        tile_store(L, buf, NEEDV, tid, kr[J], vr[J]); if (i + (J) + RD < ntiles) tile_load(src, (tile_lo + i + (J) + RD) * 64, NEEDV, tid, kr[J], vr[J]); \
        WG_BAR_LDS(); const int tile = tile_lo + i + (J); BODY }
template <int RD, class Fn>
__device__ __forceinline__ void attn_loop(LAS unsigned char* L, const TileSrc& src, int tile_lo, int ntiles, const bf16x8 (&q)[4], f32x16 (&o)[2], float& m, float& l, Fn& f, int tid, int r32, int h) {
    u32x4 kr[RD], vr[RD];
    constexpr bool NEEDV = true;
#pragma unroll
    for (int j = 0; j < RD; ++j) if (j < ntiles) tile_load(src, (tile_lo + j) * 64, true, tid, kr[j], vr[j]);
#define BODY if (f.active(tile)) { f32x16 s0, s1; qk_tile(L + AT_K0 + buf * AT_KSZ, q, r32, h, s0, s1); f.apply(s0, s1, tile); softmax_pv(L + AT_V0 + buf * AT_VSZ, s0, s1, o, m, l, r32, h); }
#pragma unroll 1
    for (int i = 0; i < ntiles; i += RD) { ATTN_STEP(0) ATTN_STEP(1) ATTN_STEP(2) if (RD > 3) ATTN_STEP(3) }
#undef BODY
    WG_BAR_LDS();
}
__device__ __forceinline__ void build_lut(Frame& F, const float* rb) {
    LAS float* lut = (LAS float*)(F.lds + AT_LUT);
    for (int i = F.tid; i < 16 * 129; i += NWAVES * 64) { const int hh = i / 129, rel = i % 129; lut[hh * LUTS + rel] = rb[(int)BKT[rel] * 16 + hh] * LOG2E; }
    __syncthreads();
}
__device__ __forceinline__ void store_o(bf16* dst, const f32x16 (&o)[2], float sc, int h) {
#pragma unroll
    for (int dt = 0; dt < 2; ++dt)
#pragma unroll
        for (int gq = 0; gq < 4; ++gq) { u32x2 w; w.x = pkbf(o[dt][4 * gq] * sc, o[dt][4 * gq + 1] * sc); w.y = pkbf(o[dt][4 * gq + 2] * sc, o[dt][4 * gq + 3] * sc);
            *(u32x2*)(dst + 32 * dt + 8 * gq + 4 * h) = w; }
}
template <int MODE>
__device__ __forceinline__ void banded_unit(Frame& F, const float* sink, int T, int g) {
    LAS unsigned char* L = F.lds; const int tid = F.tid, lane = F.lane, w = F.wave, r32 = lane & 31, h = lane >> 5;
    const int t0 = T * 64, tw = t0 + 8 * w, tq = tw + (r32 >> 2), hg = g * 4 + (r32 & 3);
    constexpr int W = MODE == 0 ? 128 : 512;
    const bf16* Qp = (const bf16*)(F.ws + (MODE == 0 ? WS_QA : WS_QB)) + (size_t)tq * 512 + hg * 64;
    bf16x8 q[4];
#pragma unroll
    for (int ks = 0; ks < 4; ++ks) q[ks] = *(const bf16x8*)(Qp + 16 * ks + 8 * h);
    f32x16 o[2];
#pragma unroll
    for (int i = 0; i < 16; ++i) { o[0][i] = 0.f; o[1][i] = 0.f; }
    float m = -1e30f, l = 0.f;
    if (MODE == 0) { m = sink[hg] * LOG2E; l = 1.f; }
    const int tlo = max(0, t0 - W + 1) >> 6, nt = T - tlo + 1;
    TileSrc src; src.K = (const bf16*)(F.ws + (MODE == 0 ? WS_KA : WS_KW)) + (size_t)g * SEQ * 64; src.Vt = (const bf16*)(F.ws + (MODE == 0 ? WS_VTA : WS_VTW)) + (size_t)g * 64 * SEQ; src.vpitch = SEQ;
    FBand<W> f; f.tq = tq; f.tw = tw; f.h = h; f.lut = (const LAS float*)(L + AT_LUT) + ((MODE == 0 ? 0 : 8) + hg) * LUTS;
    attn_loop<4>(L, src, tlo, nt, q, o, m, l, f, tid, r32, h);
    bf16* Op = (bf16*)(F.ws + (MODE == 0 ? WS_OA : WS_OW)) + (size_t)tq * 512 + hg * 64;
    store_o(Op, o, frcp(fmaxf(l, 1e-30f)), h);
}
__device__ __forceinline__ void compress_out(Frame& F, int b) {
    const int lane = F.lane, w = F.wave, r32 = lane & 31, h = lane >> 5;
    const int kvg = b >> 2, kv = kvg >> 1, g = kvg & 1, c0 = (b & 3) * 256 + 32 * w;
    const bf16* H = (const bf16*)(F.ws + WS_H) + (size_t)(256 * b + 32 * w + r32) * 256 + 8 * h;
    const bf16* W2 = (const bf16*)(F.ws + (kv ? WS_W2VT : WS_W2KT)) + (size_t)r32 * 256 + 8 * h;
    f32x16 a0, a1;
#pragma unroll
    for (int i = 0; i < 16; ++i) { a0[i] = 0.f; a1[i] = 0.f; }
#pragma unroll 4
    for (int ks = 0; ks < 16; ++ks) {
        const bf16x8 hf = *(const bf16x8*)(H + 16 * ks), w0 = *(const bf16x8*)(W2 + 16 * ks), w1 = *(const bf16x8*)(W2 + 32 * 256 + 16 * ks);
        if (kv == 0) { a0 = __builtin_amdgcn_mfma_f32_32x32x16_bf16(w0, hf, a0, 0, 0, 0); a1 = __builtin_amdgcn_mfma_f32_32x32x16_bf16(w1, hf, a1, 0, 0, 0); }
        else         { a0 = __builtin_amdgcn_mfma_f32_32x32x16_bf16(hf, w0, a0, 0, 0, 0); a1 = __builtin_amdgcn_mfma_f32_32x32x16_bf16(hf, w1, a1, 0, 0, 0); }
    }
    if (kv == 0) {
        const int c = c0 + r32; bf16* kc = (bf16*)(F.ws + WS_KC) + ((size_t)g * 1024 + c) * 64; const bool pad = (c == 1023);
#pragma unroll
        for (int nt = 0; nt < 2; ++nt)
#pragma unroll
            for (int gq = 0; gq < 4; ++gq) { const f32x16& a = nt ? a1 : a0; u32x2 wv; wv.x = pkbf(a[4 * gq], a[4 * gq + 1]); wv.y = pkbf(a[4 * gq + 2], a[4 * gq + 3]); if (pad) { wv.x = 0u; wv.y = 0u; }
                *(u32x2*)(kc + 32 * nt + 8 * gq + 4 * h) = wv; }
    } else {
        bf16* vct = (bf16*)(F.ws + WS_VCT) + (size_t)g * 64 * 1024;
#pragma unroll
        for (int nt = 0; nt < 2; ++nt)
#pragma unroll
            for (int gq = 0; gq < 4; ++gq) { const f32x16& a = nt ? a1 : a0; const int c = c0 + 8 * gq + 4 * h;
                u32x2 wv; wv.x = pkbf(a[4 * gq], a[4 * gq + 1]); wv.y = pkbf(a[4 * gq + 2], a[4 * gq + 3]); if (c + 3 == 1023) wv.y &= 0xffffu;
                *(u32x2*)(vct + (size_t)(32 * nt + r32) * 1024 + c) = wv; }
    }
}
#ifndef PROBE_SLC_MODE
#define PROBE_SLC_MODE 1
#endif
struct SlcCtx { bool probe; LAS unsigned char* L; const bf16* KSg; const bf16* VSg; const LAS float* lut; LAS unsigned char* slot; const LAS unsigned* selb; int t0, jt, lane, r32, h, hd; };
__device__ __forceinline__ int slc_perm(int k, int jt) { return k == 0 ? jt : k == 1 ? jt - 1 : k == 2 ? 0 : jt - (k - 1); }
template <int PASS>
__device__ __forceinline__ void slc_tile(const SlcCtx& C, int j, const bf16x8 (&kf)[2][4], const bf16x8 (&vf)[2][4]) {
    LAS unsigned char* L = C.L; const int lane = C.lane, r32 = C.r32, h = C.h, hd = C.hd;
    LAS unsigned* mref = (LAS unsigned*)(L + SM_OFF); LAS float* lsum = (LAS float*)(L + SL_OFF); LAS float* Oacc = (LAS float*)(L + SO_OFF);
    const bool mine = (C.selb[lane * 8 + (j >> 5)] >> (j & 31)) & 1u;
    const unsigned long long mask = __ballot(mine); const int n = __builtin_popcountll(mask);
    if (n == 0) return;
    if (mine) C.slot[__builtin_amdgcn_mbcnt_hi((unsigned)(mask >> 32), __builtin_amdgcn_mbcnt_lo((unsigned)mask, 0u))] = (unsigned char)lane;
    const bool nearb = (j + 2 >= C.jt);
    const int nch = (n + 7) >> 3;
#pragma unroll 1
    for (int pc = 0; pc < nch; ++pc) {
        const int ci = 8 * pc + (r32 >> 2); const bool cv = ci < n; const int tok = (int)C.slot[cv ? ci : 0]; const int row = tok * 4 + hd;
        const LAS unsigned char* qr = L + SQ_OFF + row * KROW + 16 * h;
        f32x16 s0, s1;
#pragma unroll
        for (int i = 0; i < 16; ++i) { s0[i] = 0.f; s1[i] = 0.f; }
#pragma unroll
        for (int ks = 0; ks < 4; ++ks) { const bf16x8 qf = *(const LAS bf16x8*)(qr + 32 * ks);
            s0 = __builtin_amdgcn_mfma_f32_32x32x16_bf16(kf[0][ks], qf, s0, 0, 0, 0); s1 = __builtin_amdgcn_mfma_f32_32x32x16_bf16(kf[1][ks], qf, s1, 0, 0, 0); }
        if (nearb) { const int rel0 = C.t0 + tok - 64 * j - 4 * h;
#pragma unroll
            for (int i = 0; i < 16; ++i) { const int r0 = rel0 - KEYOFF(0, i), r1 = rel0 - KEYOFF(1, i);
                const float b0 = C.lut[min(max(r0, 0), 128)], b1 = C.lut[min(max(r1, 0), 128)];
                s0[i] = r0 >= 0 ? s0[i] + b0 : NEG_INF; s1[i] = r1 >= 0 ? s1[i] + b1 : NEG_INF; }
        } else { const float b = C.lut[128];
#pragma unroll
            for (int i = 0; i < 16; ++i) { s0[i] += b; s1[i] += b; } }
        if (PASS == 0) {
            float mx = fmaxf(s0[0], s1[0]);
#pragma unroll
            for (int i = 1; i < 16; ++i) mx = fmaxf(mx, fmaxf(s0[i], s1[i]));
            mx = pair_max(mx);
            if (cv && h == 0) __hip_atomic_fetch_max(mref + row, ord_key(mx), __ATOMIC_RELAXED, __HIP_MEMORY_SCOPE_WORKGROUP);
        } else {
            const float mm = ord_val(mref[row]); float sum = 0.f;
#pragma unroll
            for (int i = 0; i < 16; ++i) { s0[i] = fexp2(s0[i] - mm); s1[i] = fexp2(s1[i] - mm); sum += s0[i] + s1[i]; }
            sum = pair_sum(sum);
            if (cv && h == 0) __hip_atomic_fetch_add(lsum + row, sum, __ATOMIC_RELAXED, __HIP_MEMORY_SCOPE_WORKGROUP);
            bf16x8 pf[4]; pf[0] = pack_p(s0, 0); pf[1] = pack_p(s0, 8); pf[2] = pack_p(s1, 0); pf[3] = pack_p(s1, 8);
            LAS float* orow = Oacc + row * SO_ROW + 4 * h;
#pragma unroll
            for (int dt = 0; dt < 2; ++dt) { f32x16 oo;
#pragma unroll
                for (int i = 0; i < 16; ++i) oo[i] = 0.f;
#pragma unroll
                for (int s = 0; s < 4; ++s) oo = __builtin_amdgcn_mfma_f32_32x32x16_bf16(vf[dt][s], pf[s], oo, 0, 0, 0);
                if (cv && !(C.probe && PROBE_SLC_MODE == 3)) {
#pragma unroll
                    for (int i = 0; i < 16; ++i) __hip_atomic_fetch_add((LAS int*)orow + 32 * dt + (i & 3) + 8 * (i >> 2), (int)__builtin_rintf(oo[i] * 65536.0f), __ATOMIC_RELAXED, __HIP_MEMORY_SCOPE_WORKGROUP); }
                else { asm volatile("" :: "v"(oo)); } }
        }
    }
}
template <int PASS, int NB>
__device__ __forceinline__ void slc_pass(const SlcCtx& C) {
    const int r32 = C.r32, h = C.h, jt = C.jt;
#pragma unroll 1
    for (;;) {
        int k0 = 0; if (C.lane == 0) k0 = (int)__hip_atomic_fetch_add((LAS unsigned*)(C.L + SC_OFF), (unsigned)NB, __ATOMIC_RELAXED, __HIP_MEMORY_SCOPE_WORKGROUP);
        k0 = __builtin_amdgcn_readfirstlane(k0);
        if (k0 > jt) break;
        bf16x8 kf[NB][2][4], vf[NB][2][4];
#pragma unroll
        for (int b = 0; b < NB; ++b) if (k0 + b <= jt) { const int j = slc_perm(k0 + b, jt);
#pragma unroll
            for (int kt = 0; kt < 2; ++kt)
#pragma unroll
                for (int ks = 0; ks < 4; ++ks) kf[b][kt][ks] = *(const bf16x8*)(C.KSg + (size_t)j * 4096 + ((kt * 4 + ks) * 64 + C.lane) * 8);
            if (PASS == 1) {
#pragma unroll
                for (int dt = 0; dt < 2; ++dt)
#pragma unroll
                    for (int s = 0; s < 4; ++s) vf[b][dt][s] = *(const bf16x8*)(C.VSg + (size_t)j * 4096 + ((dt * 4 + s) * 64 + C.lane) * 8); } }
#pragma unroll
        for (int b = 0; b < NB; ++b) if (k0 + b <= jt) slc_tile<PASS>(C, slc_perm(k0 + b, jt), kf[b], vf[PASS == 1 ? b : 0]);
    }
}
__device__ __forceinline__ void nsa_unit(Frame& F, int T, int g, bool probe_noslc) {
    LAS unsigned char* L = F.lds; const int tid = F.tid, lane = F.lane, w = F.wave, r32 = lane & 31, h = lane >> 5;
    const int t0 = T * 64, tw = t0 + 8 * w, ql = 8 * w + (r32 >> 2), tq = t0 + ql, hd = r32 & 3, hg = g * 4 + hd, jt = T;
    const bf16* Qp = (const bf16*)(F.ws + WS_QB) + (size_t)tq * 512 + hg * 64; bf16* Ob = (bf16*)(F.ws + WS_OB) + (size_t)tq * 512 + hg * 64;
    bf16x8 q[4];
#pragma unroll
    for (int ks = 0; ks < 4; ++ks) q[ks] = *(const bf16x8*)(Qp + 16 * ks + 8 * h);
    const float* bg = (const float*)(F.ws + WS_BG) + (size_t)tq * 24 + hg; const float g0 = bg[0], g1 = bg[8], g2 = bg[16];
    f32x16 o[2];
#pragma unroll
    for (int i = 0; i < 16; ++i) { o[0][i] = 0.f; o[1][i] = 0.f; }
    float m = -1e30f, l = 0.f;
    const int ncmp = t0 / 16 + 3, ntc = (ncmp + 63) >> 6;
    TileSrc sc; sc.K = (const bf16*)(F.ws + WS_KC) + (size_t)g * 1024 * 64; sc.Vt = (const bf16*)(F.ws + WS_VCT) + (size_t)g * 64 * 1024; sc.vpitch = 1024;
    FCmp fc; fc.lim0 = ((tq - 31) >> 4) - 4 * h; fc.cmax_w = (tw + 7 - 31) >> 4;
    attn_loop<3>(L, sc, 0, ntc, q, o, m, l, fc, tid, r32, h);
    const float inv = frcp(fmaxf(l, 1e-30f));
    { const bf16* OWp = (const bf16*)(F.ws + WS_OW) + (size_t)tq * 512 + hg * 64; const float s0_ = g0 * inv;
#pragma unroll
      for (int dt = 0; dt < 2; ++dt)
#pragma unroll
          for (int gq = 0; gq < 4; ++gq) { const u32x2 ow = *(const u32x2*)(OWp + 32 * dt + 8 * gq + 4 * h); u32x2 wv;
              wv.x = pkbf(s0_ * o[dt][4 * gq] + g2 * bf_lo(ow.x), s0_ * o[dt][4 * gq + 1] + g2 * bf_hi(ow.x));
              wv.y = pkbf(s0_ * o[dt][4 * gq + 2] + g2 * bf_lo(ow.y), s0_ * o[dt][4 * gq + 3] + g2 * bf_hi(ow.y));
              *(u32x2*)(Ob + 32 * dt + 8 * gq + 4 * h) = wv; } }
    LAS float* imp = (LAS float*)(L + AT_IMP);
    for (int i = lane; i < 8 * 256; i += 64) imp[8 * w * 256 + i] = 0.f;
    { constexpr int RD = 3; u32x4 kr[RD], vr[RD]; constexpr bool NEEDV = false; const TileSrc& src = sc; const int tile_lo = 0, ntiles = ntc;
#pragma unroll
      for (int j = 0; j < RD; ++j) if (j < ntiles) tile_load(src, j * 64, false, tid, kr[j], vr[j]);
#define BODY if (fc.active(tile)) { \
              f32x16 s0, s1; qk_tile(L + AT_K0 + buf * AT_KSZ, q, r32, h, s0, s1); \
              fc.apply(s0, s1, tile); \
              _Pragma("unroll") for (int kt = 0; kt < 2; ++kt) { const f32x16& s = kt ? s1 : s0; float mainv = 0.f, spv = 0.f; \
                  _Pragma("unroll") for (int gq = 0; gq < 4; ++gq) { const float p0 = fexp2(s[4 * gq] - m) * inv, p1 = fexp2(s[4 * gq + 1] - m) * inv, p2 = fexp2(s[4 * gq + 2] - m) * inv, p3 = fexp2(s[4 * gq + 3] - m) * inv; \
                      const float mq = quad_sum((p0 + p1) + (p2 + 0.5f * p3)), sq = quad_sum(0.5f * p3); \
                      if (gq == hd) { mainv = mq; spv = sq; } } \
                  const int j = tile * 16 + 8 * kt + 2 * hd + h; \
                  __hip_atomic_fetch_add((LAS int*)imp + ql * 256 + j, (int)__builtin_rintf(mainv * 16777216.0f), __ATOMIC_RELAXED, __HIP_MEMORY_SCOPE_WORKGROUP);   \
                  __hip_atomic_fetch_add((LAS int*)imp + ql * 256 + min(j + 1, 255), (j + 1 < 256) ? (int)__builtin_rintf(spv * 16777216.0f) : 0, __ATOMIC_RELAXED, __HIP_MEMORY_SCOPE_WORKGROUP); } }
#pragma unroll 1
      for (int i = 0; i < ntiles; i += RD) { ATTN_STEP(0) ATTN_STEP(1) ATTN_STEP(2) }
#undef BODY
      WG_BAR_LDS(); }
    LAS unsigned* selb = (LAS unsigned*)(L + AT_SEL);
#pragma unroll 1
    for (int qi = 0; qi < 8; ++qi) {
        const LAS float* row = imp + (8 * w + qi) * 256; unsigned mybits = 0u;
        if (lane == 0) mybits |= 1u;
        if (lane == (jt >> 5)) mybits |= 1u << (jt & 31);
        if (jt >= 1 && lane == ((jt - 1) >> 5)) mybits |= 1u << ((jt - 1) & 31);
        const int ncand = jt - 2;
        if (ncand > 0) {
            if (ncand <= 13) { if (lane == 0) mybits |= ((1u << (jt - 1)) - 2u); }
            else {
                unsigned k[4];
#pragma unroll
                for (int i = 0; i < 4; ++i) { const int j = lane + 64 * i; const unsigned v = ((const LAS unsigned*)row)[j]; k[i] = (j >= 1 && j <= jt - 2) ? ((v & ~255u) | (unsigned)(255 - j)) : 0u; }
#pragma unroll 1
                for (int it = 0; it < 13; ++it) { const unsigned mx = wave_max_u32(umax_(umax_(k[0], k[1]), umax_(k[2], k[3]))); const int j = 255 - (int)(mx & 255u);
                    if (lane == (j >> 5)) mybits |= 1u << (j & 31);
#pragma unroll
                    for (int i = 0; i < 4; ++i) k[i] = (k[i] == mx) ? 0u : k[i]; }
            }
        }
        if (lane < 8) selb[(8 * w + qi) * 8 + lane] = mybits;
    }
    if (probe_noslc && PROBE_SLC_MODE == 1) return;
    WG_BAR_LDS();
    { LAS unsigned char* qs = L + SQ_OFF + (ql * 4 + hd) * KROW + 16 * h;
#pragma unroll
      for (int ks = 0; ks < 4; ++ks) *(LAS bf16x8*)(qs + 32 * ks) = q[ks];
      for (int i = tid; i < 256 * SO_ROW; i += NWAVES * 64) ((LAS float*)(L + SO_OFF))[i] = 0.f;
      if (tid < 256) { ((LAS unsigned*)(L + SM_OFF))[tid] = 0u; ((LAS float*)(L + SL_OFF))[tid] = 0.f; }
      if (tid == 0) *(LAS unsigned*)(L + SC_OFF) = 0u; }
    WG_BAR_LDS();
    { SlcCtx C; C.probe = probe_noslc; C.L = L; C.KSg = (const bf16*)(F.ws + WS_KS) + (size_t)g * 256 * 4096; C.VSg = (const bf16*)(F.ws + WS_VTS) + (size_t)g * 256 * 4096;
      C.lut = (const LAS float*)(L + AT_LUT) + (8 + hg) * LUTS; C.slot = L + SS_OFF + w * 64; C.selb = selb; C.t0 = t0; C.jt = jt; C.lane = lane; C.r32 = r32; C.h = h; C.hd = hd;
      slc_pass<0, 4>(C);
      WG_BAR_LDS();
      if (tid == 0) *(LAS unsigned*)(L + SC_OFF) = 0u;
      WG_BAR_LDS();
      if (!(probe_noslc && PROBE_SLC_MODE == 2)) slc_pass<1, 1>(C);
      WG_BAR_LDS();
      LAS float* lsum = (LAS float*)(L + SL_OFF); LAS float* Oacc = (LAS float*)(L + SO_OFF);
      const int row = ql * 4 + hd; const float s2 = g1 * frcp(fmaxf(lsum[row], 1e-30f)) * (1.0f / 65536.0f); const LAS int* orow = (const LAS int*)Oacc + row * SO_ROW + 4 * h;
#pragma unroll
      for (int dt = 0; dt < 2; ++dt)
#pragma unroll
          for (int gq = 0; gq < 4; ++gq) { u32x2 wv; const u32x2 tt = *(const u32x2*)(Ob + 32 * dt + 8 * gq + 4 * h); const LAS int* op = orow + 32 * dt + 8 * gq;
              wv.x = pkbf(bf_lo(tt.x) + s2 * (float)op[0], bf_hi(tt.x) + s2 * (float)op[1]); wv.y = pkbf(bf_lo(tt.y) + s2 * (float)op[2], bf_hi(tt.y) + s2 * (float)op[3]);
              *(u32x2*)(Ob + 32 * dt + 8 * gq + 4 * h) = wv; }
    }
    WG_BAR_LDS();
}

typedef float f32x2 __attribute__((ext_vector_type(2)));
__device__ __forceinline__ float dot16_fp8(const u32x4& r, const f32x2 (&xp)[8]) {
    f32x2 a = __builtin_amdgcn_cvt_pk_f32_fp8((int)r.x, false) * xp[0];
    a = __builtin_elementwise_fma(__builtin_amdgcn_cvt_pk_f32_fp8((int)r.x, true), xp[1], a);
    a = __builtin_elementwise_fma(__builtin_amdgcn_cvt_pk_f32_fp8((int)r.y, false), xp[2], a); a = __builtin_elementwise_fma(__builtin_amdgcn_cvt_pk_f32_fp8((int)r.y, true), xp[3], a);
    a = __builtin_elementwise_fma(__builtin_amdgcn_cvt_pk_f32_fp8((int)r.z, false), xp[4], a); a = __builtin_elementwise_fma(__builtin_amdgcn_cvt_pk_f32_fp8((int)r.z, true), xp[5], a);
    a = __builtin_elementwise_fma(__builtin_amdgcn_cvt_pk_f32_fp8((int)r.w, false), xp[6], a); a = __builtin_elementwise_fma(__builtin_amdgcn_cvt_pk_f32_fp8((int)r.w, true), xp[7], a);
    return a.x + a.y;
}
typedef __bf16 v2bf __attribute__((ext_vector_type(2)));
__device__ __forceinline__ float dot2bf(unsigned a, unsigned b, float c) { return __builtin_amdgcn_fdot2_f32_bf16(__builtin_bit_cast(v2bf, a), __builtin_bit_cast(v2bf, b), c, false); }
__device__ __forceinline__ void peer_top16(const bf16* qrow, LAS const unsigned char* kmat, int r32, int h2, unsigned (&sel)[16]) {
    bf16x8 qf[8];
#pragma unroll
    for (int ks = 0; ks < 8; ++ks) qf[ks] = *(const bf16x8*)(qrow + 16 * ks + 8 * h2);
    unsigned key[64];
#pragma unroll
    for (int nt = 0; nt < 4; ++nt) { f32x16 s;
#pragma unroll
        for (int i = 0; i < 16; ++i) s[i] = 0.f;
#pragma unroll
        for (int ks = 0; ks < 8; ++ks) { const bf16x8 a = *(LAS const bf16x8*)(kmat + (32 * nt + r32) * PK_ROW + (16 * ks + 8 * h2) * 2); s = __builtin_amdgcn_mfma_f32_32x32x16_bf16(a, qf[ks], s, 0, 0, 0); }
#pragma unroll
        for (int i = 0; i < 16; ++i) key[nt * 16 + i] = (ord_key(s[i]) & ~127u) | (unsigned)(((63 - (nt * 16 + i)) << 1) | (1 - h2)); }
    unsigned prev = 0xFFFFFFFFu;
#pragma unroll
    for (int k = 0; k < 16; ++k) sel[k] = 0u;
#pragma unroll 1
    for (int it = 0; it < 16; ++it) { unsigned c = 0u;
#pragma unroll
        for (int i = 0; i < 64; ++i) c = umax_(c, key[i] - prev);
        const unsigned mloc = c + prev, mm = pair_umax(mloc);
#pragma unroll
        for (int k = 0; k < 16; ++k) sel[k] = (k == it) ? mm : sel[k];
        prev = mm; }
}
__device__ __forceinline__ int key_n(unsigned k) { const int low = k & 127, Lx = 63 - (low >> 1), hh = 1 - (low & 1); return ((Lx >> 4) << 5) + (((Lx >> 2) & 3) << 3) + (hh << 2) + (Lx & 3); }

__device__ __forceinline__ void peer_phase(Frame& F, bool dry) {
    LAS unsigned char* L = F.lds; const int tid = F.tid, lane = F.lane, w = F.wave, r32 = lane & 31, h2 = lane >> 5;
    unsigned char* ws = F.ws;
    for (int i = tid; i < 2 * 128 * 16; i += NWAVES * 64) { const int which = i >> 11, rr = (i >> 4) & 127, ch = i & 15;
        *(LAS u32x4*)(L + (which ? PK2_OFF : PK1_OFF) + rr * PK_ROW + ch * 16) = *(const u32x4*)((const bf16*)(ws + (which ? WS_K2B : WS_K1B)) + rr * 128 + ch * 8); }
    __syncthreads();
    LAS unsigned char* PW = L + PW_OFF + w * PW_BYTES;
    LAS unsigned char* XR = PW; LAS u32x2* LST = (LAS u32x2*)(PW + 2048); LAS unsigned char* I12 = PW + 6144; LAS float* WL = (LAS float*)(PW + 7168);
    const bf16* Q2 = (const bf16*)(ws + WS_Q2); const unsigned char* U8 = ws + WS_U8; const unsigned char* V8 = ws + WS_V8;
    bf16* xb = (bf16*)(ws + WS_XB2); const float* ssq1 = (const float*)(ws + WS_SSQ1); float* rs2 = (float*)(ws + WS_RS2);
    const int gw = F.vcu * NWAVES + w, NGW = F.G * NWAVES;
#pragma unroll 1
    for (int item = gw; item < SEQ / 4; item += NGW) {
        const int t0 = item * 4;
        {
            const int tk = r32 >> 3, hd = r32 & 7; const bf16* qrow = Q2 + (size_t)(t0 + tk) * 2048 + hd * 256;
            const float rsq = rs_from_ssq(ssq1, t0 + tk);
            unsigned s1[16], s2[16];
            peer_top16(qrow, L + PK1_OFF, r32, h2, s1);
            peer_top16(qrow + 128, L + PK2_OFF, r32, h2, s2);
            float v1[16], v2[16];
#pragma unroll
            for (int k = 0; k < 16; ++k) { v1[k] = ord_val(s1[k] & ~127u); v2[k] = ord_val(s2[k] & ~127u); }
            if (h2 == 0) { LAS unsigned* ip = (LAS unsigned*)(I12 + r32 * 32);
#pragma unroll
                for (int k4 = 0; k4 < 4; ++k4) { ip[k4] = (unsigned)key_n(s1[4 * k4]) | ((unsigned)key_n(s1[4 * k4 + 1]) << 8) | ((unsigned)key_n(s1[4 * k4 + 2]) << 16) | ((unsigned)key_n(s1[4 * k4 + 3]) << 24);
                    ip[4 + k4] = (unsigned)key_n(s2[4 * k4]) | ((unsigned)key_n(s2[4 * k4 + 1]) << 8) | ((unsigned)key_n(s2[4 * k4 + 2]) << 16) | ((unsigned)key_n(s2[4 * k4 + 3]) << 24); } }
            unsigned ck[50]; int nc = 0;
#pragma unroll
            for (int i = 0; i < 16; ++i)
#pragma unroll
                for (int j = 0; j < 16; ++j) if ((i + 1) * (j + 1) <= 16) { ck[nc] = (ord_key(v1[i] + v2[j]) & ~255u) | (unsigned)(255 - (16 * i + j)); ++nc; }
            unsigned prev = 0xFFFFFFFFu; float sc[16]; int ei[16];
#pragma unroll
            for (int it = 0; it < 16; ++it) { unsigned c = 0u;
#pragma unroll
                for (int i = 0; i < 50; ++i) c = umax_(c, ck[i] - prev);
                const unsigned mm = c + prev; prev = mm;
                const int flat = 255 - (int)(mm & 255u); sc[it] = ord_val(mm & ~255u);
                ei[it] = (int)I12[r32 * 32 + (flat >> 4)] * 128 + (int)I12[r32 * 32 + 16 + (flat & 15)]; }
            float den = 0.f, ex[16];
#pragma unroll
            for (int k = 0; k < 16; ++k) { ex[k] = fexp2((sc[k] - sc[0]) * (rsq * LOG2E)); den += ex[k]; }
            const float rd = frcp(den);
            if (h2 == 0) {
#pragma unroll
                for (int k = 0; k < 16; ++k) { u32x2 e; e.x = (unsigned)ei[k]; e.y = __float_as_uint(ex[k] * rd); LST[tk * 128 + hd * 16 + k] = e; } }
        }
#pragma unroll 1
        for (int tk = 0; tk < 4; ++tk) {
            const int t = t0 + tk;
            f32x2 xp[8];
            { const u32x4 xa = *(const u32x4*)(xb + (size_t)t * DM + lane * 16), xc = *(const u32x4*)(xb + (size_t)t * DM + lane * 16 + 8);
              xp[0] = (f32x2){bf_lo(xa.x), bf_hi(xa.x)}; xp[1] = (f32x2){bf_lo(xa.y), bf_hi(xa.y)}; xp[2] = (f32x2){bf_lo(xa.z), bf_hi(xa.z)}; xp[3] = (f32x2){bf_lo(xa.w), bf_hi(xa.w)};
              xp[4] = (f32x2){bf_lo(xc.x), bf_hi(xc.x)}; xp[5] = (f32x2){bf_lo(xc.y), bf_hi(xc.y)}; xp[6] = (f32x2){bf_lo(xc.z), bf_hi(xc.z)}; xp[7] = (f32x2){bf_lo(xc.w), bf_hi(xc.w)}; }
            const float rs = rs_from_ssq(ssq1, t) * (1.0f / 32.0f);
            const LAS u32x2* lst = LST + tk * 128;
#define PEER_LOAD8(R_, TAB_, e0_) _Pragma("unroll") for (int k = 0; k < 8; ++k) { const int idx = __builtin_amdgcn_readfirstlane((int)lst[(e0_) + k].x); R_[k] = *(const u32x4*)(TAB_ + (size_t)idx * DM + lane * 16); }
#define PEER_DOT16(r_) dot16_fp8(r_, xp)
#define PEER_UCOMP(R_, e0_) _Pragma("unroll") for (int k4 = 0; k4 < 2; ++k4) { \
                const float p0 = PEER_DOT16(R_[4 * k4]), p1 = PEER_DOT16(R_[4 * k4 + 1]), p2 = PEER_DOT16(R_[4 * k4 + 2]), p3 = PEER_DOT16(R_[4 * k4 + 3]); \
                auto s02 = __builtin_amdgcn_permlane32_swap(__float_as_uint(p0), __float_as_uint(p2), false, false); auto s13 = __builtin_amdgcn_permlane32_swap(__float_as_uint(p1), __float_as_uint(p3), false, false); \
                const float r0 = __uint_as_float(s02[0]) + __uint_as_float(s02[1]), r1 = __uint_as_float(s13[0]) + __uint_as_float(s13[1]); \
                auto s01 = __builtin_amdgcn_permlane16_swap(__float_as_uint(r0), __float_as_uint(r1), false, false); \
                float qv = __uint_as_float(s01[0]) + __uint_as_float(s01[1]); \
                qv += dpp_f<0xB1>(qv); qv += dpp_f<0x4E>(qv); qv += dpp_f<0x141>(qv); qv += dpp_f<0x140>(qv); \
                if ((lane & 15) == 0) { const int e = (e0_) + 4 * k4 + 2 * (lane >> 5) + ((lane >> 4) & 1); WL[e] = 0.25f * __uint_as_float(lst[e].y) * gelu_tanh(qv * rs); } }
            { u32x4 uR0[8], uR1[8];
              PEER_LOAD8(uR0, U8, 0);
#pragma unroll 1
              for (int e0 = 0; e0 < 128; e0 += 16) {
                  PEER_LOAD8(uR1, U8, e0 + 8);
                  PEER_UCOMP(uR0, e0);
                  if (e0 + 16 < 128) { PEER_LOAD8(uR0, U8, e0 + 16); }
                  PEER_UCOMP(uR1, e0 + 8);
              } }
            f32x2 o2[8];
#pragma unroll
            for (int i = 0; i < 8; ++i) o2[i] = (f32x2){0.f, 0.f};
#define PEER_VCOMP(R_, e0_) _Pragma("unroll") for (int k = 0; k < 8; ++k) { const float wv = WL[(e0_) + k]; const f32x2 w2 = (f32x2){wv, wv}; \
                o2[0] = __builtin_elementwise_fma(__builtin_amdgcn_cvt_pk_f32_fp8((int)R_[k].x, false), w2, o2[0]); o2[1] = __builtin_elementwise_fma(__builtin_amdgcn_cvt_pk_f32_fp8((int)R_[k].x, true), w2, o2[1]); \
                o2[2] = __builtin_elementwise_fma(__builtin_amdgcn_cvt_pk_f32_fp8((int)R_[k].y, false), w2, o2[2]); o2[3] = __builtin_elementwise_fma(__builtin_amdgcn_cvt_pk_f32_fp8((int)R_[k].y, true), w2, o2[3]); \
                o2[4] = __builtin_elementwise_fma(__builtin_amdgcn_cvt_pk_f32_fp8((int)R_[k].z, false), w2, o2[4]); o2[5] = __builtin_elementwise_fma(__builtin_amdgcn_cvt_pk_f32_fp8((int)R_[k].z, true), w2, o2[5]); \
                o2[6] = __builtin_elementwise_fma(__builtin_amdgcn_cvt_pk_f32_fp8((int)R_[k].w, false), w2, o2[6]); o2[7] = __builtin_elementwise_fma(__builtin_amdgcn_cvt_pk_f32_fp8((int)R_[k].w, true), w2, o2[7]); }
            { u32x4 vR0[8], vR1[8];
              PEER_LOAD8(vR0, V8, 0);
#pragma unroll 1
              for (int e0 = 0; e0 < 128; e0 += 16) {
                  PEER_LOAD8(vR1, V8, e0 + 8);
                  PEER_VCOMP(vR0, e0);
                  if (e0 + 16 < 128) { PEER_LOAD8(vR0, V8, e0 + 16); }
                  PEER_VCOMP(vR1, e0 + 8);
              } }
            float* op = F.out + (size_t)t * DM + lane * 16;
            float* od = dry ? (float*)(ws + WS_PB) + (size_t)gw * DM + lane * 16 : op; bf16* xd = dry ? (bf16*)(ws + WS_PB + 8 * MiB) + (size_t)gw * DM : xb + (size_t)t * DM; float* rd2 = dry ? (float*)(ws + WS_PB + 12 * MiB) + gw : rs2 + t;
            f32x4 a0 = *(const f32x4*)op, a1 = *(const f32x4*)(op + 4), b0 = *(const f32x4*)(op + 8), b1 = *(const f32x4*)(op + 12);
            a0[0] += o2[0].x; a0[1] += o2[0].y; a0[2] += o2[1].x; a0[3] += o2[1].y; a1[0] += o2[2].x; a1[1] += o2[2].y; a1[2] += o2[3].x; a1[3] += o2[3].y;
            b0[0] += o2[4].x; b0[1] += o2[4].y; b0[2] += o2[5].x; b0[3] += o2[5].y; b1[0] += o2[6].x; b1[1] += o2[6].y; b1[2] += o2[7].x; b1[3] += o2[7].y;
            *(f32x4*)od = a0; *(f32x4*)(od + 4) = a1; *(f32x4*)(od + 8) = b0; *(f32x4*)(od + 12) = b1;
            *(u32x4*)(xd + lane * 16) = pack8(a0, a1); *(u32x4*)(xd + lane * 16 + 8) = pack8(b0, b1);
            float ss = 0.f;
#pragma unroll
            for (int i = 0; i < 4; ++i) ss += a0[i] * a0[i] + a1[i] * a1[i] + b0[i] * b0[i] + b1[i] * b1[i];
            ss = wave_sum(ss);
            if (lane == 0) *rd2 = __builtin_amdgcn_rsqf(ss * (1.0f / DM) + EPS);
        }
    }
}
constexpr int NCONV = 512;
__device__ __forceinline__ void convert_peer_item(Frame& F, int item, const float* u, const float* v, const float* g) {
    unsigned char* U8 = F.ws + WS_U8; unsigned char* V8 = F.ws + WS_V8;
    constexpr int PER = 16384 * 1024 / 16 / NCONV;
    for (int k = F.tid; k < PER; k += NWAVES * 64) {
        const int i = item * PER + k, d0 = (i & 63) * 16; u32x4 wu, wv;
#pragma unroll
        for (int q = 0; q < 4; ++q) { const f32x4 gq = *(const f32x4*)(g + d0 + 4 * q) * 32.0f; const f32x4 a = *(const f32x4*)(u + (size_t)i * 16 + 4 * q) * gq, c = *(const f32x4*)(v + (size_t)i * 16 + 4 * q) * 4.0f;
            int pu = __builtin_amdgcn_cvt_pk_fp8_f32(a[0], a[1], 0, false); pu = __builtin_amdgcn_cvt_pk_fp8_f32(a[2], a[3], pu, true);
            int pv = __builtin_amdgcn_cvt_pk_fp8_f32(c[0], c[1], 0, false); pv = __builtin_amdgcn_cvt_pk_fp8_f32(c[2], c[3], pv, true);
            wu[q] = (unsigned)pu; wv[q] = (unsigned)pv; }
        *(u32x4*)(U8 + (size_t)i * 16) = wu; *(u32x4*)(V8 + (size_t)i * 16) = wv;
    }
}
__device__ __forceinline__ void final_norm(Frame& F, const float* gf, float* dst) {
    const int gw = F.vcu * NWAVES + F.wave, NGW = F.G * NWAVES, lane = F.lane;
    f32x4 gv[4];
#pragma unroll
    for (int j = 0; j < 4; ++j) gv[j] = ((const f32x4*)gf)[lane + 64 * j];
    for (int row = gw; row < SEQ; row += NGW) {
        f32x4* xr = (f32x4*)(F.out + (size_t)row * DM) + lane; f32x4 v[4]; float ss = 0.f;
#pragma unroll
        for (int j = 0; j < 4; ++j) { v[j] = xr[64 * j]; ss += (v[j][0] * v[j][0] + v[j][1] * v[j][1]) + (v[j][2] * v[j][2] + v[j][3] * v[j][3]); }
        const float rs = __builtin_amdgcn_rsqf(wave_sum(ss) * (1.0f / DM) + EPS);
        f32x4* dr = (f32x4*)(dst + (size_t)row * DM) + lane;
#pragma unroll
        for (int j = 0; j < 4; ++j) dr[64 * j] = v[j] * rs * gv[j];
    }
}

constexpr int NPHASE = 10;
__global__ void __launch_bounds__(NWAVES * 64, 2) hybrid_fwd(Args args) {
    extern __shared__ __attribute__((aligned(16))) unsigned char lds[];
    Frame F;
    F.lds = (LAS unsigned char*)lds; F.MISC = (volatile LAS unsigned*)(F.lds + LDSCTL_OFF);
    F.tid = threadIdx.x; F.lane = F.tid & 63; F.wave = __builtin_amdgcn_readfirstlane(F.tid >> 6);
    F.G = gridDim.x; { const int bx = blockIdx.x; F.vcu = (F.G % 8 == 0) ? (bx % 8) * (F.G / 8) + bx / 8 : bx; }
    F.ws = args.ws; F.ctl = (gu32*)(args.ws + WS_CTL); F.out = args.out;
    for (int u = F.tid; u < (LDS_BYTES - LDSCTL_OFF) / 4; u += NWAVES * 64) ((LAS unsigned*)(F.lds + LDSCTL_OFF))[u] = 0u;
    __syncthreads();
    if (F.tid < 24) ((LAS unsigned long long*)(F.lds + INTAB_OFF))[F.tid] = (unsigned long long)args.in[F.tid];
    __syncthreads();
    const int lo = args.ph_lo, hi = args.ph_hi;
    XcdBarrier bar = xcd_barrier_post((unsigned*)(F.ctl + CW_BAR) + args.li * XCD_BAR_WORDS, F.MISC + 8);
#ifndef PHASE_MASK
#define PHASE_MASK 0xFFFF
#endif
#define IN(k) (((PHASE_MASK >> (k)) & 1) && lo <= (k) && (k) < hi)
#define SEAM(k) do { if (IN(k) && IN((k) + 1)) xcd_barrier(bar); } while (0)
    unsigned char* ws = args.ws;
    const int G = F.G, bx = (int)blockIdx.x;
#if defined(PROBE_REPEAT)
    const bool dry = (args.li == 1);
#else
    constexpr bool dry = false;
#endif

    if (IN(0)) { p0_prologue(F); }
    SEAM(0);
    if (IN(1)) {
        pg8::Gemm g{(const bf16*)(ws + WS_XB), (const bf16*)(ws + WS_WIN), SEQ, N1, DM, DM, DM}; pg8::StaticOrder S; S.init(SEQ, N1, G, bx);
#if defined(PROBE_NULLEPI)
        if (args.li == PROBE_NULLEPI_LI) { EpiNull E0; pg8::gemm_phase<EpiNull, pg8::StaticOrder, true, true>(F.lds, g, S, E0); } else
#endif
        { Epi1 E{(const float*)(ws + WS_RS0), ws};
        pg8::gemm_phase<Epi1, pg8::StaticOrder, true, true>(F.lds, g, S, E); }
        if (G == 256 && !dry) { const int r = bx - 64; pg8::TailOrder T2{r >= 0 ? r : -1, (r >= 0 && r < 64) ? 192 + r : -1, 4};
            pg8::Gemm g2{(const bf16*)(ws + WS_PB), (const bf16*)(ws + WS_WPLE), SEQ, DM, 256, 256, 256}; EpiPw E2{(bf16*)(ws + WS_PW), DM};
            pg8::gemm_phase<EpiPw, pg8::TailOrder, false, true>(F.lds, g2, T2, E2);
            if (bx >= 64) { __syncthreads(); weight_items(F, 1, (bx - 64) * NWAVES + F.wave, (G - 64) * NWAVES); } }
        else if (!dry) { pg8::Gemm g2{(const bf16*)(ws + WS_PB), (const bf16*)(ws + WS_WPLE), SEQ, DM, 256, 256, 256}; pg8::StaticOrder S2; S2.init(SEQ, DM, G, bx); EpiPw E2{(bf16*)(ws + WS_PW), DM};
            pg8::gemm_phase<EpiPw, pg8::StaticOrder, true, true>(F.lds, g2, S2, E2); __syncthreads(); weight_items(F, 1, F.vcu * NWAVES + F.wave, G * NWAVES); }
        if (dry) { __syncthreads(); }
    }
    SEAM(1);
    if (IN(2)) {
        { pg8::Gemm g{(const bf16*)(ws + WS_CK), (const bf16*)(ws + WS_W1KV), 4096, 512, 2048, 1024, 2048}; pg8::OneUnit S{bx, bx >> 3, bx < 16 ? 1 : 0};
          EpiCmp E{(bf16*)(ws + WS_H), (const float*)(ws + WS_POSB)};
          pg8::gemm_phase<EpiCmp, pg8::OneUnit, false, true>(F.lds, g, S, E);
          if (bx < 16) { __threadfence(); __syncthreads(); compress_out(F, bx); } }
        __syncthreads();
        build_lut(F, in_ptr(F, 5));
        for (;;) {
            __syncthreads();
            if (F.tid == 0) F.MISC[16] = __hip_atomic_fetch_add(F.ctl + CW_QUEUE + args.li * 64, 1u, RLX_AGENT);
            __syncthreads();
            const int unit = (int)F.MISC[16];
            if (unit >= 1024 + NCONV) break;
            if (unit % 3 == 2) { convert_peer_item(F, unit / 3, in_ptr(F, 18), in_ptr(F, 19), in_ptr(F, 14)); continue; }
            const int au = (unit / 3) * 2 + unit % 3;
            if (au < 512) banded_unit<1>(F, in_ptr(F, 4), au >> 1, au & 1); else banded_unit<0>(F, in_ptr(F, 4), (au - 512) >> 1, au & 1);
        }
    }
    SEAM(2);
    if (IN(3)) {
        build_lut(F, in_ptr(F, 5));
        for (int i = bx; i < 256; i += G) {
#pragma unroll 1
            for (int hv = 0; hv < 2; ++hv) nsa_unit(F, hv == 0 ? 255 - i : i, hv == 0 ? 1 : 0, dry); }
    }
    SEAM(3);
    if (IN(4)) {
        { pg8::Gemm g{(const bf16*)(ws + WS_OA), (const bf16*)(ws + WS_WUPA), SEQ, DM, 512, 512, 512}; pg8::StaticOrder S; S.init(SEQ, DM, G, bx); EpiUp E{(bf16*)(ws + WS_MG), 0, (bf16*)(ws + (dry ? WS_QA : WS_MG))};
          pg8::gemm_phase<EpiUp, pg8::StaticOrder, true, true>(F.lds, g, S, E); }
        { pg8::Gemm g{(const bf16*)(ws + WS_OB), (const bf16*)(ws + WS_WUPB), SEQ, DM, 512, 512, 512}; pg8::StaticOrder S; S.init(SEQ, DM, G, bx); EpiUp2 E{(bf16*)(ws + WS_MG), (bf16*)(ws + (dry ? WS_QA : WS_MG))};
          pg8::gemm_phase<EpiUp2, pg8::StaticOrder, true, true>(F.lds, g, S, E); }
    }
    SEAM(4);
    if (IN(5)) {
        { pg8::Gemm g{(const bf16*)(ws + WS_MG), (const bf16*)(ws + WS_WO2), SEQ, DM, DM, 2048, DM};   pg8::StaticOrder S; S.init(SEQ, DM, G, bx);
          EpiWo E{in_ptr(F, 0), F.out, (bf16*)(ws + WS_XB2), (float*)(ws + WS_SSQ1)};
          pg8::gemm_phase<EpiWo, pg8::StaticOrder, true, true>(F.lds, g, S, E); }
    }
    SEAM(5);
    if (IN(6)) {
        { pg8::Gemm g{(const bf16*)(ws + WS_XB2), (const bf16*)(ws + WS_WQ), SEQ, 2048, DM, DM, DM}; pg8::StaticOrder S; S.init(SEQ, 2048, G, bx); EpiPw E{(bf16*)(ws + WS_Q2), 2048};
          pg8::gemm_phase<EpiPw, pg8::StaticOrder, true, true>(F.lds, g, S, E); }
    }
    SEAM(6);
    if (IN(7)) { __syncthreads(); peer_phase(F, dry); }
    SEAM(7);
    if (IN(8)) {
        pg8::Gemm g{(const bf16*)(ws + WS_XB2), (const bf16*)(ws + WS_WPG), SEQ, DM, DM, DM, DM}; pg8::StaticOrder S; S.init(SEQ, DM, G, bx);
        EpiPle E{(const float*)(ws + WS_RS2), (const bf16*)(ws + WS_PW), F.out, dry ? (float*)(ws + WS_Q2) : F.out};
        pg8::gemm_phase<EpiPle, pg8::StaticOrder, true, true>(F.lds, g, S, E);
    }
    SEAM(8);
    if (IN(9)) final_norm(F, in_ptr(F, 23), dry ? (float*)(ws + WS_Q2) : F.out);
#undef IN
#undef SEAM
}

#ifndef MK_ONE_LAUNCH
#define MK_ONE_LAUNCH 1
#endif
extern "C" void kernel_launch(void* const* d_in, const int* in_sizes, int n_in, void* d_out, int out_size, void* d_ws, size_t ws_size, hipStream_t stream) {
    static int grid = 0;
    if (grid == 0) {
        if (n_in != 24 || in_sizes[0] != SEQ * DM || out_size != SEQ * DM || ws_size < WS_END) { fprintf(stderr, "kernel_launch: unexpected shapes (n_in %d, in0 %d, out %d, ws %zu); nothing launched\n", n_in, n_in > 0 ? in_sizes[0] : -1, out_size, ws_size); grid = -1; return; }
        int dev = 0, cus = 0, per_cu = 0;
        if (hipGetDevice(&dev) != hipSuccess || hipDeviceGetAttribute(&cus, hipDeviceAttributeMultiprocessorCount, dev) != hipSuccess) { grid = -1; return; }
        if (hipFuncSetAttribute((const void*)hybrid_fwd, hipFuncAttributeMaxDynamicSharedMemorySize, LDS_BYTES) != hipSuccess) { fprintf(stderr, "kernel_launch: hipFuncSetAttribute failed\n"); grid = -1; return; }
        if (hipOccupancyMaxActiveBlocksPerMultiprocessor(&per_cu, (const void*)hybrid_fwd, NWAVES * 64, LDS_BYTES) != hipSuccess || per_cu < 1) { fprintf(stderr, "kernel_launch: occupancy query says %d blocks per CU\n", per_cu); }
        (void)hipGetLastError();
        grid = cus;
    }
    if (grid < 0) return;
    if (hipMemsetAsync((char*)d_ws + WS_CTL, 0, CTL_ZERO_BYTES, stream) != hipSuccess) return;
    Args a{};
    for (int i = 0; i < 24; ++i) a.in[i] = (const float*)d_in[i];
    a.out = (float*)d_out; a.ws = (unsigned char*)d_ws;
#if defined(PROBE_REPEAT)
    const int cuts[4] = {0, PROBE_REPEAT + 1, PROBE_REPEAT, NPHASE};
    for (int li = 0; li < 3; ++li) { a.ph_lo = li == 0 ? 0 : li == 1 ? PROBE_REPEAT : PROBE_REPEAT + 1; a.ph_hi = li == 0 ? PROBE_REPEAT + 1 : li == 1 ? PROBE_REPEAT + 1 : NPHASE; a.li = li; (void)cuts;
        if (a.ph_lo < a.ph_hi) hipLaunchKernelGGL(hybrid_fwd, dim3(grid), dim3(NWAVES * 64), LDS_BYTES, stream, a); }
#elif MK_ONE_LAUNCH
    a.ph_lo = 0; a.ph_hi = NPHASE; a.li = 0;
    hipLaunchKernelGGL(hybrid_fwd, dim3(grid), dim3(NWAVES * 64), LDS_BYTES, stream, a);
#else
    for (int p = 0; p < NPHASE; ++p) { a.ph_lo = p; a.ph_hi = p + 1; a.li = 0; hipLaunchKernelGGL(hybrid_fwd, dim3(grid), dim3(NWAVES * 64), LDS_BYTES, stream, a); }
#endif
}
```

```cpp
#include <hip/hip_runtime.h>
#include <cstdio>
#include <cstdint>

#define GAS __attribute__((address_space(1)))
#define LAS __attribute__((address_space(3)))
typedef unsigned short bf16;
typedef short bf16x8 __attribute__((ext_vector_type(8)));
typedef short s16x4 __attribute__((ext_vector_type(4)));
typedef float f32x4 __attribute__((ext_vector_type(4)));
typedef float f32x16 __attribute__((ext_vector_type(16)));
typedef unsigned u32x4 __attribute__((ext_vector_type(4)));
typedef unsigned u32x2 __attribute__((ext_vector_type(2)));
typedef _Float16 h16x8 __attribute__((ext_vector_type(8)));
typedef GAS unsigned gu32;
typedef float f32x2_t __attribute__((ext_vector_type(2))); typedef __bf16 bf16x2_t __attribute__((ext_vector_type(2)));
__device__ __forceinline__ unsigned pkbf(float lo, float hi) { f32x2_t v = {lo, hi}; bf16x2_t b = __builtin_convertvector(v, bf16x2_t); return __builtin_bit_cast(unsigned, b); }
__device__ __forceinline__ float bf_lo(unsigned u) { return __uint_as_float(u << 16); }
__device__ __forceinline__ float bf_hi(unsigned u) { return __uint_as_float(u & 0xffff0000u); }
__device__ __forceinline__ float fexp2(float x) { return __builtin_amdgcn_exp2f(x); }
__device__ __forceinline__ float frcp(float x) { return __builtin_amdgcn_rcpf(x); }
__device__ __forceinline__ float sigmoidf_(float x) { return frcp(1.0f + fexp2(-1.4426950408889634f * x)); }
__device__ __forceinline__ float gelu_tanh(float x) { const float u = x * (1.0f + 0.044715f * x * x); return x * frcp(1.0f + fexp2(-2.302208198f * u)); }
#define LOG2E 1.4426950408889634f
#define RLX_AGENT __ATOMIC_RELAXED, __HIP_MEMORY_SCOPE_AGENT
#define LDS_WAIT() asm volatile("s_waitcnt lgkmcnt(0)" ::: "memory")
#define VM_WAIT() asm volatile("s_waitcnt vmcnt(0)" ::: "memory")

namespace pg8 {
#define PG8_LAS __attribute__((address_space(3)))
typedef unsigned short bf16_t;
typedef short bf16x8 __attribute__((ext_vector_type(8)));
typedef float f32x4 __attribute__((ext_vector_type(4)));
typedef unsigned u32x4 __attribute__((ext_vector_type(4)));
constexpr int BM = 256, BK = 64, HALF = 128, HTB = HALF * BK * 2  , STAGE_BYTES = 8 * HTB, NXCD = 8, WGM = 8;

__host__ __device__ __forceinline__ int lds_byte(int r, int c) { const int st = (r >> 4) * 2 + (c >> 5), rr = r & 15, cc = c & 31, ob = rr * 64 + cc * 2; return st * 1024 + (ob ^ (((ob >> 9) & 1) << 5)); }
__host__ __device__ __forceinline__ void stage_rc(int b, int& R, int& C) { const int st = b / 1024, sb = b % 1024, swz = sb ^ (((sb >> 9) & 1) << 5); R = (st >> 1) * 16 + swz / 64; C = (st & 1) * 32 + (swz % 64) / 2; }
__host__ __device__ __forceinline__ int perm32(int rho) { const int n = rho >> 4, i = rho & 15; return 8 * (i >> 2) + 4 * n + (i & 3); }

struct Unit { int pm, pn; };
struct Gemm { const bf16_t* A; const bf16_t* Bt; int M, N, K, lda, ldb; };

struct StaticOrder {
    int nM, nN, nwg, G, c;
    __host__ __device__ void init(int M, int N, int G_, int c_) { nM = M / BM; nN = N / BM; nwg = nM * nN; G = G_; c = c_; }
    __host__ __device__ bool next(int i, Unit& u) const {
        const long L = (long)i * G + c; if (L >= nwg) return false;
        int wgid = (int)L; { const int q = nwg / NXCD, r = nwg % NXCD, xcd = wgid % NXCD, off = wgid / NXCD; wgid = (xcd < r ? xcd * (q + 1) : r * (q + 1) + (xcd - r) * q) + off; }
        const int nig = WGM * nN, gid = wgid / nig, fm = gid * WGM, gsz = (nM - fm) < WGM ? (nM - fm) : WGM;
        u.pm = fm + ((wgid % nig) % gsz); u.pn = (wgid % nig) / gsz; return true;
    }
    __device__ __forceinline__ void a_ready(const Unit&) const {}
    __device__ __forceinline__ void done(const Unit&) const {}
};
struct OneUnit {
    int pm, pn, has;
    __device__ bool next(int i, Unit& u) const { if (i == 0 && has) { u.pm = pm; u.pn = pn; return true; } return false; }
    __device__ __forceinline__ void a_ready(const Unit&) const {}
    __device__ __forceinline__ void done(const Unit&) const {}
};
struct TailOrder {
    int a, b, nN;
    __device__ bool next(int i, Unit& u) const { const int id = i == 0 ? a : i == 1 ? b : -1; if (id < 0) return false; u.pm = id / nN; u.pn = id % nN; return true; }
    __device__ __forceinline__ void a_ready(const Unit&) const {}
    __device__ __forceinline__ void done(const Unit&) const {}
};
template <class Epi, class Sched, bool ALIGN_EPI = false, bool SP2 = false>
__device__ __forceinline__ void gemm_phase(PG8_LAS unsigned char* lds, const Gemm g, const Sched& S, const Epi& E) {
    const int tid = threadIdx.x, wid = __builtin_amdgcn_readfirstlane(tid >> 6), lane = tid & 63, wr = wid >> 2, wc = wid & 3, fr = lane & 15, fq = lane >> 4;
    const int K = g.K, nt = K / BK;
    unsigned voffA[2], voffB[2];
#pragma unroll
    for (int i = 0; i < 2; ++i) { int R, C; stage_rc(tid * 16 + i * 8192, R, C); const int Rb = Epi::PERM ? ((R & ~31) + perm32(R & 31)) : R;
        voffA[i] = (unsigned)(R * g.lda + C) * 2u; voffB[i] = (unsigned)(Rb * g.ldb + C) * 2u; }
    const size_t kstep = (size_t)(BK * 2);
    const size_t hstepA = (size_t)HALF * g.lda * 2, hstepB = (size_t)HALF * g.ldb * 2;
    const size_t tstepA = 2 * hstepA, tstepB = 2 * hstepB;
    const unsigned ldsw = (unsigned)wid * 1024u;
    const int aoff = lds_byte(wr * 64 + fr, fq * 8), boff = lds_byte(wc * 32 + fr, fq * 8);
#define PG8_SA(b, h) (((b) * 2 + (h)) * HTB)
#define PG8_SB(b, h) ((4 + (b) * 2 + (h)) * HTB)
#define PG8_STAGE(bufoff, gbase, voff) do { _Pragma("unroll") for (int _i = 0; _i < 2; ++_i) \
        __builtin_amdgcn_global_load_lds((const unsigned*)((const char*)(gbase) + (voff)[_i]), (PG8_LAS unsigned*)(lds + (bufoff) + ldsw + _i * 8192), 16, 0, 0); } while (0)
#define PG8_LDA(dst, b, h) do { _Pragma("unroll") for (int m = 0; m < 4; ++m) _Pragma("unroll") for (int k = 0; k < 2; ++k) dst[m][k] = *(const PG8_LAS bf16x8*)(lds + PG8_SA(b, h) + aoff + m * 2048 + k * 1024); } while (0)
#define PG8_LDB(dst, b, h) do { _Pragma("unroll") for (int n = 0; n < 2; ++n) _Pragma("unroll") for (int k = 0; k < 2; ++k) dst[n][k] = *(const PG8_LAS bf16x8*)(lds + PG8_SB(b, h) + boff + n * 2048 + k * 1024); } while (0)
#define PG8_MMA(ai, bj, At, Bt) do { __builtin_amdgcn_s_setprio(1); _Pragma("unroll") for (int m = 0; m < 4; ++m) _Pragma("unroll") for (int n = 0; n < 2; ++n) _Pragma("unroll") for (int k = 0; k < 2; ++k) \
        acc[ai][bj][m][n] = __builtin_amdgcn_mfma_f32_16x16x32_bf16(Bt[n][k], At[m][k], acc[ai][bj][m][n], 0, 0, 0); __builtin_amdgcn_s_setprio(0); } while (0)
#define PG8_WAIT_V(n) asm volatile("s_waitcnt vmcnt(" #n ")" ::: "memory")
#define PG8_WAIT_L(n) asm volatile("s_waitcnt lgkmcnt(" #n ")" ::: "memory")
#define PG8_BAR __builtin_amdgcn_s_barrier()
#define PG8_SCHED __builtin_amdgcn_sched_barrier(0)
    Unit cur, nxt; int ui = 0;
    if (!S.next(0, cur)) return;
    f32x4 acc[2][2][4][2];
#pragma unroll
    for (int a = 0; a < 2; ++a)
#pragma unroll
        for (int b = 0; b < 2; ++b)
#pragma unroll
            for (int m = 0; m < 4; ++m)
#pragma unroll
                for (int n = 0; n < 2; ++n) acc[a][b][m][n] = (f32x4){0.f, 0.f, 0.f, 0.f};
    bf16x8 At[4][2], B0[2][2], B1[2][2];
    const char* cA = (const char*)g.A + (size_t)cur.pm * tstepA; const char* cB = (const char*)g.Bt + (size_t)cur.pn * tstepB;
    S.a_ready(cur);
    if constexpr (SP2) {
        PG8_STAGE(PG8_SB(0, 0), cB, voffB); PG8_STAGE(PG8_SB(0, 1), cB + hstepB, voffB); PG8_STAGE(PG8_SA(0, 0), cA, voffA); PG8_STAGE(PG8_SA(0, 1), cA + hstepA, voffA);
        if (wr == 1) PG8_BAR;
        PG8_WAIT_V(2); PG8_BAR;
        PG8_STAGE(PG8_SB(1, 0), cB + kstep, voffB); PG8_STAGE(PG8_SA(1, 0), cA + kstep, voffA); PG8_STAGE(PG8_SB(1, 1), cB + hstepB + kstep, voffB);
        PG8_WAIT_V(6); PG8_BAR;
    } else {
        PG8_STAGE(PG8_SB(0, 0), cB, voffB); PG8_STAGE(PG8_SA(0, 0), cA, voffA); PG8_STAGE(PG8_SB(0, 1), cB + hstepB, voffB); PG8_STAGE(PG8_SA(0, 1), cA + hstepA, voffA);
        if (wr == 1) PG8_BAR;
        PG8_WAIT_V(4); PG8_BAR;
        PG8_STAGE(PG8_SB(1, 0), cB + kstep, voffB); PG8_STAGE(PG8_SA(1, 0), cA + kstep, voffA); PG8_STAGE(PG8_SB(1, 1), cB + hstepB + kstep, voffB);
        PG8_WAIT_V(6); PG8_BAR;
    }
    for (;;) {
        const bool has_next = S.next(ui + 1, nxt);
        const char* nA = has_next ? (const char*)g.A + (size_t)nxt.pm * tstepA : cA; const char* nB = has_next ? (const char*)g.Bt + (size_t)nxt.pn * tstepB : cB;
        for (int t = 0; t < nt; t += 2) {
            const bool last = (t == nt - 2);
            const char* a1 = cA + (size_t)(t + 1) * kstep;
            const char* a2 = last ? nA : cA + (size_t)(t + 2) * kstep; const char* b2 = last ? nB : cB + (size_t)(t + 2) * kstep;
            const char* a3 = a2 + kstep; const char* b3 = b2 + kstep;
            if (last && has_next) S.a_ready(nxt);
            if constexpr (SP2) {
            PG8_LDB(B0, 0, 0); PG8_LDB(B1, 0, 1); PG8_SCHED; PG8_LDA(At, 0, 0); PG8_STAGE(PG8_SA(1, 1), a1 + hstepA, voffA);
            PG8_WAIT_V(8); PG8_WAIT_L(0); PG8_BAR; PG8_MMA(0, 0, At, B0); PG8_MMA(0, 1, At, B1); PG8_BAR; PG8_SCHED;
            PG8_LDA(At, 0, 1); PG8_STAGE(PG8_SB(0, 0), b2, voffB); PG8_STAGE(PG8_SB(0, 1), b2 + hstepB, voffB); PG8_STAGE(PG8_SA(0, 0), a2, voffA);
            PG8_WAIT_V(8); PG8_WAIT_L(0); PG8_BAR; PG8_MMA(1, 0, At, B0); PG8_MMA(1, 1, At, B1); PG8_BAR; PG8_SCHED;
            PG8_LDB(B0, 1, 0); PG8_LDB(B1, 1, 1); PG8_SCHED; PG8_LDA(At, 1, 0); PG8_STAGE(PG8_SA(0, 1), a2 + hstepA, voffA);
            PG8_WAIT_V(8); PG8_WAIT_L(0); PG8_BAR; PG8_MMA(0, 0, At, B0); PG8_MMA(0, 1, At, B1); PG8_BAR; PG8_SCHED;
            PG8_LDA(At, 1, 1); PG8_STAGE(PG8_SB(1, 0), b3, voffB); PG8_STAGE(PG8_SB(1, 1), b3 + hstepB, voffB); PG8_STAGE(PG8_SA(1, 0), a3, voffA);
            PG8_WAIT_V(8); PG8_WAIT_L(0); PG8_BAR; PG8_MMA(1, 0, At, B0); PG8_MMA(1, 1, At, B1); PG8_BAR; PG8_SCHED;
            } else {
            PG8_LDB(B0, 0, 0); PG8_SCHED; PG8_LDA(At, 0, 0); PG8_STAGE(PG8_SA(1, 1), a1 + hstepA, voffA);
            PG8_WAIT_L(8); PG8_BAR; PG8_WAIT_L(0); PG8_MMA(0, 0, At, B0); PG8_BAR; PG8_SCHED;
            PG8_LDB(B1, 0, 1); PG8_STAGE(PG8_SB(0, 0), b2, voffB);
            PG8_BAR; PG8_WAIT_L(0); PG8_MMA(0, 1, At, B1); PG8_BAR;
            PG8_LDA(At, 0, 1); PG8_STAGE(PG8_SA(0, 0), a2, voffA);
            PG8_BAR; PG8_WAIT_L(0); PG8_MMA(1, 0, At, B0); PG8_BAR; PG8_SCHED;
            PG8_STAGE(PG8_SB(0, 1), b2 + hstepB, voffB);
            PG8_WAIT_V(6); PG8_BAR; PG8_MMA(1, 1, At, B1); PG8_BAR;
            PG8_LDB(B0, 1, 0); PG8_SCHED; PG8_LDA(At, 1, 0); PG8_STAGE(PG8_SA(0, 1), a2 + hstepA, voffA);
            PG8_WAIT_L(8); PG8_BAR; PG8_WAIT_L(0); PG8_MMA(0, 0, At, B0); PG8_BAR; PG8_SCHED;
            PG8_LDB(B1, 1, 1); PG8_STAGE(PG8_SB(1, 0), b3, voffB);
            PG8_BAR; PG8_WAIT_L(0); PG8_MMA(0, 1, At, B1); PG8_BAR;
            PG8_LDA(At, 1, 1); PG8_STAGE(PG8_SA(1, 0), a3, voffA);
            PG8_BAR; PG8_WAIT_L(0); PG8_MMA(1, 0, At, B0); PG8_BAR; PG8_SCHED;
            PG8_STAGE(PG8_SB(1, 1), b3 + hstepB, voffB);
            PG8_WAIT_V(6); PG8_BAR; PG8_MMA(1, 1, At, B1); PG8_BAR;
            }
        }
        if constexpr (ALIGN_EPI) { if (wr == 0) PG8_BAR; }
        if constexpr (!Epi::AFTER_DRAIN) { E(acc, cur, wr, wc, fr, fq); S.done(cur); }
        if (!has_next) break;
#pragma unroll
        for (int a = 0; a < 2; ++a)
#pragma unroll
            for (int b = 0; b < 2; ++b)
#pragma unroll
                for (int m = 0; m < 4; ++m)
#pragma unroll
                    for (int n = 0; n < 2; ++n) acc[a][b][m][n] = (f32x4){0.f, 0.f, 0.f, 0.f};
        cur = nxt; cA = nA; cB = nB; ++ui;
        if constexpr (ALIGN_EPI) { if (wr == 1) PG8_BAR; }
    }
    PG8_WAIT_V(0);
    if constexpr (!ALIGN_EPI) { if (wr == 0) PG8_BAR; }
    PG8_BAR;
    if constexpr (Epi::AFTER_DRAIN) { E.fused(acc, cur, wr, wc, fr, fq, lds, wid, lane); S.done(cur); }
#undef PG8_SA
#undef PG8_SB
#undef PG8_STAGE
#undef PG8_LDA
#undef PG8_LDB
#undef PG8_MMA
#undef PG8_WAIT_V
#undef PG8_WAIT_L
#undef PG8_BAR
#undef PG8_SCHED
}
}
#undef PG8_LAS
#define XB_TMO      128
#define XB_XCNT(j)  (256  + 64 * (j))
#define XB_XSUB(j)  (1280 + 64 * (j))
#define XB_XGEN(j)  (2304 + 64 * (j))
#define XB_TOP      3328
#define XB_TOPGEN   3392
#define XCD_BAR_WORDS 3456
#define XB_SPIN_CAP (1u << 18)

__device__ __forceinline__ unsigned xb_ld(unsigned* p)              { return __hip_atomic_load(p, __ATOMIC_RELAXED, __HIP_MEMORY_SCOPE_AGENT); }
__device__ __forceinline__ unsigned xb_add(unsigned* p, unsigned v) { return __hip_atomic_fetch_add(p, v, __ATOMIC_RELAXED, __HIP_MEMORY_SCOPE_AGENT); }
__device__ __forceinline__ unsigned xb_xcc_id() { return (unsigned)__builtin_amdgcn_s_getreg((3 << 11) | 20) & 0xFu; }
#define XB_SPIN(cond, bar) do { unsigned _sp = 0; while (cond) { __builtin_amdgcn_s_sleep(1); \
    if ((++_sp & 255u) == 0u) { if (xb_ld(&(bar)[XB_TMO])) break; if (_sp > XB_SPIN_CAP) { atomicAdd(&(bar)[XB_TMO], 1u); break; } } } } while (0)

struct XcdBarrier {
    unsigned* bar; unsigned x;
    volatile LAS unsigned* st;
};

__device__ __forceinline__ XcdBarrier xcd_barrier_post(unsigned* bar, volatile LAS unsigned* st) {
    XcdBarrier b; b.bar = bar; b.x = xb_xcc_id(); b.st = st;
    if (threadIdx.x == 0) (void)xb_add(&bar[XB_XCNT(b.x)], 1u);
    return b;
}
__device__ __forceinline__ void xcd_barrier_complete(unsigned* bar, unsigned x, unsigned& nloc, unsigned& nx) {
    const unsigned G = gridDim.x * gridDim.y * gridDim.z;
    unsigned sum, cnt, mine, sp = 0u;
    for (;;) {
        sum = 0u; cnt = 0u; mine = 0u;
#pragma unroll
        for (unsigned j = 0; j < 16; ++j) { const unsigned c = xb_ld(&bar[XB_XCNT(j)]); sum += c; cnt += (c > 0u) ? 1u : 0u; mine = (j == x) ? c : mine; }
        if (sum == G) break;
        __builtin_amdgcn_s_sleep(1);
        if ((++sp & 255u) == 0u) { if (xb_ld(&bar[XB_TMO])) break; if (sp > XB_SPIN_CAP) { atomicAdd(&bar[XB_TMO], 1u); break; } }
    }
    nloc = mine > 0u ? mine : 1u; nx = cnt > 0u ? cnt : 1u;
}

__device__ __forceinline__ void xcd_barrier(const XcdBarrier& b) {
    asm volatile("s_waitcnt vmcnt(0)" ::: "memory");
    __syncthreads();
    if (threadIdx.x == 0) {
        unsigned* bar = b.bar;
        __builtin_amdgcn_s_waitcnt(0);
        unsigned nloc = b.st[0], nx = b.st[1];
        if (nloc == 0u) { xcd_barrier_complete(bar, b.x, nloc, nx); b.st[0] = nloc; b.st[1] = nx; }
        const unsigned old = xb_add(&bar[XB_XSUB(b.x)], 1u);
        const unsigned gen = old / nloc;
        if (old + 1u == (gen + 1u) * nloc) {
            __builtin_amdgcn_fence(__ATOMIC_RELEASE, "agent");
            asm volatile("s_waitcnt vmcnt(0)" ::: "memory");
            const unsigned og = xb_add(&bar[XB_TOP], 1u);
            const unsigned tg = og / nx;
            if (og + 1u == (tg + 1u) * nx) xb_add(&bar[XB_TOPGEN], 1u);
            else XB_SPIN(xb_ld(&bar[XB_TOPGEN]) == tg, bar);
            __builtin_amdgcn_fence(__ATOMIC_ACQUIRE, "agent");
            xb_add(&bar[XB_XGEN(b.x)], 1u);
            asm volatile("s_waitcnt vmcnt(0)" ::: "memory");
        } else {
            XB_SPIN(xb_ld(&bar[XB_XGEN(b.x)]) == gen, bar);
            __builtin_amdgcn_fence(__ATOMIC_ACQUIRE, "agent");
            asm volatile("s_waitcnt vmcnt(0)" ::: "memory");
        }
    }
    __syncthreads();
}

constexpr int SEQ = 16384, DM = 1024, N1 = 4352  , NWAVES = 8;
constexpr float EPS = 1e-6f, QSCALE = 0.125f * LOG2E;
constexpr size_t MiB = 1u << 20;
constexpr size_t WS_CTL = 0, CTL_ZERO_BYTES = 1 * MiB;
constexpr size_t WS_WIN = 1 * MiB, WS_WUPA = 10 * MiB, WS_WUPB = 11 * MiB, WS_WO2 = 12 * MiB, WS_WQ = 16 * MiB, WS_WPG = 20 * MiB, WS_WPLE = 22 * MiB, WS_W1KV = 23 * MiB;
constexpr size_t WS_SMALL = 25 * MiB, WS_W2KT = WS_SMALL, WS_W2VT = WS_SMALL + 32768, WS_K1B = WS_SMALL + 65536, WS_K2B = WS_SMALL + 98304, WS_POSB = WS_SMALL + 131072,
                 WS_RS0 = WS_SMALL + 262144, WS_RS2 = WS_SMALL + 393216, WS_POSBP = WS_SMALL + 147456  ;
constexpr size_t WS_SSQ1 = 26 * MiB, WS_BG = 27 * MiB, WS_KC = 28 * MiB + 512 * 1024, WS_VCT = WS_KC + 262144, WS_H = 29 * MiB;
constexpr size_t WS_XB = 32 * MiB, WS_MG = 64 * MiB, WS_QA = 128 * MiB, WS_QB = 144 * MiB;
constexpr size_t WS_KA = 160 * MiB, WS_VTA = 164 * MiB, WS_CK = 168 * MiB, WS_KS = 176 * MiB, WS_VTS = 180 * MiB, WS_KW = 184 * MiB, WS_VTW = 188 * MiB;
constexpr size_t WS_OW = 192 * MiB, WS_PW = 208 * MiB, WS_PB = 240 * MiB;
constexpr size_t WS_OA = WS_QA, WS_OB = WS_QB;
constexpr size_t WS_U8 = 32 * MiB, WS_V8 = 48 * MiB, WS_XB2 = 128 * MiB, WS_Q2 = 64 * MiB;
constexpr size_t WS_END = 256 * MiB;
constexpr int CW_TMO = 0, CW_BAR = 4096, CW_QUEUE = 32768;
constexpr int LDS_BYTES = 147456, LDSCTL_OFF = 143360;
constexpr int KROW = 144, VROW = 136;
constexpr int AT_K0 = 0, AT_KSZ = 64 * KROW, AT_V0 = 2 * AT_KSZ, AT_VSZ = 64 * VROW, AT_LUT = 36864, LUTS = 136, AT_IMP = 46080, AT_SEL = 112640;
constexpr int SQ_OFF = 0, SO_OFF = AT_IMP, SO_ROW = 65, SM_OFF = 114688, SL_OFF = 115712, SS_OFF = 116736, SC_OFF = 117248;
constexpr int PK_ROW = 272, PK1_OFF = 0, PK2_OFF = 128 * PK_ROW, PW_OFF = 2 * 128 * PK_ROW, PW_BYTES = 8192;
static_assert(AT_V0 + 2 * AT_VSZ <= AT_LUT && AT_LUT + 16 * LUTS * 4 <= AT_IMP && AT_IMP + 65536 <= AT_SEL && SO_OFF + 256 * SO_ROW * 4 <= AT_SEL && AT_SEL + 2048 <= SM_OFF && 256 * KROW <= AT_LUT && SC_OFF + 64 <= LDSCTL_OFF && PW_OFF + 8 * PW_BYTES <= LDSCTL_OFF, "LDS map");

__device__ const unsigned char BKT[129] = {0,1,2,3,4,5,6,7,8,9,10,11,12,13,14,15,16,16,16,17,17,18,18,18,19,19,19,20,20,20,20,21,21,21,21,22,22,22,22,22,23,23,23,23,23,23,24,24,24,24,24,24,
    25,25,25,25,25,25,25,26,26,26,26,26,26,26,26,27,27,27,27,27,27,27,27,27,27,28,28,28,28,28,28,28,28,28,28,29,29,29,29,29,29,29,29,29,29,29,29,30,30,30,30,30,30,30,30,30,30,30,30,30,30,
    31,31,31,31,31,31,31,31,31,31,31,31,31,31,31,31};

struct Args { const float* in[24]; float* out; unsigned char* ws; int ph_lo, ph_hi, li, pad; };
struct Frame {
    LAS unsigned char* lds; volatile LAS unsigned* MISC; gu32* ctl; unsigned char* ws;
    int tid, lane, wave, vcu, G;
    float* out;
};
constexpr int INTAB_OFF = LDSCTL_OFF + 256;
__device__ __forceinline__ const float* in_ptr(const Frame& F, int k) {
    const unsigned long long v = ((const LAS unsigned long long*)(F.lds + INTAB_OFF))[k];
    const unsigned lo = __builtin_amdgcn_readfirstlane((unsigned)v), hi = __builtin_amdgcn_readfirstlane((unsigned)(v >> 32));
    return (const float*)(((unsigned long long)hi << 32) | lo);
}
template <int CTRL> __device__ __forceinline__ float dpp_f(float v) { return __uint_as_float((unsigned)__builtin_amdgcn_update_dpp(0, (int)__float_as_uint(v), CTRL, 0xf, 0xf, true)); }
template <int CTRL> __device__ __forceinline__ unsigned dpp_u(unsigned v) { return (unsigned)__builtin_amdgcn_update_dpp(0, (int)v, CTRL, 0xf, 0xf, true); }
__device__ __forceinline__ float wave_sum(float v) {
#pragma unroll
    for (int o = 1; o < 64; o <<= 1) v += __shfl_xor(v, o);
    return v;
}
__device__ __forceinline__ float quad_sum(float v) { v += dpp_f<0xB1>(v); v += dpp_f<0x4E>(v); return v; }
__device__ __forceinline__ unsigned umax_(unsigned a, unsigned b) { return a > b ? a : b; }
__device__ __forceinline__ unsigned wave_max_u32(unsigned v) {
    v = umax_(v, dpp_u<0xB1>(v)); v = umax_(v, dpp_u<0x4E>(v)); v = umax_(v, dpp_u<0x141>(v)); v = umax_(v, dpp_u<0x140>(v));
    const unsigned a = __builtin_amdgcn_readlane(v, 0), b = __builtin_amdgcn_readlane(v, 16), c = __builtin_amdgcn_readlane(v, 32), d = __builtin_amdgcn_readlane(v, 48);
    return umax_(umax_(a, b), umax_(c, d));
}
__device__ __forceinline__ float pair_max(float v) { auto rr = __builtin_amdgcn_permlane32_swap(__float_as_uint(v), __float_as_uint(v), false, false); return fmaxf(__uint_as_float(rr[0]), __uint_as_float(rr[1])); }
__device__ __forceinline__ float pair_sum(float v) { auto rr = __builtin_amdgcn_permlane32_swap(__float_as_uint(v), __float_as_uint(v), false, false); return __uint_as_float(rr[0]) + __uint_as_float(rr[1]); }
__device__ __forceinline__ unsigned pair_umax(unsigned v) { auto rr = __builtin_amdgcn_permlane32_swap(v, v, false, false); return umax_(rr[0], rr[1]); }
__device__ __forceinline__ unsigned ord_key(float v) { const unsigned u = __float_as_uint(v); return u ^ ((unsigned)((int)u >> 31) | 0x80000000u); }
__device__ __forceinline__ float ord_val(unsigned k) { const unsigned u = (k & 0x80000000u) ? (k ^ 0x80000000u) : ~k; return __uint_as_float(u); }
#define WG_BAR_LDS() do { asm volatile("s_waitcnt lgkmcnt(0)" ::: "memory"); __builtin_amdgcn_s_barrier(); asm volatile("" ::: "memory"); } while (0)
__device__ __forceinline__ u32x4 pack8(const f32x4& a, const f32x4& b) { u32x4 w; w.x = pkbf(a[0], a[1]); w.y = pkbf(a[2], a[3]); w.z = pkbf(b[0], b[1]); w.w = pkbf(b[2], b[3]); return w; }

typedef const f32x4 (&AccRef)[2][2][4][2];
struct Epi1 {
    static constexpr bool PERM = true, AFTER_DRAIN = false;
    const float* rs0; unsigned char* ws;
    __device__ __forceinline__ void operator()(AccRef acc, const pg8::Unit& u, int wr, int wc, int fr, int fq) const {
        asm volatile("" : "+v"(fr), "+v"(fq) :: "memory");
        const int row0 = u.pm * 256 + wr * 64 + fr, pn = u.pn, cl = wc * 32 + 8 * fq;
        float rsv[2][4];
#pragma unroll
        for (int ai = 0; ai < 2; ++ai)
#pragma unroll
            for (int m = 0; m < 4; ++m) rsv[ai][m] = rs0[row0 + ai * 128 + m * 16];
#pragma unroll
        for (int ai = 0; ai < 2; ++ai)
#pragma unroll
            for (int m = 0; m < 4; ++m) asm volatile("" : "+v"(rsv[ai][m]));
        if (pn < 4) {
            bf16* Q = (bf16*)(ws + (pn < 2 ? WS_QA : WS_QB)) + (pn & 1) * 256 + cl;
#pragma unroll
            for (int ai = 0; ai < 2; ++ai)
#pragma unroll
                for (int m = 0; m < 4; ++m) { const int row = row0 + ai * 128 + m * 16; const float s = rsv[ai][m] * QSCALE;
#pragma unroll
                    for (int bj = 0; bj < 2; ++bj) *(u32x4*)(Q + (size_t)row * 512 + bj * 128) = pack8(acc[ai][bj][m][0] * s, acc[ai][bj][m][1] * s); }
        } else if (pn < 8) {
            const int g = wc >> 1, dl = cl & 63;
            const size_t koff = pn == 4 ? WS_KA : pn == 5 ? WS_CK : pn == 6 ? WS_KS : WS_KW;
            const size_t voff = pn == 4 ? WS_VTA : pn == 5 ? WS_CK + (size_t)2 * SEQ * 64 * 2 : pn == 6 ? WS_VTS : WS_VTW;
            bf16* Kd = (bf16*)(ws + koff) + (size_t)g * SEQ * 64 + dl;
            bf16* Vd = (bf16*)(ws + voff);
#pragma unroll
            for (int ai = 0; ai < 2; ++ai)
#pragma unroll
                for (int m = 0; m < 4; ++m) { const int row = row0 + ai * 128 + m * 16; const float s = rsv[ai][m];
                    const u32x4 kq = pack8(acc[ai][0][m][0] * s, acc[ai][0][m][1] * s);
                    const u32x4 v = pack8(acc[ai][1][m][0] * s, acc[ai][1][m][1] * s);
                    if (pn == 6) {
                        const int key = row & 63, jb = row >> 6;
                        bf16* kt_ = (bf16*)(ws + WS_KS) + ((size_t)g * 256 + jb) * 4096 + (size_t)((((key >> 5) * 4 + (dl >> 4)) * 64 + ((dl >> 3) & 1) * 32 + (key & 31)) * 8);
                        *(u32x4*)kt_ = kq;
                        const int sI = key >> 4, kk = key & 15, hI = (kk >> 2) & 1, eI = ((kk >> 3) << 2) + (kk & 3);
                        bf16* vt_ = (bf16*)(ws + WS_VTS) + ((size_t)g * 256 + jb) * 4096 + (size_t)(((((dl >> 5) * 4 + sI) * 64 + hI * 32 + (dl & 31)) * 8) + eI);
                        vt_[0] = (bf16)v.x; vt_[8] = (bf16)(v.x >> 16); vt_[16] = (bf16)v.y; vt_[24] = (bf16)(v.y >> 16); vt_[32] = (bf16)v.z; vt_[40] = (bf16)(v.z >> 16); vt_[48] = (bf16)v.w; vt_[56] = (bf16)(v.w >> 16);
                        continue; }
                    *(u32x4*)(Kd + (size_t)row * 64) = kq;
                    if (pn == 5) *(u32x4*)(Vd + ((size_t)g * SEQ + row) * 64 + dl) = v;
                    else { bf16* vt = Vd + (size_t)(g * 64 + dl) * SEQ + row;
                        vt[0 * (size_t)SEQ] = (bf16)v.x; vt[1 * (size_t)SEQ] = (bf16)(v.x >> 16); vt[2 * (size_t)SEQ] = (bf16)v.y; vt[3 * (size_t)SEQ] = (bf16)(v.y >> 16);
                        vt[4 * (size_t)SEQ] = (bf16)v.z; vt[5 * (size_t)SEQ] = (bf16)(v.z >> 16); vt[6 * (size_t)SEQ] = (bf16)v.w; vt[7 * (size_t)SEQ] = (bf16)(v.w >> 16); } }
        } else if (pn < 16) {
            bf16* MG = (bf16*)(ws + WS_MG) + (pn - 8) * 256 + cl;
#pragma unroll
            for (int ai = 0; ai < 2; ++ai)
#pragma unroll
                for (int m = 0; m < 4; ++m) { const int row = row0 + ai * 128 + m * 16; const float s = rsv[ai][m];
#pragma unroll
                    for (int bj = 0; bj < 2; ++bj) { f32x4 a = acc[ai][bj][m][0] * s, b = acc[ai][bj][m][1] * s;
#pragma unroll
                        for (int e = 0; e < 4; ++e) { a[e] = sigmoidf_(a[e]); b[e] = sigmoidf_(b[e]); }
                        *(u32x4*)(MG + (size_t)row * 2048 + bj * 128) = pack8(a, b); } }
        } else {
            if (wc == 0 && fq < 3) { float* BG = (float*)(ws + WS_BG) + 8 * fq;
#pragma unroll
                for (int ai = 0; ai < 2; ++ai)
#pragma unroll
                    for (int m = 0; m < 4; ++m) { const int row = row0 + ai * 128 + m * 16; const float s = rsv[ai][m]; f32x4 a = acc[ai][0][m][0] * s, b = acc[ai][0][m][1] * s;
#pragma unroll
                        for (int e = 0; e < 4; ++e) { a[e] = sigmoidf_(a[e]); b[e] = sigmoidf_(b[e]); }
                        *(f32x4*)(BG + (size_t)row * 24) = a; *(f32x4*)(BG + (size_t)row * 24 + 4) = b; } }
        }
    }
};
struct EpiNull {
    static constexpr bool PERM = true, AFTER_DRAIN = false;
    __device__ __forceinline__ void operator()(AccRef acc, const pg8::Unit& u, int wr, int wc, int fr, int fq) const {
        asm volatile("" : "+v"(fr), "+v"(fq) :: "memory");
#pragma unroll
        for (int ai = 0; ai < 2; ++ai)
#pragma unroll
            for (int bj = 0; bj < 2; ++bj)
#pragma unroll
                for (int m = 0; m < 4; ++m)
#pragma unroll
                    for (int n = 0; n < 2; ++n) asm volatile("" :: "v"(acc[ai][bj][m][n]));
    }
};
struct EpiUp {
    static constexpr bool PERM = true, AFTER_DRAIN = false;
    bf16* MG; int coloff; bf16* DST;
    __device__ __forceinline__ void operator()(AccRef acc, const pg8::Unit& u, int wr, int wc, int fr, int fq) const {
        asm volatile("" : "+v"(fr), "+v"(fq) :: "memory");
        const int row0 = u.pm * 256 + wr * 64 + fr; bf16* base = MG + coloff + u.pn * 256 + wc * 32 + 8 * fq; bf16* dbase = DST + coloff + u.pn * 256 + wc * 32 + 8 * fq;
        u32x4 gt[2][4][2];
#pragma unroll
        for (int m = 0; m < 4; ++m)
#pragma unroll
            for (int bj = 0; bj < 2; ++bj) gt[0][m][bj] = *(const u32x4*)(base + (size_t)(row0 + m * 16) * 2048 + bj * 128);
#pragma unroll
        for (int ai = 0; ai < 2; ++ai) {
            if (ai == 0) {
#pragma unroll
                for (int m = 0; m < 4; ++m)
#pragma unroll
                    for (int bj = 0; bj < 2; ++bj) gt[1][m][bj] = *(const u32x4*)(base + (size_t)(row0 + 128 + m * 16) * 2048 + bj * 128);
            }
#pragma unroll
            for (int m = 0; m < 4; ++m) { bf16* rp = dbase + (size_t)(row0 + ai * 128 + m * 16) * 2048;
#pragma unroll
                for (int bj = 0; bj < 2; ++bj) { const u32x4 g = gt[ai][m][bj]; const f32x4 a = acc[ai][bj][m][0], b = acc[ai][bj][m][1]; u32x4 w;
                    w.x = pkbf(bf_lo(g.x) * a[0], bf_hi(g.x) * a[1]); w.y = pkbf(bf_lo(g.y) * a[2], bf_hi(g.y) * a[3]);
                    w.z = pkbf(bf_lo(g.z) * b[0], bf_hi(g.z) * b[1]); w.w = pkbf(bf_lo(g.w) * b[2], bf_hi(g.w) * b[3]);
                    *(u32x4*)(rp + bj * 128) = w; } }
        }
    }
};
struct EpiUp2 {
    static constexpr bool PERM = true, AFTER_DRAIN = false;
    bf16* MG; bf16* DST;
    __device__ __forceinline__ void operator()(AccRef acc, const pg8::Unit& u, int wr, int wc, int fr, int fq) const {
        asm volatile("" : "+v"(fr), "+v"(fq) :: "memory");
        const int row0 = u.pm * 256 + wr * 64 + fr; bf16* base = MG + u.pn * 256 + wc * 32 + 8 * fq; bf16* dbase = DST + u.pn * 256 + wc * 32 + 8 * fq;
        u32x4 tv[2][2][2], gv[2][2][2];
#define UP2_LOAD(par, bt) _Pragma("unroll") for (int mm = 0; mm < 2; ++mm) _Pragma("unroll") for (int bj = 0; bj < 2; ++bj) { \
            const bf16* p = base + (size_t)(row0 + ((bt) >> 1) * 128 + (((bt) & 1) * 2 + mm) * 16) * 2048 + bj * 128; tv[par][mm][bj] = *(const u32x4*)p; gv[par][mm][bj] = *(const u32x4*)(p + 1024); }
        UP2_LOAD(0, 0);
#pragma unroll
        for (int bt = 0; bt < 4; ++bt) {
            if (bt == 0) { UP2_LOAD(1, 1); } else if (bt == 1) { UP2_LOAD(0, 2); } else if (bt == 2) { UP2_LOAD(1, 3); }
            const int ai = bt >> 1;
#pragma unroll
            for (int mm = 0; mm < 2; ++mm) { const int m = (bt & 1) * 2 + mm; bf16* rp = dbase + (size_t)(row0 + ai * 128 + m * 16) * 2048;
#pragma unroll
                for (int bj = 0; bj < 2; ++bj) { const u32x4 t = tv[bt & 1][mm][bj], g = gv[bt & 1][mm][bj]; const f32x4 a = acc[ai][bj][m][0], b = acc[ai][bj][m][1]; u32x4 w;
                    w.x = pkbf(bf_lo(t.x) + bf_lo(g.x) * a[0], bf_hi(t.x) + bf_hi(g.x) * a[1]); w.y = pkbf(bf_lo(t.y) + bf_lo(g.y) * a[2], bf_hi(t.y) + bf_hi(g.y) * a[3]);
                    w.z = pkbf(bf_lo(t.z) + bf_lo(g.z) * b[0], bf_hi(t.z) + bf_hi(g.z) * b[1]); w.w = pkbf(bf_lo(t.w) + bf_lo(g.w) * b[2], bf_hi(t.w) + bf_hi(g.w) * b[3]);
                    *(u32x4*)(rp + bj * 128) = w; } }
        }
#undef UP2_LOAD
    }
};
struct EpiWo {
    static constexpr bool PERM = true, AFTER_DRAIN = false;
    const float* x; float* out; bf16* xb; float* ssq;
    __device__ __forceinline__ void operator()(AccRef acc, const pg8::Unit& u, int wr, int wc, int fr, int fq) const {
        asm volatile("" : "+v"(fr), "+v"(fq) :: "memory");
        const int row0 = u.pm * 256 + wr * 64 + fr, c0 = u.pn * 256 + wc * 32 + 8 * fq;
        f32x4 xv[2][2][2][2];
#define WO_LOAD(par, bt) _Pragma("unroll") for (int mm = 0; mm < 2; ++mm) _Pragma("unroll") for (int bj = 0; bj < 2; ++bj) { \
            const size_t o = (size_t)(row0 + ((bt) >> 1) * 128 + (((bt) & 1) * 2 + mm) * 16) * DM + c0 + bj * 128; xv[par][mm][bj][0] = *(const f32x4*)(x + o); xv[par][mm][bj][1] = *(const f32x4*)(x + o + 4); }
        WO_LOAD(0, 0);
#pragma unroll
        for (int bt = 0; bt < 4; ++bt) {
            if (bt == 0) { WO_LOAD(1, 1); } else if (bt == 1) { WO_LOAD(0, 2); } else if (bt == 2) { WO_LOAD(1, 3); }
            const int ai = bt >> 1;
#pragma unroll
            for (int mm = 0; mm < 2; ++mm) { const int m = (bt & 1) * 2 + mm, row = row0 + ai * 128 + m * 16; float ss = 0.f;
#pragma unroll
                for (int bj = 0; bj < 2; ++bj) { const size_t o = (size_t)row * DM + c0 + bj * 128;
                    const f32x4 a = xv[bt & 1][mm][bj][0] + acc[ai][bj][m][0], b = xv[bt & 1][mm][bj][1] + acc[ai][bj][m][1];
                    *(f32x4*)(out + o) = a; *(f32x4*)(out + o + 4) = b; *(u32x4*)(xb + o) = pack8(a, b);
                    ss += (a[0] * a[0] + a[1] * a[1]) + (a[2] * a[2] + a[3] * a[3]) + (b[0] * b[0] + b[1] * b[1]) + (b[2] * b[2] + b[3] * b[3]); }
                ss += __shfl_xor(ss, 16); ss += __shfl_xor(ss, 32);
                if (fq == 0) ssq[(size_t)row * 16 + u.pn * 4 + wc] = ss; }
        }
#undef WO_LOAD
    }
};
__device__ __forceinline__ float rs_from_ssq(const float* ssq, int row) {
    const f32x4* p = (const f32x4*)(ssq + (size_t)row * 16); const f32x4 a = p[0], b = p[1], c = p[2], d = p[3];
    const float s = ((a[0] + a[1]) + (a[2] + a[3])) + ((b[0] + b[1]) + (b[2] + b[3])) + ((c[0] + c[1]) + (c[2] + c[3])) + ((d[0] + d[1]) + (d[2] + d[3]));
    return __builtin_amdgcn_rsqf(s * (1.0f / DM) + EPS);
}
struct EpiPw {
    static constexpr bool PERM = true, AFTER_DRAIN = false;
    bf16* O; int ldc;
    __device__ __forceinline__ void operator()(AccRef acc, const pg8::Unit& u, int wr, int wc, int fr, int fq) const {
        asm volatile("" : "+v"(fr), "+v"(fq) :: "memory");
        const int row0 = u.pm * 256 + wr * 64 + fr; bf16* base = O + u.pn * 256 + wc * 32 + 8 * fq;
#pragma unroll
        for (int ai = 0; ai < 2; ++ai)
#pragma unroll
            for (int m = 0; m < 4; ++m)
#pragma unroll
                for (int bj = 0; bj < 2; ++bj) *(u32x4*)(base + (size_t)(row0 + ai * 128 + m * 16) * ldc + bj * 128) = pack8(acc[ai][bj][m][0], acc[ai][bj][m][1]);
    }
};
struct EpiPle {
    static constexpr bool PERM = true, AFTER_DRAIN = false;
    const float* rs2; const bf16* pw; float* out; float* dst;
    __device__ __forceinline__ void operator()(AccRef acc, const pg8::Unit& u, int wr, int wc, int fr, int fq) const {
        asm volatile("" : "+v"(fr), "+v"(fq) :: "memory");
        const int row0 = u.pm * 256 + wr * 64 + fr, c0 = u.pn * 256 + wc * 32 + 8 * fq;
        float rsv[2][4];
#pragma unroll
        for (int ai = 0; ai < 2; ++ai)
#pragma unroll
            for (int m = 0; m < 4; ++m) rsv[ai][m] = rs2[row0 + ai * 128 + m * 16];
#pragma unroll
        for (int ai = 0; ai < 2; ++ai)
#pragma unroll
            for (int m = 0; m < 4; ++m) asm volatile("" : "+v"(rsv[ai][m]));
        f32x4 xv[2][2][2]; u32x4 pv[2][2];
#define PLE_LOAD(par, bt) _Pragma("unroll") for (int bj = 0; bj < 2; ++bj) { \
            const size_t o = (size_t)(row0 + ((bt) >> 2) * 128 + ((bt) & 3) * 16) * DM + c0 + bj * 128; xv[par][bj][0] = *(const f32x4*)(out + o); xv[par][bj][1] = *(const f32x4*)(out + o + 4); pv[par][bj] = *(const u32x4*)(pw + o); }
        PLE_LOAD(0, 0);
#pragma unroll
        for (int bt = 0; bt < 8; ++bt) {
            if (bt < 7) { if ((bt & 1) == 0) { PLE_LOAD(1, bt + 1); } else { PLE_LOAD(0, bt + 1); } }
            const int ai = bt >> 2, m = bt & 3, row = row0 + ai * 128 + m * 16; const float s = rsv[ai][m];
#pragma unroll
            for (int bj = 0; bj < 2; ++bj) { const size_t o = (size_t)row * DM + c0 + bj * 128; const u32x4 p = pv[bt & 1][bj];
                f32x4 a = xv[bt & 1][bj][0], b = xv[bt & 1][bj][1]; const f32x4 ga = acc[ai][bj][m][0] * s, gb = acc[ai][bj][m][1] * s;
                a[0] += sigmoidf_(ga[0]) * bf_lo(p.x); a[1] += sigmoidf_(ga[1]) * bf_hi(p.x); a[2] += sigmoidf_(ga[2]) * bf_lo(p.y); a[3] += sigmoidf_(ga[3]) * bf_hi(p.y);
                b[0] += sigmoidf_(gb[0]) * bf_lo(p.z); b[1] += sigmoidf_(gb[1]) * bf_hi(p.z); b[2] += sigmoidf_(gb[2]) * bf_lo(p.w); b[3] += sigmoidf_(gb[3]) * bf_hi(p.w);
                *(f32x4*)(dst + o) = a; *(f32x4*)(dst + o + 4) = b; }
        }
#undef PLE_LOAD
    }
};
struct EpiCmp {
    static constexpr bool PERM = true, AFTER_DRAIN = false;
    bf16* H; const float* posb;
    __device__ __forceinline__ void operator()(AccRef acc, const pg8::Unit& u, int wr, int wc, int fr, int fq) const {
        asm volatile("" : "+v"(fr), "+v"(fq) :: "memory");
        const int row0 = u.pm * 256 + wr * 64 + fr, cl = wc * 32 + 8 * fq;
#pragma unroll
        for (int bj = 0; bj < 2; ++bj) { const f32x4 pa = *(const f32x4*)(posb + u.pn * 256 + bj * 128 + cl), pb = *(const f32x4*)(posb + u.pn * 256 + bj * 128 + cl + 4);
#pragma unroll
            for (int ai = 0; ai < 2; ++ai)
#pragma unroll
                for (int m = 0; m < 4; ++m) { f32x4 a = acc[ai][bj][m][0] + pa, b = acc[ai][bj][m][1] + pb;
#pragma unroll
                    for (int e = 0; e < 4; ++e) { a[e] = gelu_tanh(a[e]); b[e] = gelu_tanh(b[e]); }
                    *(u32x4*)(H + (size_t)(row0 + ai * 128 + m * 16) * 256 + bj * 128 + cl) = pack8(a, b); } }
    }
};

__device__ __forceinline__ void tr_item(const float* W, int Nsrc, int k0, int srcc0, int nvalid, bf16* WT, int ldk, int drow0, int dk0, const float* g, LAS float* scr, int lane) {
#pragma unroll 8
    for (int i = 0; i < 32; ++i) { const int kk = 2 * i + (lane >> 5), n = lane & 31; float v = 0.f;
        if (n < nvalid) { v = W[(size_t)(k0 + kk) * Nsrc + srcc0 + n]; if (g) v *= g[k0 + kk]; }
        scr[kk * 33 + n] = v; }
    LDS_WAIT(); asm volatile("" ::: "memory");
    const int c = lane & 7;
#pragma unroll
    for (int j = 0; j < 4; ++j) { const int n = (lane >> 3) + 8 * j; const LAS float* s = scr + (8 * c) * 33 + n;
        u32x4 o; o.x = pkbf(s[0 * 33], s[1 * 33]); o.y = pkbf(s[2 * 33], s[3 * 33]); o.z = pkbf(s[4 * 33], s[5 * 33]); o.w = pkbf(s[6 * 33], s[7 * 33]);
        *(u32x4*)(WT + (size_t)(drow0 + n) * ldk + dk0 + k0 + 8 * c) = o; }
    LDS_WAIT(); asm volatile("" ::: "memory");
}
__device__ __forceinline__ void weight_items(Frame& F, int part, int gw, int NGW) {
    LAS float* scr = (LAS float*)(F.lds + F.wave * 8448); const int lane = F.lane; unsigned char* ws = F.ws;
    constexpr int I_IN = 16 * 136, I_UP = 8 * 32, I_O = 16 * 32, I_Q = 16 * 64, I_PG = 16 * 32, I_PLE = 4 * 32, I_W1 = 32 * 8, I_W2 = 4 * 2;
    if (part == 0) {
        constexpr int NITEMS = I_IN + I_PLE + 2 * I_W1 + 2 * I_W2;
        for (int it = gw; it < NITEMS; it += NGW) {
            int r = it;
            if (r < I_IN) { const int kb = r / 136, nb = r % 136, n = nb * 32; int src, nv = 32;
                if (n < 512) src = n; else if (n < 1024) src = n + 256; else if (n < 1280) src = n - 512; else if (n < 2048) src = n; else if (n < 4096) src = n + 24;
                else if (n == 4096) { src = 2048; nv = 24; } else { src = 0; nv = 0; }
                tr_item(in_ptr(F, 3), 4120, kb * 64, src, nv, (bf16*)(ws + WS_WIN), 1024, n, 0, in_ptr(F, 2), scr, lane); continue; } r -= I_IN;
            if (r < I_PLE) { tr_item(in_ptr(F, 22), 1024, (r / 32) * 64, (r % 32) * 32, 32, (bf16*)(ws + WS_WPLE), 256, (r % 32) * 32, 0, nullptr, scr, lane); continue; } r -= I_PLE;
            if (r < I_W1) { tr_item(in_ptr(F, 7), 256, (r / 8) * 64, (r % 8) * 32, 32, (bf16*)(ws + WS_W1KV), 2048, (r % 8) * 32, 0, nullptr, scr, lane); continue; } r -= I_W1;
            if (r < I_W1) { tr_item(in_ptr(F, 9), 256, (r / 8) * 64, (r % 8) * 32, 32, (bf16*)(ws + WS_W1KV), 2048, 256 + (r % 8) * 32, 0, nullptr, scr, lane); continue; } r -= I_W1;
            if (r < I_W2) { tr_item(in_ptr(F, 8), 64, (r / 2) * 64, (r % 2) * 32, 32, (bf16*)(ws + WS_W2KT), 256, (r % 2) * 32, 0, nullptr, scr, lane); continue; } r -= I_W2;
            tr_item(in_ptr(F, 10), 64, (r / 2) * 64, (r % 2) * 32, 32, (bf16*)(ws + WS_W2VT), 256, (r % 2) * 32, 0, nullptr, scr, lane);
        }
    } else {
        constexpr int NITEMS = 2 * I_UP + I_O + I_Q + I_PG;
        for (int it = gw; it < NITEMS; it += NGW) {
            int r = it;
            if (r < I_UP) { tr_item(in_ptr(F, 11), 1024, (r / 32) * 64, (r % 32) * 32, 32, (bf16*)(ws + WS_WUPA), 512, (r % 32) * 32, 0, nullptr, scr, lane); continue; } r -= I_UP;
            if (r < I_UP) { tr_item(in_ptr(F, 12), 1024, (r / 32) * 64, (r % 32) * 32, 32, (bf16*)(ws + WS_WUPB), 512, (r % 32) * 32, 0, nullptr, scr, lane); continue; } r -= I_UP;
            if (r < I_O) { tr_item(in_ptr(F, 13), 1024, (r / 32) * 64, (r % 32) * 32, 32, (bf16*)(ws + WS_WO2), 1024, (r % 32) * 32, 0, nullptr, scr, lane); continue; } r -= I_O;
            if (r < I_Q) { tr_item(in_ptr(F, 15), 2048, (r / 64) * 64, (r % 64) * 32, 32, (bf16*)(ws + WS_WQ), 1024, (r % 64) * 32, 0, in_ptr(F, 14), scr, lane); continue; } r -= I_Q;
            tr_item(in_ptr(F, 21), 1024, (r / 32) * 64, (r % 32) * 32, 32, (bf16*)(ws + WS_WPG), 1024, (r % 32) * 32, 0, in_ptr(F, 20), scr, lane);
        }
    }
}
__device__ __forceinline__ void p0_prologue(Frame& F) {
    const int gw = F.vcu * NWAVES + F.wave, NGW = F.G * NWAVES, lane = F.lane;
    unsigned char* ws = F.ws;
    weight_items(F, 0, gw, NGW);
    { const float* x = in_ptr(F, 0); bf16* xb = (bf16*)(ws + WS_XB); float* rs0 = (float*)(ws + WS_RS0);
      f32x4 nx[4];
      if (gw < SEQ) {
#pragma unroll
          for (int j = 0; j < 4; ++j) nx[j] = ((const f32x4*)(x + (size_t)gw * DM) + lane)[64 * j]; }
      for (int row = gw; row < SEQ; row += NGW) {
          f32x4 v[4]; float ss = 0.f;
#pragma unroll
          for (int j = 0; j < 4; ++j) v[j] = nx[j];
          if (row + NGW < SEQ) {
#pragma unroll
              for (int j = 0; j < 4; ++j) nx[j] = ((const f32x4*)(x + (size_t)(row + NGW) * DM) + lane)[64 * j]; }
#pragma unroll
          for (int j = 0; j < 4; ++j) ss += (v[j][0] * v[j][0] + v[j][1] * v[j][1]) + (v[j][2] * v[j][2] + v[j][3] * v[j][3]);
          ss = wave_sum(ss);
          u32x2* o8 = (u32x2*)(xb + (size_t)row * DM) + lane;
#pragma unroll
          for (int j = 0; j < 4; ++j) { u32x2 w; w.x = pkbf(v[j][0], v[j][1]); w.y = pkbf(v[j][2], v[j][3]); o8[64 * j] = w; }
          if (lane == 0) rs0[row] = __builtin_amdgcn_rsqf(ss * (1.0f / DM) + EPS);
      } }
    { const int gt = gw * 64 + lane, NGT = NGW * 64;
      const float* p = in_ptr(F, 1); bf16* pb = (bf16*)(ws + WS_PB);
      for (int i = gt; i < SEQ * 256 / 8; i += NGT) { const f32x4 a = *(const f32x4*)(p + (size_t)i * 8), b = *(const f32x4*)(p + (size_t)i * 8 + 4); *(u32x4*)(pb + (size_t)i * 8) = pack8(a, b); }
      for (int i = gt; i < 2 * 16384 / 8; i += NGT) { const int which = i >= 2048, j = i & 2047; const float* k = in_ptr(F, 16 + which) + (size_t)j * 8;
          *(u32x4*)((bf16*)(ws + (which ? WS_K2B : WS_K1B)) + (size_t)j * 8) = pack8(*(const f32x4*)k, *(const f32x4*)(k + 4)); } }
    if (F.vcu < 64) { const int grp = F.vcu >> 3, ks = F.vcu & 7, kv = grp >> 2, n = (grp & 3) * 64 + lane; const float* w1 = in_ptr(F, kv ? 9 : 7); const float* pos = in_ptr(F, 6);
        const int kb = ks * 256 + F.wave * 32; float s = 0.f;
#pragma unroll 8
        for (int k = 0; k < 32; ++k) s += pos[kb + k] * w1[(size_t)(kb + k) * 256 + n];
        LAS float* red = (LAS float*)(F.lds + 8 * 8448);
        red[F.wave * 64 + lane] = s; __syncthreads();
        if (F.wave == 0) { float t = 0.f;
#pragma unroll
            for (int w = 0; w < 8; ++w) t += red[w * 64 + lane];
            ((float*)(ws + WS_POSBP))[ks * 512 + grp * 64 + lane] = t; }
    }
}
__device__ __forceinline__ void posb_finish(Frame& F) {
    int tid = F.tid; asm volatile("" : "+v"(tid));
    const float* part = (const float*)(F.ws + WS_POSBP); float t = 0.f;
#pragma unroll
    for (int s = 0; s < 8; ++s) t += part[s * 512 + tid];
    ((float*)(F.ws + WS_POSB))[tid] = t;
}

struct TileSrc { const bf16* K; const bf16* Vt; int vpitch; };
__device__ __forceinline__ void tile_load(const TileSrc& s, int key0, bool needV, int tid, u32x4& kr, u32x4& vr) {
    const int row = tid >> 3, ch = tid & 7;
    kr = *(const u32x4*)(s.K + (size_t)(key0 + row) * 64 + ch * 8);
    if (needV) vr = *(const u32x4*)(s.Vt + (size_t)row * s.vpitch + key0 + ch * 8);
}
__device__ __forceinline__ void tile_store(LAS unsigned char* L, int buf, bool needV, int tid, const u32x4& kr, const u32x4& vr) {
    const int row = tid >> 3, ch = tid & 7;
    *(LAS u32x4*)(L + AT_K0 + buf * AT_KSZ + row * KROW + ch * 16) = kr;
    if (needV) { LAS u32x2* p = (LAS u32x2*)(L + AT_V0 + buf * AT_VSZ + row * VROW + ch * 16); u32x2 a, b; a.x = vr.x; a.y = vr.y; b.x = vr.z; b.y = vr.w; p[0] = a; p[1] = b; }
}
__device__ __forceinline__ void qk_tile(LAS const unsigned char* Kb, const bf16x8 (&q)[4], int r32, int h, f32x16& s0, f32x16& s1) {
#pragma unroll
    for (int i = 0; i < 16; ++i) { s0[i] = 0.f; s1[i] = 0.f; }
#pragma unroll
    for (int ks = 0; ks < 4; ++ks) {
        const bf16x8 a0 = *(LAS const bf16x8*)(Kb + r32 * KROW + (16 * ks + 8 * h) * 2), a1 = *(LAS const bf16x8*)(Kb + (32 + r32) * KROW + (16 * ks + 8 * h) * 2);
        s0 = __builtin_amdgcn_mfma_f32_32x32x16_bf16(a0, q[ks], s0, 0, 0, 0); s1 = __builtin_amdgcn_mfma_f32_32x32x16_bf16(a1, q[ks], s1, 0, 0, 0);
    }
}
__device__ __forceinline__ bf16x8 pack_p(const f32x16& s, int o) {
    u32x4 w; w.x = pkbf(s[o + 0], s[o + 1]); w.y = pkbf(s[o + 2], s[o + 3]); w.z = pkbf(s[o + 4], s[o + 5]); w.w = pkbf(s[o + 6], s[o + 7]); return __builtin_bit_cast(bf16x8, w);
}
__device__ __forceinline__ void softmax_pv(LAS const unsigned char* Vb, f32x16& s0, f32x16& s1, f32x16 (&o)[2], float& m, float& l, int r32, int h) {
    float mx = fmaxf(s0[0], s1[0]);
#pragma unroll
    for (int i = 1; i < 16; ++i) mx = fmaxf(mx, fmaxf(s0[i], s1[i]));
    mx = pair_max(mx);
    const float mn = fmaxf(m, mx), alpha = fexp2(m - mn); const bool moved = __any(mx > m); m = mn;
    float sum = 0.f;
#pragma unroll
    for (int i = 0; i < 16; ++i) { s0[i] = fexp2(s0[i] - mn); s1[i] = fexp2(s1[i] - mn); sum += s0[i] + s1[i]; }
    sum = pair_sum(sum); l = l * alpha + sum;
    if (moved) {
#pragma unroll
        for (int i = 0; i < 16; ++i) { o[0][i] *= alpha; o[1][i] *= alpha; } }
    bf16x8 pf[4]; pf[0] = pack_p(s0, 0); pf[1] = pack_p(s0, 8); pf[2] = pack_p(s1, 0); pf[3] = pack_p(s1, 8);
#pragma unroll
    for (int dt = 0; dt < 2; ++dt)
#pragma unroll
        for (int s = 0; s < 4; ++s) { LAS const unsigned char* vp = Vb + (32 * dt + r32) * VROW + (16 * s + 4 * h) * 2;
            const u32x2 lo = *(LAS const u32x2*)vp, hi = *(LAS const u32x2*)(vp + 16); u32x4 a; a.x = lo.x; a.y = lo.y; a.z = hi.x; a.w = hi.y;
            o[dt] = __builtin_amdgcn_mfma_f32_32x32x16_bf16(__builtin_bit_cast(bf16x8, a), pf[s], o[dt], 0, 0, 0); }
}
#define KEYOFF(kt, i) (32 * (kt) + ((i) & 3) + 8 * ((i) >> 2))
#define NEG_INF (-__builtin_inff())

template <int W> struct FBand {
    int tq, tw, h; const LAS float* lut;
    __device__ __forceinline__ bool active(int tile) { const int key0 = tile * 64; return key0 <= tw + 7 && key0 + 63 >= tw - W + 1; }
    __device__ __forceinline__ void apply(f32x16& s0, f32x16& s1, int tile) {
        const int rel0 = tq - tile * 64 - 4 * h;
        if (tw - tile * 64 - 63 >= 128) { const float b = lut[128];
            if (tw + 7 - tile * 64 < W) {
#pragma unroll
                for (int i = 0; i < 16; ++i) { s0[i] += b; s1[i] += b; }
            } else {
#pragma unroll
                for (int i = 0; i < 16; ++i) { const int r0 = rel0 - KEYOFF(0, i), r1 = rel0 - KEYOFF(1, i);
                    s0[i] = (unsigned)r0 < (unsigned)W ? s0[i] + b : NEG_INF; s1[i] = (unsigned)r1 < (unsigned)W ? s1[i] + b : NEG_INF; } }
        } else {
#pragma unroll
            for (int i = 0; i < 16; ++i) { const int r0 = rel0 - KEYOFF(0, i), r1 = rel0 - KEYOFF(1, i);
                const float b0 = lut[min(max(r0, 0), 128)], b1 = lut[min(max(r1, 0), 128)];
                s0[i] = (unsigned)r0 < (unsigned)W ? s0[i] + b0 : NEG_INF; s1[i] = (unsigned)r1 < (unsigned)W ? s1[i] + b1 : NEG_INF; }
        }
    }
};
struct FCmp {
    int lim0, cmax_w;
    __device__ __forceinline__ bool active(int tile) { return tile * 64 <= cmax_w; }
    __device__ __forceinline__ void apply(f32x16& s0, f32x16& s1, int tile) {
        const int lim = lim0 - tile * 64;
        if (__all(lim >= 59)) return;
#pragma unroll
        for (int i = 0; i < 16; ++i) { s0[i] = KEYOFF(0, i) <= lim ? s0[i] : NEG_INF; s1[i] = KEYOFF(1, i) <= lim ? s1[i] : NEG_INF; }
    }
};
#define ATTN_STEP(J) { if (i + (J) >= ntiles) break; const int buf = (i + (J)) & 1; \
        tile_store(L, buf, NEEDV, tid, kr[J], vr[J]); if (i + (J) + RD < ntiles) tile_load(src, (tile_lo + i + (J) + RD) * 64, NEEDV, tid, kr[J], vr[J]); \
        WG_BAR_LDS(); const int tile = tile_lo + i + (J); BODY }
template <int RD, class Fn>
__device__ __forceinline__ void attn_loop(LAS unsigned char* L, const TileSrc& src, int tile_lo, int ntiles, const bf16x8 (&q)[4], f32x16 (&o)[2], float& m, float& l, Fn& f, int tid, int r32, int h) {
    u32x4 kr[RD], vr[RD];
    constexpr bool NEEDV = true;
#pragma unroll
    for (int j = 0; j < RD; ++j) if (j < ntiles) tile_load(src, (tile_lo + j) * 64, true, tid, kr[j], vr[j]);
#define BODY if (f.active(tile)) { f32x16 s0, s1; qk_tile(L + AT_K0 + buf * AT_KSZ, q, r32, h, s0, s1); f.apply(s0, s1, tile); softmax_pv(L + AT_V0 + buf * AT_VSZ, s0, s1, o, m, l, r32, h); }
#pragma unroll 1
    for (int i = 0; i < ntiles; i += RD) { ATTN_STEP(0) ATTN_STEP(1) ATTN_STEP(2) if (RD > 3) ATTN_STEP(3) }
#undef BODY
    WG_BAR_LDS();
}
__device__ __forceinline__ void build_lut(Frame& F, const float* rb) {
    LAS float* lut = (LAS float*)(F.lds + AT_LUT);
    for (int i = F.tid; i < 16 * 129; i += NWAVES * 64) { const int hh = i / 129, rel = i % 129; lut[hh * LUTS + rel] = rb[(int)BKT[rel] * 16 + hh] * LOG2E; }
    __syncthreads();
}
__device__ __forceinline__ void store_o(bf16* dst, const f32x16 (&o)[2], float sc, int h) {
#pragma unroll
    for (int dt = 0; dt < 2; ++dt)
#pragma unroll
        for (int gq = 0; gq < 4; ++gq) { u32x2 w; w.x = pkbf(o[dt][4 * gq] * sc, o[dt][4 * gq + 1] * sc); w.y = pkbf(o[dt][4 * gq + 2] * sc, o[dt][4 * gq + 3] * sc);
            *(u32x2*)(dst + 32 * dt + 8 * gq + 4 * h) = w; }
}
template <int MODE>
__device__ __forceinline__ void banded_unit(Frame& F, const float* sink, int T, int g) {
    LAS unsigned char* L = F.lds; const int tid = F.tid, lane = F.lane, w = F.wave, r32 = lane & 31, h = lane >> 5;
    const int t0 = T * 64, tw = t0 + 8 * w, tq = tw + (r32 >> 2), hg = g * 4 + (r32 & 3);
    constexpr int W = MODE == 0 ? 128 : 512;
    const bf16* Qp = (const bf16*)(F.ws + (MODE == 0 ? WS_QA : WS_QB)) + (size_t)tq * 512 + hg * 64;
    bf16x8 q[4];
#pragma unroll
    for (int ks = 0; ks < 4; ++ks) q[ks] = *(const bf16x8*)(Qp + 16 * ks + 8 * h);
    f32x16 o[2];
#pragma unroll
    for (int i = 0; i < 16; ++i) { o[0][i] = 0.f; o[1][i] = 0.f; }
    float m = -1e30f, l = 0.f;
    if (MODE == 0) { m = sink[hg] * LOG2E; l = 1.f; }
    const int tlo = max(0, t0 - W + 1) >> 6, nt = T - tlo + 1;
    TileSrc src; src.K = (const bf16*)(F.ws + (MODE == 0 ? WS_KA : WS_KW)) + (size_t)g * SEQ * 64; src.Vt = (const bf16*)(F.ws + (MODE == 0 ? WS_VTA : WS_VTW)) + (size_t)g * 64 * SEQ; src.vpitch = SEQ;
    FBand<W> f; f.tq = tq; f.tw = tw; f.h = h; f.lut = (const LAS float*)(L + AT_LUT) + ((MODE == 0 ? 0 : 8) + hg) * LUTS;
    attn_loop<4>(L, src, tlo, nt, q, o, m, l, f, tid, r32, h);
    bf16* Op = (bf16*)(F.ws + (MODE == 0 ? WS_OA : WS_OW)) + (size_t)tq * 512 + hg * 64;
    store_o(Op, o, frcp(fmaxf(l, 1e-30f)), h);
}
__device__ __forceinline__ void compress_out(Frame& F, int b) {
    const int lane = F.lane, w = F.wave, r32 = lane & 31, h = lane >> 5;
    const int kvg = b >> 2, kv = kvg >> 1, g = kvg & 1, c0 = (b & 3) * 256 + 32 * w;
    const bf16* H = (const bf16*)(F.ws + WS_H) + (size_t)(256 * b + 32 * w + r32) * 256 + 8 * h;
    const bf16* W2 = (const bf16*)(F.ws + (kv ? WS_W2VT : WS_W2KT)) + (size_t)r32 * 256 + 8 * h;
    f32x16 a0, a1;
#pragma unroll
    for (int i = 0; i < 16; ++i) { a0[i] = 0.f; a1[i] = 0.f; }
#pragma unroll 4
    for (int ks = 0; ks < 16; ++ks) {
        const bf16x8 hf = *(const bf16x8*)(H + 16 * ks), w0 = *(const bf16x8*)(W2 + 16 * ks), w1 = *(const bf16x8*)(W2 + 32 * 256 + 16 * ks);
        if (kv == 0) { a0 = __builtin_amdgcn_mfma_f32_32x32x16_bf16(w0, hf, a0, 0, 0, 0); a1 = __builtin_amdgcn_mfma_f32_32x32x16_bf16(w1, hf, a1, 0, 0, 0); }
        else         { a0 = __builtin_amdgcn_mfma_f32_32x32x16_bf16(hf, w0, a0, 0, 0, 0); a1 = __builtin_amdgcn_mfma_f32_32x32x16_bf16(hf, w1, a1, 0, 0, 0); }
    }
    if (kv == 0) {
        const int c = c0 + r32; bf16* kc = (bf16*)(F.ws + WS_KC) + ((size_t)g * 1024 + c) * 64; const bool pad = (c == 1023);
#pragma unroll
        for (int nt = 0; nt < 2; ++nt)
#pragma unroll
            for (int gq = 0; gq < 4; ++gq) { const f32x16& a = nt ? a1 : a0; u32x2 wv; wv.x = pkbf(a[4 * gq], a[4 * gq + 1]); wv.y = pkbf(a[4 * gq + 2], a[4 * gq + 3]); if (pad) { wv.x = 0u; wv.y = 0u; }
                *(u32x2*)(kc + 32 * nt + 8 * gq + 4 * h) = wv; }
    } else {
        bf16* vct = (bf16*)(F.ws + WS_VCT) + (size_t)g * 64 * 1024;
#pragma unroll
        for (int nt = 0; nt < 2; ++nt)
#pragma unroll
            for (int gq = 0; gq < 4; ++gq) { const f32x16& a = nt ? a1 : a0; const int c = c0 + 8 * gq + 4 * h;
                u32x2 wv; wv.x = pkbf(a[4 * gq], a[4 * gq + 1]); wv.y = pkbf(a[4 * gq + 2], a[4 * gq + 3]); if (c + 3 == 1023) wv.y &= 0xffffu;
                *(u32x2*)(vct + (size_t)(32 * nt + r32) * 1024 + c) = wv; }
    }
}
#ifndef PROBE_SLC_MODE
#define PROBE_SLC_MODE 1
#endif
struct SlcCtx { bool probe; LAS unsigned char* L; const bf16* KSg; const bf16* VSg; const LAS float* lut; LAS unsigned char* slot; const LAS unsigned* selb; int t0, jt, lane, r32, h, hd; };
__device__ __forceinline__ int slc_perm(int k, int jt) { return k == 0 ? jt : k == 1 ? jt - 1 : k == 2 ? 0 : jt - (k - 1); }
template <int PASS>
__device__ __forceinline__ void slc_tile(const SlcCtx& C, int j, const bf16x8 (&kf)[2][4], const bf16x8 (&vf)[2][4]) {
    LAS unsigned char* L = C.L; const int lane = C.lane, r32 = C.r32, h = C.h, hd = C.hd;
    LAS unsigned* mref = (LAS unsigned*)(L + SM_OFF); LAS float* lsum = (LAS float*)(L + SL_OFF); LAS float* Oacc = (LAS float*)(L + SO_OFF);
    const bool mine = (C.selb[lane * 8 + (j >> 5)] >> (j & 31)) & 1u;
    const unsigned long long mask = __ballot(mine); const int n = __builtin_popcountll(mask);
    if (n == 0) return;
    if (mine) C.slot[__builtin_amdgcn_mbcnt_hi((unsigned)(mask >> 32), __builtin_amdgcn_mbcnt_lo((unsigned)mask, 0u))] = (unsigned char)lane;
    const bool nearb = (j + 2 >= C.jt);
    const int nch = (n + 7) >> 3;
#pragma unroll 1
    for (int pc = 0; pc < nch; ++pc) {
        const int ci = 8 * pc + (r32 >> 2); const bool cv = ci < n; const int tok = (int)C.slot[cv ? ci : 0]; const int row = tok * 4 + hd;
        const LAS unsigned char* qr = L + SQ_OFF + row * KROW + 16 * h;
        f32x16 s0, s1;
#pragma unroll
        for (int i = 0; i < 16; ++i) { s0[i] = 0.f; s1[i] = 0.f; }
#pragma unroll
        for (int ks = 0; ks < 4; ++ks) { const bf16x8 qf = *(const LAS bf16x8*)(qr + 32 * ks);
            s0 = __builtin_amdgcn_mfma_f32_32x32x16_bf16(kf[0][ks], qf, s0, 0, 0, 0); s1 = __builtin_amdgcn_mfma_f32_32x32x16_bf16(kf[1][ks], qf, s1, 0, 0, 0); }
        if (nearb) { const int rel0 = C.t0 + tok - 64 * j - 4 * h;
#pragma unroll
            for (int i = 0; i < 16; ++i) { const int r0 = rel0 - KEYOFF(0, i), r1 = rel0 - KEYOFF(1, i);
                const float b0 = C.lut[min(max(r0, 0), 128)], b1 = C.lut[min(max(r1, 0), 128)];
                s0[i] = r0 >= 0 ? s0[i] + b0 : NEG_INF; s1[i] = r1 >= 0 ? s1[i] + b1 : NEG_INF; }
        } else { const float b = C.lut[128];
#pragma unroll
            for (int i = 0; i < 16; ++i) { s0[i] += b; s1[i] += b; } }
        if (PASS == 0) {
            float mx = fmaxf(s0[0], s1[0]);
#pragma unroll
            for (int i = 1; i < 16; ++i) mx = fmaxf(mx, fmaxf(s0[i], s1[i]));
            mx = pair_max(mx);
            if (cv && h == 0) __hip_atomic_fetch_max(mref + row, ord_key(mx), __ATOMIC_RELAXED, __HIP_MEMORY_SCOPE_WORKGROUP);
        } else {
            const float mm = ord_val(mref[row]); float sum = 0.f;
#pragma unroll
            for (int i = 0; i < 16; ++i) { s0[i] = fexp2(s0[i] - mm); s1[i] = fexp2(s1[i] - mm); sum += s0[i] + s1[i]; }
            sum = pair_sum(sum);
            if (cv && h == 0) __hip_atomic_fetch_add(lsum + row, sum, __ATOMIC_RELAXED, __HIP_MEMORY_SCOPE_WORKGROUP);
            bf16x8 pf[4]; pf[0] = pack_p(s0, 0); pf[1] = pack_p(s0, 8); pf[2] = pack_p(s1, 0); pf[3] = pack_p(s1, 8);
            LAS float* orow = Oacc + row * SO_ROW + 4 * h;
#pragma unroll
            for (int dt = 0; dt < 2; ++dt) { f32x16 oo;
#pragma unroll
                for (int i = 0; i < 16; ++i) oo[i] = 0.f;
#pragma unroll
                for (int s = 0; s < 4; ++s) oo = __builtin_amdgcn_mfma_f32_32x32x16_bf16(vf[dt][s], pf[s], oo, 0, 0, 0);
                if (cv && !(C.probe && PROBE_SLC_MODE == 3)) {
#pragma unroll
                    for (int i = 0; i < 16; ++i) __hip_atomic_fetch_add((LAS int*)orow + 32 * dt + (i & 3) + 8 * (i >> 2), (int)__builtin_rintf(oo[i] * 65536.0f), __ATOMIC_RELAXED, __HIP_MEMORY_SCOPE_WORKGROUP); }
                else { asm volatile("" :: "v"(oo)); } }
        }
    }
}
template <int PASS, int NB>
__device__ __forceinline__ void slc_pass(const SlcCtx& C) {
    const int r32 = C.r32, h = C.h, jt = C.jt;
#pragma unroll 1
    for (;;) {
        int k0 = 0; if (C.lane == 0) k0 = (int)__hip_atomic_fetch_add((LAS unsigned*)(C.L + SC_OFF), (unsigned)NB, __ATOMIC_RELAXED, __HIP_MEMORY_SCOPE_WORKGROUP);
        k0 = __builtin_amdgcn_readfirstlane(k0);
        if (k0 > jt) break;
        bf16x8 kf[NB][2][4], vf[NB][2][4];
#pragma unroll
        for (int b = 0; b < NB; ++b) if (k0 + b <= jt) { const int j = slc_perm(k0 + b, jt);
#pragma unroll
            for (int kt = 0; kt < 2; ++kt)
#pragma unroll
                for (int ks = 0; ks < 4; ++ks) kf[b][kt][ks] = *(const bf16x8*)(C.KSg + (size_t)j * 4096 + ((kt * 4 + ks) * 64 + C.lane) * 8);
            if (PASS == 1) {
#pragma unroll
                for (int dt = 0; dt < 2; ++dt)
#pragma unroll
                    for (int s = 0; s < 4; ++s) vf[b][dt][s] = *(const bf16x8*)(C.VSg + (size_t)j * 4096 + ((dt * 4 + s) * 64 + C.lane) * 8); } }
#pragma unroll
        for (int b = 0; b < NB; ++b) if (k0 + b <= jt) slc_tile<PASS>(C, slc_perm(k0 + b, jt), kf[b], vf[PASS == 1 ? b : 0]);
    }
}
__device__ __forceinline__ void nsa_unit(Frame& F, int T, int g, bool probe_noslc) {
    LAS unsigned char* L = F.lds; const int tid = F.tid, lane = F.lane, w = F.wave, r32 = lane & 31, h = lane >> 5;
    const int t0 = T * 64, tw = t0 + 8 * w, ql = 8 * w + (r32 >> 2), tq = t0 + ql, hd = r32 & 3, hg = g * 4 + hd, jt = T;
    const bf16* Qp = (const bf16*)(F.ws + WS_QB) + (size_t)tq * 512 + hg * 64; bf16* Ob = (bf16*)(F.ws + WS_OB) + (size_t)tq * 512 + hg * 64;
    bf16x8 q[4];
#pragma unroll
    for (int ks = 0; ks < 4; ++ks) q[ks] = *(const bf16x8*)(Qp + 16 * ks + 8 * h);
    const float* bg = (const float*)(F.ws + WS_BG) + (size_t)tq * 24 + hg; const float g0 = bg[0], g1 = bg[8], g2 = bg[16];
    f32x16 o[2];
#pragma unroll
    for (int i = 0; i < 16; ++i) { o[0][i] = 0.f; o[1][i] = 0.f; }
    float m = -1e30f, l = 0.f;
    const int ncmp = t0 / 16 + 3, ntc = (ncmp + 63) >> 6;
    TileSrc sc; sc.K = (const bf16*)(F.ws + WS_KC) + (size_t)g * 1024 * 64; sc.Vt = (const bf16*)(F.ws + WS_VCT) + (size_t)g * 64 * 1024; sc.vpitch = 1024;
    FCmp fc; fc.lim0 = ((tq - 31) >> 4) - 4 * h; fc.cmax_w = (tw + 7 - 31) >> 4;
    attn_loop<3>(L, sc, 0, ntc, q, o, m, l, fc, tid, r32, h);
    const float inv = frcp(fmaxf(l, 1e-30f));
    { const bf16* OWp = (const bf16*)(F.ws + WS_OW) + (size_t)tq * 512 + hg * 64; const float s0_ = g0 * inv;
#pragma unroll
      for (int dt = 0; dt < 2; ++dt)
#pragma unroll
          for (int gq = 0; gq < 4; ++gq) { const u32x2 ow = *(const u32x2*)(OWp + 32 * dt + 8 * gq + 4 * h); u32x2 wv;
              wv.x = pkbf(s0_ * o[dt][4 * gq] + g2 * bf_lo(ow.x), s0_ * o[dt][4 * gq + 1] + g2 * bf_hi(ow.x));
              wv.y = pkbf(s0_ * o[dt][4 * gq + 2] + g2 * bf_lo(ow.y), s0_ * o[dt][4 * gq + 3] + g2 * bf_hi(ow.y));
              *(u32x2*)(Ob + 32 * dt + 8 * gq + 4 * h) = wv; } }
    LAS float* imp = (LAS float*)(L + AT_IMP);
    for (int i = lane; i < 8 * 256; i += 64) imp[8 * w * 256 + i] = 0.f;
    { constexpr int RD = 3; u32x4 kr[RD], vr[RD]; constexpr bool NEEDV = false; const TileSrc& src = sc; const int tile_lo = 0, ntiles = ntc;
#pragma unroll
      for (int j = 0; j < RD; ++j) if (j < ntiles) tile_load(src, j * 64, false, tid, kr[j], vr[j]);
#define BODY if (fc.active(tile)) { \
              f32x16 s0, s1; qk_tile(L + AT_K0 + buf * AT_KSZ, q, r32, h, s0, s1); \
              fc.apply(s0, s1, tile); \
              _Pragma("unroll") for (int kt = 0; kt < 2; ++kt) { const f32x16& s = kt ? s1 : s0; float mainv = 0.f, spv = 0.f; \
                  _Pragma("unroll") for (int gq = 0; gq < 4; ++gq) { const float p0 = fexp2(s[4 * gq] - m) * inv, p1 = fexp2(s[4 * gq + 1] - m) * inv, p2 = fexp2(s[4 * gq + 2] - m) * inv, p3 = fexp2(s[4 * gq + 3] - m) * inv; \
                      const float mq = quad_sum((p0 + p1) + (p2 + 0.5f * p3)), sq = quad_sum(0.5f * p3); \
                      if (gq == hd) { mainv = mq; spv = sq; } } \
                  const int j = tile * 16 + 8 * kt + 2 * hd + h; \
                  __hip_atomic_fetch_add((LAS int*)imp + ql * 256 + j, (int)__builtin_rintf(mainv * 16777216.0f), __ATOMIC_RELAXED, __HIP_MEMORY_SCOPE_WORKGROUP);   \
                  __hip_atomic_fetch_add((LAS int*)imp + ql * 256 + min(j + 1, 255), (j + 1 < 256) ? (int)__builtin_rintf(spv * 16777216.0f) : 0, __ATOMIC_RELAXED, __HIP_MEMORY_SCOPE_WORKGROUP); } }
#pragma unroll 1
      for (int i = 0; i < ntiles; i += RD) { ATTN_STEP(0) ATTN_STEP(1) ATTN_STEP(2) }
#undef BODY
      WG_BAR_LDS(); }
    LAS unsigned* selb = (LAS unsigned*)(L + AT_SEL);
#pragma unroll 1
    for (int qi = 0; qi < 8; ++qi) {
        const LAS float* row = imp + (8 * w + qi) * 256; unsigned mybits = 0u;
        if (lane == 0) mybits |= 1u;
        if (lane == (jt >> 5)) mybits |= 1u << (jt & 31);
        if (jt >= 1 && lane == ((jt - 1) >> 5)) mybits |= 1u << ((jt - 1) & 31);
        const int ncand = jt - 2;
        if (ncand > 0) {
            if (ncand <= 13) { if (lane == 0) mybits |= ((1u << (jt - 1)) - 2u); }
            else {
                unsigned k[4];
#pragma unroll
                for (int i = 0; i < 4; ++i) { const int j = lane + 64 * i; const unsigned v = ((const LAS unsigned*)row)[j]; k[i] = (j >= 1 && j <= jt - 2) ? ((v & ~255u) | (unsigned)(255 - j)) : 0u; }
#pragma unroll 1
                for (int it = 0; it < 13; ++it) { const unsigned mx = wave_max_u32(umax_(umax_(k[0], k[1]), umax_(k[2], k[3]))); const int j = 255 - (int)(mx & 255u);
                    if (lane == (j >> 5)) mybits |= 1u << (j & 31);
#pragma unroll
                    for (int i = 0; i < 4; ++i) k[i] = (k[i] == mx) ? 0u : k[i]; }
            }
        }
        if (lane < 8) selb[(8 * w + qi) * 8 + lane] = mybits;
    }
    if (probe_noslc && PROBE_SLC_MODE == 1) return;
    WG_BAR_LDS();
    { LAS unsigned char* qs = L + SQ_OFF + (ql * 4 + hd) * KROW + 16 * h;
#pragma unroll
      for (int ks = 0; ks < 4; ++ks) *(LAS bf16x8*)(qs + 32 * ks) = q[ks];
      for (int i = tid; i < 256 * SO_ROW; i += NWAVES * 64) ((LAS float*)(L + SO_OFF))[i] = 0.f;
      if (tid < 256) { ((LAS unsigned*)(L + SM_OFF))[tid] = 0u; ((LAS float*)(L + SL_OFF))[tid] = 0.f; }
      if (tid == 0) *(LAS unsigned*)(L + SC_OFF) = 0u; }
    WG_BAR_LDS();
    { SlcCtx C; C.probe = probe_noslc; C.L = L; C.KSg = (const bf16*)(F.ws + WS_KS) + (size_t)g * 256 * 4096; C.VSg = (const bf16*)(F.ws + WS_VTS) + (size_t)g * 256 * 4096;
      C.lut = (const LAS float*)(L + AT_LUT) + (8 + hg) * LUTS; C.slot = L + SS_OFF + w * 64; C.selb = selb; C.t0 = t0; C.jt = jt; C.lane = lane; C.r32 = r32; C.h = h; C.hd = hd;
      slc_pass<0, 4>(C);
      WG_BAR_LDS();
      if (tid == 0) *(LAS unsigned*)(L + SC_OFF) = 0u;
      WG_BAR_LDS();
      if (!(probe_noslc && PROBE_SLC_MODE == 2)) slc_pass<1, 1>(C);
      WG_BAR_LDS();
      LAS float* lsum = (LAS float*)(L + SL_OFF); LAS float* Oacc = (LAS float*)(L + SO_OFF);
      const int row = ql * 4 + hd; const float s2 = g1 * frcp(fmaxf(lsum[row], 1e-30f)) * (1.0f / 65536.0f); const LAS int* orow = (const LAS int*)Oacc + row * SO_ROW + 4 * h;
#pragma unroll
      for (int dt = 0; dt < 2; ++dt)
#pragma unroll
          for (int gq = 0; gq < 4; ++gq) { u32x2 wv; const u32x2 tt = *(const u32x2*)(Ob + 32 * dt + 8 * gq + 4 * h); const LAS int* op = orow + 32 * dt + 8 * gq;
              wv.x = pkbf(bf_lo(tt.x) + s2 * (float)op[0], bf_hi(tt.x) + s2 * (float)op[1]); wv.y = pkbf(bf_lo(tt.y) + s2 * (float)op[2], bf_hi(tt.y) + s2 * (float)op[3]);
              *(u32x2*)(Ob + 32 * dt + 8 * gq + 4 * h) = wv; }
    }
    WG_BAR_LDS();
}

typedef float f32x2 __attribute__((ext_vector_type(2)));
__device__ __forceinline__ float dot16_fp8(const u32x4& r, const f32x2 (&xp)[8]) {
    f32x2 a = __builtin_amdgcn_cvt_pk_f32_fp8((int)r.x, false) * xp[0];
    a = __builtin_elementwise_fma(__builtin_amdgcn_cvt_pk_f32_fp8((int)r.x, true), xp[1], a);
    a = __builtin_elementwise_fma(__builtin_amdgcn_cvt_pk_f32_fp8((int)r.y, false), xp[2], a); a = __builtin_elementwise_fma(__builtin_amdgcn_cvt_pk_f32_fp8((int)r.y, true), xp[3], a);
    a = __builtin_elementwise_fma(__builtin_amdgcn_cvt_pk_f32_fp8((int)r.z, false), xp[4], a); a = __builtin_elementwise_fma(__builtin_amdgcn_cvt_pk_f32_fp8((int)r.z, true), xp[5], a);
    a = __builtin_elementwise_fma(__builtin_amdgcn_cvt_pk_f32_fp8((int)r.w, false), xp[6], a); a = __builtin_elementwise_fma(__builtin_amdgcn_cvt_pk_f32_fp8((int)r.w, true), xp[7], a);
    return a.x + a.y;
}
typedef __bf16 v2bf __attribute__((ext_vector_type(2)));
__device__ __forceinline__ float dot2bf(unsigned a, unsigned b, float c) { return __builtin_amdgcn_fdot2_f32_bf16(__builtin_bit_cast(v2bf, a), __builtin_bit_cast(v2bf, b), c, false); }
__device__ __forceinline__ void peer_top16(const bf16* qrow, LAS const unsigned char* kmat, int r32, int h2, unsigned (&sel)[16]) {
    bf16x8 qf[8];
#pragma unroll
    for (int ks = 0; ks < 8; ++ks) qf[ks] = *(const bf16x8*)(qrow + 16 * ks + 8 * h2);
    unsigned key[64];
#pragma unroll
    for (int nt = 0; nt < 4; ++nt) { f32x16 s;
#pragma unroll
        for (int i = 0; i < 16; ++i) s[i] = 0.f;
#pragma unroll
        for (int ks = 0; ks < 8; ++ks) { const bf16x8 a = *(LAS const bf16x8*)(kmat + (32 * nt + r32) * PK_ROW + (16 * ks + 8 * h2) * 2); s = __builtin_amdgcn_mfma_f32_32x32x16_bf16(a, qf[ks], s, 0, 0, 0); }
#pragma unroll
        for (int i = 0; i < 16; ++i) key[nt * 16 + i] = (ord_key(s[i]) & ~127u) | (unsigned)(((63 - (nt * 16 + i)) << 1) | (1 - h2)); }
    unsigned prev = 0xFFFFFFFFu;
#pragma unroll
    for (int k = 0; k < 16; ++k) sel[k] = 0u;
#pragma unroll 1
    for (int it = 0; it < 16; ++it) { unsigned c = 0u;
#pragma unroll
        for (int i = 0; i < 64; ++i) c = umax_(c, key[i] - prev);
        const unsigned mloc = c + prev, mm = pair_umax(mloc);
#pragma unroll
        for (int k = 0; k < 16; ++k) sel[k] = (k == it) ? mm : sel[k];
        prev = mm; }
}
__device__ __forceinline__ int key_n(unsigned k) { const int low = k & 127, Lx = 63 - (low >> 1), hh = 1 - (low & 1); return ((Lx >> 4) << 5) + (((Lx >> 2) & 3) << 3) + (hh << 2) + (Lx & 3); }

__device__ __forceinline__ void peer_phase(Frame& F, bool dry) {
    LAS unsigned char* L = F.lds; const int tid = F.tid, lane = F.lane, w = F.wave, r32 = lane & 31, h2 = lane >> 5;
    unsigned char* ws = F.ws;
    for (int i = tid; i < 2 * 128 * 16; i += NWAVES * 64) { const int which = i >> 11, rr = (i >> 4) & 127, ch = i & 15;
        *(LAS u32x4*)(L + (which ? PK2_OFF : PK1_OFF) + rr * PK_ROW + ch * 16) = *(const u32x4*)((const bf16*)(ws + (which ? WS_K2B : WS_K1B)) + rr * 128 + ch * 8); }
    __syncthreads();
    LAS unsigned char* PW = L + PW_OFF + w * PW_BYTES;
    LAS unsigned char* XR = PW; LAS u32x2* LST = (LAS u32x2*)(PW + 2048); LAS unsigned char* I12 = PW + 6144; LAS float* WL = (LAS float*)(PW + 7168);
    const bf16* Q2 = (const bf16*)(ws + WS_Q2); const unsigned char* U8 = ws + WS_U8; const unsigned char* V8 = ws + WS_V8;
    bf16* xb = (bf16*)(ws + WS_XB2); const float* ssq1 = (const float*)(ws + WS_SSQ1); float* rs2 = (float*)(ws + WS_RS2);
    const int gw = F.vcu * NWAVES + w, NGW = F.G * NWAVES;
#pragma unroll 1
    for (int item = gw; item < SEQ / 4; item += NGW) {
        const int t0 = item * 4;
        {
            const int tk = r32 >> 3, hd = r32 & 7; const bf16* qrow = Q2 + (size_t)(t0 + tk) * 2048 + hd * 256;
            const float rsq = rs_from_ssq(ssq1, t0 + tk);
            unsigned s1[16], s2[16];
            peer_top16(qrow, L + PK1_OFF, r32, h2, s1);
            peer_top16(qrow + 128, L + PK2_OFF, r32, h2, s2);
            float v1[16], v2[16];
#pragma unroll
            for (int k = 0; k < 16; ++k) { v1[k] = ord_val(s1[k] & ~127u); v2[k] = ord_val(s2[k] & ~127u); }
            if (h2 == 0) { LAS unsigned* ip = (LAS unsigned*)(I12 + r32 * 32);
#pragma unroll
                for (int k4 = 0; k4 < 4; ++k4) { ip[k4] = (unsigned)key_n(s1[4 * k4]) | ((unsigned)key_n(s1[4 * k4 + 1]) << 8) | ((unsigned)key_n(s1[4 * k4 + 2]) << 16) | ((unsigned)key_n(s1[4 * k4 + 3]) << 24);
                    ip[4 + k4] = (unsigned)key_n(s2[4 * k4]) | ((unsigned)key_n(s2[4 * k4 + 1]) << 8) | ((unsigned)key_n(s2[4 * k4 + 2]) << 16) | ((unsigned)key_n(s2[4 * k4 + 3]) << 24); } }
            unsigned ck[50]; int nc = 0;
#pragma unroll
            for (int i = 0; i < 16; ++i)
#pragma unroll
                for (int j = 0; j < 16; ++j) if ((i + 1) * (j + 1) <= 16) { ck[nc] = (ord_key(v1[i] + v2[j]) & ~255u) | (unsigned)(255 - (16 * i + j)); ++nc; }
            unsigned prev = 0xFFFFFFFFu; float sc[16]; int ei[16];
#pragma unroll
            for (int it = 0; it < 16; ++it) { unsigned c = 0u;
#pragma unroll
                for (int i = 0; i < 50; ++i) c = umax_(c, ck[i] - prev);
                const unsigned mm = c + prev; prev = mm;
                const int flat = 255 - (int)(mm & 255u); sc[it] = ord_val(mm & ~255u);
                ei[it] = (int)I12[r32 * 32 + (flat >> 4)] * 128 + (int)I12[r32 * 32 + 16 + (flat & 15)]; }
            float den = 0.f, ex[16];
#pragma unroll
            for (int k = 0; k < 16; ++k) { ex[k] = fexp2((sc[k] - sc[0]) * (rsq * LOG2E)); den += ex[k]; }
            const float rd = frcp(den);
            if (h2 == 0) {
#pragma unroll
                for (int k = 0; k < 16; ++k) { u32x2 e; e.x = (unsigned)ei[k]; e.y = __float_as_uint(ex[k] * rd); LST[tk * 128 + hd * 16 + k] = e; } }
        }
#pragma unroll 1
        for (int tk = 0; tk < 4; ++tk) {
            const int t = t0 + tk;
            f32x2 xp[8];
            { const u32x4 xa = *(const u32x4*)(xb + (size_t)t * DM + lane * 16), xc = *(const u32x4*)(xb + (size_t)t * DM + lane * 16 + 8);
              xp[0] = (f32x2){bf_lo(xa.x), bf_hi(xa.x)}; xp[1] = (f32x2){bf_lo(xa.y), bf_hi(xa.y)}; xp[2] = (f32x2){bf_lo(xa.z), bf_hi(xa.z)}; xp[3] = (f32x2){bf_lo(xa.w), bf_hi(xa.w)};
              xp[4] = (f32x2){bf_lo(xc.x), bf_hi(xc.x)}; xp[5] = (f32x2){bf_lo(xc.y), bf_hi(xc.y)}; xp[6] = (f32x2){bf_lo(xc.z), bf_hi(xc.z)}; xp[7] = (f32x2){bf_lo(xc.w), bf_hi(xc.w)}; }
            const float rs = rs_from_ssq(ssq1, t) * (1.0f / 32.0f);
            const LAS u32x2* lst = LST + tk * 128;
#if defined(PROBE_L2PEER)
            const int idxmask = dry ? 1023 : 16383;
#else
            constexpr int idxmask = 16383;
#endif
#define PEER_LOAD8(R_, TAB_, e0_) _Pragma("unroll") for (int k = 0; k < 8; ++k) { const int idx = __builtin_amdgcn_readfirstlane((int)lst[(e0_) + k].x) & idxmask; R_[k] = *(const u32x4*)(TAB_ + (size_t)idx * DM + lane * 16); }
#define PEER_DOT16(r_) dot16_fp8(r_, xp)
#define PEER_UCOMP(R_, e0_) _Pragma("unroll") for (int k4 = 0; k4 < 2; ++k4) { \
                const float p0 = PEER_DOT16(R_[4 * k4]), p1 = PEER_DOT16(R_[4 * k4 + 1]), p2 = PEER_DOT16(R_[4 * k4 + 2]), p3 = PEER_DOT16(R_[4 * k4 + 3]); \
                auto s02 = __builtin_amdgcn_permlane32_swap(__float_as_uint(p0), __float_as_uint(p2), false, false); auto s13 = __builtin_amdgcn_permlane32_swap(__float_as_uint(p1), __float_as_uint(p3), false, false); \
                const float r0 = __uint_as_float(s02[0]) + __uint_as_float(s02[1]), r1 = __uint_as_float(s13[0]) + __uint_as_float(s13[1]); \
                auto s01 = __builtin_amdgcn_permlane16_swap(__float_as_uint(r0), __float_as_uint(r1), false, false); \
                float qv = __uint_as_float(s01[0]) + __uint_as_float(s01[1]); \
                qv += dpp_f<0xB1>(qv); qv += dpp_f<0x4E>(qv); qv += dpp_f<0x141>(qv); qv += dpp_f<0x140>(qv); \
                if ((lane & 15) == 0) { const int e = (e0_) + 4 * k4 + 2 * (lane >> 5) + ((lane >> 4) & 1); WL[e] = 0.25f * __uint_as_float(lst[e].y) * gelu_tanh(qv * rs); } }
            { u32x4 uR0[8], uR1[8];
              PEER_LOAD8(uR0, U8, 0);
#pragma unroll 1
              for (int e0 = 0; e0 < 128; e0 += 16) {
                  PEER_LOAD8(uR1, U8, e0 + 8);
                  PEER_UCOMP(uR0, e0);
                  if (e0 + 16 < 128) { PEER_LOAD8(uR0, U8, e0 + 16); }
                  PEER_UCOMP(uR1, e0 + 8);
              } }
            f32x2 o2[8];
#pragma unroll
            for (int i = 0; i < 8; ++i) o2[i] = (f32x2){0.f, 0.f};
#define PEER_VCOMP(R_, e0_) _Pragma("unroll") for (int k = 0; k < 8; ++k) { const float wv = WL[(e0_) + k]; const f32x2 w2 = (f32x2){wv, wv}; \
                o2[0] = __builtin_elementwise_fma(__builtin_amdgcn_cvt_pk_f32_fp8((int)R_[k].x, false), w2, o2[0]); o2[1] = __builtin_elementwise_fma(__builtin_amdgcn_cvt_pk_f32_fp8((int)R_[k].x, true), w2, o2[1]); \
                o2[2] = __builtin_elementwise_fma(__builtin_amdgcn_cvt_pk_f32_fp8((int)R_[k].y, false), w2, o2[2]); o2[3] = __builtin_elementwise_fma(__builtin_amdgcn_cvt_pk_f32_fp8((int)R_[k].y, true), w2, o2[3]); \
                o2[4] = __builtin_elementwise_fma(__builtin_amdgcn_cvt_pk_f32_fp8((int)R_[k].z, false), w2, o2[4]); o2[5] = __builtin_elementwise_fma(__builtin_amdgcn_cvt_pk_f32_fp8((int)R_[k].z, true), w2, o2[5]); \
                o2[6] = __builtin_elementwise_fma(__builtin_amdgcn_cvt_pk_f32_fp8((int)R_[k].w, false), w2, o2[6]); o2[7] = __builtin_elementwise_fma(__builtin_amdgcn_cvt_pk_f32_fp8((int)R_[k].w, true), w2, o2[7]); }
            { u32x4 vR0[8], vR1[8];
              PEER_LOAD8(vR0, V8, 0);
#pragma unroll 1
              for (int e0 = 0; e0 < 128; e0 += 16) {
                  PEER_LOAD8(vR1, V8, e0 + 8);
                  PEER_VCOMP(vR0, e0);
                  if (e0 + 16 < 128) { PEER_LOAD8(vR0, V8, e0 + 16); }
                  PEER_VCOMP(vR1, e0 + 8);
              } }
            float* op = F.out + (size_t)t * DM + lane * 16;
            float* od = dry ? (float*)(ws + WS_PB) + (size_t)gw * DM + lane * 16 : op; bf16* xd = dry ? (bf16*)(ws + WS_PB + 8 * MiB) + (size_t)gw * DM : xb + (size_t)t * DM; float* rd2 = dry ? (float*)(ws + WS_PB + 12 * MiB) + gw : rs2 + t;
            f32x4 a0 = *(const f32x4*)op, a1 = *(const f32x4*)(op + 4), b0 = *(const f32x4*)(op + 8), b1 = *(const f32x4*)(op + 12);
            a0[0] += o2[0].x; a0[1] += o2[0].y; a0[2] += o2[1].x; a0[3] += o2[1].y; a1[0] += o2[2].x; a1[1] += o2[2].y; a1[2] += o2[3].x; a1[3] += o2[3].y;
            b0[0] += o2[4].x; b0[1] += o2[4].y; b0[2] += o2[5].x; b0[3] += o2[5].y; b1[0] += o2[6].x; b1[1] += o2[6].y; b1[2] += o2[7].x; b1[3] += o2[7].y;
            *(f32x4*)od = a0; *(f32x4*)(od + 4) = a1; *(f32x4*)(od + 8) = b0; *(f32x4*)(od + 12) = b1;
            *(u32x4*)(xd + lane * 16) = pack8(a0, a1); *(u32x4*)(xd + lane * 16 + 8) = pack8(b0, b1);
            float ss = 0.f;
#pragma unroll
            for (int i = 0; i < 4; ++i) ss += a0[i] * a0[i] + a1[i] * a1[i] + b0[i] * b0[i] + b1[i] * b1[i];
            ss = wave_sum(ss);
            if (lane == 0) *rd2 = __builtin_amdgcn_rsqf(ss * (1.0f / DM) + EPS);
        }
    }
}
constexpr int NCONV = 512;
__device__ __forceinline__ void convert_peer_item(Frame& F, int item, const float* u, const float* v, const float* g) {
    unsigned char* U8 = F.ws + WS_U8; unsigned char* V8 = F.ws + WS_V8;
    constexpr int PER = 16384 * 1024 / 16 / NCONV;
    for (int k = F.tid; k < PER; k += NWAVES * 64) {
        const int i = item * PER + k, d0 = (i & 63) * 16; u32x4 wu, wv;
#pragma unroll
        for (int q = 0; q < 4; ++q) { const f32x4 gq = *(const f32x4*)(g + d0 + 4 * q) * 32.0f; const f32x4 a = *(const f32x4*)(u + (size_t)i * 16 + 4 * q) * gq, c = *(const f32x4*)(v + (size_t)i * 16 + 4 * q) * 4.0f;
            int pu = __builtin_amdgcn_cvt_pk_fp8_f32(a[0], a[1], 0, false); pu = __builtin_amdgcn_cvt_pk_fp8_f32(a[2], a[3], pu, true);
            int pv = __builtin_amdgcn_cvt_pk_fp8_f32(c[0], c[1], 0, false); pv = __builtin_amdgcn_cvt_pk_fp8_f32(c[2], c[3], pv, true);
            wu[q] = (unsigned)pu; wv[q] = (unsigned)pv; }
        *(u32x4*)(U8 + (size_t)i * 16) = wu; *(u32x4*)(V8 + (size_t)i * 16) = wv;
    }
}
__device__ __forceinline__ void final_norm(Frame& F, const float* gf, float* dst) {
    const int gw = F.vcu * NWAVES + F.wave, NGW = F.G * NWAVES, lane = F.lane;
    f32x4 gv[4];
#pragma unroll
    for (int j = 0; j < 4; ++j) gv[j] = ((const f32x4*)gf)[lane + 64 * j];
    for (int row = gw; row < SEQ; row += NGW) {
        f32x4* xr = (f32x4*)(F.out + (size_t)row * DM) + lane; f32x4 v[4]; float ss = 0.f;
#pragma unroll
        for (int j = 0; j < 4; ++j) { v[j] = xr[64 * j]; ss += (v[j][0] * v[j][0] + v[j][1] * v[j][1]) + (v[j][2] * v[j][2] + v[j][3] * v[j][3]); }
        const float rs = __builtin_amdgcn_rsqf(wave_sum(ss) * (1.0f / DM) + EPS);
        f32x4* dr = (f32x4*)(dst + (size_t)row * DM) + lane;
#pragma unroll
        for (int j = 0; j < 4; ++j) dr[64 * j] = v[j] * rs * gv[j];
    }
}

constexpr int NPHASE = 10;
__global__ void __launch_bounds__(NWAVES * 64, 2) hybrid_fwd(Args args) {
    extern __shared__ __attribute__((aligned(16))) unsigned char lds[];
    Frame F;
    F.lds = (LAS unsigned char*)lds; F.MISC = (volatile LAS unsigned*)(F.lds + LDSCTL_OFF);
    F.tid = threadIdx.x; F.lane = F.tid & 63; F.wave = __builtin_amdgcn_readfirstlane(F.tid >> 6);
    F.G = gridDim.x; { const int bx = blockIdx.x; F.vcu = (F.G % 8 == 0) ? (bx % 8) * (F.G / 8) + bx / 8 : bx; }
    F.ws = args.ws; F.ctl = (gu32*)(args.ws + WS_CTL); F.out = args.out;
    for (int u = F.tid; u < (LDS_BYTES - LDSCTL_OFF) / 4; u += NWAVES * 64) ((LAS unsigned*)(F.lds + LDSCTL_OFF))[u] = 0u;
    __syncthreads();
    if (F.tid < 24) ((LAS unsigned long long*)(F.lds + INTAB_OFF))[F.tid] = (unsigned long long)args.in[F.tid];
    __syncthreads();
    const int lo = args.ph_lo, hi = args.ph_hi;
    XcdBarrier bar = xcd_barrier_post((unsigned*)(F.ctl + CW_BAR) + args.li * XCD_BAR_WORDS, F.MISC + 8);
#ifndef PHASE_MASK
#define PHASE_MASK 0xFFFF
#endif
#define IN(k) (((PHASE_MASK >> (k)) & 1) && lo <= (k) && (k) < hi)
#define SEAM(k) do { if (IN(k) && IN((k) + 1)) xcd_barrier(bar); } while (0)
    unsigned char* ws = args.ws;
    const int G = F.G, bx = (int)blockIdx.x;
#if defined(PROBE_REPEAT)
    const bool dry = (args.li == 1);
#else
    constexpr bool dry = false;
#endif

    if (IN(0)) { p0_prologue(F); }
    SEAM(0);
    if (IN(1)) {
        pg8::Gemm g{(const bf16*)(ws + WS_XB), (const bf16*)(ws + WS_WIN), SEQ, N1, DM, DM, DM}; pg8::StaticOrder S; S.init(SEQ, N1, G, bx);
#if defined(PROBE_NULLEPI)
        if (args.li == PROBE_NULLEPI_LI) { EpiNull E0; pg8::gemm_phase<EpiNull, pg8::StaticOrder, true, true>(F.lds, g, S, E0); } else
#endif
        { Epi1 E{(const float*)(ws + WS_RS0), ws};
        pg8::gemm_phase<Epi1, pg8::StaticOrder, true, true>(F.lds, g, S, E); }
        if (G == 256 && !dry) { const int r = bx - 64; pg8::TailOrder T2{r >= 0 ? r : -1, (r >= 0 && r < 64) ? 192 + r : -1, 4};
            pg8::Gemm g2{(const bf16*)(ws + WS_PB), (const bf16*)(ws + WS_WPLE), SEQ, DM, 256, 256, 256}; EpiPw E2{(bf16*)(ws + WS_PW), DM};
            pg8::gemm_phase<EpiPw, pg8::TailOrder, false, true>(F.lds, g2, T2, E2);
            if (bx >= 64) { __syncthreads(); weight_items(F, 1, (bx - 64) * NWAVES + F.wave, (G - 64) * NWAVES); }
            if (bx == 255) posb_finish(F); }
        else if (!dry) { pg8::Gemm g2{(const bf16*)(ws + WS_PB), (const bf16*)(ws + WS_WPLE), SEQ, DM, 256, 256, 256}; pg8::StaticOrder S2; S2.init(SEQ, DM, G, bx); EpiPw E2{(bf16*)(ws + WS_PW), DM};
            pg8::gemm_phase<EpiPw, pg8::StaticOrder, true, true>(F.lds, g2, S2, E2); __syncthreads(); weight_items(F, 1, F.vcu * NWAVES + F.wave, G * NWAVES); if (bx == 0) posb_finish(F); }
        if (dry) { __syncthreads(); }
    }
    SEAM(1);
    if (IN(2)) {
        { pg8::Gemm g{(const bf16*)(ws + WS_CK), (const bf16*)(ws + WS_W1KV), 4096, 512, 2048, 1024, 2048}; pg8::OneUnit S{bx, bx >> 3, bx < 16 ? 1 : 0};
          EpiCmp E{(bf16*)(ws + WS_H), (const float*)(ws + WS_POSB)};
          pg8::gemm_phase<EpiCmp, pg8::OneUnit, false, true>(F.lds, g, S, E);
          if (bx < 16) { __threadfence(); __syncthreads(); compress_out(F, bx); } }
        __syncthreads();
        build_lut(F, in_ptr(F, 5));
        for (;;) {
            __syncthreads();
            if (F.tid == 0) F.MISC[16] = __hip_atomic_fetch_add(F.ctl + CW_QUEUE + args.li * 64, 1u, RLX_AGENT);
            __syncthreads();
            const int unit = (int)F.MISC[16];
            if (unit >= 1024 + NCONV) break;
            if (unit % 3 == 2) { convert_peer_item(F, unit / 3, in_ptr(F, 18), in_ptr(F, 19), in_ptr(F, 14)); continue; }
            const int au = (unit / 3) * 2 + unit % 3;
            if (au < 512) banded_unit<1>(F, in_ptr(F, 4), au >> 1, au & 1); else banded_unit<0>(F, in_ptr(F, 4), (au - 512) >> 1, au & 1);
        }
    }
    SEAM(2);
    if (IN(3)) {
        build_lut(F, in_ptr(F, 5));
        for (;;) {
            __syncthreads();
            if (F.tid == 0) F.MISC[16] = __hip_atomic_fetch_add(F.ctl + CW_QUEUE + 1024 + args.li * 64, 1u, RLX_AGENT);
            __syncthreads();
            const int unit = (int)F.MISC[16];
            if (unit >= 512) break;
            nsa_unit(F, 255 - (unit >> 1), unit & 1, dry);
        }
    }
    SEAM(3);
    if (IN(4)) {
        { pg8::Gemm g{(const bf16*)(ws + WS_OA), (const bf16*)(ws + WS_WUPA), SEQ, DM, 512, 512, 512}; pg8::StaticOrder S; S.init(SEQ, DM, G, bx); EpiUp E{(bf16*)(ws + WS_MG), 0, (bf16*)(ws + (dry ? WS_QA : WS_MG))};
          pg8::gemm_phase<EpiUp, pg8::StaticOrder, true, true>(F.lds, g, S, E); }
        { pg8::Gemm g{(const bf16*)(ws + WS_OB), (const bf16*)(ws + WS_WUPB), SEQ, DM, 512, 512, 512}; pg8::StaticOrder S; S.init(SEQ, DM, G, bx); EpiUp2 E{(bf16*)(ws + WS_MG), (bf16*)(ws + (dry ? WS_QA : WS_MG))};
          pg8::gemm_phase<EpiUp2, pg8::StaticOrder, true, true>(F.lds, g, S, E); }
    }
    SEAM(4);
    if (IN(5)) {
        { pg8::Gemm g{(const bf16*)(ws + WS_MG), (const bf16*)(ws + WS_WO2), SEQ, DM, DM, 2048, DM};   pg8::StaticOrder S; S.init(SEQ, DM, G, bx);
          EpiWo E{in_ptr(F, 0), F.out, (bf16*)(ws + WS_XB2), (float*)(ws + WS_SSQ1)};
          pg8::gemm_phase<EpiWo, pg8::StaticOrder, true, true>(F.lds, g, S, E); }
    }
    SEAM(5);
    if (IN(6)) {
        { pg8::Gemm g{(const bf16*)(ws + WS_XB2), (const bf16*)(ws + WS_WQ), SEQ, 2048, DM, DM, DM}; pg8::StaticOrder S; S.init(SEQ, 2048, G, bx); EpiPw E{(bf16*)(ws + WS_Q2), 2048};
          pg8::gemm_phase<EpiPw, pg8::StaticOrder, true, true>(F.lds, g, S, E); }
    }
    SEAM(6);
    if (IN(7)) { __syncthreads(); peer_phase(F, dry); }
    SEAM(7);
    if (IN(8)) {
        pg8::Gemm g{(const bf16*)(ws + WS_XB2), (const bf16*)(ws + WS_WPG), SEQ, DM, DM, DM, DM}; pg8::StaticOrder S; S.init(SEQ, DM, G, bx);
        EpiPle E{(const float*)(ws + WS_RS2), (const bf16*)(ws + WS_PW), F.out, dry ? (float*)(ws + WS_Q2) : F.out};
        pg8::gemm_phase<EpiPle, pg8::StaticOrder, true, true>(F.lds, g, S, E);
    }
    SEAM(8);
    if (IN(9)) final_norm(F, in_ptr(F, 23), dry ? (float*)(ws + WS_Q2) : F.out);
#undef IN
#undef SEAM
}

#ifndef MK_ONE_LAUNCH
#define MK_ONE_LAUNCH 1
#endif
extern "C" void kernel_launch(void* const* d_in, const int* in_sizes, int n_in, void* d_out, int out_size, void* d_ws, size_t ws_size, hipStream_t stream) {
    static int grid = 0;
    if (grid == 0) {
        if (n_in != 24 || in_sizes[0] != SEQ * DM || out_size != SEQ * DM || ws_size < WS_END) { fprintf(stderr, "kernel_launch: unexpected shapes (n_in %d, in0 %d, out %d, ws %zu); nothing launched\n", n_in, n_in > 0 ? in_sizes[0] : -1, out_size, ws_size); grid = -1; return; }
        int dev = 0, cus = 0, per_cu = 0;
        if (hipGetDevice(&dev) != hipSuccess || hipDeviceGetAttribute(&cus, hipDeviceAttributeMultiprocessorCount, dev) != hipSuccess) { grid = -1; return; }
        if (hipFuncSetAttribute((const void*)hybrid_fwd, hipFuncAttributeMaxDynamicSharedMemorySize, LDS_BYTES) != hipSuccess) { fprintf(stderr, "kernel_launch: hipFuncSetAttribute failed\n"); grid = -1; return; }
        if (hipOccupancyMaxActiveBlocksPerMultiprocessor(&per_cu, (const void*)hybrid_fwd, NWAVES * 64, LDS_BYTES) != hipSuccess || per_cu < 1) { fprintf(stderr, "kernel_launch: occupancy query says %d blocks per CU\n", per_cu); }
        (void)hipGetLastError();
        grid = cus;
    }
    if (grid < 0) return;
    if (hipMemsetAsync((char*)d_ws + WS_CTL, 0, CTL_ZERO_BYTES, stream) != hipSuccess) return;
    Args a{};
    for (int i = 0; i < 24; ++i) a.in[i] = (const float*)d_in[i];
    a.out = (float*)d_out; a.ws = (unsigned char*)d_ws;
#if defined(PROBE_REPEAT)
    const int cuts[4] = {0, PROBE_REPEAT + 1, PROBE_REPEAT, NPHASE};
    for (int li = 0; li < 3; ++li) { a.ph_lo = li == 0 ? 0 : li == 1 ? PROBE_REPEAT : PROBE_REPEAT + 1; a.ph_hi = li == 0 ? PROBE_REPEAT + 1 : li == 1 ? PROBE_REPEAT + 1 : NPHASE; a.li = li; (void)cuts;
        if (a.ph_lo < a.ph_hi) hipLaunchKernelGGL(hybrid_fwd, dim3(grid), dim3(NWAVES * 64), LDS_BYTES, stream, a); }
#elif MK_ONE_LAUNCH
    a.ph_lo = 0; a.ph_hi = NPHASE; a.li = 0;
    hipLaunchKernelGGL(hybrid_fwd, dim3(grid), dim3(NWAVES * 64), LDS_BYTES, stream, a);
#else
    for (int p = 0; p < NPHASE; ++p) { a.ph_lo = p; a.ph_hi = p + 1; a.li = 0; hipLaunchKernelGGL(hybrid_fwd, dim3(grid), dim3(NWAVES * 64), LDS_BYTES, stream, a); }
#endif
}
```

```cpp
#include <hip/hip_runtime.h>
#include <cstdio>
#include <cstdint>

#define GAS __attribute__((address_space(1)))
#define LAS __attribute__((address_space(3)))
typedef unsigned short bf16;
typedef short bf16x8 __attribute__((ext_vector_type(8)));
typedef short s16x4 __attribute__((ext_vector_type(4)));
typedef float f32x4 __attribute__((ext_vector_type(4)));
typedef float f32x16 __attribute__((ext_vector_type(16)));
typedef unsigned u32x4 __attribute__((ext_vector_type(4)));
typedef unsigned u32x2 __attribute__((ext_vector_type(2)));
typedef _Float16 h16x8 __attribute__((ext_vector_type(8)));
typedef GAS unsigned gu32;
typedef float f32x2_t __attribute__((ext_vector_type(2))); typedef __bf16 bf16x2_t __attribute__((ext_vector_type(2)));
__device__ __forceinline__ unsigned pkbf(float lo, float hi) { f32x2_t v = {lo, hi}; bf16x2_t b = __builtin_convertvector(v, bf16x2_t); return __builtin_bit_cast(unsigned, b); }
__device__ __forceinline__ float bf_lo(unsigned u) { return __uint_as_float(u << 16); }
__device__ __forceinline__ float bf_hi(unsigned u) { return __uint_as_float(u & 0xffff0000u); }
__device__ __forceinline__ float fexp2(float x) { return __builtin_amdgcn_exp2f(x); }
__device__ __forceinline__ float frcp(float x) { return __builtin_amdgcn_rcpf(x); }
__device__ __forceinline__ float sigmoidf_(float x) { return frcp(1.0f + fexp2(-1.4426950408889634f * x)); }
__device__ __forceinline__ float gelu_tanh(float x) { const float u = x * (1.0f + 0.044715f * x * x); return x * frcp(1.0f + fexp2(-2.302208198f * u)); }
#define LOG2E 1.4426950408889634f
#define RLX_AGENT __ATOMIC_RELAXED, __HIP_MEMORY_SCOPE_AGENT
#define LDS_WAIT() asm volatile("s_waitcnt lgkmcnt(0)" ::: "memory")
#define VM_WAIT() asm volatile("s_waitcnt vmcnt(0)" ::: "memory")

namespace pg8 {
#define PG8_LAS __attribute__((address_space(3)))
typedef unsigned short bf16_t;
typedef short bf16x8 __attribute__((ext_vector_type(8)));
typedef float f32x4 __attribute__((ext_vector_type(4)));
typedef unsigned u32x4 __attribute__((ext_vector_type(4)));
constexpr int BM = 256, BK = 64, HALF = 128, HTB = HALF * BK * 2  , STAGE_BYTES = 8 * HTB, NXCD = 8, WGM = 8;

__host__ __device__ __forceinline__ int lds_byte(int r, int c) { const int st = (r >> 4) * 2 + (c >> 5), rr = r & 15, cc = c & 31, ob = rr * 64 + cc * 2; return st * 1024 + (ob ^ (((ob >> 9) & 1) << 5)); }
__host__ __device__ __forceinline__ void stage_rc(int b, int& R, int& C) { const int st = b / 1024, sb = b % 1024, swz = sb ^ (((sb >> 9) & 1) << 5); R = (st >> 1) * 16 + swz / 64; C = (st & 1) * 32 + (swz % 64) / 2; }
__host__ __device__ __forceinline__ int perm32(int rho) { const int n = rho >> 4, i = rho & 15; return 8 * (i >> 2) + 4 * n + (i & 3); }

struct Unit { int pm, pn; };
struct Gemm { const bf16_t* A; const bf16_t* Bt; int M, N, K, lda, ldb; };

struct StaticOrder {
    int nM, nN, nwg, G, c;
    __host__ __device__ void init(int M, int N, int G_, int c_) { nM = M / BM; nN = N / BM; nwg = nM * nN; G = G_; c = c_; }
    __host__ __device__ bool next(int i, Unit& u) const {
        const long L = (long)i * G + c; if (L >= nwg) return false;
        int wgid = (int)L; { const int q = nwg / NXCD, r = nwg % NXCD, xcd = wgid % NXCD, off = wgid / NXCD; wgid = (xcd < r ? xcd * (q + 1) : r * (q + 1) + (xcd - r) * q) + off; }
        const int nig = WGM * nN, gid = wgid / nig, fm = gid * WGM, gsz = (nM - fm) < WGM ? (nM - fm) : WGM;
        u.pm = fm + ((wgid % nig) % gsz); u.pn = (wgid % nig) / gsz; return true;
    }
    __device__ __forceinline__ void a_ready(const Unit&) const {}
    __device__ __forceinline__ void done(const Unit&) const {}
};
struct OneUnit {
    int pm, pn, has;
    __device__ bool next(int i, Unit& u) const { if (i == 0 && has) { u.pm = pm; u.pn = pn; return true; } return false; }
    __device__ __forceinline__ void a_ready(const Unit&) const {}
    __device__ __forceinline__ void done(const Unit&) const {}
};
struct TailOrder {
    int a, b, nN;
    __device__ bool next(int i, Unit& u) const { const int id = i == 0 ? a : i == 1 ? b : -1; if (id < 0) return false; u.pm = id / nN; u.pn = id % nN; return true; }
    __device__ __forceinline__ void a_ready(const Unit&) const {}
    __device__ __forceinline__ void done(const Unit&) const {}
};
template <class Epi, class Sched, bool ALIGN_EPI = false, bool SP2 = false>
__device__ __forceinline__ void gemm_phase(PG8_LAS unsigned char* lds, const Gemm g, const Sched& S, const Epi& E) {
    const int tid = threadIdx.x, wid = __builtin_amdgcn_readfirstlane(tid >> 6), lane = tid & 63, wr = wid >> 2, wc = wid & 3, fr = lane & 15, fq = lane >> 4;
    const int K = g.K, nt = K / BK;
    unsigned voffA[2], voffB[2];
#pragma unroll
    for (int i = 0; i < 2; ++i) { int R, C; stage_rc(tid * 16 + i * 8192, R, C); const int Rb = Epi::PERM ? ((R & ~31) + perm32(R & 31)) : R;
        voffA[i] = (unsigned)(R * g.lda + C) * 2u; voffB[i] = (unsigned)(Rb * g.ldb + C) * 2u; }
    const size_t kstep = (size_t)(BK * 2);
    const size_t hstepA = (size_t)HALF * g.lda * 2, hstepB = (size_t)HALF * g.ldb * 2;
    const size_t tstepA = 2 * hstepA, tstepB = 2 * hstepB;
    const unsigned ldsw = (unsigned)wid * 1024u;
    const int aoff = lds_byte(wr * 64 + fr, fq * 8), boff = lds_byte(wc * 32 + fr, fq * 8);
#define PG8_SA(b, h) (((b) * 2 + (h)) * HTB)
#define PG8_SB(b, h) ((4 + (b) * 2 + (h)) * HTB)
#define PG8_STAGE(bufoff, gbase, voff) do { _Pragma("unroll") for (int _i = 0; _i < 2; ++_i) \
        __builtin_amdgcn_global_load_lds((const unsigned*)((const char*)(gbase) + (voff)[_i]), (PG8_LAS unsigned*)(lds + (bufoff) + ldsw + _i * 8192), 16, 0, 0); } while (0)
#define PG8_LDA(dst, b, h) do { _Pragma("unroll") for (int m = 0; m < 4; ++m) _Pragma("unroll") for (int k = 0; k < 2; ++k) dst[m][k] = *(const PG8_LAS bf16x8*)(lds + PG8_SA(b, h) + aoff + m * 2048 + k * 1024); } while (0)
#define PG8_LDB(dst, b, h) do { _Pragma("unroll") for (int n = 0; n < 2; ++n) _Pragma("unroll") for (int k = 0; k < 2; ++k) dst[n][k] = *(const PG8_LAS bf16x8*)(lds + PG8_SB(b, h) + boff + n * 2048 + k * 1024); } while (0)
#define PG8_MMA(ai, bj, At, Bt) do { __builtin_amdgcn_s_setprio(1); _Pragma("unroll") for (int m = 0; m < 4; ++m) _Pragma("unroll") for (int n = 0; n < 2; ++n) _Pragma("unroll") for (int k = 0; k < 2; ++k) \
        acc[ai][bj][m][n] = __builtin_amdgcn_mfma_f32_16x16x32_bf16(Bt[n][k], At[m][k], acc[ai][bj][m][n], 0, 0, 0); __builtin_amdgcn_s_setprio(0); } while (0)
#define PG8_WAIT_V(n) asm volatile("s_waitcnt vmcnt(" #n ")" ::: "memory")
#define PG8_WAIT_L(n) asm volatile("s_waitcnt lgkmcnt(" #n ")" ::: "memory")
#define PG8_BAR __builtin_amdgcn_s_barrier()
#define PG8_SCHED __builtin_amdgcn_sched_barrier(0)
    Unit cur, nxt; int ui = 0;
    if (!S.next(0, cur)) return;
    f32x4 acc[2][2][4][2];
#pragma unroll
    for (int a = 0; a < 2; ++a)
#pragma unroll
        for (int b = 0; b < 2; ++b)
#pragma unroll
            for (int m = 0; m < 4; ++m)
#pragma unroll
                for (int n = 0; n < 2; ++n) acc[a][b][m][n] = (f32x4){0.f, 0.f, 0.f, 0.f};
    bf16x8 At[4][2], B0[2][2], B1[2][2];
    const char* cA = (const char*)g.A + (size_t)cur.pm * tstepA; const char* cB = (const char*)g.Bt + (size_t)cur.pn * tstepB;
    S.a_ready(cur);
    if constexpr (SP2) {
        PG8_STAGE(PG8_SB(0, 0), cB, voffB); PG8_STAGE(PG8_SB(0, 1), cB + hstepB, voffB); PG8_STAGE(PG8_SA(0, 0), cA, voffA); PG8_STAGE(PG8_SA(0, 1), cA + hstepA, voffA);
        if (wr == 1) PG8_BAR;
        PG8_WAIT_V(2); PG8_BAR;
        PG8_STAGE(PG8_SB(1, 0), cB + kstep, voffB); PG8_STAGE(PG8_SA(1, 0), cA + kstep, voffA); PG8_STAGE(PG8_SB(1, 1), cB + hstepB + kstep, voffB);
        PG8_WAIT_V(6); PG8_BAR;
    } else {
        PG8_STAGE(PG8_SB(0, 0), cB, voffB); PG8_STAGE(PG8_SA(0, 0), cA, voffA); PG8_STAGE(PG8_SB(0, 1), cB + hstepB, voffB); PG8_STAGE(PG8_SA(0, 1), cA + hstepA, voffA);
        if (wr == 1) PG8_BAR;
        PG8_WAIT_V(4); PG8_BAR;
        PG8_STAGE(PG8_SB(1, 0), cB + kstep, voffB); PG8_STAGE(PG8_SA(1, 0), cA + kstep, voffA); PG8_STAGE(PG8_SB(1, 1), cB + hstepB + kstep, voffB);
        PG8_WAIT_V(6); PG8_BAR;
    }
    for (;;) {
        const bool has_next = S.next(ui + 1, nxt);
        const char* nA = has_next ? (const char*)g.A + (size_t)nxt.pm * tstepA : cA; const char* nB = has_next ? (const char*)g.Bt + (size_t)nxt.pn * tstepB : cB;
        for (int t = 0; t < nt; t += 2) {
            const bool last = (t == nt - 2);
            const char* a1 = cA + (size_t)(t + 1) * kstep;
            const char* a2 = last ? nA : cA + (size_t)(t + 2) * kstep; const char* b2 = last ? nB : cB + (size_t)(t + 2) * kstep;
            const char* a3 = a2 + kstep; const char* b3 = b2 + kstep;
            if (last && has_next) S.a_ready(nxt);
            if constexpr (SP2) {
            PG8_LDB(B0, 0, 0); PG8_LDB(B1, 0, 1); PG8_SCHED; PG8_LDA(At, 0, 0); PG8_STAGE(PG8_SA(1, 1), a1 + hstepA, voffA);
            PG8_WAIT_V(8); PG8_WAIT_L(0); PG8_BAR; PG8_MMA(0, 0, At, B0); PG8_MMA(0, 1, At, B1); PG8_BAR; PG8_SCHED;
            PG8_LDA(At, 0, 1); PG8_STAGE(PG8_SB(0, 0), b2, voffB); PG8_STAGE(PG8_SB(0, 1), b2 + hstepB, voffB); PG8_STAGE(PG8_SA(0, 0), a2, voffA);
            PG8_WAIT_V(8); PG8_WAIT_L(0); PG8_BAR; PG8_MMA(1, 0, At, B0); PG8_MMA(1, 1, At, B1); PG8_BAR; PG8_SCHED;
            PG8_LDB(B0, 1, 0); PG8_LDB(B1, 1, 1); PG8_SCHED; PG8_LDA(At, 1, 0); PG8_STAGE(PG8_SA(0, 1), a2 + hstepA, voffA);
            PG8_WAIT_V(8); PG8_WAIT_L(0); PG8_BAR; PG8_MMA(0, 0, At, B0); PG8_MMA(0, 1, At, B1); PG8_BAR; PG8_SCHED;
            PG8_LDA(At, 1, 1); PG8_STAGE(PG8_SB(1, 0), b3, voffB); PG8_STAGE(PG8_SB(1, 1), b3 + hstepB, voffB); PG8_STAGE(PG8_SA(1, 0), a3, voffA);
            PG8_WAIT_V(8); PG8_WAIT_L(0); PG8_BAR; PG8_MMA(1, 0, At, B0); PG8_MMA(1, 1, At, B1); PG8_BAR; PG8_SCHED;
            } else {
            PG8_LDB(B0, 0, 0); PG8_SCHED; PG8_LDA(At, 0, 0); PG8_STAGE(PG8_SA(1, 1), a1 + hstepA, voffA);
            PG8_WAIT_L(8); PG8_BAR; PG8_WAIT_L(0); PG8_MMA(0, 0, At, B0); PG8_BAR; PG8_SCHED;
            PG8_LDB(B1, 0, 1); PG8_STAGE(PG8_SB(0, 0), b2, voffB);
            PG8_BAR; PG8_WAIT_L(0); PG8_MMA(0, 1, At, B1); PG8_BAR;
            PG8_LDA(At, 0, 1); PG8_STAGE(PG8_SA(0, 0), a2, voffA);
            PG8_BAR; PG8_WAIT_L(0); PG8_MMA(1, 0, At, B0); PG8_BAR; PG8_SCHED;
            PG8_STAGE(PG8_SB(0, 1), b2 + hstepB, voffB);
            PG8_WAIT_V(6); PG8_BAR; PG8_MMA(1, 1, At, B1); PG8_BAR;
            PG8_LDB(B0, 1, 0); PG8_SCHED; PG8_LDA(At, 1, 0); PG8_STAGE(PG8_SA(0, 1), a2 + hstepA, voffA);
            PG8_WAIT_L(8); PG8_BAR; PG8_WAIT_L(0); PG8_MMA(0, 0, At, B0); PG8_BAR; PG8_SCHED;
            PG8_LDB(B1, 1, 1); PG8_STAGE(PG8_SB(1, 0), b3, voffB);
            PG8_BAR; PG8_WAIT_L(0); PG8_MMA(0, 1, At, B1); PG8_BAR;
            PG8_LDA(At, 1, 1); PG8_STAGE(PG8_SA(1, 0), a3, voffA);
            PG8_BAR; PG8_WAIT_L(0); PG8_MMA(1, 0, At, B0); PG8_BAR; PG8_SCHED;
            PG8_STAGE(PG8_SB(1, 1), b3 + hstepB, voffB);
            PG8_WAIT_V(6); PG8_BAR; PG8_MMA(1, 1, At, B1); PG8_BAR;
            }
        }
        if constexpr (ALIGN_EPI) { if (wr == 0) PG8_BAR; }
        if constexpr (!Epi::AFTER_DRAIN) { E(acc, cur, wr, wc, fr, fq); S.done(cur); }
        if (!has_next) break;
#pragma unroll
        for (int a = 0; a < 2; ++a)
#pragma unroll
            for (int b = 0; b < 2; ++b)
#pragma unroll
                for (int m = 0; m < 4; ++m)
#pragma unroll
                    for (int n = 0; n < 2; ++n) acc[a][b][m][n] = (f32x4){0.f, 0.f, 0.f, 0.f};
        cur = nxt; cA = nA; cB = nB; ++ui;
        if constexpr (ALIGN_EPI) { if (wr == 1) PG8_BAR; }
    }
    PG8_WAIT_V(0);
    if constexpr (!ALIGN_EPI) { if (wr == 0) PG8_BAR; }
    PG8_BAR;
    if constexpr (Epi::AFTER_DRAIN) { E.fused(acc, cur, wr, wc, fr, fq, lds, wid, lane); S.done(cur); }
#undef PG8_SA
#undef PG8_SB
#undef PG8_STAGE
#undef PG8_LDA
#undef PG8_LDB
#undef PG8_MMA
#undef PG8_WAIT_V
#undef PG8_WAIT_L
#undef PG8_BAR
#undef PG8_SCHED
}
}
#undef PG8_LAS
#define XB_TMO      128
#define XB_XCNT(j)  (256  + 64 * (j))
#define XB_XSUB(j)  (1280 + 64 * (j))
#define XB_XGEN(j)  (2304 + 64 * (j))
#define XB_TOP      3328
#define XB_TOPGEN   3392
#define XCD_BAR_WORDS 3456
#define XB_SPIN_CAP (1u << 18)

__device__ __forceinline__ unsigned xb_ld(unsigned* p)              { return __hip_atomic_load(p, __ATOMIC_RELAXED, __HIP_MEMORY_SCOPE_AGENT); }
__device__ __forceinline__ unsigned xb_add(unsigned* p, unsigned v) { return __hip_atomic_fetch_add(p, v, __ATOMIC_RELAXED, __HIP_MEMORY_SCOPE_AGENT); }
__device__ __forceinline__ unsigned xb_xcc_id() { return (unsigned)__builtin_amdgcn_s_getreg((3 << 11) | 20) & 0xFu; }
#define XB_SPIN(cond, bar) do { unsigned _sp = 0; while (cond) { __builtin_amdgcn_s_sleep(1); \
    if ((++_sp & 255u) == 0u) { if (xb_ld(&(bar)[XB_TMO])) break; if (_sp > XB_SPIN_CAP) { atomicAdd(&(bar)[XB_TMO], 1u); break; } } } } while (0)

struct XcdBarrier {
    unsigned* bar; unsigned x;
    volatile LAS unsigned* st;
};

__device__ __forceinline__ XcdBarrier xcd_barrier_post(unsigned* bar, volatile LAS unsigned* st) {
    XcdBarrier b; b.bar = bar; b.x = xb_xcc_id(); b.st = st;
    if (threadIdx.x == 0) (void)xb_add(&bar[XB_XCNT(b.x)], 1u);
    return b;
}
__device__ __forceinline__ void xcd_barrier_complete(unsigned* bar, unsigned x, unsigned& nloc, unsigned& nx) {
    const unsigned G = gridDim.x * gridDim.y * gridDim.z;
    unsigned sum, cnt, mine, sp = 0u;
    for (;;) {
        sum = 0u; cnt = 0u; mine = 0u;
#pragma unroll
        for (unsigned j = 0; j < 16; ++j) { const unsigned c = xb_ld(&bar[XB_XCNT(j)]); sum += c; cnt += (c > 0u) ? 1u : 0u; mine = (j == x) ? c : mine; }
        if (sum == G) break;
        __builtin_amdgcn_s_sleep(1);
        if ((++sp & 255u) == 0u) { if (xb_ld(&bar[XB_TMO])) break; if (sp > XB_SPIN_CAP) { atomicAdd(&bar[XB_TMO], 1u); break; } }
    }
    nloc = mine > 0u ? mine : 1u; nx = cnt > 0u ? cnt : 1u;
}

__device__ __forceinline__ void xcd_barrier(const XcdBarrier& b) {
    asm volatile("s_waitcnt vmcnt(0)" ::: "memory");
    __syncthreads();
    if (threadIdx.x == 0) {
        unsigned* bar = b.bar;
        __builtin_amdgcn_s_waitcnt(0);
        unsigned nloc = b.st[0], nx = b.st[1];
        if (nloc == 0u) { xcd_barrier_complete(bar, b.x, nloc, nx); b.st[0] = nloc; b.st[1] = nx; }
        const unsigned old = xb_add(&bar[XB_XSUB(b.x)], 1u);
        const unsigned gen = old / nloc;
        if (old + 1u == (gen + 1u) * nloc) {
            __builtin_amdgcn_fence(__ATOMIC_RELEASE, "agent");
            asm volatile("s_waitcnt vmcnt(0)" ::: "memory");
            const unsigned og = xb_add(&bar[XB_TOP], 1u);
            const unsigned tg = og / nx;
            if (og + 1u == (tg + 1u) * nx) xb_add(&bar[XB_TOPGEN], 1u);
            else XB_SPIN(xb_ld(&bar[XB_TOPGEN]) == tg, bar);
            __builtin_amdgcn_fence(__ATOMIC_ACQUIRE, "agent");
            xb_add(&bar[XB_XGEN(b.x)], 1u);
            asm volatile("s_waitcnt vmcnt(0)" ::: "memory");
        } else {
            XB_SPIN(xb_ld(&bar[XB_XGEN(b.x)]) == gen, bar);
            __builtin_amdgcn_fence(__ATOMIC_ACQUIRE, "agent");
            asm volatile("s_waitcnt vmcnt(0)" ::: "memory");
        }
    }
    __syncthreads();
}

constexpr int SEQ = 16384, DM = 1024, N1 = 4352  , NWAVES = 8;
constexpr float EPS = 1e-6f, QSCALE = 0.125f * LOG2E;
constexpr size_t MiB = 1u << 20;
constexpr size_t WS_CTL = 0, CTL_ZERO_BYTES = 1 * MiB;
constexpr size_t WS_WIN = 1 * MiB, WS_WUPA = 10 * MiB, WS_WUPB = 11 * MiB, WS_WO2 = 12 * MiB, WS_WQ = 16 * MiB, WS_WPG = 20 * MiB, WS_WPLE = 22 * MiB, WS_W1KV = 23 * MiB;
constexpr size_t WS_SMALL = 25 * MiB, WS_W2KT = WS_SMALL, WS_W2VT = WS_SMALL + 32768, WS_K1B = WS_SMALL + 65536, WS_K2B = WS_SMALL + 98304, WS_POSB = WS_SMALL + 131072,
                 WS_RS0 = WS_SMALL + 262144, WS_RS2 = WS_SMALL + 393216, WS_POSBP = WS_SMALL + 147456  ;
constexpr size_t WS_SSQ1 = 26 * MiB, WS_BG = 27 * MiB, WS_KC = 28 * MiB + 512 * 1024, WS_VCT = WS_KC + 262144, WS_H = 29 * MiB;
constexpr size_t WS_XB = 32 * MiB, WS_MG = 64 * MiB, WS_QA = 128 * MiB, WS_QB = 144 * MiB;
constexpr size_t WS_KA = 160 * MiB, WS_VTA = 164 * MiB, WS_CK = 168 * MiB, WS_KS = 176 * MiB, WS_VTS = 180 * MiB, WS_KW = 184 * MiB, WS_VTW = 188 * MiB;
constexpr size_t WS_OW = 192 * MiB, WS_PW = 208 * MiB, WS_PB = 240 * MiB;
constexpr size_t WS_OA = WS_QA, WS_OB = WS_QB;
constexpr size_t WS_U8 = 32 * MiB, WS_V8 = 48 * MiB, WS_XB2 = 128 * MiB, WS_Q2 = 64 * MiB;
constexpr size_t WS_END = 256 * MiB;
constexpr int CW_TMO = 0, CW_BAR = 4096, CW_QUEUE = 32768;
constexpr int LDS_BYTES = 147456, LDSCTL_OFF = 143360;
constexpr int KROW = 144, VROW = 136;
constexpr int AT_K0 = 0, AT_KSZ = 64 * KROW, AT_V0 = 2 * AT_KSZ, AT_VSZ = 64 * VROW, AT_LUT = 36864, LUTS = 136, AT_IMP = 46080, AT_SEL = 112640;
constexpr int SQ_OFF = 0, SO_OFF = AT_IMP, SO_ROW = 65, SM_OFF = 114688, SL_OFF = 115712, SS_OFF = 116736, SC_OFF = 117248;
constexpr int PK_ROW = 272, PK1_OFF = 0, PK2_OFF = 128 * PK_ROW, PW_OFF = 2 * 128 * PK_ROW, PW_BYTES = 8192;
static_assert(AT_V0 + 2 * AT_VSZ <= AT_LUT && AT_LUT + 16 * LUTS * 4 <= AT_IMP && AT_IMP + 65536 <= AT_SEL && SO_OFF + 256 * SO_ROW * 4 <= AT_SEL && AT_SEL + 2048 <= SM_OFF && 256 * KROW <= AT_LUT && SC_OFF + 64 <= LDSCTL_OFF && PW_OFF + 8 * PW_BYTES <= LDSCTL_OFF, "LDS map");

__device__ const unsigned char BKT[129] = {0,1,2,3,4,5,6,7,8,9,10,11,12,13,14,15,16,16,16,17,17,18,18,18,19,19,19,20,20,20,20,21,21,21,21,22,22,22,22,22,23,23,23,23,23,23,24,24,24,24,24,24,
    25,25,25,25,25,25,25,26,26,26,26,26,26,26,26,27,27,27,27,27,27,27,27,27,27,28,28,28,28,28,28,28,28,28,28,29,29,29,29,29,29,29,29,29,29,29,29,30,30,30,30,30,30,30,30,30,30,30,30,30,30,
    31,31,31,31,31,31,31,31,31,31,31,31,31,31,31,31};

struct Args { const float* in[24]; float* out; unsigned char* ws; int ph_lo, ph_hi, li, pad; };
struct Frame {
    LAS unsigned char* lds; volatile LAS unsigned* MISC; gu32* ctl; unsigned char* ws;
    int tid, lane, wave, vcu, G;
    float* out;
};
constexpr int INTAB_OFF = LDSCTL_OFF + 256;
__device__ __forceinline__ const float* in_ptr(const Frame& F, int k) {
    const unsigned long long v = ((const LAS unsigned long long*)(F.lds + INTAB_OFF))[k];
    const unsigned lo = __builtin_amdgcn_readfirstlane((unsigned)v), hi = __builtin_amdgcn_readfirstlane((unsigned)(v >> 32));
    return (const float*)(((unsigned long long)hi << 32) | lo);
}
template <int CTRL> __device__ __forceinline__ float dpp_f(float v) { return __uint_as_float((unsigned)__builtin_amdgcn_update_dpp(0, (int)__float_as_uint(v), CTRL, 0xf, 0xf, true)); }
template <int CTRL> __device__ __forceinline__ unsigned dpp_u(unsigned v) { return (unsigned)__builtin_amdgcn_update_dpp(0, (int)v, CTRL, 0xf, 0xf, true); }
__device__ __forceinline__ float wave_sum(float v) {
#pragma unroll
    for (int o = 1; o < 64; o <<= 1) v += __shfl_xor(v, o);
    return v;
}
__device__ __forceinline__ float quad_sum(float v) { v += dpp_f<0xB1>(v); v += dpp_f<0x4E>(v); return v; }
__device__ __forceinline__ unsigned umax_(unsigned a, unsigned b) { return a > b ? a : b; }
__device__ __forceinline__ unsigned wave_max_u32(unsigned v) {
    v = umax_(v, dpp_u<0xB1>(v)); v = umax_(v, dpp_u<0x4E>(v)); v = umax_(v, dpp_u<0x141>(v)); v = umax_(v, dpp_u<0x140>(v));
    const unsigned a = __builtin_amdgcn_readlane(v, 0), b = __builtin_amdgcn_readlane(v, 16), c = __builtin_amdgcn_readlane(v, 32), d = __builtin_amdgcn_readlane(v, 48);
    return umax_(umax_(a, b), umax_(c, d));
}
__device__ __forceinline__ float pair_max(float v) { auto rr = __builtin_amdgcn_permlane32_swap(__float_as_uint(v), __float_as_uint(v), false, false); return fmaxf(__uint_as_float(rr[0]), __uint_as_float(rr[1])); }
__device__ __forceinline__ float pair_sum(float v) { auto rr = __builtin_amdgcn_permlane32_swap(__float_as_uint(v), __float_as_uint(v), false, false); return __uint_as_float(rr[0]) + __uint_as_float(rr[1]); }
__device__ __forceinline__ unsigned pair_umax(unsigned v) { auto rr = __builtin_amdgcn_permlane32_swap(v, v, false, false); return umax_(rr[0], rr[1]); }
__device__ __forceinline__ unsigned ord_key(float v) { const unsigned u = __float_as_uint(v); return u ^ ((unsigned)((int)u >> 31) | 0x80000000u); }
__device__ __forceinline__ float ord_val(unsigned k) { const unsigned u = (k & 0x80000000u) ? (k ^ 0x80000000u) : ~k; return __uint_as_float(u); }
#define WG_BAR_LDS() do { asm volatile("s_waitcnt lgkmcnt(0)" ::: "memory"); __builtin_amdgcn_s_barrier(); asm volatile("" ::: "memory"); } while (0)
__device__ __forceinline__ u32x4 pack8(const f32x4& a, const f32x4& b) { u32x4 w; w.x = pkbf(a[0], a[1]); w.y = pkbf(a[2], a[3]); w.z = pkbf(b[0], b[1]); w.w = pkbf(b[2], b[3]); return w; }

typedef const f32x4 (&AccRef)[2][2][4][2];
struct Epi1 {
    static constexpr bool PERM = true, AFTER_DRAIN = false;
    const float* rs0; unsigned char* ws;
    __device__ __forceinline__ void operator()(AccRef acc, const pg8::Unit& u, int wr, int wc, int fr, int fq) const {
        asm volatile("" : "+v"(fr), "+v"(fq) :: "memory");
        const int row0 = u.pm * 256 + wr * 64 + fr, pn = u.pn, cl = wc * 32 + 8 * fq;
        float rsv[2][4];
#pragma unroll
        for (int ai = 0; ai < 2; ++ai)
#pragma unroll
            for (int m = 0; m < 4; ++m) rsv[ai][m] = rs0[row0 + ai * 128 + m * 16];
#pragma unroll
        for (int ai = 0; ai < 2; ++ai)
#pragma unroll
            for (int m = 0; m < 4; ++m) asm volatile("" : "+v"(rsv[ai][m]));
        if (pn < 4) {
            bf16* Q = (bf16*)(ws + (pn < 2 ? WS_QA : WS_QB)) + (pn & 1) * 256 + cl;
#pragma unroll
            for (int ai = 0; ai < 2; ++ai)
#pragma unroll
                for (int m = 0; m < 4; ++m) { const int row = row0 + ai * 128 + m * 16; const float s = rsv[ai][m] * QSCALE;
#pragma unroll
                    for (int bj = 0; bj < 2; ++bj) *(u32x4*)(Q + (size_t)row * 512 + bj * 128) = pack8(acc[ai][bj][m][0] * s, acc[ai][bj][m][1] * s); }
        } else if (pn < 8) {
            const int g = wc >> 1, dl = cl & 63;
            const size_t koff = pn == 4 ? WS_KA : pn == 5 ? WS_CK : pn == 6 ? WS_KS : WS_KW;
            const size_t voff = pn == 4 ? WS_VTA : pn == 5 ? WS_CK + (size_t)2 * SEQ * 64 * 2 : pn == 6 ? WS_VTS : WS_VTW;
            bf16* Kd = (bf16*)(ws + koff) + (size_t)g * SEQ * 64 + dl;
            bf16* Vd = (bf16*)(ws + voff);
#pragma unroll
            for (int ai = 0; ai < 2; ++ai)
#pragma unroll
                for (int m = 0; m < 4; ++m) { const int row = row0 + ai * 128 + m * 16; const float s = rsv[ai][m];
                    const u32x4 kq = pack8(acc[ai][0][m][0] * s, acc[ai][0][m][1] * s);
                    const u32x4 v = pack8(acc[ai][1][m][0] * s, acc[ai][1][m][1] * s);
                    if (pn == 6) {
                        const int key = row & 63, jb = row >> 6;
                        bf16* kt_ = (bf16*)(ws + WS_KS) + ((size_t)g * 256 + jb) * 4096 + (size_t)((((key >> 5) * 4 + (dl >> 4)) * 64 + ((dl >> 3) & 1) * 32 + (key & 31)) * 8);
                        *(u32x4*)kt_ = kq;
                        const int sI = key >> 4, kk = key & 15, hI = (kk >> 2) & 1, eI = ((kk >> 3) << 2) + (kk & 3);
                        bf16* vt_ = (bf16*)(ws + WS_VTS) + ((size_t)g * 256 + jb) * 4096 + (size_t)(((((dl >> 5) * 4 + sI) * 64 + hI * 32 + (dl & 31)) * 8) + eI);
                        vt_[0] = (bf16)v.x; vt_[8] = (bf16)(v.x >> 16); vt_[16] = (bf16)v.y; vt_[24] = (bf16)(v.y >> 16); vt_[32] = (bf16)v.z; vt_[40] = (bf16)(v.z >> 16); vt_[48] = (bf16)v.w; vt_[56] = (bf16)(v.w >> 16);
                        continue; }
                    *(u32x4*)(Kd + (size_t)row * 64) = kq;
                    if (pn == 5) *(u32x4*)(Vd + ((size_t)g * SEQ + row) * 64 + dl) = v;
                    else { bf16* vt = Vd + (size_t)(g * 64 + dl) * SEQ + row;
                        vt[0 * (size_t)SEQ] = (bf16)v.x; vt[1 * (size_t)SEQ] = (bf16)(v.x >> 16); vt[2 * (size_t)SEQ] = (bf16)v.y; vt[3 * (size_t)SEQ] = (bf16)(v.y >> 16);
                        vt[4 * (size_t)SEQ] = (bf16)v.z; vt[5 * (size_t)SEQ] = (bf16)(v.z >> 16); vt[6 * (size_t)SEQ] = (bf16)v.w; vt[7 * (size_t)SEQ] = (bf16)(v.w >> 16); } }
        } else if (pn < 16) {
            bf16* MG = (bf16*)(ws + WS_MG) + (pn - 8) * 256 + cl;
#pragma unroll
            for (int ai = 0; ai < 2; ++ai)
#pragma unroll
                for (int m = 0; m < 4; ++m) { const int row = row0 + ai * 128 + m * 16; const float s = rsv[ai][m];
#pragma unroll
                    for (int bj = 0; bj < 2; ++bj) { f32x4 a = acc[ai][bj][m][0] * s, b = acc[ai][bj][m][1] * s;
#pragma unroll
                        for (int e = 0; e < 4; ++e) { a[e] = sigmoidf_(a[e]); b[e] = sigmoidf_(b[e]); }
                        *(u32x4*)(MG + (size_t)row * 2048 + bj * 128) = pack8(a, b); } }
        } else {
            if (wc == 0 && fq < 3) { float* BG = (float*)(ws + WS_BG) + 8 * fq;
#pragma unroll
                for (int ai = 0; ai < 2; ++ai)
#pragma unroll
                    for (int m = 0; m < 4; ++m) { const int row = row0 + ai * 128 + m * 16; const float s = rsv[ai][m]; f32x4 a = acc[ai][0][m][0] * s, b = acc[ai][0][m][1] * s;
#pragma unroll
                        for (int e = 0; e < 4; ++e) { a[e] = sigmoidf_(a[e]); b[e] = sigmoidf_(b[e]); }
                        *(f32x4*)(BG + (size_t)row * 24) = a; *(f32x4*)(BG + (size_t)row * 24 + 4) = b; } }
        }
    }
};
struct EpiNull {
    static constexpr bool PERM = true, AFTER_DRAIN = false;
    __device__ __forceinline__ void operator()(AccRef acc, const pg8::Unit& u, int wr, int wc, int fr, int fq) const {
        asm volatile("" : "+v"(fr), "+v"(fq) :: "memory");
#pragma unroll
        for (int ai = 0; ai < 2; ++ai)
#pragma unroll
            for (int bj = 0; bj < 2; ++bj)
#pragma unroll
                for (int m = 0; m < 4; ++m)
#pragma unroll
                    for (int n = 0; n < 2; ++n) asm volatile("" :: "v"(acc[ai][bj][m][n]));
    }
};
struct EpiUp {
    static constexpr bool PERM = true, AFTER_DRAIN = false;
    bf16* MG; int coloff; bf16* DST;
    __device__ __forceinline__ void operator()(AccRef acc, const pg8::Unit& u, int wr, int wc, int fr, int fq) const {
        asm volatile("" : "+v"(fr), "+v"(fq) :: "memory");
        const int row0 = u.pm * 256 + wr * 64 + fr; bf16* base = MG + coloff + u.pn * 256 + wc * 32 + 8 * fq; bf16* dbase = DST + coloff + u.pn * 256 + wc * 32 + 8 * fq;
        u32x4 gt[2][4][2];
#pragma unroll
        for (int m = 0; m < 4; ++m)
#pragma unroll
            for (int bj = 0; bj < 2; ++bj) gt[0][m][bj] = *(const u32x4*)(base + (size_t)(row0 + m * 16) * 2048 + bj * 128);
#pragma unroll
        for (int ai = 0; ai < 2; ++ai) {
            if (ai == 0) {
#pragma unroll
                for (int m = 0; m < 4; ++m)
#pragma unroll
                    for (int bj = 0; bj < 2; ++bj) gt[1][m][bj] = *(const u32x4*)(base + (size_t)(row0 + 128 + m * 16) * 2048 + bj * 128);
            }
#pragma unroll
            for (int m = 0; m < 4; ++m) { bf16* rp = dbase + (size_t)(row0 + ai * 128 + m * 16) * 2048;
#pragma unroll
                for (int bj = 0; bj < 2; ++bj) { const u32x4 g = gt[ai][m][bj]; const f32x4 a = acc[ai][bj][m][0], b = acc[ai][bj][m][1]; u32x4 w;
                    w.x = pkbf(bf_lo(g.x) * a[0], bf_hi(g.x) * a[1]); w.y = pkbf(bf_lo(g.y) * a[2], bf_hi(g.y) * a[3]);
                    w.z = pkbf(bf_lo(g.z) * b[0], bf_hi(g.z) * b[1]); w.w = pkbf(bf_lo(g.w) * b[2], bf_hi(g.w) * b[3]);
                    *(u32x4*)(rp + bj * 128) = w; } }
        }
    }
};
struct EpiUp2 {
    static constexpr bool PERM = true, AFTER_DRAIN = false;
    bf16* MG; bf16* DST;
    __device__ __forceinline__ void operator()(AccRef acc, const pg8::Unit& u, int wr, int wc, int fr, int fq) const {
        asm volatile("" : "+v"(fr), "+v"(fq) :: "memory");
        const int row0 = u.pm * 256 + wr * 64 + fr; bf16* base = MG + u.pn * 256 + wc * 32 + 8 * fq; bf16* dbase = DST + u.pn * 256 + wc * 32 + 8 * fq;
        u32x4 tv[2][2][2], gv[2][2][2];
#define UP2_LOAD(par, bt) _Pragma("unroll") for (int mm = 0; mm < 2; ++mm) _Pragma("unroll") for (int bj = 0; bj < 2; ++bj) { \
            const bf16* p = base + (size_t)(row0 + ((bt) >> 1) * 128 + (((bt) & 1) * 2 + mm) * 16) * 2048 + bj * 128; tv[par][mm][bj] = *(const u32x4*)p; gv[par][mm][bj] = *(const u32x4*)(p + 1024); }
        UP2_LOAD(0, 0);
#pragma unroll
        for (int bt = 0; bt < 4; ++bt) {
            if (bt == 0) { UP2_LOAD(1, 1); } else if (bt == 1) { UP2_LOAD(0, 2); } else if (bt == 2) { UP2_LOAD(1, 3); }
            const int ai = bt >> 1;
#pragma unroll
            for (int mm = 0; mm < 2; ++mm) { const int m = (bt & 1) * 2 + mm; bf16* rp = dbase + (size_t)(row0 + ai * 128 + m * 16) * 2048;
#pragma unroll
                for (int bj = 0; bj < 2; ++bj) { const u32x4 t = tv[bt & 1][mm][bj], g = gv[bt & 1][mm][bj]; const f32x4 a = acc[ai][bj][m][0], b = acc[ai][bj][m][1]; u32x4 w;
                    w.x = pkbf(bf_lo(t.x) + bf_lo(g.x) * a[0], bf_hi(t.x) + bf_hi(g.x) * a[1]); w.y = pkbf(bf_lo(t.y) + bf_lo(g.y) * a[2], bf_hi(t.y) + bf_hi(g.y) * a[3]);
                    w.z = pkbf(bf_lo(t.z) + bf_lo(g.z) * b[0], bf_hi(t.z) + bf_hi(g.z) * b[1]); w.w = pkbf(bf_lo(t.w) + bf_lo(g.w) * b[2], bf_hi(t.w) + bf_hi(g.w) * b[3]);
                    *(u32x4*)(rp + bj * 128) = w; } }
        }
#undef UP2_LOAD
    }
};
struct EpiWo {
    static constexpr bool PERM = true, AFTER_DRAIN = false;
    const float* x; float* out; bf16* xb; float* ssq;
    __device__ __forceinline__ void operator()(AccRef acc, const pg8::Unit& u, int wr, int wc, int fr, int fq) const {
        asm volatile("" : "+v"(fr), "+v"(fq) :: "memory");
        const int row0 = u.pm * 256 + wr * 64 + fr, c0 = u.pn * 256 + wc * 32 + 8 * fq;
        f32x4 xv[2][2][2][2];
#define WO_LOAD(par, bt) _Pragma("unroll") for (int mm = 0; mm < 2; ++mm) _Pragma("unroll") for (int bj = 0; bj < 2; ++bj) { \
            const size_t o = (size_t)(row0 + ((bt) >> 1) * 128 + (((bt) & 1) * 2 + mm) * 16) * DM + c0 + bj * 128; xv[par][mm][bj][0] = *(const f32x4*)(x + o); xv[par][mm][bj][1] = *(const f32x4*)(x + o + 4); }
        WO_LOAD(0, 0);
#pragma unroll
        for (int bt = 0; bt < 4; ++bt) {
            if (bt == 0) { WO_LOAD(1, 1); } else if (bt == 1) { WO_LOAD(0, 2); } else if (bt == 2) { WO_LOAD(1, 3); }
            const int ai = bt >> 1;
#pragma unroll
            for (int mm = 0; mm < 2; ++mm) { const int m = (bt & 1) * 2 + mm, row = row0 + ai * 128 + m * 16; float ss = 0.f;
#pragma unroll
                for (int bj = 0; bj < 2; ++bj) { const size_t o = (size_t)row * DM + c0 + bj * 128;
                    const f32x4 a = xv[bt & 1][mm][bj][0] + acc[ai][bj][m][0], b = xv[bt & 1][mm][bj][1] + acc[ai][bj][m][1];
                    *(f32x4*)(out + o) = a; *(f32x4*)(out + o + 4) = b; *(u32x4*)(xb + o) = pack8(a, b);
                    ss += (a[0] * a[0] + a[1] * a[1]) + (a[2] * a[2] + a[3] * a[3]) + (b[0] * b[0] + b[1] * b[1]) + (b[2] * b[2] + b[3] * b[3]); }
                ss += __shfl_xor(ss, 16); ss += __shfl_xor(ss, 32);
                if (fq == 0) ssq[(size_t)row * 16 + u.pn * 4 + wc] = ss; }
        }
#undef WO_LOAD
    }
};
__device__ __forceinline__ float rs_from_ssq(const float* ssq, int row) {
    const f32x4* p = (const f32x4*)(ssq + (size_t)row * 16); const f32x4 a = p[0], b = p[1], c = p[2], d = p[3];
    const float s = ((a[0] + a[1]) + (a[2] + a[3])) + ((b[0] + b[1]) + (b[2] + b[3])) + ((c[0] + c[1]) + (c[2] + c[3])) + ((d[0] + d[1]) + (d[2] + d[3]));
    return __builtin_amdgcn_rsqf(s * (1.0f / DM) + EPS);
}
struct EpiPw {
    static constexpr bool PERM = true, AFTER_DRAIN = false;
    bf16* O; int ldc;
    __device__ __forceinline__ void operator()(AccRef acc, const pg8::Unit& u, int wr, int wc, int fr, int fq) const {
        asm volatile("" : "+v"(fr), "+v"(fq) :: "memory");
        const int row0 = u.pm * 256 + wr * 64 + fr; bf16* base = O + u.pn * 256 + wc * 32 + 8 * fq;
#pragma unroll
        for (int ai = 0; ai < 2; ++ai)
#pragma unroll
            for (int m = 0; m < 4; ++m)
#pragma unroll
                for (int bj = 0; bj < 2; ++bj) *(u32x4*)(base + (size_t)(row0 + ai * 128 + m * 16) * ldc + bj * 128) = pack8(acc[ai][bj][m][0], acc[ai][bj][m][1]);
    }
};
struct EpiPle {
    static constexpr bool PERM = true, AFTER_DRAIN = false;
    const float* rs2; const bf16* pw; float* out; float* dst;
    __device__ __forceinline__ void operator()(AccRef acc, const pg8::Unit& u, int wr, int wc, int fr, int fq) const {
        asm volatile("" : "+v"(fr), "+v"(fq) :: "memory");
        const int row0 = u.pm * 256 + wr * 64 + fr, c0 = u.pn * 256 + wc * 32 + 8 * fq;
        float rsv[2][4];
#pragma unroll
        for (int ai = 0; ai < 2; ++ai)
#pragma unroll
            for (int m = 0; m < 4; ++m) rsv[ai][m] = rs2[row0 + ai * 128 + m * 16];
#pragma unroll
        for (int ai = 0; ai < 2; ++ai)
#pragma unroll
            for (int m = 0; m < 4; ++m) asm volatile("" : "+v"(rsv[ai][m]));
        f32x4 xv[2][2][2]; u32x4 pv[2][2];
#define PLE_LOAD(par, bt) _Pragma("unroll") for (int bj = 0; bj < 2; ++bj) { \
            const size_t o = (size_t)(row0 + ((bt) >> 2) * 128 + ((bt) & 3) * 16) * DM + c0 + bj * 128; xv[par][bj][0] = *(const f32x4*)(out + o); xv[par][bj][1] = *(const f32x4*)(out + o + 4); pv[par][bj] = *(const u32x4*)(pw + o); }
        PLE_LOAD(0, 0);
#pragma unroll
        for (int bt = 0; bt < 8; ++bt) {
            if (bt < 7) { if ((bt & 1) == 0) { PLE_LOAD(1, bt + 1); } else { PLE_LOAD(0, bt + 1); } }
            const int ai = bt >> 2, m = bt & 3, row = row0 + ai * 128 + m * 16; const float s = rsv[ai][m];
#pragma unroll
            for (int bj = 0; bj < 2; ++bj) { const size_t o = (size_t)row * DM + c0 + bj * 128; const u32x4 p = pv[bt & 1][bj];
                f32x4 a = xv[bt & 1][bj][0], b = xv[bt & 1][bj][1]; const f32x4 ga = acc[ai][bj][m][0] * s, gb = acc[ai][bj][m][1] * s;
                a[0] += sigmoidf_(ga[0]) * bf_lo(p.x); a[1] += sigmoidf_(ga[1]) * bf_hi(p.x); a[2] += sigmoidf_(ga[2]) * bf_lo(p.y); a[3] += sigmoidf_(ga[3]) * bf_hi(p.y);
                b[0] += sigmoidf_(gb[0]) * bf_lo(p.z); b[1] += sigmoidf_(gb[1]) * bf_hi(p.z); b[2] += sigmoidf_(gb[2]) * bf_lo(p.w); b[3] += sigmoidf_(gb[3]) * bf_hi(p.w);
                *(f32x4*)(dst + o) = a; *(f32x4*)(dst + o + 4) = b; }
        }
#undef PLE_LOAD
    }
};
struct EpiCmp {
    static constexpr bool PERM = true, AFTER_DRAIN = false;
    bf16* H; const float* posb;
    __device__ __forceinline__ void operator()(AccRef acc, const pg8::Unit& u, int wr, int wc, int fr, int fq) const {
        asm volatile("" : "+v"(fr), "+v"(fq) :: "memory");
        const int row0 = u.pm * 256 + wr * 64 + fr, cl = wc * 32 + 8 * fq;
#pragma unroll
        for (int bj = 0; bj < 2; ++bj) { const f32x4 pa = *(const f32x4*)(posb + u.pn * 256 + bj * 128 + cl), pb = *(const f32x4*)(posb + u.pn * 256 + bj * 128 + cl + 4);
#pragma unroll
            for (int ai = 0; ai < 2; ++ai)
#pragma unroll
                for (int m = 0; m < 4; ++m) { f32x4 a = acc[ai][bj][m][0] + pa, b = acc[ai][bj][m][1] + pb;
#pragma unroll
                    for (int e = 0; e < 4; ++e) { a[e] = gelu_tanh(a[e]); b[e] = gelu_tanh(b[e]); }
                    *(u32x4*)(H + (size_t)(row0 + ai * 128 + m * 16) * 256 + bj * 128 + cl) = pack8(a, b); } }
    }
};

__device__ __forceinline__ void tr_item(const float* W, int Nsrc, int k0, int srcc0, int nvalid, bf16* WT, int ldk, int drow0, int dk0, const float* g, LAS float* scr, int lane) {
#pragma unroll 8
    for (int i = 0; i < 32; ++i) { const int kk = 2 * i + (lane >> 5), n = lane & 31; float v = 0.f;
        if (n < nvalid) { v = W[(size_t)(k0 + kk) * Nsrc + srcc0 + n]; if (g) v *= g[k0 + kk]; }
        scr[kk * 33 + n] = v; }
    LDS_WAIT(); asm volatile("" ::: "memory");
    const int c = lane & 7;
#pragma unroll
    for (int j = 0; j < 4; ++j) { const int n = (lane >> 3) + 8 * j; const LAS float* s = scr + (8 * c) * 33 + n;
        u32x4 o; o.x = pkbf(s[0 * 33], s[1 * 33]); o.y = pkbf(s[2 * 33], s[3 * 33]); o.z = pkbf(s[4 * 33], s[5 * 33]); o.w = pkbf(s[6 * 33], s[7 * 33]);
        *(u32x4*)(WT + (size_t)(drow0 + n) * ldk + dk0 + k0 + 8 * c) = o; }
    LDS_WAIT(); asm volatile("" ::: "memory");
}
__device__ __forceinline__ void weight_items(Frame& F, int part, int gw, int NGW) {
    LAS float* scr = (LAS float*)(F.lds + F.wave * 8448); const int lane = F.lane; unsigned char* ws = F.ws;
    constexpr int I_IN = 16 * 136, I_UP = 8 * 32, I_O = 16 * 32, I_Q = 16 * 64, I_PG = 16 * 32, I_PLE = 4 * 32, I_W1 = 32 * 8, I_W2 = 4 * 2;
    if (part == 0) {
        constexpr int NITEMS = I_IN + I_PLE + 2 * I_W1 + 2 * I_W2;
        for (int it = gw; it < NITEMS; it += NGW) {
            int r = it;
            if (r < I_IN) { const int kb = r / 136, nb = r % 136, n = nb * 32; int src, nv = 32;
                if (n < 512) src = n; else if (n < 1024) src = n + 256; else if (n < 1280) src = n - 512; else if (n < 2048) src = n; else if (n < 4096) src = n + 24;
                else if (n == 4096) { src = 2048; nv = 24; } else { src = 0; nv = 0; }
                tr_item(in_ptr(F, 3), 4120, kb * 64, src, nv, (bf16*)(ws + WS_WIN), 1024, n, 0, in_ptr(F, 2), scr, lane); continue; } r -= I_IN;
            if (r < I_PLE) { tr_item(in_ptr(F, 22), 1024, (r / 32) * 64, (r % 32) * 32, 32, (bf16*)(ws + WS_WPLE), 256, (r % 32) * 32, 0, nullptr, scr, lane); continue; } r -= I_PLE;
            if (r < I_W1) { tr_item(in_ptr(F, 7), 256, (r / 8) * 64, (r % 8) * 32, 32, (bf16*)(ws + WS_W1KV), 2048, (r % 8) * 32, 0, nullptr, scr, lane); continue; } r -= I_W1;
            if (r < I_W1) { tr_item(in_ptr(F, 9), 256, (r / 8) * 64, (r % 8) * 32, 32, (bf16*)(ws + WS_W1KV), 2048, 256 + (r % 8) * 32, 0, nullptr, scr, lane); continue; } r -= I_W1;
            if (r < I_W2) { tr_item(in_ptr(F, 8), 64, (r / 2) * 64, (r % 2) * 32, 32, (bf16*)(ws + WS_W2KT), 256, (r % 2) * 32, 0, nullptr, scr, lane); continue; } r -= I_W2;
            tr_item(in_ptr(F, 10), 64, (r / 2) * 64, (r % 2) * 32, 32, (bf16*)(ws + WS_W2VT), 256, (r % 2) * 32, 0, nullptr, scr, lane);
        }
    } else {
        constexpr int NITEMS = 2 * I_UP + I_O + I_Q + I_PG;
        for (int it = gw; it < NITEMS; it += NGW) {
            int r = it;
            if (r < I_UP) { tr_item(in_ptr(F, 11), 1024, (r / 32) * 64, (r % 32) * 32, 32, (bf16*)(ws + WS_WUPA), 512, (r % 32) * 32, 0, nullptr, scr, lane); continue; } r -= I_UP;
            if (r < I_UP) { tr_item(in_ptr(F, 12), 1024, (r / 32) * 64, (r % 32) * 32, 32, (bf16*)(ws + WS_WUPB), 512, (r % 32) * 32, 0, nullptr, scr, lane); continue; } r -= I_UP;
            if (r < I_O) { tr_item(in_ptr(F, 13), 1024, (r / 32) * 64, (r % 32) * 32, 32, (bf16*)(ws + WS_WO2), 1024, (r % 32) * 32, 0, nullptr, scr, lane); continue; } r -= I_O;
            if (r < I_Q) { tr_item(in_ptr(F, 15), 2048, (r / 64) * 64, (r % 64) * 32, 32, (bf16*)(ws + WS_WQ), 1024, (r % 64) * 32, 0, in_ptr(F, 14), scr, lane); continue; } r -= I_Q;
            tr_item(in_ptr(F, 21), 1024, (r / 32) * 64, (r % 32) * 32, 32, (bf16*)(ws + WS_WPG), 1024, (r % 32) * 32, 0, in_ptr(F, 20), scr, lane);
        }
    }
}
__device__ __forceinline__ void p0_prologue(Frame& F) {
    const int gw = F.vcu * NWAVES + F.wave, NGW = F.G * NWAVES, lane = F.lane;
    unsigned char* ws = F.ws;
    weight_items(F, 0, gw, NGW);
    { const float* x = in_ptr(F, 0); bf16* xb = (bf16*)(ws + WS_XB); float* rs0 = (float*)(ws + WS_RS0);
      f32x4 nx[4];
      if (gw < SEQ) {
#pragma unroll
          for (int j = 0; j < 4; ++j) nx[j] = ((const f32x4*)(x + (size_t)gw * DM) + lane)[64 * j]; }
      for (int row = gw; row < SEQ; row += NGW) {
          f32x4 v[4]; float ss = 0.f;
#pragma unroll
          for (int j = 0; j < 4; ++j) v[j] = nx[j];
          if (row + NGW < SEQ) {
#pragma unroll
              for (int j = 0; j < 4; ++j) nx[j] = ((const f32x4*)(x + (size_t)(row + NGW) * DM) + lane)[64 * j]; }
#pragma unroll
          for (int j = 0; j < 4; ++j) ss += (v[j][0] * v[j][0] + v[j][1] * v[j][1]) + (v[j][2] * v[j][2] + v[j][3] * v[j][3]);
          ss = wave_sum(ss);
          u32x2* o8 = (u32x2*)(xb + (size_t)row * DM) + lane;
#pragma unroll
          for (int j = 0; j < 4; ++j) { u32x2 w; w.x = pkbf(v[j][0], v[j][1]); w.y = pkbf(v[j][2], v[j][3]); o8[64 * j] = w; }
          if (lane == 0) rs0[row] = __builtin_amdgcn_rsqf(ss * (1.0f / DM) + EPS);
      } }
    { const int gt = gw * 64 + lane, NGT = NGW * 64;
      const float* p = in_ptr(F, 1); bf16* pb = (bf16*)(ws + WS_PB);
      for (int i = gt; i < SEQ * 256 / 8; i += NGT) { const f32x4 a = *(const f32x4*)(p + (size_t)i * 8), b = *(const f32x4*)(p + (size_t)i * 8 + 4); *(u32x4*)(pb + (size_t)i * 8) = pack8(a, b); }
      for (int i = gt; i < 2 * 16384 / 8; i += NGT) { const int which = i >= 2048, j = i & 2047; const float* k = in_ptr(F, 16 + which) + (size_t)j * 8;
          *(u32x4*)((bf16*)(ws + (which ? WS_K2B : WS_K1B)) + (size_t)j * 8) = pack8(*(const f32x4*)k, *(const f32x4*)(k + 4)); } }
    if (F.vcu < 64) { const int grp = F.vcu >> 3, ks = F.vcu & 7, kv = grp >> 2, n = (grp & 3) * 64 + lane; const float* w1 = in_ptr(F, kv ? 9 : 7); const float* pos = in_ptr(F, 6);
        const int kb = ks * 256 + F.wave * 32; float s = 0.f;
#pragma unroll 8
        for (int k = 0; k < 32; ++k) s += pos[kb + k] * w1[(size_t)(kb + k) * 256 + n];
        LAS float* red = (LAS float*)(F.lds + 8 * 8448);
        red[F.wave * 64 + lane] = s; __syncthreads();
        if (F.wave == 0) { float t = 0.f;
#pragma unroll
            for (int w = 0; w < 8; ++w) t += red[w * 64 + lane];
            ((float*)(ws + WS_POSBP))[ks * 512 + grp * 64 + lane] = t; }
    }
}
__device__ __forceinline__ void posb_finish(Frame& F) {
    int tid = F.tid; asm volatile("" : "+v"(tid));
    const float* part = (const float*)(F.ws + WS_POSBP); float t = 0.f;
#pragma unroll
    for (int s = 0; s < 8; ++s) t += part[s * 512 + tid];
    ((float*)(F.ws + WS_POSB))[tid] = t;
}

struct TileSrc { const bf16* K; const bf16* Vt; int vpitch; };
__device__ __forceinline__ void tile_load(const TileSrc& s, int key0, bool needV, int tid, u32x4& kr, u32x4& vr) {
    const int row = tid >> 3, ch = tid & 7;
    kr = *(const u32x4*)(s.K + (size_t)(key0 + row) * 64 + ch * 8);
    if (needV) vr = *(const u32x4*)(s.Vt + (size_t)row * s.vpitch + key0 + ch * 8);
}
__device__ __forceinline__ void tile_store(LAS unsigned char* L, int buf, bool needV, int tid, const u32x4& kr, const u32x4& vr) {
    const int row = tid >> 3, ch = tid & 7;
    *(LAS u32x4*)(L + AT_K0 + buf * AT_KSZ + row * KROW + ch * 16) = kr;
    if (needV) { LAS u32x2* p = (LAS u32x2*)(L + AT_V0 + buf * AT_VSZ + row * VROW + ch * 16); u32x2 a, b; a.x = vr.x; a.y = vr.y; b.x = vr.z; b.y = vr.w; p[0] = a; p[1] = b; }
}
__device__ __forceinline__ void qk_tile(LAS const unsigned char* Kb, const bf16x8 (&q)[4], int r32, int h, f32x16& s0, f32x16& s1) {
#pragma unroll
    for (int i = 0; i < 16; ++i) { s0[i] = 0.f; s1[i] = 0.f; }
#pragma unroll
    for (int ks = 0; ks < 4; ++ks) {
        const bf16x8 a0 = *(LAS const bf16x8*)(Kb + r32 * KROW + (16 * ks + 8 * h) * 2), a1 = *(LAS const bf16x8*)(Kb + (32 + r32) * KROW + (16 * ks + 8 * h) * 2);
        s0 = __builtin_amdgcn_mfma_f32_32x32x16_bf16(a0, q[ks], s0, 0, 0, 0); s1 = __builtin_amdgcn_mfma_f32_32x32x16_bf16(a1, q[ks], s1, 0, 0, 0);
    }
}
__device__ __forceinline__ bf16x8 pack_p(const f32x16& s, int o) {
    u32x4 w; w.x = pkbf(s[o + 0], s[o + 1]); w.y = pkbf(s[o + 2], s[o + 3]); w.z = pkbf(s[o + 4], s[o + 5]); w.w = pkbf(s[o + 6], s[o + 7]); return __builtin_bit_cast(bf16x8, w);
}
__device__ __forceinline__ void softmax_pv(LAS const unsigned char* Vb, f32x16& s0, f32x16& s1, f32x16 (&o)[2], float& m, float& l, int r32, int h) {
    float mx = fmaxf(s0[0], s1[0]);
#pragma unroll
    for (int i = 1; i < 16; ++i) mx = fmaxf(mx, fmaxf(s0[i], s1[i]));
    mx = pair_max(mx);
    const float mn = fmaxf(m, mx), alpha = fexp2(m - mn); const bool moved = __any(mx > m); m = mn;
    u32x2 va[4][2];
    LAS const unsigned char* vp0 = Vb + r32 * VROW + 8 * h;
#pragma unroll
    for (int s = 0; s < 4; ++s) { va[s][0] = *(LAS const u32x2*)(vp0 + 32 * s); va[s][1] = *(LAS const u32x2*)(vp0 + 32 * s + 16); }
    float sum = 0.f;
#pragma unroll
    for (int i = 0; i < 16; ++i) { s0[i] = fexp2(s0[i] - mn); s1[i] = fexp2(s1[i] - mn); sum += s0[i] + s1[i]; }
    sum = pair_sum(sum); l = l * alpha + sum;
    if (moved) {
#pragma unroll
        for (int i = 0; i < 16; ++i) { o[0][i] *= alpha; o[1][i] *= alpha; } }
    bf16x8 pf[4]; pf[0] = pack_p(s0, 0); pf[1] = pack_p(s0, 8); pf[2] = pack_p(s1, 0); pf[3] = pack_p(s1, 8);
    u32x2 vb[4][2];
    LAS const unsigned char* vp1 = vp0 + 32 * VROW;
#pragma unroll
    for (int s = 0; s < 4; ++s) { vb[s][0] = *(LAS const u32x2*)(vp1 + 32 * s); vb[s][1] = *(LAS const u32x2*)(vp1 + 32 * s + 16); }
#pragma unroll
    for (int s = 0; s < 4; ++s) { u32x4 a; a.x = va[s][0].x; a.y = va[s][0].y; a.z = va[s][1].x; a.w = va[s][1].y; o[0] = __builtin_amdgcn_mfma_f32_32x32x16_bf16(__builtin_bit_cast(bf16x8, a), pf[s], o[0], 0, 0, 0); }
#pragma unroll
    for (int s = 0; s < 4; ++s) { u32x4 a; a.x = vb[s][0].x; a.y = vb[s][0].y; a.z = vb[s][1].x; a.w = vb[s][1].y; o[1] = __builtin_amdgcn_mfma_f32_32x32x16_bf16(__builtin_bit_cast(bf16x8, a), pf[s], o[1], 0, 0, 0); }
}
#define KEYOFF(kt, i) (32 * (kt) + ((i) & 3) + 8 * ((i) >> 2))
#define NEG_INF (-__builtin_inff())

template <int W> struct FBand {
    int tq, tw, h; const LAS float* lut;
    __device__ __forceinline__ bool active(int tile) { const int key0 = tile * 64; return key0 <= tw + 7 && key0 + 63 >= tw - W + 1; }
    __device__ __forceinline__ void apply(f32x16& s0, f32x16& s1, int tile) {
        const int rel0 = tq - tile * 64 - 4 * h;
        if (tw - tile * 64 - 63 >= 128) { const float b = lut[128];
            if (tw + 7 - tile * 64 < W) {
#pragma unroll
                for (int i = 0; i < 16; ++i) { s0[i] += b; s1[i] += b; }
            } else {
#pragma unroll
                for (int i = 0; i < 16; ++i) { const int r0 = rel0 - KEYOFF(0, i), r1 = rel0 - KEYOFF(1, i);
                    s0[i] = (unsigned)r0 < (unsigned)W ? s0[i] + b : NEG_INF; s1[i] = (unsigned)r1 < (unsigned)W ? s1[i] + b : NEG_INF; } }
        } else {
#pragma unroll
            for (int i = 0; i < 16; ++i) { const int r0 = rel0 - KEYOFF(0, i), r1 = rel0 - KEYOFF(1, i);
                const float b0 = lut[min(max(r0, 0), 128)], b1 = lut[min(max(r1, 0), 128)];
                s0[i] = (unsigned)r0 < (unsigned)W ? s0[i] + b0 : NEG_INF; s1[i] = (unsigned)r1 < (unsigned)W ? s1[i] + b1 : NEG_INF; }
        }
    }
};
struct FCmp {
    int lim0, cmax_w;
    __device__ __forceinline__ bool active(int tile) { return tile * 64 <= cmax_w; }
    __device__ __forceinline__ void apply(f32x16& s0, f32x16& s1, int tile) {
        const int lim = lim0 - tile * 64;
        if (__all(lim >= 59)) return;
#pragma unroll
        for (int i = 0; i < 16; ++i) { s0[i] = KEYOFF(0, i) <= lim ? s0[i] : NEG_INF; s1[i] = KEYOFF(1, i) <= lim ? s1[i] : NEG_INF; }
    }
};
#define ATTN_STEP(J) { if (i + (J) >= ntiles) break; const int buf = (i + (J)) & 1; \
        tile_store(L, buf, NEEDV, tid, kr[J], vr[J]); if (i + (J) + RD < ntiles) tile_load(src, (tile_lo + i + (J) + RD) * 64, NEEDV, tid, kr[J], vr[J]); \
        WG_BAR_LDS(); const int tile = tile_lo + i + (J); BODY }
template <int RD, class Fn>
__device__ __forceinline__ void attn_loop(LAS unsigned char* L, const TileSrc& src, int tile_lo, int ntiles, const bf16x8 (&q)[4], f32x16 (&o)[2], float& m, float& l, Fn& f, int tid, int r32, int h) {
    u32x4 kr[RD], vr[RD];
    constexpr bool NEEDV = true;
#pragma unroll
    for (int j = 0; j < RD; ++j) if (j < ntiles) tile_load(src, (tile_lo + j) * 64, true, tid, kr[j], vr[j]);
#define BODY if (f.active(tile)) { f32x16 s0, s1; qk_tile(L + AT_K0 + buf * AT_KSZ, q, r32, h, s0, s1); f.apply(s0, s1, tile); softmax_pv(L + AT_V0 + buf * AT_VSZ, s0, s1, o, m, l, r32, h); }
#pragma unroll 1
    for (int i = 0; i < ntiles; i += RD) { ATTN_STEP(0) ATTN_STEP(1) ATTN_STEP(2) if (RD > 3) ATTN_STEP(3) }
#undef BODY
    WG_BAR_LDS();
}
#define PIPE_STEP(J, CA, CB, NA, NB_) { if (i + (J) >= ntiles) break; const int t_ = i + (J); \
        tile_store_v(L, t_ & 1, tid, vr[J]); if (t_ + 2 < ntiles) vr[J] = tile_load_v(src, (tile_lo + t_ + 2) * 64, tid); \
        if (t_ + 1 < ntiles) { tile_store_k(L, (t_ + 1) & 1, tid, kr[1 - (J)]); if (t_ + 3 < ntiles) kr[1 - (J)] = tile_load_k(src, (tile_lo + t_ + 3) * 64, tid); } \
        WG_BAR_LDS(); \
        if (t_ + 1 < ntiles) qk_tile(L + AT_K0 + ((t_ + 1) & 1) * AT_KSZ, q, r32, h, NA, NB_); \
        f.apply(CA, CB, tile_lo + t_); softmax_pv(L + AT_V0 + (t_ & 1) * AT_VSZ, CA, CB, o, m, l, r32, h); }
__device__ __forceinline__ u32x4 tile_load_k(const TileSrc& s, int key0, int tid) { return *(const u32x4*)(s.K + (size_t)(key0 + (tid >> 3)) * 64 + (tid & 7) * 8); }
__device__ __forceinline__ u32x4 tile_load_v(const TileSrc& s, int key0, int tid) { return *(const u32x4*)(s.Vt + (size_t)(tid >> 3) * s.vpitch + key0 + (tid & 7) * 8); }
__device__ __forceinline__ void tile_store_k(LAS unsigned char* L, int buf, int tid, const u32x4& kr) { *(LAS u32x4*)(L + AT_K0 + buf * AT_KSZ + (tid >> 3) * KROW + (tid & 7) * 16) = kr; }
__device__ __forceinline__ void tile_store_v(LAS unsigned char* L, int buf, int tid, const u32x4& vr) { LAS u32x2* p = (LAS u32x2*)(L + AT_V0 + buf * AT_VSZ + (tid >> 3) * VROW + (tid & 7) * 16); u32x2 a, b; a.x = vr.x; a.y = vr.y; b.x = vr.z; b.y = vr.w; p[0] = a; p[1] = b; }
template <class Fn>
__device__ __forceinline__ void attn_loop_pipe(LAS unsigned char* L, const TileSrc& src, int tile_lo, int ntiles, const bf16x8 (&q)[4], f32x16 (&o)[2], float& m, float& l, Fn& f, int tid, int r32, int h) {
    u32x4 kr[2], vr[2];
    kr[0] = tile_load_k(src, tile_lo * 64, tid); vr[0] = tile_load_v(src, tile_lo * 64, tid);
    if (1 < ntiles) { kr[1] = tile_load_k(src, (tile_lo + 1) * 64, tid); vr[1] = tile_load_v(src, (tile_lo + 1) * 64, tid); }
    tile_store_k(L, 0, tid, kr[0]); if (2 < ntiles) kr[0] = tile_load_k(src, (tile_lo + 2) * 64, tid);
    WG_BAR_LDS();
    f32x16 a0, a1, b0, b1;
    qk_tile(L + AT_K0, q, r32, h, a0, a1);
#pragma unroll 1
    for (int i = 0; i < ntiles; i += 2) { PIPE_STEP(0, a0, a1, b0, b1) PIPE_STEP(1, b0, b1, a0, a1) }
    WG_BAR_LDS();
}
__device__ __forceinline__ void build_lut(Frame& F, const float* rb) {
    LAS float* lut = (LAS float*)(F.lds + AT_LUT);
    for (int i = F.tid; i < 16 * 129; i += NWAVES * 64) { const int hh = i / 129, rel = i % 129; lut[hh * LUTS + rel] = rb[(int)BKT[rel] * 16 + hh] * LOG2E; }
    __syncthreads();
}
__device__ __forceinline__ void store_o(bf16* dst, const f32x16 (&o)[2], float sc, int h) {
#pragma unroll
    for (int dt = 0; dt < 2; ++dt)
#pragma unroll
        for (int gq = 0; gq < 4; ++gq) { u32x2 w; w.x = pkbf(o[dt][4 * gq] * sc, o[dt][4 * gq + 1] * sc); w.y = pkbf(o[dt][4 * gq + 2] * sc, o[dt][4 * gq + 3] * sc);
            *(u32x2*)(dst + 32 * dt + 8 * gq + 4 * h) = w; }
}
template <int MODE>
__device__ __forceinline__ void banded_unit(Frame& F, const float* sink, int T, int g) {
    LAS unsigned char* L = F.lds; const int tid = F.tid, lane = F.lane, w = F.wave, r32 = lane & 31, h = lane >> 5;
    const int t0 = T * 64, tw = t0 + 8 * w, tq = tw + (r32 >> 2), hg = g * 4 + (r32 & 3);
    constexpr int W = MODE == 0 ? 128 : 512;
    const bf16* Qp = (const bf16*)(F.ws + (MODE == 0 ? WS_QA : WS_QB)) + (size_t)tq * 512 + hg * 64;
    bf16x8 q[4];
#pragma unroll
    for (int ks = 0; ks < 4; ++ks) q[ks] = *(const bf16x8*)(Qp + 16 * ks + 8 * h);
    f32x16 o[2];
#pragma unroll
    for (int i = 0; i < 16; ++i) { o[0][i] = 0.f; o[1][i] = 0.f; }
    float m = -1e30f, l = 0.f;
    if (MODE == 0) { m = sink[hg] * LOG2E; l = 1.f; }
    const int tlo = max(0, t0 - W + 1) >> 6, nt = T - tlo + 1;
    TileSrc src; src.K = (const bf16*)(F.ws + (MODE == 0 ? WS_KA : WS_KW)) + (size_t)g * SEQ * 64; src.Vt = (const bf16*)(F.ws + (MODE == 0 ? WS_VTA : WS_VTW)) + (size_t)g * 64 * SEQ; src.vpitch = SEQ;
    FBand<W> f; f.tq = tq; f.tw = tw; f.h = h; f.lut = (const LAS float*)(L + AT_LUT) + ((MODE == 0 ? 0 : 8) + hg) * LUTS;
    attn_loop<3>(L, src, tlo, nt, q, o, m, l, f, tid, r32, h);
    bf16* Op = (bf16*)(F.ws + (MODE == 0 ? WS_OA : WS_OW)) + (size_t)tq * 512 + hg * 64;
    store_o(Op, o, frcp(fmaxf(l, 1e-30f)), h);
}
__device__ __forceinline__ void compress_out(Frame& F, int b) {
    const int lane = F.lane, w = F.wave, r32 = lane & 31, h = lane >> 5;
    const int kvg = b >> 2, kv = kvg >> 1, g = kvg & 1, c0 = (b & 3) * 256 + 32 * w;
    const bf16* H = (const bf16*)(F.ws + WS_H) + (size_t)(256 * b + 32 * w + r32) * 256 + 8 * h;
    const bf16* W2 = (const bf16*)(F.ws + (kv ? WS_W2VT : WS_W2KT)) + (size_t)r32 * 256 + 8 * h;
    f32x16 a0, a1;
#pragma unroll
    for (int i = 0; i < 16; ++i) { a0[i] = 0.f; a1[i] = 0.f; }
#pragma unroll 4
    for (int ks = 0; ks < 16; ++ks) {
        const bf16x8 hf = *(const bf16x8*)(H + 16 * ks), w0 = *(const bf16x8*)(W2 + 16 * ks), w1 = *(const bf16x8*)(W2 + 32 * 256 + 16 * ks);
        if (kv == 0) { a0 = __builtin_amdgcn_mfma_f32_32x32x16_bf16(w0, hf, a0, 0, 0, 0); a1 = __builtin_amdgcn_mfma_f32_32x32x16_bf16(w1, hf, a1, 0, 0, 0); }
        else         { a0 = __builtin_amdgcn_mfma_f32_32x32x16_bf16(hf, w0, a0, 0, 0, 0); a1 = __builtin_amdgcn_mfma_f32_32x32x16_bf16(hf, w1, a1, 0, 0, 0); }
    }
    if (kv == 0) {
        const int c = c0 + r32; bf16* kc = (bf16*)(F.ws + WS_KC) + ((size_t)g * 1024 + c) * 64; const bool pad = (c == 1023);
#pragma unroll
        for (int nt = 0; nt < 2; ++nt)
#pragma unroll
            for (int gq = 0; gq < 4; ++gq) { const f32x16& a = nt ? a1 : a0; u32x2 wv; wv.x = pkbf(a[4 * gq], a[4 * gq + 1]); wv.y = pkbf(a[4 * gq + 2], a[4 * gq + 3]); if (pad) { wv.x = 0u; wv.y = 0u; }
                *(u32x2*)(kc + 32 * nt + 8 * gq + 4 * h) = wv; }
    } else {
        bf16* vct = (bf16*)(F.ws + WS_VCT) + (size_t)g * 64 * 1024;
#pragma unroll
        for (int nt = 0; nt < 2; ++nt)
#pragma unroll
            for (int gq = 0; gq < 4; ++gq) { const f32x16& a = nt ? a1 : a0; const int c = c0 + 8 * gq + 4 * h;
                u32x2 wv; wv.x = pkbf(a[4 * gq], a[4 * gq + 1]); wv.y = pkbf(a[4 * gq + 2], a[4 * gq + 3]); if (c + 3 == 1023) wv.y &= 0xffffu;
                *(u32x2*)(vct + (size_t)(32 * nt + r32) * 1024 + c) = wv; }
    }
}
#ifndef PROBE_SLC_MODE
#define PROBE_SLC_MODE 1
#endif
struct SlcCtx { bool probe; LAS unsigned char* L; const bf16* KSg; const bf16* VSg; const LAS float* lut; LAS unsigned char* slot; const LAS unsigned* selb; int t0, jt, lane, r32, h, hd; };
__device__ __forceinline__ int slc_perm(int k, int jt) { return k == 0 ? jt : k == 1 ? jt - 1 : k == 2 ? 0 : jt - (k - 1); }
template <int PASS>
__device__ __forceinline__ void slc_tile(const SlcCtx& C, int j, const bf16x8 (&kf)[2][4], const bf16x8 (&vf)[2][4]) {
    LAS unsigned char* L = C.L; const int lane = C.lane, r32 = C.r32, h = C.h, hd = C.hd;
    LAS unsigned* mref = (LAS unsigned*)(L + SM_OFF); LAS float* lsum = (LAS float*)(L + SL_OFF); LAS float* Oacc = (LAS float*)(L + SO_OFF);
    const bool mine = (C.selb[lane * 8 + (j >> 5)] >> (j & 31)) & 1u;
    const unsigned long long mask = __ballot(mine); const int n = __builtin_popcountll(mask);
    if (n == 0) return;
    if (mine) C.slot[__builtin_amdgcn_mbcnt_hi((unsigned)(mask >> 32), __builtin_amdgcn_mbcnt_lo((unsigned)mask, 0u))] = (unsigned char)lane;
    const bool nearb = (j + 2 >= C.jt);
    const int nch = (n + 7) >> 3;
#pragma unroll 1
    for (int pc = 0; pc < nch; ++pc) {
        const int ci = 8 * pc + (r32 >> 2); const bool cv = ci < n; const int tok = (int)C.slot[cv ? ci : 0]; const int row = tok * 4 + hd;
        const LAS unsigned char* qr = L + SQ_OFF + row * KROW + 16 * h;
        f32x16 s0, s1;
#pragma unroll
        for (int i = 0; i < 16; ++i) { s0[i] = 0.f; s1[i] = 0.f; }
#pragma unroll
        for (int ks = 0; ks < 4; ++ks) { const bf16x8 qf = *(const LAS bf16x8*)(qr + 32 * ks);
            s0 = __builtin_amdgcn_mfma_f32_32x32x16_bf16(kf[0][ks], qf, s0, 0, 0, 0); s1 = __builtin_amdgcn_mfma_f32_32x32x16_bf16(kf[1][ks], qf, s1, 0, 0, 0); }
        if (nearb) { const int rel0 = C.t0 + tok - 64 * j - 4 * h;
#pragma unroll
            for (int i = 0; i < 16; ++i) { const int r0 = rel0 - KEYOFF(0, i), r1 = rel0 - KEYOFF(1, i);
                const float b0 = C.lut[min(max(r0, 0), 128)], b1 = C.lut[min(max(r1, 0), 128)];
                s0[i] = r0 >= 0 ? s0[i] + b0 : NEG_INF; s1[i] = r1 >= 0 ? s1[i] + b1 : NEG_INF; }
        } else { const float b = C.lut[128];
#pragma unroll
            for (int i = 0; i < 16; ++i) { s0[i] += b; s1[i] += b; } }
        if (PASS == 0) {
            float mx = fmaxf(s0[0], s1[0]);
#pragma unroll
            for (int i = 1; i < 16; ++i) mx = fmaxf(mx, fmaxf(s0[i], s1[i]));
            mx = pair_max(mx);
            if (cv && h == 0) __hip_atomic_fetch_max(mref + row, ord_key(mx), __ATOMIC_RELAXED, __HIP_MEMORY_SCOPE_WORKGROUP);
        } else {
            const float mm = ord_val(mref[row]); float sum = 0.f;
#pragma unroll
            for (int i = 0; i < 16; ++i) { s0[i] = fexp2(s0[i] - mm); s1[i] = fexp2(s1[i] - mm); sum += s0[i] + s1[i]; }
            sum = pair_sum(sum);
            if (cv && h == 0) __hip_atomic_fetch_add(lsum + row, sum, __ATOMIC_RELAXED, __HIP_MEMORY_SCOPE_WORKGROUP);
            bf16x8 pf[4]; pf[0] = pack_p(s0, 0); pf[1] = pack_p(s0, 8); pf[2] = pack_p(s1, 0); pf[3] = pack_p(s1, 8);
            LAS float* orow = Oacc + row * SO_ROW + 4 * h;
#pragma unroll
            for (int dt = 0; dt < 2; ++dt) { f32x16 oo;
#pragma unroll
                for (int i = 0; i < 16; ++i) oo[i] = 0.f;
#pragma unroll
                for (int s = 0; s < 4; ++s) oo = __builtin_amdgcn_mfma_f32_32x32x16_bf16(vf[dt][s], pf[s], oo, 0, 0, 0);
                if (cv && !(C.probe && PROBE_SLC_MODE == 3)) {
#pragma unroll
                    for (int i = 0; i < 16; ++i) __hip_atomic_fetch_add((LAS int*)orow + 32 * dt + (i & 3) + 8 * (i >> 2), (int)__builtin_rintf(oo[i] * 65536.0f), __ATOMIC_RELAXED, __HIP_MEMORY_SCOPE_WORKGROUP); }
                else { asm volatile("" :: "v"(oo)); } }
        }
    }
}
template <int PASS, int NB>
__device__ __forceinline__ void slc_pass(const SlcCtx& C) {
    const int r32 = C.r32, h = C.h, jt = C.jt;
#pragma unroll 1
    for (;;) {
        int k0 = 0; if (C.lane == 0) k0 = (int)__hip_atomic_fetch_add((LAS unsigned*)(C.L + SC_OFF), (unsigned)NB, __ATOMIC_RELAXED, __HIP_MEMORY_SCOPE_WORKGROUP);
        k0 = __builtin_amdgcn_readfirstlane(k0);
        if (k0 > jt) break;
        bf16x8 kf[NB][2][4], vf[NB][2][4];
#pragma unroll
        for (int b = 0; b < NB; ++b) if (k0 + b <= jt) { const int j = slc_perm(k0 + b, jt);
#pragma unroll
            for (int kt = 0; kt < 2; ++kt)
#pragma unroll
                for (int ks = 0; ks < 4; ++ks) kf[b][kt][ks] = *(const bf16x8*)(C.KSg + (size_t)j * 4096 + ((kt * 4 + ks) * 64 + C.lane) * 8);
            if (PASS == 1) {
#pragma unroll
                for (int dt = 0; dt < 2; ++dt)
#pragma unroll
                    for (int s = 0; s < 4; ++s) vf[b][dt][s] = *(const bf16x8*)(C.VSg + (size_t)j * 4096 + ((dt * 4 + s) * 64 + C.lane) * 8); } }
#pragma unroll
        for (int b = 0; b < NB; ++b) if (k0 + b <= jt) slc_tile<PASS>(C, slc_perm(k0 + b, jt), kf[b], vf[PASS == 1 ? b : 0]);
    }
}
__device__ __forceinline__ void nsa_unit(Frame& F, int T, int g, bool probe_noslc) {
    LAS unsigned char* L = F.lds; const int tid = F.tid, lane = F.lane, w = F.wave, r32 = lane & 31, h = lane >> 5;
    const int t0 = T * 64, tw = t0 + 8 * w, ql = 8 * w + (r32 >> 2), tq = t0 + ql, hd = r32 & 3, hg = g * 4 + hd, jt = T;
    const bf16* Qp = (const bf16*)(F.ws + WS_QB) + (size_t)tq * 512 + hg * 64; bf16* Ob = (bf16*)(F.ws + WS_OB) + (size_t)tq * 512 + hg * 64;
    bf16x8 q[4];
#pragma unroll
    for (int ks = 0; ks < 4; ++ks) q[ks] = *(const bf16x8*)(Qp + 16 * ks + 8 * h);
    const float* bg = (const float*)(F.ws + WS_BG) + (size_t)tq * 24 + hg; const float g0 = bg[0], g1 = bg[8], g2 = bg[16];
    f32x16 o[2];
#pragma unroll
    for (int i = 0; i < 16; ++i) { o[0][i] = 0.f; o[1][i] = 0.f; }
    float m = -1e30f, l = 0.f;
    const int ncmp = t0 / 16 + 3, ntc = (ncmp + 63) >> 6;
    TileSrc sc; sc.K = (const bf16*)(F.ws + WS_KC) + (size_t)g * 1024 * 64; sc.Vt = (const bf16*)(F.ws + WS_VCT) + (size_t)g * 64 * 1024; sc.vpitch = 1024;
    FCmp fc; fc.lim0 = ((tq - 31) >> 4) - 4 * h; fc.cmax_w = (tw + 7 - 31) >> 4;
    attn_loop<3>(L, sc, 0, ntc, q, o, m, l, fc, tid, r32, h);
    const float inv = frcp(fmaxf(l, 1e-30f));
    { const bf16* OWp = (const bf16*)(F.ws + WS_OW) + (size_t)tq * 512 + hg * 64; const float s0_ = g0 * inv;
#pragma unroll
      for (int dt = 0; dt < 2; ++dt)
#pragma unroll
          for (int gq = 0; gq < 4; ++gq) { const u32x2 ow = *(const u32x2*)(OWp + 32 * dt + 8 * gq + 4 * h); u32x2 wv;
              wv.x = pkbf(s0_ * o[dt][4 * gq] + g2 * bf_lo(ow.x), s0_ * o[dt][4 * gq + 1] + g2 * bf_hi(ow.x));
              wv.y = pkbf(s0_ * o[dt][4 * gq + 2] + g2 * bf_lo(ow.y), s0_ * o[dt][4 * gq + 3] + g2 * bf_hi(ow.y));
              *(u32x2*)(Ob + 32 * dt + 8 * gq + 4 * h) = wv; } }
    LAS float* imp = (LAS float*)(L + AT_IMP);
    for (int i = lane; i < 8 * 256; i += 64) imp[8 * w * 256 + i] = 0.f;
    { constexpr int RD = 3; u32x4 kr[RD], vr[RD]; constexpr bool NEEDV = false; const TileSrc& src = sc; const int tile_lo = 0, ntiles = ntc;
#pragma unroll
      for (int j = 0; j < RD; ++j) if (j < ntiles) tile_load(src, j * 64, false, tid, kr[j], vr[j]);
#define BODY if (fc.active(tile)) { \
              f32x16 s0, s1; qk_tile(L + AT_K0 + buf * AT_KSZ, q, r32, h, s0, s1); \
              fc.apply(s0, s1, tile); \
              _Pragma("unroll") for (int kt = 0; kt < 2; ++kt) { const f32x16& s = kt ? s1 : s0; float mainv = 0.f, spv = 0.f; \
                  _Pragma("unroll") for (int gq = 0; gq < 4; ++gq) { const float p0 = fexp2(s[4 * gq] - m) * inv, p1 = fexp2(s[4 * gq + 1] - m) * inv, p2 = fexp2(s[4 * gq + 2] - m) * inv, p3 = fexp2(s[4 * gq + 3] - m) * inv; \
                      const float mq = quad_sum((p0 + p1) + (p2 + 0.5f * p3)), sq = quad_sum(0.5f * p3); \
                      if (gq == hd) { mainv = mq; spv = sq; } } \
                  const int j = tile * 16 + 8 * kt + 2 * hd + h; \
                  __hip_atomic_fetch_add((LAS int*)imp + ql * 256 + j, (int)__builtin_rintf(mainv * 16777216.0f), __ATOMIC_RELAXED, __HIP_MEMORY_SCOPE_WORKGROUP);   \
                  __hip_atomic_fetch_add((LAS int*)imp + ql * 256 + min(j + 1, 255), (j + 1 < 256) ? (int)__builtin_rintf(spv * 16777216.0f) : 0, __ATOMIC_RELAXED, __HIP_MEMORY_SCOPE_WORKGROUP); } }
#pragma unroll 1
      for (int i = 0; i < ntiles; i += RD) { ATTN_STEP(0) ATTN_STEP(1) ATTN_STEP(2) }
#undef BODY
      WG_BAR_LDS(); }
    LAS unsigned* selb = (LAS unsigned*)(L + AT_SEL);
#pragma unroll 1
    for (int qi = 0; qi < 8; ++qi) {
        const LAS float* row = imp + (8 * w + qi) * 256; unsigned mybits = 0u;
        if (lane == 0) mybits |= 1u;
        if (lane == (jt >> 5)) mybits |= 1u << (jt & 31);
        if (jt >= 1 && lane == ((jt - 1) >> 5)) mybits |= 1u << ((jt - 1) & 31);
        const int ncand = jt - 2;
        if (ncand > 0) {
            if (ncand <= 13) { if (lane == 0) mybits |= ((1u << (jt - 1)) - 2u); }
            else {
                unsigned k[4];
#pragma unroll
                for (int i = 0; i < 4; ++i) { const int j = lane + 64 * i; const unsigned v = ((const LAS unsigned*)row)[j]; k[i] = (j >= 1 && j <= jt - 2) ? ((v & ~255u) | (unsigned)(255 - j)) : 0u; }
#pragma unroll 1
                for (int it = 0; it < 13; ++it) { const unsigned mx = wave_max_u32(umax_(umax_(k[0], k[1]), umax_(k[2], k[3]))); const int j = 255 - (int)(mx & 255u);
                    if (lane == (j >> 5)) mybits |= 1u << (j & 31);
#pragma unroll
                    for (int i = 0; i < 4; ++i) k[i] = (k[i] == mx) ? 0u : k[i]; }
            }
        }
        if (lane < 8) selb[(8 * w + qi) * 8 + lane] = mybits;
    }
    if (probe_noslc && PROBE_SLC_MODE == 1) return;
    WG_BAR_LDS();
    { LAS unsigned char* qs = L + SQ_OFF + (ql * 4 + hd) * KROW + 16 * h;
#pragma unroll
      for (int ks = 0; ks < 4; ++ks) *(LAS bf16x8*)(qs + 32 * ks) = q[ks];
      for (int i = tid; i < 256 * SO_ROW; i += NWAVES * 64) ((LAS float*)(L + SO_OFF))[i] = 0.f;
      if (tid < 256) { ((LAS unsigned*)(L + SM_OFF))[tid] = 0u; ((LAS float*)(L + SL_OFF))[tid] = 0.f; }
      if (tid == 0) *(LAS unsigned*)(L + SC_OFF) = 0u; }
    WG_BAR_LDS();
    { SlcCtx C; C.probe = probe_noslc; C.L = L; C.KSg = (const bf16*)(F.ws + WS_KS) + (size_t)g * 256 * 4096; C.VSg = (const bf16*)(F.ws + WS_VTS) + (size_t)g * 256 * 4096;
      C.lut = (const LAS float*)(L + AT_LUT) + (8 + hg) * LUTS; C.slot = L + SS_OFF + w * 64; C.selb = selb; C.t0 = t0; C.jt = jt; C.lane = lane; C.r32 = r32; C.h = h; C.hd = hd;
      slc_pass<0, 4>(C);
      WG_BAR_LDS();
      if (tid == 0) *(LAS unsigned*)(L + SC_OFF) = 0u;
      WG_BAR_LDS();
      if (!(probe_noslc && PROBE_SLC_MODE == 2)) slc_pass<1, 1>(C);
      WG_BAR_LDS();
      LAS float* lsum = (LAS float*)(L + SL_OFF); LAS float* Oacc = (LAS float*)(L + SO_OFF);
      const int row = ql * 4 + hd; const float s2 = g1 * frcp(fmaxf(lsum[row], 1e-30f)) * (1.0f / 65536.0f); const LAS int* orow = (const LAS int*)Oacc + row * SO_ROW + 4 * h;
#pragma unroll
      for (int dt = 0; dt < 2; ++dt)
#pragma unroll
          for (int gq = 0; gq < 4; ++gq) { u32x2 wv; const u32x2 tt = *(const u32x2*)(Ob + 32 * dt + 8 * gq + 4 * h); const LAS int* op = orow + 32 * dt + 8 * gq;
              wv.x = pkbf(bf_lo(tt.x) + s2 * (float)op[0], bf_hi(tt.x) + s2 * (float)op[1]); wv.y = pkbf(bf_lo(tt.y) + s2 * (float)op[2], bf_hi(tt.y) + s2 * (float)op[3]);
              *(u32x2*)(Ob + 32 * dt + 8 * gq + 4 * h) = wv; }
    }
    WG_BAR_LDS();
}

typedef float f32x2 __attribute__((ext_vector_type(2)));
__device__ __forceinline__ float dot16_fp8(const u32x4& r, const f32x2 (&xp)[8]) {
    f32x2 a = __builtin_amdgcn_cvt_pk_f32_fp8((int)r.x, false) * xp[0];
    a = __builtin_elementwise_fma(__builtin_amdgcn_cvt_pk_f32_fp8((int)r.x, true), xp[1], a);
    a = __builtin_elementwise_fma(__builtin_amdgcn_cvt_pk_f32_fp8((int)r.y, false), xp[2], a); a = __builtin_elementwise_fma(__builtin_amdgcn_cvt_pk_f32_fp8((int)r.y, true), xp[3], a);
    a = __builtin_elementwise_fma(__builtin_amdgcn_cvt_pk_f32_fp8((int)r.z, false), xp[4], a); a = __builtin_elementwise_fma(__builtin_amdgcn_cvt_pk_f32_fp8((int)r.z, true), xp[5], a);
    a = __builtin_elementwise_fma(__builtin_amdgcn_cvt_pk_f32_fp8((int)r.w, false), xp[6], a); a = __builtin_elementwise_fma(__builtin_amdgcn_cvt_pk_f32_fp8((int)r.w, true), xp[7], a);
    return a.x + a.y;
}
typedef __bf16 v2bf __attribute__((ext_vector_type(2)));
__device__ __forceinline__ float dot2bf(unsigned a, unsigned b, float c) { return __builtin_amdgcn_fdot2_f32_bf16(__builtin_bit_cast(v2bf, a), __builtin_bit_cast(v2bf, b), c, false); }
__device__ __forceinline__ void peer_top16(const bf16* qrow, LAS const unsigned char* kmat, int r32, int h2, unsigned (&sel)[16]) {
    bf16x8 qf[8];
#pragma unroll
    for (int ks = 0; ks < 8; ++ks) qf[ks] = *(const bf16x8*)(qrow + 16 * ks + 8 * h2);
    unsigned key[64];
#pragma unroll
    for (int nt = 0; nt < 4; ++nt) { f32x16 s;
#pragma unroll
        for (int i = 0; i < 16; ++i) s[i] = 0.f;
#pragma unroll
        for (int ks = 0; ks < 8; ++ks) { const bf16x8 a = *(LAS const bf16x8*)(kmat + (32 * nt + r32) * PK_ROW + (16 * ks + 8 * h2) * 2); s = __builtin_amdgcn_mfma_f32_32x32x16_bf16(a, qf[ks], s, 0, 0, 0); }
#pragma unroll
        for (int i = 0; i < 16; ++i) key[nt * 16 + i] = (ord_key(s[i]) & ~127u) | (unsigned)(((63 - (nt * 16 + i)) << 1) | (1 - h2)); }
    unsigned prev = 0xFFFFFFFFu;
#pragma unroll
    for (int k = 0; k < 16; ++k) sel[k] = 0u;
#pragma unroll 1
    for (int it = 0; it < 16; ++it) { unsigned c = 0u;
#pragma unroll
        for (int i = 0; i < 64; ++i) c = umax_(c, key[i] - prev);
        const unsigned mloc = c + prev, mm = pair_umax(mloc);
#pragma unroll
        for (int k = 0; k < 16; ++k) sel[k] = (k == it) ? mm : sel[k];
        prev = mm; }
}
__device__ __forceinline__ int key_n(unsigned k) { const int low = k & 127, Lx = 63 - (low >> 1), hh = 1 - (low & 1); return ((Lx >> 4) << 5) + (((Lx >> 2) & 3) << 3) + (hh << 2) + (Lx & 3); }

__device__ __forceinline__ void peer_phase(Frame& F, bool dry) {
    LAS unsigned char* L = F.lds; const int tid = F.tid, lane = F.lane, w = F.wave, r32 = lane & 31, h2 = lane >> 5;
    unsigned char* ws = F.ws;
    for (int i = tid; i < 2 * 128 * 16; i += NWAVES * 64) { const int which = i >> 11, rr = (i >> 4) & 127, ch = i & 15;
        *(LAS u32x4*)(L + (which ? PK2_OFF : PK1_OFF) + rr * PK_ROW + ch * 16) = *(const u32x4*)((const bf16*)(ws + (which ? WS_K2B : WS_K1B)) + rr * 128 + ch * 8); }
    __syncthreads();
    LAS unsigned char* PW = L + PW_OFF + w * PW_BYTES;
    LAS unsigned char* XR = PW; LAS u32x2* LST = (LAS u32x2*)(PW + 2048); LAS unsigned char* I12 = PW + 6144; LAS float* WL = (LAS float*)(PW + 7168);
    const bf16* Q2 = (const bf16*)(ws + WS_Q2); const unsigned char* U8 = ws + WS_U8; const unsigned char* V8 = ws + WS_V8;
    bf16* xb = (bf16*)(ws + WS_XB2); const float* ssq1 = (const float*)(ws + WS_SSQ1); float* rs2 = (float*)(ws + WS_RS2);
    const int gw = F.vcu * NWAVES + w, NGW = F.G * NWAVES;
#pragma unroll 1
    for (int item = gw; item < SEQ / 4; item += NGW) {
        const int t0 = item * 4;
        {
            const int tk = r32 >> 3, hd = r32 & 7; const bf16* qrow = Q2 + (size_t)(t0 + tk) * 2048 + hd * 256;
            const float rsq = rs_from_ssq(ssq1, t0 + tk);
            unsigned s1[16], s2[16];
            peer_top16(qrow, L + PK1_OFF, r32, h2, s1);
            peer_top16(qrow + 128, L + PK2_OFF, r32, h2, s2);
            float v1[16], v2[16];
#pragma unroll
            for (int k = 0; k < 16; ++k) { v1[k] = ord_val(s1[k] & ~127u); v2[k] = ord_val(s2[k] & ~127u); }
            if (h2 == 0) { LAS unsigned* ip = (LAS unsigned*)(I12 + r32 * 32);
#pragma unroll
                for (int k4 = 0; k4 < 4; ++k4) { ip[k4] = (unsigned)key_n(s1[4 * k4]) | ((unsigned)key_n(s1[4 * k4 + 1]) << 8) | ((unsigned)key_n(s1[4 * k4 + 2]) << 16) | ((unsigned)key_n(s1[4 * k4 + 3]) << 24);
                    ip[4 + k4] = (unsigned)key_n(s2[4 * k4]) | ((unsigned)key_n(s2[4 * k4 + 1]) << 8) | ((unsigned)key_n(s2[4 * k4 + 2]) << 16) | ((unsigned)key_n(s2[4 * k4 + 3]) << 24); } }
            unsigned ck[50]; int nc = 0;
#pragma unroll
            for (int i = 0; i < 16; ++i)
#pragma unroll
                for (int j = 0; j < 16; ++j) if ((i + 1) * (j + 1) <= 16) { ck[nc] = (ord_key(v1[i] + v2[j]) & ~255u) | (unsigned)(255 - (16 * i + j)); ++nc; }
            unsigned prev = 0xFFFFFFFFu; float sc[16]; int ei[16];
#pragma unroll
            for (int it = 0; it < 16; ++it) { unsigned c = 0u;
#pragma unroll
                for (int i = 0; i < 50; ++i) c = umax_(c, ck[i] - prev);
                const unsigned mm = c + prev; prev = mm;
                const int flat = 255 - (int)(mm & 255u); sc[it] = ord_val(mm & ~255u);
                ei[it] = (int)I12[r32 * 32 + (flat >> 4)] * 128 + (int)I12[r32 * 32 + 16 + (flat & 15)]; }
            float den = 0.f, ex[16];
#pragma unroll
            for (int k = 0; k < 16; ++k) { ex[k] = fexp2((sc[k] - sc[0]) * (rsq * LOG2E)); den += ex[k]; }
            const float rd = frcp(den);
            if (h2 == 0) {
#pragma unroll
                for (int k = 0; k < 16; ++k) { u32x2 e; e.x = (unsigned)ei[k]; e.y = __float_as_uint(ex[k] * rd); LST[tk * 128 + hd * 16 + k] = e; } }
        }
#pragma unroll 1
        for (int tk = 0; tk < 4; ++tk) {
            const int t = t0 + tk;
            f32x2 xp[8];
            { const u32x4 xa = *(const u32x4*)(xb + (size_t)t * DM + lane * 16), xc = *(const u32x4*)(xb + (size_t)t * DM + lane * 16 + 8);
              xp[0] = (f32x2){bf_lo(xa.x), bf_hi(xa.x)}; xp[1] = (f32x2){bf_lo(xa.y), bf_hi(xa.y)}; xp[2] = (f32x2){bf_lo(xa.z), bf_hi(xa.z)}; xp[3] = (f32x2){bf_lo(xa.w), bf_hi(xa.w)};
              xp[4] = (f32x2){bf_lo(xc.x), bf_hi(xc.x)}; xp[5] = (f32x2){bf_lo(xc.y), bf_hi(xc.y)}; xp[6] = (f32x2){bf_lo(xc.z), bf_hi(xc.z)}; xp[7] = (f32x2){bf_lo(xc.w), bf_hi(xc.w)}; }
            const float rs = rs_from_ssq(ssq1, t) * (1.0f / 32.0f);
            const LAS u32x2* lst = LST + tk * 128;
#if defined(PROBE_L2PEER)
            const int idxmask = dry ? 1023 : 16383;
#else
            constexpr int idxmask = 16383;
#endif
#define PEER_LOAD8(R_, TAB_, e0_) _Pragma("unroll") for (int k = 0; k < 8; ++k) { const int idx = __builtin_amdgcn_readfirstlane((int)lst[(e0_) + k].x) & idxmask; R_[k] = *(const u32x4*)(TAB_ + (size_t)idx * DM + lane * 16); }
#define PEER_DOT16(r_) dot16_fp8(r_, xp)
#define PEER_UCOMP(R_, e0_) _Pragma("unroll") for (int k4 = 0; k4 < 2; ++k4) { \
                const float p0 = PEER_DOT16(R_[4 * k4]), p1 = PEER_DOT16(R_[4 * k4 + 1]), p2 = PEER_DOT16(R_[4 * k4 + 2]), p3 = PEER_DOT16(R_[4 * k4 + 3]); \
                auto s02 = __builtin_amdgcn_permlane32_swap(__float_as_uint(p0), __float_as_uint(p2), false, false); auto s13 = __builtin_amdgcn_permlane32_swap(__float_as_uint(p1), __float_as_uint(p3), false, false); \
                const float r0 = __uint_as_float(s02[0]) + __uint_as_float(s02[1]), r1 = __uint_as_float(s13[0]) + __uint_as_float(s13[1]); \
                auto s01 = __builtin_amdgcn_permlane16_swap(__float_as_uint(r0), __float_as_uint(r1), false, false); \
                float qv = __uint_as_float(s01[0]) + __uint_as_float(s01[1]); \
                qv += dpp_f<0xB1>(qv); qv += dpp_f<0x4E>(qv); qv += dpp_f<0x141>(qv); qv += dpp_f<0x140>(qv); \
                if ((lane & 15) == 0) { const int e = (e0_) + 4 * k4 + 2 * (lane >> 5) + ((lane >> 4) & 1); WL[e] = 0.25f * __uint_as_float(lst[e].y) * gelu_tanh(qv * rs); } }
            { u32x4 uR0[8], uR1[8];
              PEER_LOAD8(uR0, U8, 0);
#pragma unroll 1
              for (int e0 = 0; e0 < 128; e0 += 16) {
                  PEER_LOAD8(uR1, U8, e0 + 8);
                  PEER_UCOMP(uR0, e0);
                  if (e0 + 16 < 128) { PEER_LOAD8(uR0, U8, e0 + 16); }
                  PEER_UCOMP(uR1, e0 + 8);
              } }
            f32x2 o2[8];
#pragma unroll
            for (int i = 0; i < 8; ++i) o2[i] = (f32x2){0.f, 0.f};
#define PEER_VCOMP(R_, e0_) _Pragma("unroll") for (int k = 0; k < 8; ++k) { const float wv = WL[(e0_) + k]; const f32x2 w2 = (f32x2){wv, wv}; \
                o2[0] = __builtin_elementwise_fma(__builtin_amdgcn_cvt_pk_f32_fp8((int)R_[k].x, false), w2, o2[0]); o2[1] = __builtin_elementwise_fma(__builtin_amdgcn_cvt_pk_f32_fp8((int)R_[k].x, true), w2, o2[1]); \
                o2[2] = __builtin_elementwise_fma(__builtin_amdgcn_cvt_pk_f32_fp8((int)R_[k].y, false), w2, o2[2]); o2[3] = __builtin_elementwise_fma(__builtin_amdgcn_cvt_pk_f32_fp8((int)R_[k].y, true), w2, o2[3]); \
                o2[4] = __builtin_elementwise_fma(__builtin_amdgcn_cvt_pk_f32_fp8((int)R_[k].z, false), w2, o2[4]); o2[5] = __builtin_elementwise_fma(__builtin_amdgcn_cvt_pk_f32_fp8((int)R_[k].z, true), w2, o2[5]); \
                o2[6] = __builtin_elementwise_fma(__builtin_amdgcn_cvt_pk_f32_fp8((int)R_[k].w, false), w2, o2[6]); o2[7] = __builtin_elementwise_fma(__builtin_amdgcn_cvt_pk_f32_fp8((int)R_[k].w, true), w2, o2[7]); }
            { u32x4 vR0[8], vR1[8];
              PEER_LOAD8(vR0, V8, 0);
#pragma unroll 1
              for (int e0 = 0; e0 < 128; e0 += 16) {
                  PEER_LOAD8(vR1, V8, e0 + 8);
                  PEER_VCOMP(vR0, e0);
                  if (e0 + 16 < 128) { PEER_LOAD8(vR0, V8, e0 + 16); }
                  PEER_VCOMP(vR1, e0 + 8);
              } }
            float* op = F.out + (size_t)t * DM + lane * 16;
            float* od = dry ? (float*)(ws + WS_PB) + (size_t)gw * DM + lane * 16 : op; bf16* xd = dry ? (bf16*)(ws + WS_PB + 8 * MiB) + (size_t)gw * DM : xb + (size_t)t * DM; float* rd2 = dry ? (float*)(ws + WS_PB + 12 * MiB) + gw : rs2 + t;
            f32x4 a0 = *(const f32x4*)op, a1 = *(const f32x4*)(op + 4), b0 = *(const f32x4*)(op + 8), b1 = *(const f32x4*)(op + 12);
            a0[0] += o2[0].x; a0[1] += o2[0].y; a0[2] += o2[1].x; a0[3] += o2[1].y; a1[0] += o2[2].x; a1[1] += o2[2].y; a1[2] += o2[3].x; a1[3] += o2[3].y;
            b0[0] += o2[4].x; b0[1] += o2[4].y; b0[2] += o2[5].x; b0[3] += o2[5].y; b1[0] += o2[6].x; b1[1] += o2[6].y; b1[2] += o2[7].x; b1[3] += o2[7].y;
            *(f32x4*)od = a0; *(f32x4*)(od + 4) = a1; *(f32x4*)(od + 8) = b0; *(f32x4*)(od + 12) = b1;
            *(u32x4*)(xd + lane * 16) = pack8(a0, a1); *(u32x4*)(xd + lane * 16 + 8) = pack8(b0, b1);
            float ss = 0.f;
#pragma unroll
            for (int i = 0; i < 4; ++i) ss += a0[i] * a0[i] + a1[i] * a1[i] + b0[i] * b0[i] + b1[i] * b1[i];
            ss = wave_sum(ss);
            if (lane == 0) *rd2 = __builtin_amdgcn_rsqf(ss * (1.0f / DM) + EPS);
        }
    }
}
constexpr int NCONV = 512;
__device__ __forceinline__ void convert_peer_item(Frame& F, int item, const float* u, const float* v, const float* g) {
    unsigned char* U8 = F.ws + WS_U8; unsigned char* V8 = F.ws + WS_V8;
    constexpr int PER = 16384 * 1024 / 16 / NCONV;
    for (int k = F.tid; k < PER; k += NWAVES * 64) {
        const int i = item * PER + k, d0 = (i & 63) * 16; u32x4 wu, wv;
#pragma unroll
        for (int q = 0; q < 4; ++q) { const f32x4 gq = *(const f32x4*)(g + d0 + 4 * q) * 32.0f; const f32x4 a = *(const f32x4*)(u + (size_t)i * 16 + 4 * q) * gq, c = *(const f32x4*)(v + (size_t)i * 16 + 4 * q) * 4.0f;
            int pu = __builtin_amdgcn_cvt_pk_fp8_f32(a[0], a[1], 0, false); pu = __builtin_amdgcn_cvt_pk_fp8_f32(a[2], a[3], pu, true);
            int pv = __builtin_amdgcn_cvt_pk_fp8_f32(c[0], c[1], 0, false); pv = __builtin_amdgcn_cvt_pk_fp8_f32(c[2], c[3], pv, true);
            wu[q] = (unsigned)pu; wv[q] = (unsigned)pv; }
        *(u32x4*)(U8 + (size_t)i * 16) = wu; *(u32x4*)(V8 + (size_t)i * 16) = wv;
    }
}
__device__ __forceinline__ void final_norm(Frame& F, const float* gf, float* dst) {
    const int gw = F.vcu * NWAVES + F.wave, NGW = F.G * NWAVES, lane = F.lane;
    f32x4 gv[4];
#pragma unroll
    for (int j = 0; j < 4; ++j) gv[j] = ((const f32x4*)gf)[lane + 64 * j];
    for (int row = gw; row < SEQ; row += NGW) {
        f32x4* xr = (f32x4*)(F.out + (size_t)row * DM) + lane; f32x4 v[4]; float ss = 0.f;
#pragma unroll
        for (int j = 0; j < 4; ++j) { v[j] = xr[64 * j]; ss += (v[j][0] * v[j][0] + v[j][1] * v[j][1]) + (v[j][2] * v[j][2] + v[j][3] * v[j][3]); }
        const float rs = __builtin_amdgcn_rsqf(wave_sum(ss) * (1.0f / DM) + EPS);
        f32x4* dr = (f32x4*)(dst + (size_t)row * DM) + lane;
#pragma unroll
        for (int j = 0; j < 4; ++j) dr[64 * j] = v[j] * rs * gv[j];
    }
}

constexpr int NPHASE = 10;
__global__ void __launch_bounds__(NWAVES * 64, 2) hybrid_fwd(Args args) {
    extern __shared__ __attribute__((aligned(16))) unsigned char lds[];
    Frame F;
    F.lds = (LAS unsigned char*)lds; F.MISC = (volatile LAS unsigned*)(F.lds + LDSCTL_OFF);
    F.tid = threadIdx.x; F.lane = F.tid & 63; F.wave = __builtin_amdgcn_readfirstlane(F.tid >> 6);
    F.G = gridDim.x; { const int bx = blockIdx.x; F.vcu = (F.G % 8 == 0) ? (bx % 8) * (F.G / 8) + bx / 8 : bx; }
    F.ws = args.ws; F.ctl = (gu32*)(args.ws + WS_CTL); F.out = args.out;
    for (int u = F.tid; u < (LDS_BYTES - LDSCTL_OFF) / 4; u += NWAVES * 64) ((LAS unsigned*)(F.lds + LDSCTL_OFF))[u] = 0u;
    __syncthreads();
    if (F.tid < 24) ((LAS unsigned long long*)(F.lds + INTAB_OFF))[F.tid] = (unsigned long long)args.in[F.tid];
    __syncthreads();
    const int lo = args.ph_lo, hi = args.ph_hi;
    XcdBarrier bar = xcd_barrier_post((unsigned*)(F.ctl + CW_BAR) + args.li * XCD_BAR_WORDS, F.MISC + 8);
#ifndef PHASE_MASK
#define PHASE_MASK 0xFFFF
#endif
#define IN(k) (((PHASE_MASK >> (k)) & 1) && lo <= (k) && (k) < hi)
#define SEAM(k) do { if (IN(k) && IN((k) + 1)) xcd_barrier(bar); } while (0)
    unsigned char* ws = args.ws;
    const int G = F.G, bx = (int)blockIdx.x;
#if defined(PROBE_REPEAT)
    const bool dry = (args.li == 1);
#else
    constexpr bool dry = false;
#endif

    if (IN(0)) { p0_prologue(F); }
    SEAM(0);
    if (IN(1)) {
        pg8::Gemm g{(const bf16*)(ws + WS_XB), (const bf16*)(ws + WS_WIN), SEQ, N1, DM, DM, DM}; pg8::StaticOrder S; S.init(SEQ, N1, G, bx);
#if defined(PROBE_NULLEPI)
        if (args.li == PROBE_NULLEPI_LI) { EpiNull E0; pg8::gemm_phase<EpiNull, pg8::StaticOrder, true, true>(F.lds, g, S, E0); } else
#endif
        { Epi1 E{(const float*)(ws + WS_RS0), ws};
        pg8::gemm_phase<Epi1, pg8::StaticOrder, true, true>(F.lds, g, S, E); }
        if (G == 256 && !dry) { const int r = bx - 64; pg8::TailOrder T2{r >= 0 ? r : -1, (r >= 0 && r < 64) ? 192 + r : -1, 4};
            pg8::Gemm g2{(const bf16*)(ws + WS_PB), (const bf16*)(ws + WS_WPLE), SEQ, DM, 256, 256, 256}; EpiPw E2{(bf16*)(ws + WS_PW), DM};
            pg8::gemm_phase<EpiPw, pg8::TailOrder, false, true>(F.lds, g2, T2, E2);
            if (bx >= 64) { __syncthreads(); weight_items(F, 1, (bx - 64) * NWAVES + F.wave, (G - 64) * NWAVES); }
            if (bx == 255) posb_finish(F); }
        else if (!dry) { pg8::Gemm g2{(const bf16*)(ws + WS_PB), (const bf16*)(ws + WS_WPLE), SEQ, DM, 256, 256, 256}; pg8::StaticOrder S2; S2.init(SEQ, DM, G, bx); EpiPw E2{(bf16*)(ws + WS_PW), DM};
            pg8::gemm_phase<EpiPw, pg8::StaticOrder, true, true>(F.lds, g2, S2, E2); __syncthreads(); weight_items(F, 1, F.vcu * NWAVES + F.wave, G * NWAVES); if (bx == 0) posb_finish(F); }
        if (dry) { __syncthreads(); }
    }
    SEAM(1);
    if (IN(2)) {
        { pg8::Gemm g{(const bf16*)(ws + WS_CK), (const bf16*)(ws + WS_W1KV), 4096, 512, 2048, 1024, 2048}; pg8::OneUnit S{bx, bx >> 3, bx < 16 ? 1 : 0};
          EpiCmp E{(bf16*)(ws + WS_H), (const float*)(ws + WS_POSB)};
          pg8::gemm_phase<EpiCmp, pg8::OneUnit, false, true>(F.lds, g, S, E);
          if (bx < 16) { __threadfence(); __syncthreads(); compress_out(F, bx); } }
        __syncthreads();
        build_lut(F, in_ptr(F, 5));
        for (;;) {
            __syncthreads();
            if (F.tid == 0) F.MISC[16] = __hip_atomic_fetch_add(F.ctl + CW_QUEUE + args.li * 64, 1u, RLX_AGENT);
            __syncthreads();
            const int unit = (int)F.MISC[16];
            if (unit >= 1024 + NCONV) break;
            if (unit % 3 == 2) { convert_peer_item(F, unit / 3, in_ptr(F, 18), in_ptr(F, 19), in_ptr(F, 14)); continue; }
            const int au = (unit / 3) * 2 + unit % 3;
            if (au < 512) banded_unit<1>(F, in_ptr(F, 4), au >> 1, au & 1); else banded_unit<0>(F, in_ptr(F, 4), (au - 512) >> 1, au & 1);
        }
    }
    SEAM(2);
    if (IN(3)) {
        build_lut(F, in_ptr(F, 5));
        { int own = bx & 1, tries = 0;
          for (;;) {
            __syncthreads();
            if (F.tid == 0) F.MISC[16] = __hip_atomic_fetch_add(F.ctl + CW_QUEUE + 1024 + own * 1024 + args.li * 64, 1u, RLX_AGENT);
            __syncthreads();
            const int unit = (int)F.MISC[16];
            if (unit >= 256) { if (++tries == 2) break; own ^= 1; continue; }
            nsa_unit(F, 255 - unit, own, dry);
          } }
    }
    SEAM(3);
    if (IN(4)) {
        { pg8::Gemm g{(const bf16*)(ws + WS_OA), (const bf16*)(ws + WS_WUPA), SEQ, DM, 512, 512, 512}; pg8::StaticOrder S; S.init(SEQ, DM, G, bx); EpiUp E{(bf16*)(ws + WS_MG), 0, (bf16*)(ws + (dry ? WS_QA : WS_MG))};
          pg8::gemm_phase<EpiUp, pg8::StaticOrder, true, true>(F.lds, g, S, E); }
        { pg8::Gemm g{(const bf16*)(ws + WS_OB), (const bf16*)(ws + WS_WUPB), SEQ, DM, 512, 512, 512}; pg8::StaticOrder S; S.init(SEQ, DM, G, bx); EpiUp2 E{(bf16*)(ws + WS_MG), (bf16*)(ws + (dry ? WS_QA : WS_MG))};
          pg8::gemm_phase<EpiUp2, pg8::StaticOrder, true, true>(F.lds, g, S, E); }
    }
    SEAM(4);
    if (IN(5)) {
        { pg8::Gemm g{(const bf16*)(ws + WS_MG), (const bf16*)(ws + WS_WO2), SEQ, DM, DM, 2048, DM};   pg8::StaticOrder S; S.init(SEQ, DM, G, bx);
          EpiWo E{in_ptr(F, 0), F.out, (bf16*)(ws + WS_XB2), (float*)(ws + WS_SSQ1)};
          pg8::gemm_phase<EpiWo, pg8::StaticOrder, true, true>(F.lds, g, S, E); }
    }
    SEAM(5);
    if (IN(6)) {
        { pg8::Gemm g{(const bf16*)(ws + WS_XB2), (const bf16*)(ws + WS_WQ), SEQ, 2048, DM, DM, DM}; pg8::StaticOrder S; S.init(SEQ, 2048, G, bx); EpiPw E{(bf16*)(ws + WS_Q2), 2048};
          pg8::gemm_phase<EpiPw, pg8::StaticOrder, true, true>(F.lds, g, S, E); }
    }
    SEAM(6);
    if (IN(7)) { __syncthreads(); peer_phase(F, dry); }
    SEAM(7);
    if (IN(8)) {
        pg8::Gemm g{(const bf16*)(ws + WS_XB2), (const bf16*)(ws + WS_WPG), SEQ, DM, DM, DM, DM}; pg8::StaticOrder S; S.init(SEQ, DM, G, bx);
        EpiPle E{(const float*)(ws + WS_RS2), (const bf16*)(ws + WS_PW), F.out, dry ? (float*)(ws + WS_Q2) : F.out};
        pg8::gemm_phase<EpiPle, pg8::StaticOrder, true, true>(F.lds, g, S, E);
    }
    SEAM(8);
    if (IN(9)) final_norm(F, in_ptr(F, 23), dry ? (float*)(ws + WS_Q2) : F.out);
#undef IN
#undef SEAM
}

#ifndef MK_ONE_LAUNCH
#define MK_ONE_LAUNCH 1
#endif
extern "C" void kernel_launch(void* const* d_in, const int* in_sizes, int n_in, void* d_out, int out_size, void* d_ws, size_t ws_size, hipStream_t stream) {
    static int grid = 0;
    if (grid == 0) {
        if (n_in != 24 || in_sizes[0] != SEQ * DM || out_size != SEQ * DM || ws_size < WS_END) { fprintf(stderr, "kernel_launch: unexpected shapes (n_in %d, in0 %d, out %d, ws %zu); nothing launched\n", n_in, n_in > 0 ? in_sizes[0] : -1, out_size, ws_size); grid = -1; return; }
        int dev = 0, cus = 0, per_cu = 0;
        if (hipGetDevice(&dev) != hipSuccess || hipDeviceGetAttribute(&cus, hipDeviceAttributeMultiprocessorCount, dev) != hipSuccess) { grid = -1; return; }
        if (hipFuncSetAttribute((const void*)hybrid_fwd, hipFuncAttributeMaxDynamicSharedMemorySize, LDS_BYTES) != hipSuccess) { fprintf(stderr, "kernel_launch: hipFuncSetAttribute failed\n"); grid = -1; return; }
        if (hipOccupancyMaxActiveBlocksPerMultiprocessor(&per_cu, (const void*)hybrid_fwd, NWAVES * 64, LDS_BYTES) != hipSuccess || per_cu < 1) { fprintf(stderr, "kernel_launch: occupancy query says %d blocks per CU\n", per_cu); }
        (void)hipGetLastError();
        grid = cus;
    }
    if (grid < 0) return;
    if (hipMemsetAsync((char*)d_ws + WS_CTL, 0, CTL_ZERO_BYTES, stream) != hipSuccess) return;
    Args a{};
    for (int i = 0; i < 24; ++i) a.in[i] = (const float*)d_in[i];
    a.out = (float*)d_out; a.ws = (unsigned char*)d_ws;
#if defined(PROBE_REPEAT)
    const int cuts[4] = {0, PROBE_REPEAT + 1, PROBE_REPEAT, NPHASE};
    for (int li = 0; li < 3; ++li) { a.ph_lo = li == 0 ? 0 : li == 1 ? PROBE_REPEAT : PROBE_REPEAT + 1; a.ph_hi = li == 0 ? PROBE_REPEAT + 1 : li == 1 ? PROBE_REPEAT + 1 : NPHASE; a.li = li; (void)cuts;
        if (a.ph_lo < a.ph_hi) hipLaunchKernelGGL(hybrid_fwd, dim3(grid), dim3(NWAVES * 64), LDS_BYTES, stream, a); }
#elif MK_ONE_LAUNCH
    a.ph_lo = 0; a.ph_hi = NPHASE; a.li = 0;
    hipLaunchKernelGGL(hybrid_fwd, dim3(grid), dim3(NWAVES * 64), LDS_BYTES, stream, a);
#else
    for (int p = 0; p < NPHASE; ++p) { a.ph_lo = p; a.ph_hi = p + 1; a.li = 0; hipLaunchKernelGGL(hybrid_fwd, dim3(grid), dim3(NWAVES * 64), LDS_BYTES, stream, a); }
#endif
}
```
